# Optimizing an MI355X kernel written in HIP

```python
import jax, jax.numpy as jnp
from jax import lax
import numpy as np

D_MODEL = 1024
BATCH = 2
SEQ = 8192
DEPTH = 2

GRID_W = 64
CTX_LEN = 256
HEAD_DIM = 64
A_Q_HEADS = 6
A_KV_HEADS = 2
WINDOW = 128
BLOCK = 128
B_Q_HEADS = 6
B_KV_HEADS = 2
C_HEADS = 6
NA_KH_MAX = 8
NA_KW = 16
NA_QW = 16
NA_SLAB = NA_QW + NA_KW
N_BRANCH = 3
A_WIDTH = A_Q_HEADS * HEAD_DIM
B_WIDTH = B_Q_HEADS * HEAD_DIM
C_WIDTH = C_HEADS * HEAD_DIM
MLP_HIDDEN = 4 * D_MODEL
ROPE_THETA = 10000.0
NORM_EPS = 1e-6
NEG_INF = -1e30
SPLIT_SIZES = (A_Q_HEADS * HEAD_DIM, A_KV_HEADS * HEAD_DIM, A_KV_HEADS * HEAD_DIM,
               B_Q_HEADS * HEAD_DIM, B_KV_HEADS * HEAD_DIM, B_KV_HEADS * HEAD_DIM,
               C_HEADS * HEAD_DIM, C_HEADS * HEAD_DIM, C_HEADS * HEAD_DIM,
               N_BRANCH * D_MODEL)
IN_COLS = (A_Q_HEADS + 2 * A_KV_HEADS + B_Q_HEADS + 2 * B_KV_HEADS + 3 * C_HEADS) * HEAD_DIM + N_BRANCH * D_MODEL

kernel_name = "hybrid_parallel_gated_dit_block"


def rms_norm(x, gain):
    x32 = x.astype(jnp.float32)
    y = x32 * lax.rsqrt(jnp.mean(x32 * x32, axis=-1, keepdims=True) + NORM_EPS)
    return (y * gain.astype(jnp.float32)).astype(x.dtype)


def modulate(h, shift, scale):
    return h * (1 + scale) + shift


def axial_angles(n_tok):
    pos = jnp.arange(n_tok)
    row = (pos // GRID_W).astype(jnp.float32)
    col = (pos % GRID_W).astype(jnp.float32)
    n_freq = HEAD_DIM // 4
    freqs = ROPE_THETA ** (-jnp.arange(n_freq, dtype=jnp.float32) / n_freq)
    ang = jnp.concatenate([row[:, None] * freqs, col[:, None] * freqs], axis=-1)
    return jnp.cos(ang), jnp.sin(ang)


def rope_2d(x, cos, sin):
    xp = x.reshape(x.shape[:-1] + (HEAD_DIM // 2, 2))
    x0, x1 = xp[..., 0], xp[..., 1]
    c = cos[:, None, :].astype(x.dtype)
    s = sin[:, None, :].astype(x.dtype)
    return jnp.stack([x0 * c - x1 * s, x0 * s + x1 * c], axis=-1).reshape(x.shape)


def to_heads(t, n_heads):
    return t.reshape(t.shape[:2] + (n_heads, HEAD_DIM))


def split_cols(p):
    out = []
    start = 0
    for n in SPLIT_SIZES:
        out.append(p[..., start:start + n])
        start += n
    return out


def dense_context_attn(q, k, v, sink):
    bsz, lq, hkv, g, _ = q.shape
    s = jnp.einsum('bqkgd,bmkd->bkgqm', q, k).astype(jnp.float32) * (HEAD_DIM ** -0.5)
    if sink is not None:
        sink_col = jnp.broadcast_to(sink.astype(jnp.float32).reshape(hkv, g)[None, :, :, None, None], s.shape[:-1] + (1,))
        s = jnp.concatenate([s, sink_col], axis=-1)
    p = jax.nn.softmax(s, axis=-1)
    if sink is not None:
        p = p[..., :-1]
    o = jnp.einsum('bkgqm,bmkd->bqkgd', p.astype(v.dtype), v)
    return o.reshape(bsz, lq, hkv * g * HEAD_DIM)


def window_attention_latent(q, k, v, k_ctx, v_ctx, sink):
    bsz, seq = q.shape[:2]
    nb = seq // BLOCK
    g = A_Q_HEADS // A_KV_HEADS
    scale = HEAD_DIM ** -0.5
    qb = q.reshape(bsz, nb, BLOCK, A_KV_HEADS, g, HEAD_DIM)

    def band(t):
        tp = jnp.pad(t, ((0, 0), (BLOCK, BLOCK), (0, 0), (0, 0))).reshape(bsz, nb + 2, BLOCK, A_KV_HEADS, HEAD_DIM)
        return jnp.concatenate([tp[:, :-2], tp[:, 1:-1], tp[:, 2:]], axis=2)

    kb, vb = band(k), band(v)
    blk = jnp.arange(nb) * BLOCK
    qpos = blk[:, None, None] + jnp.arange(BLOCK)[None, :, None]
    kpos = (blk - BLOCK)[:, None, None] + jnp.arange(3 * BLOCK)[None, None, :]
    valid = (jnp.abs(qpos - kpos) <= WINDOW) & (kpos >= 0) & (kpos < seq)
    s_win = jnp.einsum('bnqkgd,bnmkd->bnkgqm', qb, kb).astype(jnp.float32) * scale
    s_win = jnp.where(valid[None, :, None, None], s_win, NEG_INF)
    s_ctx = jnp.einsum('bnqkgd,blkd->bnkgql', qb, k_ctx).astype(jnp.float32) * scale
    sink_col = jnp.broadcast_to(sink.astype(jnp.float32).reshape(A_KV_HEADS, g)[None, None, :, :, None, None], s_win.shape[:-1] + (1,))
    p = jax.nn.softmax(jnp.concatenate([s_win, s_ctx, sink_col], axis=-1), axis=-1)
    n_win = 3 * BLOCK
    n_ctx = k_ctx.shape[1]
    p_win = p[..., :n_win].astype(v.dtype)
    p_ctx = p[..., n_win:n_win + n_ctx].astype(v.dtype)
    o = jnp.einsum('bnkgqm,bnmkd->bnqkgd', p_win, vb) + jnp.einsum('bnkgql,blkd->bnqkgd', p_ctx, v_ctx)
    return o.reshape(bsz, seq, A_WIDTH)


def global_attention_latent(q, k, v, k_ctx, v_ctx):
    bsz, seq = q.shape[:2]
    nb = seq // BLOCK
    g = B_Q_HEADS // B_KV_HEADS
    scale = HEAD_DIM ** -0.5
    k_all = jnp.concatenate([k_ctx, k], axis=1)
    v_all = jnp.concatenate([v_ctx, v], axis=1)
    q_blocks = q.reshape(bsz, nb, BLOCK, B_KV_HEADS, g, HEAD_DIM).swapaxes(0, 1)

    def one_block(qb):
        s = jnp.einsum('bqkgd,bmkd->bkgqm', qb, k_all).astype(jnp.float32) * scale
        p = jax.nn.softmax(s, axis=-1).astype(v_all.dtype)
        return jnp.einsum('bkgqm,bmkd->bqkgd', p, v_all)

    o = lax.map(one_block, q_blocks)
    return o.swapaxes(0, 1).reshape(bsz, seq, B_WIDTH)


def neighbourhood_attention_latent(q, k, v, k_ctx, v_ctx, rpb):
    bsz, seq = q.shape[:2]
    rows = seq // GRID_W
    kh = min(NA_KH_MAX, rows)
    ncb = GRID_W // NA_QW
    scale = HEAD_DIM ** -0.5
    q_g = q.reshape(bsz, rows, ncb, NA_QW, C_HEADS, HEAD_DIM)
    k_g = k.reshape(bsz, rows, GRID_W, C_HEADS, HEAD_DIM)
    v_g = v.reshape(bsz, rows, GRID_W, C_HEADS, HEAD_DIM)
    r = jnp.arange(rows)
    row_start = jnp.clip(r - kh // 2, 0, rows - kh)
    row_idx = row_start[:, None] + jnp.arange(kh)[None, :]
    slab_start = jnp.clip(jnp.arange(ncb) * NA_QW - NA_KW // 2, 0, GRID_W - NA_SLAB)
    col_idx = slab_start[:, None] + jnp.arange(NA_SLAB)[None, :]

    def gather(t):
        return jnp.take(jnp.take(t, col_idx, axis=2), row_idx, axis=1)

    k_blk, v_blk = gather(k_g), gather(v_g)
    q_col = jnp.arange(ncb)[:, None] * NA_QW + jnp.arange(NA_QW)[None, :]
    win_start = jnp.clip(q_col - NA_KW // 2, 0, GRID_W - NA_KW)
    key_col = col_idx[:, None, :]
    col_valid = (key_col >= win_start[..., None]) & (key_col < win_start[..., None] + NA_KW)
    col_off = jnp.clip(key_col - q_col[..., None] + NA_KW - 1, 0, 2 * NA_KW - 2)
    row_off = row_idx - r[:, None] + NA_KH_MAX - 1
    bias = jnp.take(jnp.take(rpb, row_off, axis=1), col_off, axis=3)
    bias = bias.transpose(1, 3, 0, 4, 2, 5).astype(jnp.float32)
    s_nb = jnp.einsum('brcqhd,brkcshd->brchqks', q_g, k_blk).astype(jnp.float32) * scale + bias[None]
    s_nb = jnp.where(col_valid[None, None, :, None, :, None, :], s_nb, NEG_INF)
    s_ctx = jnp.einsum('brcqhd,blhd->brchql', q_g, k_ctx).astype(jnp.float32) * scale
    n_nb = kh * NA_SLAB
    p = jax.nn.softmax(jnp.concatenate([s_nb.reshape(s_nb.shape[:5] + (n_nb,)), s_ctx], axis=-1), axis=-1)
    p_nb = p[..., :n_nb].reshape(s_nb.shape).astype(v.dtype)
    p_ctx = p[..., n_nb:].astype(v.dtype)
    o = jnp.einsum('brchqks,brkcshd->brcqhd', p_nb, v_blk) + jnp.einsum('brchql,blhd->brcqhd', p_ctx, v_ctx)
    return o.reshape(bsz, seq, C_WIDTH)


def gated_merge(o_a, o_b, o_c, gates, w_br_a, w_br_b, w_br_c, w_out):
    g_a, g_b, g_c = jnp.split(gates, N_BRANCH, axis=-1)
    merged = (jax.nn.sigmoid(g_a) * (o_a @ w_br_a)
              + jax.nn.sigmoid(g_b) * (o_b @ w_br_b)
              + jax.nn.sigmoid(g_c) * (o_c @ w_br_c))
    return merged @ w_out


def token_mixer(h_lat, h_ctx, cos, sin, w_in, sink_a, qnorm_b, knorm_b, rpb_c,
                w_br_a, w_br_b, w_br_c, w_out, with_ctx_out):
    qa, ka, va, qb, kb, vb, qc, kc, vc, gates = split_cols(h_lat @ w_in)
    qa_c, ka_c, va_c, qb_c, kb_c, vb_c, qc_c, kc_c, vc_c, gates_c = split_cols(h_ctx @ w_in)
    bsz, n_ctx = h_ctx.shape[:2]
    qa = rope_2d(to_heads(qa, A_Q_HEADS), cos, sin)
    ka = rope_2d(to_heads(ka, A_KV_HEADS), cos, sin)
    va = to_heads(va, A_KV_HEADS)
    ka_c, va_c = to_heads(ka_c, A_KV_HEADS), to_heads(va_c, A_KV_HEADS)
    o_a = window_attention_latent(qa, ka, va, ka_c, va_c, sink_a)
    qb = rope_2d(rms_norm(to_heads(qb, B_Q_HEADS), qnorm_b), cos, sin)
    kb = rope_2d(rms_norm(to_heads(kb, B_KV_HEADS), knorm_b), cos, sin)
    vb = to_heads(vb, B_KV_HEADS)
    kb_c = rms_norm(to_heads(kb_c, B_KV_HEADS), knorm_b)
    vb_c = to_heads(vb_c, B_KV_HEADS)
    o_b = global_attention_latent(qb, kb, vb, kb_c, vb_c)
    qc, kc, vc = to_heads(qc, C_HEADS), to_heads(kc, C_HEADS), to_heads(vc, C_HEADS)
    kc_c, vc_c = to_heads(kc_c, C_HEADS), to_heads(vc_c, C_HEADS)
    o_c = neighbourhood_attention_latent(qc, kc, vc, kc_c, vc_c, rpb_c)
    y_lat = gated_merge(o_a, o_b, o_c, gates, w_br_a, w_br_b, w_br_c, w_out)
    if not with_ctx_out:
        return y_lat, None
    qa_c = to_heads(qa_c, A_Q_HEADS).reshape(bsz, n_ctx, A_KV_HEADS, A_Q_HEADS // A_KV_HEADS, HEAD_DIM)
    o_a_c = dense_context_attn(qa_c, ka_c, va_c, sink_a)
    qb_c = rms_norm(to_heads(qb_c, B_Q_HEADS), qnorm_b).reshape(bsz, n_ctx, B_KV_HEADS, B_Q_HEADS // B_KV_HEADS, HEAD_DIM)
    o_b_c = dense_context_attn(qb_c, kb_c, vb_c, None)
    qc_c = to_heads(qc_c, C_HEADS)[:, :, :, None, :]
    o_c_c = dense_context_attn(qc_c, kc_c, vc_c, None)
    y_ctx = gated_merge(o_a_c, o_b_c, o_c_c, gates_c, w_br_a, w_br_b, w_br_c, w_out)
    return y_lat, y_ctx


def sq_relu_mlp(h, w1, w2):
    a = jax.nn.relu(h @ w1)
    return (a * a) @ w2


def setup_inputs(seed: int = 0) -> dict:
    key = jax.random.key(seed)
    ks = jax.random.split(key, 24)

    def nrm(k, shape, scale):
        return jax.random.normal(k, shape, jnp.float32) * scale

    def gain(k, shape):
        return 1.0 + 0.05 * jax.random.normal(k, shape, jnp.float32)

    return {
        "x": nrm(ks[0], (BATCH, SEQ, D_MODEL), 1.0),
        "c": nrm(ks[1], (BATCH, D_MODEL), 1.0),
        "ctx": nrm(ks[2], (BATCH, CTX_LEN, D_MODEL), 1.0),
        "c_ctx": nrm(ks[3], (D_MODEL,), 1.0),
        "w_ada": nrm(ks[4], (DEPTH, D_MODEL, 6 * D_MODEL), 0.5 * D_MODEL ** -0.5),
        "b_ada": nrm(ks[5], (DEPTH, 6 * D_MODEL), 0.02),
        "norm_mix_pre": gain(ks[6], (DEPTH, D_MODEL)),
        "norm_mix_post": gain(ks[7], (DEPTH, D_MODEL)),
        "w_in": nrm(ks[8], (DEPTH, D_MODEL, IN_COLS), D_MODEL ** -0.5),
        "sink_a": nrm(ks[9], (DEPTH, A_Q_HEADS), 0.5),
        "qnorm_b": gain(ks[10], (DEPTH, HEAD_DIM)),
        "knorm_b": gain(ks[11], (DEPTH, HEAD_DIM)),
        "rpb_c": nrm(ks[12], (DEPTH, C_HEADS, 2 * NA_KH_MAX - 1, 2 * NA_KW - 1), 0.2),
        "w_br_a": nrm(ks[13], (DEPTH, A_WIDTH, D_MODEL), A_WIDTH ** -0.5),
        "w_br_b": nrm(ks[14], (DEPTH, B_WIDTH, D_MODEL), B_WIDTH ** -0.5),
        "w_br_c": nrm(ks[15], (DEPTH, C_WIDTH, D_MODEL), C_WIDTH ** -0.5),
        "w_out": nrm(ks[16], (DEPTH, D_MODEL, D_MODEL), D_MODEL ** -0.5),
        "norm_mlp_pre": gain(ks[17], (DEPTH, D_MODEL)),
        "norm_mlp_post": gain(ks[18], (DEPTH, D_MODEL)),
        "w_mlp_in": nrm(ks[19], (DEPTH, D_MODEL, MLP_HIDDEN), D_MODEL ** -0.5),
        "w_mlp_out": nrm(ks[20], (DEPTH, MLP_HIDDEN, D_MODEL), MLP_HIDDEN ** -0.5),
    }


def reference(x, c, ctx, c_ctx, w_ada, b_ada, norm_mix_pre, norm_mix_post, w_in, sink_a,
              qnorm_b, knorm_b, rpb_c, w_br_a, w_br_b, w_br_c, w_out, norm_mlp_pre,
              norm_mlp_post, w_mlp_in, w_mlp_out):
    seq = x.shape[1]
    cos, sin = axial_angles(seq)
    silu_c = jax.nn.silu(c)
    silu_cc = jax.nn.silu(c_ctx)
    x_lat, x_ctx = x, ctx
    for l in range(DEPTH):
        last = l == DEPTH - 1
        mod_lat = (silu_c @ w_ada[l] + b_ada[l])[:, None, :]
        mod_ctx = (silu_cc @ w_ada[l] + b_ada[l])[None, None, :]
        sh1, sc1, g1, sh2, sc2, g2 = jnp.split(mod_lat, 6, axis=-1)
        csh1, csc1, cg1, csh2, csc2, cg2 = jnp.split(mod_ctx, 6, axis=-1)
        h_lat = modulate(rms_norm(x_lat, norm_mix_pre[l]), sh1, sc1)
        h_ctx = modulate(rms_norm(x_ctx, norm_mix_pre[l]), csh1, csc1)
        y_lat, y_ctx = token_mixer(h_lat, h_ctx, cos, sin, w_in[l], sink_a[l], qnorm_b[l], knorm_b[l],
                                   rpb_c[l], w_br_a[l], w_br_b[l], w_br_c[l], w_out[l], not last)
        x_lat = x_lat + g1 * rms_norm(y_lat, norm_mix_post[l])
        h2 = modulate(rms_norm(x_lat, norm_mlp_pre[l]), sh2, sc2)
        x_lat = x_lat + g2 * rms_norm(sq_relu_mlp(h2, w_mlp_in[l], w_mlp_out[l]), norm_mlp_post[l])
        if not last:
            x_ctx = x_ctx + cg1 * rms_norm(y_ctx, norm_mix_post[l])
            h2c = modulate(rms_norm(x_ctx, norm_mlp_pre[l]), csh2, csc2)
            x_ctx = x_ctx + cg2 * rms_norm(sq_relu_mlp(h2c, w_mlp_in[l], w_mlp_out[l]), norm_mlp_post[l])
    return x_lat
```

```cpp
#include <hip/hip_runtime.h>
#include <hip/hip_cooperative_groups.h>
#include <cstdio>
#include <cstdint>
namespace cg = cooperative_groups;

namespace pg8 {
#define PG8_LAS __attribute__((address_space(3)))
typedef unsigned short bf16_t;
typedef short bf16x8 __attribute__((ext_vector_type(8)));
typedef float f32x4 __attribute__((ext_vector_type(4)));
typedef unsigned u32x4 __attribute__((ext_vector_type(4)));
constexpr int BM = 256, BK = 64, HALF = 128, HTB = HALF * BK * 2, STAGE_BYTES = 8 * HTB, NXCD = 8, WGM = 8;

__host__ __device__ __forceinline__ int lds_byte(int r, int c) { const int st = (r >> 4) * 2 + (c >> 5), rr = r & 15, cc = c & 31, ob = rr * 64 + cc * 2; return st * 1024 + (ob ^ (((ob >> 9) & 1) << 5)); }
__host__ __device__ __forceinline__ void stage_rc(int b, int& R, int& C) { const int st = b / 1024, sb = b % 1024, swz = sb ^ (((sb >> 9) & 1) << 5); R = (st >> 1) * 16 + swz / 64; C = (st & 1) * 32 + (swz % 64) / 2; }
__host__ __device__ __forceinline__ int perm32(int rho) { const int n = rho >> 4, i = rho & 15; return 8 * (i >> 2) + 4 * n + (i & 3); }

struct Unit { int pm, pn; };
struct Gemm { const bf16_t* A; const bf16_t* Bt; int M, N, K, lda, ldb, a_split; size_t a_stride; };

struct StaticOrder {
    int nM, nN, nwg, G, c;
    __host__ __device__ void init(int M, int N, int G_, int c_) { nM = M / BM; nN = N / BM; nwg = nM * nN; G = G_; c = c_; }
    __host__ __device__ bool next(int i, Unit& u) const {
        const long L = (long)i * G + c; if (L >= nwg) return false;
        int wgid = (int)L; { const int q = nwg / NXCD, r = nwg % NXCD, xcd = wgid % NXCD, off = wgid / NXCD; wgid = (xcd < r ? xcd * (q + 1) : r * (q + 1) + (xcd - r) * q) + off; }
        const int nig = WGM * nN, gid = wgid / nig, fm = gid * WGM, gsz = (nM - fm) < WGM ? (nM - fm) : WGM;
        u.pm = fm + ((wgid % nig) % gsz); u.pn = (wgid % nig) / gsz; return true;
    }
};

__device__ __forceinline__ unsigned cvt_pk_bf16(float lo, float hi) { unsigned r; asm volatile("v_cvt_pk_bf16_f32 %0, %1, %2" : "=v"(r) : "v"(lo), "v"(hi)); return r; }


template <class Epi, class Sched, bool ALIGN_EPI = false, bool SP2 = false>
__device__ __forceinline__ void gemm_phase(PG8_LAS unsigned char* lds, const Gemm g, const Sched& S, const Epi& E) {
    int tid_ = threadIdx.x; asm volatile("" : "+v"(tid_));
    const int tid = tid_, wid = __builtin_amdgcn_readfirstlane(tid >> 6), lane = tid & 63, wr = wid >> 2, wc = wid & 3, fr = lane & 15, fq = lane >> 4;
    const int K = g.K, nt = K / BK;
    unsigned voffA[2], voffB[2];
#pragma unroll
    for (int i = 0; i < 2; ++i) { int R, C; stage_rc(tid * 16 + i * 8192, R, C); const int Rb = Epi::PERM ? ((R & ~31) + perm32(R & 31)) : R;
        voffA[i] = (unsigned)(R * g.lda + C) * 2u; voffB[i] = (unsigned)(Rb * g.ldb + C) * 2u; }
    const size_t kstep = (size_t)(BK * 2);
    const size_t hstepA = (size_t)HALF * g.lda * 2, hstepB = (size_t)HALF * g.ldb * 2;
    const size_t tstepA = 2 * hstepA, tstepB = 2 * hstepB;
    const unsigned ldsw = (unsigned)wid * 1024u;
    const int aoff = lds_byte(wr * 64 + fr, fq * 8), boff = lds_byte(wc * 32 + fr, fq * 8);
#define PG8_SA(b, h) (((b) * 2 + (h)) * HTB)
#define PG8_SB(b, h) ((4 + (b) * 2 + (h)) * HTB)
#define PG8_STAGE(bufoff, gbase, voff) do { _Pragma("unroll") for (int _i = 0; _i < 2; ++_i) \
        __builtin_amdgcn_global_load_lds((const unsigned*)((const char*)(gbase) + (voff)[_i]), (PG8_LAS unsigned*)(lds + (bufoff) + ldsw + _i * 8192), 16, 0, 0); } while (0)
#define PG8_LDA(dst, b, h) do { _Pragma("unroll") for (int m = 0; m < 4; ++m) _Pragma("unroll") for (int k = 0; k < 2; ++k) dst[m][k] = *(const PG8_LAS bf16x8*)(lds + PG8_SA(b, h) + aoff + m * 2048 + k * 1024); } while (0)
#define PG8_LDB(dst, b, h) do { _Pragma("unroll") for (int n = 0; n < 2; ++n) _Pragma("unroll") for (int k = 0; k < 2; ++k) dst[n][k] = *(const PG8_LAS bf16x8*)(lds + PG8_SB(b, h) + boff + n * 2048 + k * 1024); } while (0)
#define PG8_MMA(ai, bj, At, Bt) do { __builtin_amdgcn_s_setprio(1); _Pragma("unroll") for (int m = 0; m < 4; ++m) _Pragma("unroll") for (int n = 0; n < 2; ++n) _Pragma("unroll") for (int k = 0; k < 2; ++k) \
        acc[ai][bj][m][n] = __builtin_amdgcn_mfma_f32_16x16x32_bf16(Bt[n][k], At[m][k], acc[ai][bj][m][n], 0, 0, 0); __builtin_amdgcn_s_setprio(0); } while (0)
#define PG8_WAIT_V(n) asm volatile("s_waitcnt vmcnt(" #n ")" ::: "memory")
#define PG8_WAIT_L(n) asm volatile("s_waitcnt lgkmcnt(" #n ")" ::: "memory")
#define PG8_BAR __builtin_amdgcn_s_barrier()
#define PG8_SCHED __builtin_amdgcn_sched_barrier(0)
#define PG8_ABASE(u) ((const char*)g.A + (size_t)(u).pm * tstepA + (g.a_split ? (size_t)((u).pn / g.a_split) * g.a_stride : (size_t)0))
    Unit cur, nxt; int ui = 0;
    if (!S.next(0, cur)) return;
    f32x4 acc[2][2][4][2];
#pragma unroll
    for (int a = 0; a < 2; ++a)
#pragma unroll
        for (int b = 0; b < 2; ++b)
#pragma unroll
            for (int m = 0; m < 4; ++m)
#pragma unroll
                for (int n = 0; n < 2; ++n) acc[a][b][m][n] = (f32x4){0.f, 0.f, 0.f, 0.f};
    bf16x8 At[4][2], B0[2][2], B1[2][2];
    const char* cA = PG8_ABASE(cur); const char* cB = (const char*)g.Bt + (size_t)cur.pn * tstepB;
    if constexpr (SP2) {
        PG8_STAGE(PG8_SB(0, 0), cB, voffB); PG8_STAGE(PG8_SB(0, 1), cB + hstepB, voffB); PG8_STAGE(PG8_SA(0, 0), cA, voffA); PG8_STAGE(PG8_SA(0, 1), cA + hstepA, voffA);
        if (wr == 1) PG8_BAR;
        PG8_WAIT_V(2); PG8_BAR;
        PG8_STAGE(PG8_SB(1, 0), cB + kstep, voffB); PG8_STAGE(PG8_SA(1, 0), cA + kstep, voffA); PG8_STAGE(PG8_SB(1, 1), cB + hstepB + kstep, voffB);
        PG8_WAIT_V(6); PG8_BAR;
    } else {
        PG8_STAGE(PG8_SB(0, 0), cB, voffB); PG8_STAGE(PG8_SA(0, 0), cA, voffA); PG8_STAGE(PG8_SB(0, 1), cB + hstepB, voffB); PG8_STAGE(PG8_SA(0, 1), cA + hstepA, voffA);
        if (wr == 1) PG8_BAR;
        PG8_WAIT_V(4); PG8_BAR;
        PG8_STAGE(PG8_SB(1, 0), cB + kstep, voffB); PG8_STAGE(PG8_SA(1, 0), cA + kstep, voffA); PG8_STAGE(PG8_SB(1, 1), cB + hstepB + kstep, voffB);
        PG8_WAIT_V(6); PG8_BAR;
    }
    for (;;) {
        const bool has_next = S.next(ui + 1, nxt);
        const char* nA = has_next ? PG8_ABASE(nxt) : cA; const char* nB = has_next ? (const char*)g.Bt + (size_t)nxt.pn * tstepB : cB;
#pragma unroll 1
        for (int t = 0; t < nt; t += 2) {
            const bool last = (t == nt - 2);
            const char* a1 = cA + (size_t)(t + 1) * kstep;
            const char* a2 = last ? nA : cA + (size_t)(t + 2) * kstep; const char* b2 = last ? nB : cB + (size_t)(t + 2) * kstep;
            const char* a3 = a2 + kstep; const char* b3 = b2 + kstep;
            if constexpr (SP2) {
            PG8_LDB(B0, 0, 0); PG8_LDB(B1, 0, 1); PG8_SCHED; PG8_LDA(At, 0, 0); PG8_STAGE(PG8_SA(1, 1), a1 + hstepA, voffA);
            PG8_WAIT_V(8); PG8_WAIT_L(0); PG8_BAR; PG8_MMA(0, 0, At, B0); PG8_MMA(0, 1, At, B1); PG8_BAR; PG8_SCHED;
            PG8_LDA(At, 0, 1); PG8_STAGE(PG8_SB(0, 0), b2, voffB); PG8_STAGE(PG8_SB(0, 1), b2 + hstepB, voffB); PG8_STAGE(PG8_SA(0, 0), a2, voffA);
            PG8_WAIT_V(8); PG8_WAIT_L(0); PG8_BAR; PG8_MMA(1, 0, At, B0); PG8_MMA(1, 1, At, B1); PG8_BAR; PG8_SCHED;
            PG8_LDB(B0, 1, 0); PG8_LDB(B1, 1, 1); PG8_SCHED; PG8_LDA(At, 1, 0); PG8_STAGE(PG8_SA(0, 1), a2 + hstepA, voffA);
            PG8_WAIT_V(8); PG8_WAIT_L(0); PG8_BAR; PG8_MMA(0, 0, At, B0); PG8_MMA(0, 1, At, B1); PG8_BAR; PG8_SCHED;
            PG8_LDA(At, 1, 1); PG8_STAGE(PG8_SB(1, 0), b3, voffB); PG8_STAGE(PG8_SB(1, 1), b3 + hstepB, voffB); PG8_STAGE(PG8_SA(1, 0), a3, voffA);
            PG8_WAIT_V(8); PG8_WAIT_L(0); PG8_BAR; PG8_MMA(1, 0, At, B0); PG8_MMA(1, 1, At, B1); PG8_BAR; PG8_SCHED;
            } else {
            PG8_LDB(B0, 0, 0); PG8_SCHED; PG8_LDA(At, 0, 0); PG8_STAGE(PG8_SA(1, 1), a1 + hstepA, voffA);
            PG8_WAIT_L(8); PG8_BAR; PG8_WAIT_L(0); PG8_MMA(0, 0, At, B0); PG8_BAR; PG8_SCHED;
            PG8_LDB(B1, 0, 1); PG8_STAGE(PG8_SB(0, 0), b2, voffB);
            PG8_BAR; PG8_WAIT_L(0); PG8_MMA(0, 1, At, B1); PG8_BAR;
            PG8_LDA(At, 0, 1); PG8_STAGE(PG8_SA(0, 0), a2, voffA);
            PG8_BAR; PG8_WAIT_L(0); PG8_MMA(1, 0, At, B0); PG8_BAR; PG8_SCHED;
            PG8_STAGE(PG8_SB(0, 1), b2 + hstepB, voffB);
            PG8_WAIT_V(6); PG8_BAR; PG8_MMA(1, 1, At, B1); PG8_BAR;
            PG8_LDB(B0, 1, 0); PG8_SCHED; PG8_LDA(At, 1, 0); PG8_STAGE(PG8_SA(0, 1), a2 + hstepA, voffA);
            PG8_WAIT_L(8); PG8_BAR; PG8_WAIT_L(0); PG8_MMA(0, 0, At, B0); PG8_BAR; PG8_SCHED;
            PG8_LDB(B1, 1, 1); PG8_STAGE(PG8_SB(1, 0), b3, voffB);
            PG8_BAR; PG8_WAIT_L(0); PG8_MMA(0, 1, At, B1); PG8_BAR;
            PG8_LDA(At, 1, 1); PG8_STAGE(PG8_SA(1, 0), a3, voffA);
            PG8_BAR; PG8_WAIT_L(0); PG8_MMA(1, 0, At, B0); PG8_BAR; PG8_SCHED;
            PG8_STAGE(PG8_SB(1, 1), b3 + hstepB, voffB);
            PG8_WAIT_V(6); PG8_BAR; PG8_MMA(1, 1, At, B1); PG8_BAR;
            }
        }
        if constexpr (ALIGN_EPI) { if (wr == 0) PG8_BAR; }
        E(acc, cur, wr, wc, fr, fq);
        if (!has_next) break;
#pragma unroll
        for (int a = 0; a < 2; ++a)
#pragma unroll
            for (int b = 0; b < 2; ++b)
#pragma unroll
                for (int m = 0; m < 4; ++m)
#pragma unroll
                    for (int n = 0; n < 2; ++n) acc[a][b][m][n] = (f32x4){0.f, 0.f, 0.f, 0.f};
        cur = nxt; cA = nA; cB = nB; ++ui;
        if constexpr (ALIGN_EPI) { if (wr == 1) PG8_BAR; }
    }
    PG8_WAIT_V(0);
    if constexpr (!ALIGN_EPI) { if (wr == 0) PG8_BAR; }
    PG8_BAR;
#undef PG8_SA
#undef PG8_SB
#undef PG8_STAGE
#undef PG8_LDA
#undef PG8_LDB
#undef PG8_MMA
#undef PG8_WAIT_V
#undef PG8_WAIT_L
#undef PG8_BAR
#undef PG8_SCHED
#undef PG8_ABASE
}
}

using pg8::bf16_t; using pg8::f32x4; using pg8::u32x4; using pg8::Unit; using pg8::cvt_pk_bf16;
typedef short bf16x8 __attribute__((ext_vector_type(8)));
typedef float f32x16 __attribute__((ext_vector_type(16)));
typedef unsigned u32x2 __attribute__((ext_vector_type(2)));
#define LAS __attribute__((address_space(3)))

constexpr int DM = 1024, SEQ = 8192, NB = 2, LCTX = 256, DEPTH = 2;
constexpr int MLAT = NB * SEQ;
constexpr int MALL = MLAT + NB * LCTX;
constexpr int KEYS = LCTX + SEQ;
constexpr int NIN = 5504, NINP = 5632;
constexpr int FF = 4096;
constexpr int QW = 1152;
constexpr float EPS = 1e-6f;
constexpr float LOG2E = 1.4426950408889634f;
constexpr float QSCALE = 0.125f * LOG2E;

constexpr size_t MiB = 1u << 20;
constexpr size_t WS_CTL = 0, CTL_ZERO_BYTES = 256 * 1024;
constexpr size_t WS_MODS = 64 * 1024;
constexpr size_t WS_ROPE = 256 * 1024;
constexpr size_t WS_XC = 1 * MiB;
constexpr size_t WS_WIN = 4 * MiB;
constexpr size_t WS_WBR = WS_WIN + 11 * MiB;
constexpr size_t WS_WOUT = WS_WBR + 9 * MiB / 4;
constexpr size_t WS_W1 = WS_WOUT + 6 * MiB;
constexpr size_t WS_W2 = WS_W1 + 8 * MiB;
constexpr size_t WS_R1 = 40 * MiB;
constexpr size_t WS_KAB = WS_R1 + 33 * MiB;
constexpr size_t WS_KC = WS_KAB + (size_t)NB * KEYS * 256 * 2;
constexpr size_t WS_VTAB = WS_KC + (size_t)NB * KEYS * 384 * 2;
constexpr size_t WS_VTC = WS_VTAB + (size_t)NB * 4 * 64 * KEYS * 2;
constexpr size_t WS_PG = WS_VTC + (size_t)NB * 6 * 64 * KEYS * 2;
constexpr size_t WS_Q = WS_PG + (size_t)MALL * 3072 * 2;
constexpr size_t WS_END = WS_Q + (size_t)MALL * QW * 2;
constexpr size_t WS_Y = WS_R1;
constexpr size_t WS_A = WS_R1;
constexpr size_t WS_Y2 = WS_A + (size_t)MALL * FF * 2;
static_assert(WS_W2 + 8 * MiB <= WS_R1, "weights");
static_assert(WS_Y + (size_t)MALL * DM * 4 <= WS_PG, "Y overlay");
static_assert(WS_A + (size_t)MALL * FF * 2 <= WS_Q, "A overlay");
static_assert(WS_Y2 + (size_t)MALL * DM * 4 <= WS_END && WS_END <= 256 * MiB, "ws map");

constexpr int LDS_BYTES = 147456;

struct EpiScatter {
    static constexpr bool PERM = true;
    bf16_t *Q, *KAB, *KC, *VtAB, *VtC, *PG;
    __device__ __forceinline__ void operator()(const f32x4 (&acc)[2][2][4][2], const Unit& u, int wr, int wc, int fr, int fq) const {
        const int pm = u.pm; int b, kroff;
        if (pm < 64) { b = pm >> 5; kroff = 256 * b + 256; } else { b = pm - 64; kroff = -MLAT + SEQ * b; }
        const int row0 = pm * 256 + wr * 64 + fr, cin = wc * 32 + 8 * fq;
#pragma unroll
        for (int bj = 0; bj < 2; ++bj) {
            const int cb = 2 * u.pn + bj;
            if (cb >= 43) continue;
            int mode = 0, pitch = 0, col = 0, radd = 0, nhv = 0, hd = 0; bf16_t* base = nullptr;
            if (cb >= 19) { base = PG; pitch = 3072; col = 128 * (cb - 19) + cin; }
            else if (cb <= 2) { base = Q; pitch = QW; col = 128 * cb + cin; }
            else if (cb == 3) { base = KAB; pitch = 256; col = cin; radd = kroff; }
            else if (cb == 4) { mode = 1; base = VtAB; nhv = 4; hd = cin; }
            else if (cb <= 7) { base = Q; pitch = QW; col = 384 + 128 * (cb - 5) + cin; }
            else if (cb == 8) { base = KAB; pitch = 256; col = 128 + cin; radd = kroff; }
            else if (cb == 9) { mode = 1; base = VtAB; nhv = 4; hd = 128 + cin; }
            else if (cb <= 12) { base = Q; pitch = QW; col = 768 + 128 * (cb - 10) + cin; }
            else if (cb <= 15) { base = KC; pitch = 384; col = 128 * (cb - 13) + cin; radd = kroff; }
            else { mode = 1; base = VtC; nhv = 6; hd = 128 * (cb - 16) + cin; }
#pragma unroll
            for (int ai = 0; ai < 2; ++ai)
#pragma unroll
                for (int m = 0; m < 4; ++m) {
                    const int row = row0 + ai * 128 + m * 16;
                    const f32x4 v0 = acc[ai][bj][m][0], v1 = acc[ai][bj][m][1];
                    u32x4 w; w.x = cvt_pk_bf16(v0[0], v0[1]); w.y = cvt_pk_bf16(v0[2], v0[3]); w.z = cvt_pk_bf16(v1[0], v1[1]); w.w = cvt_pk_bf16(v1[2], v1[3]);
                    if (mode == 0) { *(u32x4*)(base + (size_t)(row + radd) * pitch + col) = w; }
                    else {
                        bf16_t* p = base + ((size_t)(b * nhv + (hd >> 6)) * 64 + (hd & 63)) * KEYS + (row + kroff - b * KEYS);
                        p[0 * KEYS] = (bf16_t)(w.x & 0xffffu); p[1 * KEYS] = (bf16_t)(w.x >> 16); p[2 * KEYS] = (bf16_t)(w.y & 0xffffu); p[3 * KEYS] = (bf16_t)(w.y >> 16);
                        p[4 * KEYS] = (bf16_t)(w.z & 0xffffu); p[5 * KEYS] = (bf16_t)(w.z >> 16); p[6 * KEYS] = (bf16_t)(w.w & 0xffffu); p[7 * KEYS] = (bf16_t)(w.w >> 16);
                    }
                }
        }
    }
};
__device__ __forceinline__ float bf2f(unsigned h) { return __uint_as_float(h << 16); }
struct EpiGate {
    static constexpr bool PERM = true;
    bf16_t* PG;
    static __device__ __forceinline__ unsigned gate2(unsigned g, float a0, float a1) {
        const float g0 = bf2f(g & 0xffffu), g1 = bf2f(g >> 16);
        const float s0 = __builtin_amdgcn_rcpf(1.0f + __builtin_amdgcn_exp2f(-LOG2E * g0)), s1 = __builtin_amdgcn_rcpf(1.0f + __builtin_amdgcn_exp2f(-LOG2E * g1));
        return cvt_pk_bf16(a0 * s0, a1 * s1);
    }
    __device__ __forceinline__ void operator()(const f32x4 (&acc)[2][2][4][2], const Unit& u, int wr, int wc, int fr, int fq) const {
        const int row0 = u.pm * 256 + wr * 64 + fr, col0 = u.pn * 256 + wc * 32 + 8 * fq;
        bf16_t* pb = PG + (size_t)row0 * 3072 + col0;
#pragma unroll
        for (int ai = 0; ai < 2; ++ai)
#pragma unroll
            for (int m = 0; m < 4; ++m)
#pragma unroll
                for (int bj = 0; bj < 2; ++bj) {
                    u32x4* p = (u32x4*)(pb + (size_t)(ai * 128 + m * 16) * 3072 + bj * 128);
                    const u32x4 gq = *p; const f32x4 v0 = acc[ai][bj][m][0], v1 = acc[ai][bj][m][1];
                    u32x4 w; w.x = gate2(gq.x, v0[0], v0[1]); w.y = gate2(gq.y, v0[2], v0[3]); w.z = gate2(gq.z, v1[0], v1[1]); w.w = gate2(gq.w, v1[2], v1[3]);
                    *p = w;
                    asm volatile("" ::: "memory");
                }
    }
};
template <int ACT  > struct EpiBf16 {
    static constexpr bool PERM = true;
    bf16_t* O; int ldc;
    __device__ __forceinline__ void operator()(const f32x4 (&acc)[2][2][4][2], const Unit& u, int wr, int wc, int fr, int fq) const {
        const int row0 = u.pm * 256 + wr * 64 + fr, col0 = u.pn * 256 + wc * 32 + 8 * fq;
#pragma unroll
        for (int ai = 0; ai < 2; ++ai)
#pragma unroll
            for (int m = 0; m < 4; ++m)
#pragma unroll
                for (int bj = 0; bj < 2; ++bj) {
                    f32x4 v0 = acc[ai][bj][m][0], v1 = acc[ai][bj][m][1];
                    if (ACT == 1) {
#pragma unroll
                        for (int e = 0; e < 4; ++e) { const float a = fmaxf(v0[e], 0.f), c = fmaxf(v1[e], 0.f); v0[e] = a * a; v1[e] = c * c; }
                    }
                    u32x4 w; w.x = cvt_pk_bf16(v0[0], v0[1]); w.y = cvt_pk_bf16(v0[2], v0[3]); w.z = cvt_pk_bf16(v1[0], v1[1]); w.w = cvt_pk_bf16(v1[2], v1[3]);
                    *(u32x4*)(O + (size_t)(row0 + ai * 128 + m * 16) * ldc + col0 + bj * 128) = w;
                }
    }
};
struct EpiF32 {
    static constexpr bool PERM = true;
    float* O; int ldc;
    __device__ __forceinline__ void operator()(const f32x4 (&acc)[2][2][4][2], const Unit& u, int wr, int wc, int fr, int fq) const {
        const int row0 = u.pm * 256 + wr * 64 + fr, col0 = u.pn * 256 + wc * 32 + 8 * fq;
#pragma unroll
        for (int ai = 0; ai < 2; ++ai)
#pragma unroll
            for (int m = 0; m < 4; ++m)
#pragma unroll
                for (int bj = 0; bj < 2; ++bj) {
                    float* p = O + (size_t)(row0 + ai * 128 + m * 16) * ldc + col0 + bj * 128;
                    *(f32x4*)p = acc[ai][bj][m][0]; *(f32x4*)(p + 4) = acc[ai][bj][m][1];
                }
    }
};

__device__ __forceinline__ float wave_sum(float v) {
#pragma unroll
    for (int o = 1; o < 64; o <<= 1) v += __shfl_xor(v, o);
    return v;
}
__device__ __forceinline__ unsigned f2bf(float f) { unsigned u = __builtin_bit_cast(unsigned, f); return (u + 0x7fffu + ((u >> 16) & 1u)) >> 16; }
__device__ __forceinline__ unsigned pk2(float lo, float hi) { return f2bf(lo) | (f2bf(hi) << 16); }

__device__ __forceinline__ void transpose_item(const float* W, int K, int N, bf16_t* WT, int ldk, int row_off, int copies, int copy_stride, LAS float* scr, int item, int lane) {
    const int nblk = N / 32, kb = item / nblk, nb = item % nblk, k0 = 64 * kb, n0 = 32 * nb;
#pragma unroll 8
    for (int i = 0; i < 32; ++i) { const int kk = 2 * i + (lane >> 5); scr[kk * 33 + (lane & 31)] = W[(size_t)(k0 + kk) * N + n0 + (lane & 31)]; }
    asm volatile("s_waitcnt lgkmcnt(0)" ::: "memory");
    const int c = lane & 7;
#pragma unroll
    for (int j = 0; j < 4; ++j) { const int n = (lane >> 3) + 8 * j; const LAS float* s = scr + (8 * c) * 33 + n;
        u32x4 o; o.x = pk2(s[0 * 33], s[1 * 33]); o.y = pk2(s[2 * 33], s[3 * 33]); o.z = pk2(s[4 * 33], s[5 * 33]); o.w = pk2(s[6 * 33], s[7 * 33]);
        for (int cc = 0; cc < copies; ++cc) *(u32x4*)(WT + (size_t)(row_off + n0 + n) * ldk + cc * copy_stride + k0 + 8 * c) = o; }
    asm volatile("s_waitcnt lgkmcnt(0)" ::: "memory");
}

struct Args { const float* in[21]; float* out; unsigned char* ws; int pad0, pad1; };
typedef const __attribute__((address_space(4))) Args* KAP;
#define KARGS() ({ KAP p_ = (KAP)__builtin_amdgcn_kernarg_segment_ptr(); asm volatile("" : "+s"(p_)); p_; })

__device__ __forceinline__ void conv_weights(KAP ap, int l, LAS unsigned char* lds, int gw, int NGW, int wave, int lane) {
    unsigned char* ws = ap->ws;
    LAS float* scr = (LAS float*)(lds + wave * 16384);
    constexpr int I_IN = 16 * (NIN / 32), I_BR = 6 * 32, I_OUT = 16 * 32, I_1 = 16 * (FF / 32), I_2 = (FF / 64) * 32;
    constexpr int NITEMS = I_IN + 3 * I_BR + I_OUT + I_1 + I_2;
    for (int it = gw; it < NITEMS; it += NGW) {
        int r = it;
        if (r < I_IN) { transpose_item(ap->in[8] + (size_t)l * DM * NIN, DM, NIN, (bf16_t*)(ws + WS_WIN), DM, 0, 1, 0, scr, r, lane); continue; } r -= I_IN;
        if (r < I_BR) { transpose_item(ap->in[13] + (size_t)l * 384 * DM, 384, DM, (bf16_t*)(ws + WS_WBR), 384, 0, 1, 0, scr, r, lane); continue; } r -= I_BR;
        if (r < I_BR) { transpose_item(ap->in[14] + (size_t)l * 384 * DM, 384, DM, (bf16_t*)(ws + WS_WBR), 384, 1024, 1, 0, scr, r, lane); continue; } r -= I_BR;
        if (r < I_BR) { transpose_item(ap->in[15] + (size_t)l * 384 * DM, 384, DM, (bf16_t*)(ws + WS_WBR), 384, 2048, 1, 0, scr, r, lane); continue; } r -= I_BR;
        if (r < I_OUT) { transpose_item(ap->in[16] + (size_t)l * DM * DM, DM, DM, (bf16_t*)(ws + WS_WOUT), 3072, 0, 3, 1024, scr, r, lane); continue; } r -= I_OUT;
        if (r < I_1) { transpose_item(ap->in[19] + (size_t)l * DM * FF, DM, FF, (bf16_t*)(ws + WS_W1), DM, 0, 1, 0, scr, r, lane); continue; } r -= I_1;
        transpose_item(ap->in[20] + (size_t)l * FF * DM, FF, DM, (bf16_t*)(ws + WS_W2), FF, 0, 1, 0, scr, r, lane);
    }
    u32x4* pad = (u32x4*)(ws + WS_WIN + (size_t)NIN * DM * 2);
    for (int i = gw * 64 + lane; i < (NINP - NIN) * DM * 2 / 16; i += NGW * 64) pad[i] = (u32x4){0u, 0u, 0u, 0u};
}

__device__ __forceinline__ void ada_phase(KAP ap, int gw, int NGW, int lane) {
    float* mods = (float*)(ap->ws + WS_MODS);
    const float* c = ap->in[1]; const float* cc = ap->in[3];
    for (int t = gw; t < DEPTH * 16 * 24; t += NGW) {
        const int l = t / (16 * 24), kc = (t / 24) % 16, jc = t % 24, col = jc * 256 + lane * 4;
        const float* W = ap->in[4] + ((size_t)l * DM + kc * 64) * 6144 + col;
        f32x4 s0 = {0.f, 0.f, 0.f, 0.f}, s1 = s0, s2 = s0;
        for (int k = 0; k < 64; ++k) {
            const f32x4 w = *(const f32x4*)(W + (size_t)k * 6144);
            const float x0 = c[kc * 64 + k], x1 = c[DM + kc * 64 + k], x2 = cc[kc * 64 + k];
            const float a0 = x0 / (1.f + __expf(-x0)), a1 = x1 / (1.f + __expf(-x1)), a2 = x2 / (1.f + __expf(-x2));
            s0 += w * a0; s1 += w * a1; s2 += w * a2;
        }
        if (kc == 0) { const f32x4 bb = *(const f32x4*)(ap->in[5] + (size_t)l * 6144 + col); s0 += bb; s1 += bb; s2 += bb; }
        float* m0 = mods + (size_t)(l * 3) * 6144 + col;
#pragma unroll
        for (int e = 0; e < 4; ++e) { atomicAdd(m0 + e, s0[e]); atomicAdd(m0 + 6144 + e, s1[e]); atomicAdd(m0 + 2 * 6144 + e, s2[e]); }
    }
}

__device__ __forceinline__ void row_phase(int gw, int NGW, int lane, int nrows, const float* Y, const float* gainY, const float* modsG, int gate_off,
                                          const float* rin_lat, const float* rin_ctx, float* rout_lat, float* rout_ctx,
                                          bf16_t* H, const float* gainH, const float* modsH, int shift_off, int scale_off) {
    for (int m = gw; m < nrows; m += NGW) {
        const int v = m < MLAT ? (m >> 13) : 2;
        const size_t roff = m < MLAT ? (size_t)m * DM : (size_t)(m - MLAT) * DM;
        const f32x4* xr = (const f32x4*)((m < MLAT ? rin_lat : rin_ctx) + roff) + lane;
        f32x4 x[4];
#pragma unroll
        for (int j = 0; j < 4; ++j) x[j] = xr[64 * j];
        if (Y) {
            const f32x4* yr = (const f32x4*)(Y + (size_t)m * DM) + lane;
            f32x4 y[4]; float ss = 0.f;
#pragma unroll
            for (int j = 0; j < 4; ++j) { y[j] = yr[64 * j]; ss += (y[j].x * y[j].x + y[j].y * y[j].y) + (y[j].z * y[j].z + y[j].w * y[j].w); }
            const float rstd = rsqrtf(wave_sum(ss) * (1.f / DM) + EPS);
            const f32x4* gy = (const f32x4*)gainY + lane; const f32x4* gt = (const f32x4*)(modsG + (size_t)v * 6144 + gate_off) + lane;
            f32x4* ro = (f32x4*)((m < MLAT ? rout_lat : rout_ctx) + roff) + lane;
#pragma unroll
            for (int j = 0; j < 4; ++j) { x[j] = x[j] + gt[64 * j] * (y[j] * rstd * gy[64 * j]); ro[64 * j] = x[j]; }
        }
        if (H) {
            float ss = 0.f;
#pragma unroll
            for (int j = 0; j < 4; ++j) ss += (x[j].x * x[j].x + x[j].y * x[j].y) + (x[j].z * x[j].z + x[j].w * x[j].w);
            const float rstd = rsqrtf(wave_sum(ss) * (1.f / DM) + EPS);
            const f32x4* gh = (const f32x4*)gainH + lane; const f32x4* sh = (const f32x4*)(modsH + (size_t)v * 6144 + shift_off) + lane; const f32x4* sc = (const f32x4*)(modsH + (size_t)v * 6144 + scale_off) + lane;
            u32x2* ho = (u32x2*)(H + (size_t)m * DM) + lane;
#pragma unroll
            for (int j = 0; j < 4; ++j) { const f32x4 h = (x[j] * rstd * gh[64 * j]) * (sc[64 * j] + 1.0f) + sh[64 * j]; u32x2 w; w.x = pk2(h.x, h.y); w.y = pk2(h.z, h.w); ho[64 * j] = w; }
        }
    }
}

__device__ __forceinline__ void post_phase(KAP ap, int l, int gw, int NGW, int lane) {
    bf16_t* Q = (bf16_t*)(ap->ws + WS_Q); bf16_t* KAB = (bf16_t*)(ap->ws + WS_KAB);
    const float* rope = (const float*)(ap->ws + WS_ROPE);
    const float* qn = ap->in[10] + l * 64; const float* kn = ap->in[11] + l * 64;
    const int p = lane & 31, hh = lane >> 5;
    for (int m = gw; m < MALL; m += NGW) {
        const bool lat = m < MLAT; const int s = m & (SEQ - 1);
        float cs = 1.f, sn = 0.f;
        if (lat) { const int pos = p < 16 ? (s >> 6) : (s & 63); const float* t = rope + (pos * 16 + (p & 15)) * 2; cs = t[0]; sn = t[1]; }
        const int kr = lat ? m + 256 * (m >> 13) + 256 : ((m - MLAT) >> 8) * KEYS + ((m - MLAT) & 255);
#pragma unroll 1
        for (int it = 0; it < 11; ++it) {
            const int head = it * 2 + hh;
            unsigned* ptr; bool norm, rot, scl; const float* gn;
            if (head < 18) { ptr = (unsigned*)(Q + (size_t)m * QW + head * 64) + p; norm = (head >= 6 && head < 12); rot = head < 12; scl = true; gn = qn; }
            else { ptr = (unsigned*)(KAB + (size_t)kr * 256 + (head - 18) * 64) + p; norm = head >= 20; rot = true; scl = false; gn = kn; }
            const unsigned w = *ptr; float x0 = bf2f(w & 0xffffu), x1 = bf2f(w >> 16);
            float ss = x0 * x0 + x1 * x1;
#pragma unroll
            for (int o = 1; o < 32; o <<= 1) ss += __shfl_xor(ss, o);
            if (norm) { const float rstd = rsqrtf(ss * (1.f / 64.f) + EPS); x0 = x0 * rstd * gn[2 * p]; x1 = x1 * rstd * gn[2 * p + 1]; }
            if (rot) { const float y0 = x0 * cs - x1 * sn, y1 = x0 * sn + x1 * cs; x0 = y0; x1 = y1; }
            if (scl) { x0 *= QSCALE; x1 *= QSCALE; }
            *ptr = pk2(x0, x1);
        }
    }
}

__device__ __forceinline__ void attn_task(KAP ap, int l, int t, int lane) {
    const unsigned char* ws = ap->ws;
    int type, b, h, j; bool ctxq = false;
    if (t < 9216) { type = t / 3072; const int u = t % 3072; b = u / 1536; h = (u / 256) % 6; j = u % 256; type = (type == 0) ? 1 : (type == 1 ? 0 : 2); }
    else { const int u = t - 9216; type = u / 96; b = (u / 48) % 2; h = (u / 8) % 6; j = u % 8; ctxq = true; }
    const int r32 = lane & 31, hi = lane >> 5;
    const int m0 = ctxq ? MLAT + b * LCTX + 32 * j : b * SEQ + 32 * j;
    bf16_t* Qp = (bf16_t*)(ws + WS_Q) + (size_t)(m0 + r32) * QW + (type * 6 + h) * 64;
    const bf16_t* Kb; const bf16_t* Vb; int pitchK;
    if (type == 2) { Kb = (const bf16_t*)(ws + WS_KC) + (size_t)b * KEYS * 384 + h * 64; pitchK = 384; Vb = (const bf16_t*)(ws + WS_VTC) + (size_t)(b * 6 + h) * 64 * KEYS; }
    else { const int kvh = h / 3; Kb = (const bf16_t*)(ws + WS_KAB) + (size_t)b * KEYS * 256 + type * 128 + kvh * 64; pitchK = 256; Vb = (const bf16_t*)(ws + WS_VTAB) + (size_t)(b * 4 + type * 2 + kvh) * 64 * KEYS; }
    const int q0 = 32 * j; int nmain = 0, tlo = 0, rs = 0;
    if (!ctxq) {
        if (type == 1) nmain = 128;
        else if (type == 0) { tlo = (q0 - 128) >> 6; if (tlo < 0) tlo = 0; int thi = (q0 + 31 + 128) >> 6; if (thi > 127) thi = 127; nmain = thi - tlo + 1; }
        else { const int r = j >> 1; rs = r - 4; if (rs < 0) rs = 0; if (rs > 120) rs = 120; tlo = rs; nmain = 8; }
    }
    bf16x8 qr[4];
#pragma unroll
    for (int d0 = 0; d0 < 4; ++d0) qr[d0] = *(const bf16x8*)(Qp + d0 * 16 + hi * 8);
    float mrun = -INFINITY, lrun = 0.f;
    if (type == 0) { mrun = ap->in[9][l * 6 + h] * LOG2E; lrun = hi == 0 ? 1.f : 0.f; }
    f32x16 o0 = {}, o1 = {};
    const int rsw = (r32 & ~12) | ((r32 & 4) << 1) | ((r32 & 8) >> 1);
    const float* rpb = ap->in[12] + (size_t)(l * 6 + h) * 15 * 31;
    const int qc = 32 * (j & 1) + r32; int wsn = qc - 8; wsn = wsn < 0 ? 0 : (wsn > 48 ? 48 : wsn);
    const int ntile = 4 + nmain;
#pragma unroll 1
    for (int tt = 0; tt < ntile; ++tt) {
        const int key0 = tt < 4 ? 64 * tt : LCTX + 64 * (tlo + tt - 4);
        const bf16_t* kp = Kb + (size_t)(key0 + rsw) * pitchK + 8 * hi;
        bf16x8 kf0[4], kf1[4];
#pragma unroll
        for (int d0 = 0; d0 < 4; ++d0) { kf0[d0] = *(const bf16x8*)(kp + d0 * 16); kf1[d0] = *(const bf16x8*)(kp + (size_t)32 * pitchK + d0 * 16); }
        const bf16_t* vp = Vb + (size_t)r32 * KEYS + key0 + 8 * hi;
        bf16x8 vf0[4], vf1[4];
#pragma unroll
        for (int ks = 0; ks < 4; ++ks) { vf0[ks] = *(const bf16x8*)(vp + 16 * ks); vf1[ks] = *(const bf16x8*)(vp + (size_t)32 * KEYS + 16 * ks); }
        f32x16 p0 = {}, p1 = {};
#pragma unroll
        for (int d0 = 0; d0 < 4; ++d0) { p0 = __builtin_amdgcn_mfma_f32_32x32x16_bf16(kf0[d0], qr[d0], p0, 0, 0, 0); p1 = __builtin_amdgcn_mfma_f32_32x32x16_bf16(kf1[d0], qr[d0], p1, 0, 0, 0); }
        if (tt >= 4 && type == 0) {
            const int kpos0 = 64 * (tlo + tt - 4) + 8 * hi - (q0 + r32);
#pragma unroll
            for (int r = 0; r < 16; ++r) { const int d0_ = kpos0 + 16 * (r >> 3) + (r & 7); if (d0_ > 128 || d0_ < -128) p0[r] = -INFINITY; const int d1_ = d0_ + 32; if (d1_ > 128 || d1_ < -128) p1[r] = -INFINITY; }
        } else if (tt >= 4 && type == 2) {
            const int ro = (rs + tt - 4) - (j >> 1) + 7;
            const float* rb = rpb + ro * 31 + 15 - qc;
#pragma unroll
            for (int r = 0; r < 16; ++r) {
                const int kc0 = 16 * (r >> 3) + 8 * hi + (r & 7), kc1 = kc0 + 32;
                if (kc0 >= wsn && kc0 < wsn + 16) p0[r] += rb[kc0] * LOG2E; else p0[r] = -INFINITY;
                if (kc1 >= wsn && kc1 < wsn + 16) p1[r] += rb[kc1] * LOG2E; else p1[r] = -INFINITY;
            }
        }
        float rm = fmaxf(p0[0], p1[0]);
#pragma unroll
        for (int r = 1; r < 16; ++r) rm = fmaxf(rm, fmaxf(p0[r], p1[r]));
        rm = fmaxf(rm, __shfl_xor(rm, 32));
        const float mn = fmaxf(mrun, rm);
        const float alpha = __builtin_amdgcn_exp2f(mrun - mn);
        mrun = mn;
        float sum = 0.f;
#pragma unroll
        for (int r = 0; r < 16; ++r) { p0[r] = __builtin_amdgcn_exp2f(p0[r] - mn); p1[r] = __builtin_amdgcn_exp2f(p1[r] - mn); sum += p0[r] + p1[r]; }
        lrun = lrun * alpha + sum;
#pragma unroll
        for (int r = 0; r < 16; ++r) { o0[r] *= alpha; o1[r] *= alpha; }
        bf16x8 pk[4];
#pragma unroll
        for (int ks = 0; ks < 4; ++ks) {
            u32x4 w;
            if (ks < 2) { w.x = cvt_pk_bf16(p0[8 * ks + 0], p0[8 * ks + 1]); w.y = cvt_pk_bf16(p0[8 * ks + 2], p0[8 * ks + 3]); w.z = cvt_pk_bf16(p0[8 * ks + 4], p0[8 * ks + 5]); w.w = cvt_pk_bf16(p0[8 * ks + 6], p0[8 * ks + 7]); }
            else { const int k2 = ks - 2; w.x = cvt_pk_bf16(p1[8 * k2 + 0], p1[8 * k2 + 1]); w.y = cvt_pk_bf16(p1[8 * k2 + 2], p1[8 * k2 + 3]); w.z = cvt_pk_bf16(p1[8 * k2 + 4], p1[8 * k2 + 5]); w.w = cvt_pk_bf16(p1[8 * k2 + 6], p1[8 * k2 + 7]); }
            pk[ks] = __builtin_bit_cast(bf16x8, w);
        }
#pragma unroll
        for (int ks = 0; ks < 4; ++ks) { o0 = __builtin_amdgcn_mfma_f32_32x32x16_bf16(vf0[ks], pk[ks], o0, 0, 0, 0); o1 = __builtin_amdgcn_mfma_f32_32x32x16_bf16(vf1[ks], pk[ks], o1, 0, 0, 0); }
    }
    const float lt = lrun + __shfl_xor(lrun, 32);
    const float inv = 1.0f / lt;
#pragma unroll
    for (int g = 0; g < 4; ++g) {
        u32x2 w0, w1;
        w0.x = cvt_pk_bf16(o0[4 * g + 0] * inv, o0[4 * g + 1] * inv); w0.y = cvt_pk_bf16(o0[4 * g + 2] * inv, o0[4 * g + 3] * inv);
        w1.x = cvt_pk_bf16(o1[4 * g + 0] * inv, o1[4 * g + 1] * inv); w1.y = cvt_pk_bf16(o1[4 * g + 2] * inv, o1[4 * g + 3] * inv);
        *(u32x2*)(Qp + 8 * g + 4 * hi) = w0; *(u32x2*)(Qp + 32 + 8 * g + 4 * hi) = w1;
    }
}

__global__ void __launch_bounds__(512, 2) fwd_mega(Args a) {
    extern __shared__ __attribute__((aligned(16))) unsigned char lds_raw[];
    cg::grid_group grid = cg::this_grid();
    PG8_LAS unsigned char* lds = (PG8_LAS unsigned char*)lds_raw;
    const int tid = threadIdx.x, wave = __builtin_amdgcn_readfirstlane(tid >> 6);
    const int G = gridDim.x, gw = blockIdx.x * 8 + wave, NGW = G * 8;
#define LANE() ({ int l_ = threadIdx.x & 63; asm volatile("" : "+v"(l_)); l_; })
    unsigned char* ws; { KAP ap0 = KARGS(); ws = ap0->ws; }
    float* mods = (float*)(ws + WS_MODS);
    unsigned* ctl = (unsigned*)(ws + WS_CTL);

    conv_weights(KARGS(), 0, (LAS unsigned char*)lds_raw, gw, NGW, wave, LANE());
    ada_phase(KARGS(), gw, NGW, LANE());
    if (blockIdx.x == 0) {
        float* rope = (float*)(ws + WS_ROPE);
        for (int i = tid; i < 128 * 16; i += 512) { const int pos = i >> 4, f = i & 15; const float fr = powf(10000.0f, -(float)f / 16.0f); const float ang = (float)pos * fr; float s, c; sincosf(ang, &s, &c); rope[2 * i] = c; rope[2 * i + 1] = s; }
    }
    grid.sync();
    { KAP ap = KARGS();
      row_phase(gw, NGW, LANE(), MALL, nullptr, nullptr, nullptr, 0, ap->in[0], ap->in[2], nullptr, nullptr,
              (bf16_t*)(ws + WS_R1), ap->in[6], mods, 0, 1024); }
    grid.sync();

#pragma unroll 1
    for (int l = 0; l < DEPTH; ++l) {
        const bool last = (l == DEPTH - 1);
        const int MX = last ? MLAT : MALL;
        const float* modl = mods + (size_t)l * 3 * 6144;
        {
            pg8::Gemm g{(const bf16_t*)(ws + WS_R1), (const bf16_t*)(ws + WS_WIN), MALL, NINP, DM, DM, DM, 0, 0};
            pg8::StaticOrder S; S.init(MALL, NINP, G, (int)blockIdx.x);
            EpiScatter E{(bf16_t*)(ws + WS_Q), (bf16_t*)(ws + WS_KAB), (bf16_t*)(ws + WS_KC), (bf16_t*)(ws + WS_VTAB), (bf16_t*)(ws + WS_VTC), (bf16_t*)(ws + WS_PG)};
            pg8::gemm_phase<EpiScatter, pg8::StaticOrder, true, true>(lds, g, S, E);
        }
        grid.sync();
        post_phase(KARGS(), l, gw, NGW, LANE());
        grid.sync();
        {
            KAP ap = KARGS(); const int lane = LANE();
            const int ntask = 9216 + (last ? 0 : 288);
            unsigned* ctr = ctl + 64 * l;
            for (;;) {
                int t = 0;
                if (lane == 0) t = (int)atomicAdd(ctr, 1u);
                t = __builtin_amdgcn_readfirstlane(t);
                if (t >= ntask) break;
                attn_task(ap, l, t, lane);
            }
        }
        grid.sync();
        {
            pg8::Gemm g{(const bf16_t*)(ws + WS_Q), (const bf16_t*)(ws + WS_WBR), MX, 3072, 384, QW, 384, 4, (size_t)384 * 2};
            pg8::StaticOrder S; S.init(MX, 3072, G, (int)blockIdx.x);
            EpiGate E{(bf16_t*)(ws + WS_PG)};
            pg8::gemm_phase<EpiGate, pg8::StaticOrder, true, true>(lds, g, S, E);
        }
        grid.sync();
        {
            pg8::Gemm g{(const bf16_t*)(ws + WS_PG), (const bf16_t*)(ws + WS_WOUT), MX, DM, 3072, 3072, 3072, 0, 0};
            pg8::StaticOrder S; S.init(MX, DM, G, (int)blockIdx.x);
            EpiF32 E{(float*)(ws + WS_Y), DM};
            pg8::gemm_phase<EpiF32, pg8::StaticOrder, true, true>(lds, g, S, E);
        }
        grid.sync();
        { KAP ap = KARGS();
          row_phase(gw, NGW, LANE(), MX, (const float*)(ws + WS_Y), ap->in[7] + l * DM, modl, 2048,
                  l == 0 ? ap->in[0] : ap->out, l == 0 ? ap->in[2] : (const float*)(ws + WS_XC), ap->out, (float*)(ws + WS_XC),
                  (bf16_t*)(ws + WS_Q), ap->in[17] + l * DM, modl, 3072, 4096); }
        grid.sync();
        {
            pg8::Gemm g{(const bf16_t*)(ws + WS_Q), (const bf16_t*)(ws + WS_W1), MX, FF, DM, DM, DM, 0, 0};
            pg8::StaticOrder S; S.init(MX, FF, G, (int)blockIdx.x);
            EpiBf16<1> E{(bf16_t*)(ws + WS_A), FF};
            pg8::gemm_phase<EpiBf16<1>, pg8::StaticOrder, true, true>(lds, g, S, E);
        }
        grid.sync();
        {
            pg8::Gemm g{(const bf16_t*)(ws + WS_A), (const bf16_t*)(ws + WS_W2), MX, DM, FF, FF, FF, 0, 0};
            pg8::StaticOrder S; S.init(MX, DM, G, (int)blockIdx.x);
            EpiF32 E{(float*)(ws + WS_Y2), DM};
            pg8::gemm_phase<EpiF32, pg8::StaticOrder, true, true>(lds, g, S, E);
        }
        grid.sync();
        if (!last) {
            { KAP ap = KARGS();
              row_phase(gw, NGW, LANE(), MX, (const float*)(ws + WS_Y2), ap->in[18] + l * DM, modl, 5120,
                      ap->out, (const float*)(ws + WS_XC), ap->out, (float*)(ws + WS_XC),
                      (bf16_t*)(ws + WS_R1), ap->in[6] + (l + 1) * DM, modl + 3 * 6144, 0, 1024); }
            conv_weights(KARGS(), l + 1, (LAS unsigned char*)lds_raw, gw, NGW, wave, LANE());
            grid.sync();
        } else {
            { KAP ap = KARGS();
              row_phase(gw, NGW, LANE(), MX, (const float*)(ws + WS_Y2), ap->in[18] + l * DM, modl, 5120,
                      ap->out, (const float*)(ws + WS_XC), ap->out, (float*)(ws + WS_XC),
                      nullptr, nullptr, nullptr, 0, 0); }
        }
    }
}

extern "C" void kernel_launch(void* const* d_in, const int* in_sizes, int n_in, void* d_out, int out_size, void* d_ws, size_t ws_size, hipStream_t stream) {
    static int grid = 0;
    if (grid == 0) {
        if (n_in != 21 || out_size != MLAT * DM || ws_size < WS_END) { fprintf(stderr, "kernel_launch: unexpected shapes (n_in %d, out %d, ws %zu need %zu)\n", n_in, out_size, ws_size, (size_t)WS_END); grid = -1; return; }
        int dev = 0, cus = 0, per_cu = 0;
        if (hipGetDevice(&dev) != hipSuccess || hipDeviceGetAttribute(&cus, hipDeviceAttributeMultiprocessorCount, dev) != hipSuccess) { grid = -1; return; }
        if (hipFuncSetAttribute((const void*)fwd_mega, hipFuncAttributeMaxDynamicSharedMemorySize, LDS_BYTES) != hipSuccess) { fprintf(stderr, "kernel_launch: hipFuncSetAttribute failed\n"); grid = -1; return; }
        if (hipOccupancyMaxActiveBlocksPerMultiprocessor(&per_cu, (const void*)fwd_mega, 512, LDS_BYTES) != hipSuccess || per_cu < 1) { fprintf(stderr, "kernel_launch: occupancy query says %d blocks per CU\n", per_cu); grid = -1; return; }
        grid = cus;
    }
    if (grid < 0) return;
    (void)hipMemsetAsync((char*)d_ws + WS_CTL, 0, CTL_ZERO_BYTES, stream);
    Args a{};
    for (int i = 0; i < 21; ++i) a.in[i] = (const float*)d_in[i];
    a.out = (float*)d_out; a.ws = (unsigned char*)d_ws;
    void* args[] = {&a};
    hipError_t e = hipLaunchCooperativeKernel((const void*)fwd_mega, dim3(grid), dim3(512), args, LDS_BYTES, stream);
    if (e != hipSuccess) fprintf(stderr, "cooperative launch failed: %s (grid %d)\n", hipGetErrorString(e), grid);
}
```

```cpp
#include <hip/hip_runtime.h>
#include <hip/hip_cooperative_groups.h>
#include <cstdio>
#include <cstdint>
namespace cg = cooperative_groups;

namespace pg8 {
#define PG8_LAS __attribute__((address_space(3)))
typedef unsigned short bf16_t;
typedef short bf16x8 __attribute__((ext_vector_type(8)));
typedef float f32x4 __attribute__((ext_vector_type(4)));
typedef unsigned u32x4 __attribute__((ext_vector_type(4)));
constexpr int BM = 256, BK = 64, HALF = 128, HTB = HALF * BK * 2, STAGE_BYTES = 8 * HTB, NXCD = 8, WGM = 8;

__host__ __device__ __forceinline__ int lds_byte(int r, int c) { const int st = (r >> 4) * 2 + (c >> 5), rr = r & 15, cc = c & 31, ob = rr * 64 + cc * 2; return st * 1024 + (ob ^ (((ob >> 9) & 1) << 5)); }
__host__ __device__ __forceinline__ void stage_rc(int b, int& R, int& C) { const int st = b / 1024, sb = b % 1024, swz = sb ^ (((sb >> 9) & 1) << 5); R = (st >> 1) * 16 + swz / 64; C = (st & 1) * 32 + (swz % 64) / 2; }
__host__ __device__ __forceinline__ int perm32(int rho) { const int n = rho >> 4, i = rho & 15; return 8 * (i >> 2) + 4 * n + (i & 3); }

struct Unit { int pm, pn; };
struct Gemm { const bf16_t* A; const bf16_t* Bt; int M, N, K, lda, ldb, a_split; size_t a_stride; };

struct StaticOrder {
    int nM, nN, nwg, G, c;
    __host__ __device__ void init(int M, int N, int G_, int c_) { nM = M / BM; nN = N / BM; nwg = nM * nN; G = G_; c = c_; }
    __host__ __device__ bool next(int i, Unit& u) const {
        const long L = (long)i * G + c; if (L >= nwg) return false;
        int wgid = (int)L; { const int q = nwg / NXCD, r = nwg % NXCD, xcd = wgid % NXCD, off = wgid / NXCD; wgid = (xcd < r ? xcd * (q + 1) : r * (q + 1) + (xcd - r) * q) + off; }
        const int nig = WGM * nN, gid = wgid / nig, fm = gid * WGM, gsz = (nM - fm) < WGM ? (nM - fm) : WGM;
        u.pm = fm + ((wgid % nig) % gsz); u.pn = (wgid % nig) / gsz; return true;
    }
};

__device__ __forceinline__ unsigned cvt_pk_bf16(float lo, float hi) { unsigned r; asm volatile("v_cvt_pk_bf16_f32 %0, %1, %2" : "=v"(r) : "v"(lo), "v"(hi)); return r; }


template <class Epi, class Sched, bool ALIGN_EPI = false, bool SP2 = false>
__device__ __forceinline__ void gemm_phase(PG8_LAS unsigned char* lds, const Gemm g, const Sched& S, const Epi& E) {
    int tid_ = threadIdx.x; asm volatile("" : "+v"(tid_));
    const int tid = tid_, wid = __builtin_amdgcn_readfirstlane(tid >> 6), lane = tid & 63, wr = wid >> 2, wc = wid & 3, fr = lane & 15, fq = lane >> 4;
    const int K = g.K, nt = K / BK;
    unsigned voffA[2], voffB[2];
#pragma unroll
    for (int i = 0; i < 2; ++i) { int R, C; stage_rc(tid * 16 + i * 8192, R, C); const int Rb = Epi::PERM ? ((R & ~31) + perm32(R & 31)) : R;
        voffA[i] = (unsigned)(R * g.lda + C) * 2u; voffB[i] = (unsigned)(Rb * g.ldb + C) * 2u; }
    const size_t kstep = (size_t)(BK * 2);
    const size_t hstepA = (size_t)HALF * g.lda * 2, hstepB = (size_t)HALF * g.ldb * 2;
    const size_t tstepA = 2 * hstepA, tstepB = 2 * hstepB;
    const unsigned ldsw = (unsigned)wid * 1024u;
    const int aoff = lds_byte(wr * 64 + fr, fq * 8), boff = lds_byte(wc * 32 + fr, fq * 8);
#define PG8_SA(b, h) (((b) * 2 + (h)) * HTB)
#define PG8_SB(b, h) ((4 + (b) * 2 + (h)) * HTB)
#define PG8_STAGE(bufoff, gbase, voff) do { _Pragma("unroll") for (int _i = 0; _i < 2; ++_i) \
        __builtin_amdgcn_global_load_lds((const unsigned*)((const char*)(gbase) + (voff)[_i]), (PG8_LAS unsigned*)(lds + (bufoff) + ldsw + _i * 8192), 16, 0, 0); } while (0)
#define PG8_LDA(dst, b, h) do { _Pragma("unroll") for (int m = 0; m < 4; ++m) _Pragma("unroll") for (int k = 0; k < 2; ++k) dst[m][k] = *(const PG8_LAS bf16x8*)(lds + PG8_SA(b, h) + aoff + m * 2048 + k * 1024); } while (0)
#define PG8_LDB(dst, b, h) do { _Pragma("unroll") for (int n = 0; n < 2; ++n) _Pragma("unroll") for (int k = 0; k < 2; ++k) dst[n][k] = *(const PG8_LAS bf16x8*)(lds + PG8_SB(b, h) + boff + n * 2048 + k * 1024); } while (0)
#define PG8_MMA(ai, bj, At, Bt) do { __builtin_amdgcn_s_setprio(1); _Pragma("unroll") for (int m = 0; m < 4; ++m) _Pragma("unroll") for (int n = 0; n < 2; ++n) _Pragma("unroll") for (int k = 0; k < 2; ++k) \
        acc[ai][bj][m][n] = __builtin_amdgcn_mfma_f32_16x16x32_bf16(Bt[n][k], At[m][k], acc[ai][bj][m][n], 0, 0, 0); __builtin_amdgcn_s_setprio(0); } while (0)
#define PG8_WAIT_V(n) asm volatile("s_waitcnt vmcnt(" #n ")" ::: "memory")
#define PG8_WAIT_L(n) asm volatile("s_waitcnt lgkmcnt(" #n ")" ::: "memory")
#define PG8_BAR __builtin_amdgcn_s_barrier()
#define PG8_SCHED __builtin_amdgcn_sched_barrier(0)
#define PG8_ABASE(u) ((const char*)g.A + (size_t)(u).pm * tstepA + (g.a_split ? (size_t)((u).pn / g.a_split) * g.a_stride : (size_t)0))
    Unit cur, nxt; int ui = 0;
    if (!S.next(0, cur)) return;
    f32x4 acc[2][2][4][2];
#pragma unroll
    for (int a = 0; a < 2; ++a)
#pragma unroll
        for (int b = 0; b < 2; ++b)
#pragma unroll
            for (int m = 0; m < 4; ++m)
#pragma unroll
                for (int n = 0; n < 2; ++n) acc[a][b][m][n] = (f32x4){0.f, 0.f, 0.f, 0.f};
    bf16x8 At[4][2], B0[2][2], B1[2][2];
    const char* cA = PG8_ABASE(cur); const char* cB = (const char*)g.Bt + (size_t)cur.pn * tstepB;
    if constexpr (SP2) {
        PG8_STAGE(PG8_SB(0, 0), cB, voffB); PG8_STAGE(PG8_SB(0, 1), cB + hstepB, voffB); PG8_STAGE(PG8_SA(0, 0), cA, voffA); PG8_STAGE(PG8_SA(0, 1), cA + hstepA, voffA);
        if (wr == 1) PG8_BAR;
        PG8_WAIT_V(2); PG8_BAR;
        PG8_STAGE(PG8_SB(1, 0), cB + kstep, voffB); PG8_STAGE(PG8_SA(1, 0), cA + kstep, voffA); PG8_STAGE(PG8_SB(1, 1), cB + hstepB + kstep, voffB);
        PG8_WAIT_V(6); PG8_BAR;
    } else {
        PG8_STAGE(PG8_SB(0, 0), cB, voffB); PG8_STAGE(PG8_SA(0, 0), cA, voffA); PG8_STAGE(PG8_SB(0, 1), cB + hstepB, voffB); PG8_STAGE(PG8_SA(0, 1), cA + hstepA, voffA);
        if (wr == 1) PG8_BAR;
        PG8_WAIT_V(4); PG8_BAR;
        PG8_STAGE(PG8_SB(1, 0), cB + kstep, voffB); PG8_STAGE(PG8_SA(1, 0), cA + kstep, voffA); PG8_STAGE(PG8_SB(1, 1), cB + hstepB + kstep, voffB);
        PG8_WAIT_V(6); PG8_BAR;
    }
    for (;;) {
        const bool has_next = S.next(ui + 1, nxt);
        const char* nA = has_next ? PG8_ABASE(nxt) : cA; const char* nB = has_next ? (const char*)g.Bt + (size_t)nxt.pn * tstepB : cB;
#pragma unroll 1
        for (int t = 0; t < nt; t += 2) {
            const bool last = (t == nt - 2);
            const char* a1 = cA + (size_t)(t + 1) * kstep;
            const char* a2 = last ? nA : cA + (size_t)(t + 2) * kstep; const char* b2 = last ? nB : cB + (size_t)(t + 2) * kstep;
            const char* a3 = a2 + kstep; const char* b3 = b2 + kstep;
            if constexpr (SP2) {
            PG8_LDB(B0, 0, 0); PG8_LDB(B1, 0, 1); PG8_SCHED; PG8_LDA(At, 0, 0); PG8_STAGE(PG8_SA(1, 1), a1 + hstepA, voffA);
            PG8_WAIT_V(8); PG8_WAIT_L(0); PG8_BAR; PG8_MMA(0, 0, At, B0); PG8_MMA(0, 1, At, B1); PG8_BAR; PG8_SCHED;
            PG8_LDA(At, 0, 1); PG8_STAGE(PG8_SB(0, 0), b2, voffB); PG8_STAGE(PG8_SB(0, 1), b2 + hstepB, voffB); PG8_STAGE(PG8_SA(0, 0), a2, voffA);
            PG8_WAIT_V(8); PG8_WAIT_L(0); PG8_BAR; PG8_MMA(1, 0, At, B0); PG8_MMA(1, 1, At, B1); PG8_BAR; PG8_SCHED;
            PG8_LDB(B0, 1, 0); PG8_LDB(B1, 1, 1); PG8_SCHED; PG8_LDA(At, 1, 0); PG8_STAGE(PG8_SA(0, 1), a2 + hstepA, voffA);
            PG8_WAIT_V(8); PG8_WAIT_L(0); PG8_BAR; PG8_MMA(0, 0, At, B0); PG8_MMA(0, 1, At, B1); PG8_BAR; PG8_SCHED;
            PG8_LDA(At, 1, 1); PG8_STAGE(PG8_SB(1, 0), b3, voffB); PG8_STAGE(PG8_SB(1, 1), b3 + hstepB, voffB); PG8_STAGE(PG8_SA(1, 0), a3, voffA);
            PG8_WAIT_V(8); PG8_WAIT_L(0); PG8_BAR; PG8_MMA(1, 0, At, B0); PG8_MMA(1, 1, At, B1); PG8_BAR; PG8_SCHED;
            } else {
            PG8_LDB(B0, 0, 0); PG8_SCHED; PG8_LDA(At, 0, 0); PG8_STAGE(PG8_SA(1, 1), a1 + hstepA, voffA);
            PG8_WAIT_L(8); PG8_BAR; PG8_WAIT_L(0); PG8_MMA(0, 0, At, B0); PG8_BAR; PG8_SCHED;
            PG8_LDB(B1, 0, 1); PG8_STAGE(PG8_SB(0, 0), b2, voffB);
            PG8_BAR; PG8_WAIT_L(0); PG8_MMA(0, 1, At, B1); PG8_BAR;
            PG8_LDA(At, 0, 1); PG8_STAGE(PG8_SA(0, 0), a2, voffA);
            PG8_BAR; PG8_WAIT_L(0); PG8_MMA(1, 0, At, B0); PG8_BAR; PG8_SCHED;
            PG8_STAGE(PG8_SB(0, 1), b2 + hstepB, voffB);
            PG8_WAIT_V(6); PG8_BAR; PG8_MMA(1, 1, At, B1); PG8_BAR;
            PG8_LDB(B0, 1, 0); PG8_SCHED; PG8_LDA(At, 1, 0); PG8_STAGE(PG8_SA(0, 1), a2 + hstepA, voffA);
            PG8_WAIT_L(8); PG8_BAR; PG8_WAIT_L(0); PG8_MMA(0, 0, At, B0); PG8_BAR; PG8_SCHED;
            PG8_LDB(B1, 1, 1); PG8_STAGE(PG8_SB(1, 0), b3, voffB);
            PG8_BAR; PG8_WAIT_L(0); PG8_MMA(0, 1, At, B1); PG8_BAR;
            PG8_LDA(At, 1, 1); PG8_STAGE(PG8_SA(1, 0), a3, voffA);
            PG8_BAR; PG8_WAIT_L(0); PG8_MMA(1, 0, At, B0); PG8_BAR; PG8_SCHED;
            PG8_STAGE(PG8_SB(1, 1), b3 + hstepB, voffB);
            PG8_WAIT_V(6); PG8_BAR; PG8_MMA(1, 1, At, B1); PG8_BAR;
            }
        }
        if constexpr (ALIGN_EPI) { if (wr == 0) PG8_BAR; }
        E(acc, cur, wr, wc, fr, fq);
        if (!has_next) break;
#pragma unroll
        for (int a = 0; a < 2; ++a)
#pragma unroll
            for (int b = 0; b < 2; ++b)
#pragma unroll
                for (int m = 0; m < 4; ++m)
#pragma unroll
                    for (int n = 0; n < 2; ++n) acc[a][b][m][n] = (f32x4){0.f, 0.f, 0.f, 0.f};
        cur = nxt; cA = nA; cB = nB; ++ui;
        if constexpr (ALIGN_EPI) { if (wr == 1) PG8_BAR; }
    }
    PG8_WAIT_V(0);
    if constexpr (!ALIGN_EPI) { if (wr == 0) PG8_BAR; }
    PG8_BAR;
#undef PG8_SA
#undef PG8_SB
#undef PG8_STAGE
#undef PG8_LDA
#undef PG8_LDB
#undef PG8_MMA
#undef PG8_WAIT_V
#undef PG8_WAIT_L
#undef PG8_BAR
#undef PG8_SCHED
#undef PG8_ABASE
}
}

using pg8::bf16_t; using pg8::f32x4; using pg8::u32x4; using pg8::Unit; using pg8::cvt_pk_bf16;
typedef short bf16x8 __attribute__((ext_vector_type(8)));
typedef float f32x16 __attribute__((ext_vector_type(16)));
typedef unsigned u32x2 __attribute__((ext_vector_type(2)));
#define LAS __attribute__((address_space(3)))

constexpr int DM = 1024, SEQ = 8192, NB = 2, LCTX = 256, DEPTH = 2;
constexpr int MLAT = NB * SEQ;
constexpr int MALL = MLAT + NB * LCTX;
constexpr int KEYS = LCTX + SEQ;
constexpr int NIN = 5504, NINP = 5632;
constexpr int FF = 4096;
constexpr int QW = 1152;
constexpr float EPS = 1e-6f;
constexpr float LOG2E = 1.4426950408889634f;
constexpr float QSCALE = 0.125f * LOG2E;

constexpr size_t MiB = 1u << 20;
constexpr size_t WS_CTL = 0, CTL_ZERO_BYTES = 256 * 1024;
constexpr size_t WS_MODS = 64 * 1024;
constexpr size_t WS_ROPE = 256 * 1024;
constexpr size_t WS_XC = 1 * MiB;
constexpr size_t WS_WIN = 4 * MiB;
constexpr size_t WS_WBR = WS_WIN + 11 * MiB;
constexpr size_t WS_WOUT = WS_WBR + 9 * MiB / 4;
constexpr size_t WS_W1 = WS_WOUT + 6 * MiB;
constexpr size_t WS_W2 = WS_W1 + 8 * MiB;
constexpr size_t WS_R1 = 40 * MiB;
constexpr size_t WS_KAB = WS_R1 + 33 * MiB;
constexpr size_t WS_KC = WS_KAB + (size_t)NB * KEYS * 256 * 2;
constexpr size_t WS_VTAB = WS_KC + (size_t)NB * KEYS * 384 * 2;
constexpr size_t WS_VTC = WS_VTAB + (size_t)NB * 4 * 64 * KEYS * 2;
constexpr size_t WS_PG = WS_VTC + (size_t)NB * 6 * 64 * KEYS * 2;
constexpr size_t WS_Q = WS_PG + (size_t)MALL * 3072 * 2;
constexpr size_t WS_VB = WS_Q + (size_t)MALL * QW * 2;
constexpr size_t WS_END = WS_VB + (size_t)NB * KEYS * 128 * 2;
constexpr size_t WS_Y = WS_R1;
constexpr size_t WS_A = WS_R1;
constexpr size_t WS_Y2 = WS_A + (size_t)MALL * FF * 2;
static_assert(WS_W2 + 8 * MiB <= WS_R1, "weights");
static_assert(WS_Y + (size_t)MALL * DM * 4 <= WS_PG, "Y overlay");
static_assert(WS_A + (size_t)MALL * FF * 2 <= WS_Q, "A overlay");
static_assert(WS_Y2 + (size_t)MALL * DM * 4 <= WS_END && WS_END <= 256 * MiB, "ws map");

constexpr int LDS_BYTES = 147456;

struct EpiScatter {
    static constexpr bool PERM = true;
    bf16_t *Q, *KAB, *KC, *VtAB, *VtC, *PG, *VB;
    __device__ __forceinline__ void operator()(const f32x4 (&acc)[2][2][4][2], const Unit& u, int wr, int wc, int fr, int fq) const {
        const int pm = u.pm; int b, kroff;
        if (pm < 64) { b = pm >> 5; kroff = 256 * b + 256; } else { b = pm - 64; kroff = -MLAT + SEQ * b; }
        const int row0 = pm * 256 + wr * 64 + fr, cin = wc * 32 + 8 * fq;
#pragma unroll
        for (int bj = 0; bj < 2; ++bj) {
            const int cb = 2 * u.pn + bj;
            if (cb >= 43) continue;
            int mode = 0, pitch = 0, col = 0, radd = 0, nhv = 0, hd = 0; bf16_t* base = nullptr;
            if (cb >= 19) { base = PG; pitch = 3072; col = 128 * (cb - 19) + cin; }
            else if (cb <= 2) { base = Q; pitch = QW; col = 128 * cb + cin; }
            else if (cb == 3) { base = KAB; pitch = 256; col = cin; radd = kroff; }
            else if (cb == 4) { mode = 1; base = VtAB; nhv = 4; hd = cin; }
            else if (cb <= 7) { base = Q; pitch = QW; col = 384 + 128 * (cb - 5) + cin; }
            else if (cb == 8) { base = KAB; pitch = 256; col = 128 + cin; radd = kroff; }
            else if (cb == 9) { mode = 1; base = VtAB; nhv = 4; hd = 128 + cin; }
            else if (cb <= 12) { base = Q; pitch = QW; col = 768 + 128 * (cb - 10) + cin; }
            else if (cb <= 15) { base = KC; pitch = 384; col = 128 * (cb - 13) + cin; radd = kroff; }
            else { mode = 1; base = VtC; nhv = 6; hd = 128 * (cb - 16) + cin; }
#pragma unroll
            for (int ai = 0; ai < 2; ++ai)
#pragma unroll
                for (int m = 0; m < 4; ++m) {
                    const int row = row0 + ai * 128 + m * 16;
                    const f32x4 v0 = acc[ai][bj][m][0], v1 = acc[ai][bj][m][1];
                    u32x4 w; w.x = cvt_pk_bf16(v0[0], v0[1]); w.y = cvt_pk_bf16(v0[2], v0[3]); w.z = cvt_pk_bf16(v1[0], v1[1]); w.w = cvt_pk_bf16(v1[2], v1[3]);
                    if (cb == 9) *(u32x4*)(VB + (size_t)(row + kroff) * 128 + cin) = w;
                    if (mode == 0) { *(u32x4*)(base + (size_t)(row + radd) * pitch + col) = w; }
                    else {
                        bf16_t* p = base + ((size_t)(b * nhv + (hd >> 6)) * 64 + (hd & 63)) * KEYS + (row + kroff - b * KEYS);
                        p[0 * KEYS] = (bf16_t)(w.x & 0xffffu); p[1 * KEYS] = (bf16_t)(w.x >> 16); p[2 * KEYS] = (bf16_t)(w.y & 0xffffu); p[3 * KEYS] = (bf16_t)(w.y >> 16);
                        p[4 * KEYS] = (bf16_t)(w.z & 0xffffu); p[5 * KEYS] = (bf16_t)(w.z >> 16); p[6 * KEYS] = (bf16_t)(w.w & 0xffffu); p[7 * KEYS] = (bf16_t)(w.w >> 16);
                    }
                }
        }
    }
};
__device__ __forceinline__ float bf2f(unsigned h) { return __uint_as_float(h << 16); }
struct EpiGate {
    static constexpr bool PERM = true;
    bf16_t* PG;
    static __device__ __forceinline__ unsigned gate2(unsigned g, float a0, float a1) {
        const float g0 = bf2f(g & 0xffffu), g1 = bf2f(g >> 16);
        const float s0 = __builtin_amdgcn_rcpf(1.0f + __builtin_amdgcn_exp2f(-LOG2E * g0)), s1 = __builtin_amdgcn_rcpf(1.0f + __builtin_amdgcn_exp2f(-LOG2E * g1));
        return cvt_pk_bf16(a0 * s0, a1 * s1);
    }
    __device__ __forceinline__ void operator()(const f32x4 (&acc)[2][2][4][2], const Unit& u, int wr, int wc, int fr, int fq) const {
        const int row0 = u.pm * 256 + wr * 64 + fr, col0 = u.pn * 256 + wc * 32 + 8 * fq;
        bf16_t* pb = PG + (size_t)row0 * 3072 + col0;
#pragma unroll
        for (int ai = 0; ai < 2; ++ai)
#pragma unroll
            for (int m = 0; m < 4; ++m)
#pragma unroll
                for (int bj = 0; bj < 2; ++bj) {
                    u32x4* p = (u32x4*)(pb + (size_t)(ai * 128 + m * 16) * 3072 + bj * 128);
                    const u32x4 gq = *p; const f32x4 v0 = acc[ai][bj][m][0], v1 = acc[ai][bj][m][1];
                    u32x4 w; w.x = gate2(gq.x, v0[0], v0[1]); w.y = gate2(gq.y, v0[2], v0[3]); w.z = gate2(gq.z, v1[0], v1[1]); w.w = gate2(gq.w, v1[2], v1[3]);
                    *p = w;
                    asm volatile("" ::: "memory");
                }
    }
};
template <int ACT  > struct EpiBf16 {
    static constexpr bool PERM = true;
    bf16_t* O; int ldc;
    __device__ __forceinline__ void operator()(const f32x4 (&acc)[2][2][4][2], const Unit& u, int wr, int wc, int fr, int fq) const {
        const int row0 = u.pm * 256 + wr * 64 + fr, col0 = u.pn * 256 + wc * 32 + 8 * fq;
#pragma unroll
        for (int ai = 0; ai < 2; ++ai)
#pragma unroll
            for (int m = 0; m < 4; ++m)
#pragma unroll
                for (int bj = 0; bj < 2; ++bj) {
                    f32x4 v0 = acc[ai][bj][m][0], v1 = acc[ai][bj][m][1];
                    if (ACT == 1) {
#pragma unroll
                        for (int e = 0; e < 4; ++e) { const float a = fmaxf(v0[e], 0.f), c = fmaxf(v1[e], 0.f); v0[e] = a * a; v1[e] = c * c; }
                    }
                    u32x4 w; w.x = cvt_pk_bf16(v0[0], v0[1]); w.y = cvt_pk_bf16(v0[2], v0[3]); w.z = cvt_pk_bf16(v1[0], v1[1]); w.w = cvt_pk_bf16(v1[2], v1[3]);
                    *(u32x4*)(O + (size_t)(row0 + ai * 128 + m * 16) * ldc + col0 + bj * 128) = w;
                }
    }
};
struct EpiF32 {
    static constexpr bool PERM = true;
    float* O; int ldc;
    __device__ __forceinline__ void operator()(const f32x4 (&acc)[2][2][4][2], const Unit& u, int wr, int wc, int fr, int fq) const {
        const int row0 = u.pm * 256 + wr * 64 + fr, col0 = u.pn * 256 + wc * 32 + 8 * fq;
#pragma unroll
        for (int ai = 0; ai < 2; ++ai)
#pragma unroll
            for (int m = 0; m < 4; ++m)
#pragma unroll
                for (int bj = 0; bj < 2; ++bj) {
                    float* p = O + (size_t)(row0 + ai * 128 + m * 16) * ldc + col0 + bj * 128;
                    *(f32x4*)p = acc[ai][bj][m][0]; *(f32x4*)(p + 4) = acc[ai][bj][m][1];
                }
    }
};

__device__ __forceinline__ float wave_sum(float v) {
#pragma unroll
    for (int o = 1; o < 64; o <<= 1) v += __shfl_xor(v, o);
    return v;
}
__device__ __forceinline__ unsigned f2bf(float f) { unsigned u = __builtin_bit_cast(unsigned, f); return (u + 0x7fffu + ((u >> 16) & 1u)) >> 16; }
__device__ __forceinline__ unsigned pk2(float lo, float hi) { return f2bf(lo) | (f2bf(hi) << 16); }

__device__ __forceinline__ void transpose_item(const float* W, int K, int N, bf16_t* WT, int ldk, int row_off, int copies, int copy_stride, LAS float* scr, int item, int lane) {
    const int nblk = N / 32, kb = item / nblk, nb = item % nblk, k0 = 64 * kb, n0 = 32 * nb;
#pragma unroll 8
    for (int i = 0; i < 32; ++i) { const int kk = 2 * i + (lane >> 5); scr[kk * 33 + (lane & 31)] = W[(size_t)(k0 + kk) * N + n0 + (lane & 31)]; }
    asm volatile("s_waitcnt lgkmcnt(0)" ::: "memory");
    const int c = lane & 7;
#pragma unroll
    for (int j = 0; j < 4; ++j) { const int n = (lane >> 3) + 8 * j; const LAS float* s = scr + (8 * c) * 33 + n;
        u32x4 o; o.x = pk2(s[0 * 33], s[1 * 33]); o.y = pk2(s[2 * 33], s[3 * 33]); o.z = pk2(s[4 * 33], s[5 * 33]); o.w = pk2(s[6 * 33], s[7 * 33]);
        for (int cc = 0; cc < copies; ++cc) *(u32x4*)(WT + (size_t)(row_off + n0 + n) * ldk + cc * copy_stride + k0 + 8 * c) = o; }
    asm volatile("s_waitcnt lgkmcnt(0)" ::: "memory");
}

struct Args { const float* in[21]; float* out; unsigned char* ws; int pad0, pad1; };
typedef const __attribute__((address_space(4))) Args* KAP;
#define KARGS() ({ KAP p_ = (KAP)__builtin_amdgcn_kernarg_segment_ptr(); asm volatile("" : "+s"(p_)); p_; })

__device__ __forceinline__ void conv_weights(KAP ap, int l, LAS unsigned char* lds, int gw, int NGW, int wave, int lane) {
    unsigned char* ws = ap->ws;
    LAS float* scr = (LAS float*)(lds + wave * 16384);
    constexpr int I_IN = 16 * (NIN / 32), I_BR = 6 * 32, I_OUT = 16 * 32, I_1 = 16 * (FF / 32), I_2 = (FF / 64) * 32;
    constexpr int NITEMS = I_IN + 3 * I_BR + I_OUT + I_1 + I_2;
    for (int it = gw; it < NITEMS; it += NGW) {
        int r = it;
        if (r < I_IN) { transpose_item(ap->in[8] + (size_t)l * DM * NIN, DM, NIN, (bf16_t*)(ws + WS_WIN), DM, 0, 1, 0, scr, r, lane); continue; } r -= I_IN;
        if (r < I_BR) { transpose_item(ap->in[13] + (size_t)l * 384 * DM, 384, DM, (bf16_t*)(ws + WS_WBR), 384, 0, 1, 0, scr, r, lane); continue; } r -= I_BR;
        if (r < I_BR) { transpose_item(ap->in[14] + (size_t)l * 384 * DM, 384, DM, (bf16_t*)(ws + WS_WBR), 384, 1024, 1, 0, scr, r, lane); continue; } r -= I_BR;
        if (r < I_BR) { transpose_item(ap->in[15] + (size_t)l * 384 * DM, 384, DM, (bf16_t*)(ws + WS_WBR), 384, 2048, 1, 0, scr, r, lane); continue; } r -= I_BR;
        if (r < I_OUT) { transpose_item(ap->in[16] + (size_t)l * DM * DM, DM, DM, (bf16_t*)(ws + WS_WOUT), 3072, 0, 3, 1024, scr, r, lane); continue; } r -= I_OUT;
        if (r < I_1) { transpose_item(ap->in[19] + (size_t)l * DM * FF, DM, FF, (bf16_t*)(ws + WS_W1), DM, 0, 1, 0, scr, r, lane); continue; } r -= I_1;
        transpose_item(ap->in[20] + (size_t)l * FF * DM, FF, DM, (bf16_t*)(ws + WS_W2), FF, 0, 1, 0, scr, r, lane);
    }
    u32x4* pad = (u32x4*)(ws + WS_WIN + (size_t)NIN * DM * 2);
    unsigned z0 = 0u; asm volatile("" : "+v"(z0));
    for (int i = gw * 64 + lane; i < (NINP - NIN) * DM * 2 / 16; i += NGW * 64) pad[i] = (u32x4){z0, z0, z0, z0};
}

__device__ __forceinline__ void ada_phase(KAP ap, int gw, int NGW, int lane) {
    float* mods = (float*)(ap->ws + WS_MODS);
    const float* c = ap->in[1]; const float* cc = ap->in[3];
    for (int t = gw; t < DEPTH * 16 * 24; t += NGW) {
        const int l = t / (16 * 24), kc = (t / 24) % 16, jc = t % 24, col = jc * 256 + lane * 4;
        const float* W = ap->in[4] + ((size_t)l * DM + kc * 64) * 6144 + col;
        f32x4 s0 = {0.f, 0.f, 0.f, 0.f}, s1 = s0, s2 = s0;
        for (int k = 0; k < 64; ++k) {
            const f32x4 w = *(const f32x4*)(W + (size_t)k * 6144);
            const float x0 = c[kc * 64 + k], x1 = c[DM + kc * 64 + k], x2 = cc[kc * 64 + k];
            const float a0 = x0 / (1.f + __expf(-x0)), a1 = x1 / (1.f + __expf(-x1)), a2 = x2 / (1.f + __expf(-x2));
            s0 += w * a0; s1 += w * a1; s2 += w * a2;
        }
        if (kc == 0) { const f32x4 bb = *(const f32x4*)(ap->in[5] + (size_t)l * 6144 + col); s0 += bb; s1 += bb; s2 += bb; }
        float* m0 = mods + (size_t)(l * 3) * 6144 + col;
#pragma unroll
        for (int e = 0; e < 4; ++e) { atomicAdd(m0 + e, s0[e]); atomicAdd(m0 + 6144 + e, s1[e]); atomicAdd(m0 + 2 * 6144 + e, s2[e]); }
    }
}

__device__ __forceinline__ void row_phase(int gw, int NGW, int lane, int nrows, const float* Y, const float* gainY, const float* modsG, int gate_off,
                                          const float* rin_lat, const float* rin_ctx, float* rout_lat, float* rout_ctx,
                                          bf16_t* H, const float* gainH, const float* modsH, int shift_off, int scale_off) {
    for (int m = gw; m < nrows; m += NGW) {
        const int v = m < MLAT ? (m >> 13) : 2;
        const size_t roff = m < MLAT ? (size_t)m * DM : (size_t)(m - MLAT) * DM;
        const f32x4* xr = (const f32x4*)((m < MLAT ? rin_lat : rin_ctx) + roff) + lane;
        f32x4 x[4];
#pragma unroll
        for (int j = 0; j < 4; ++j) x[j] = xr[64 * j];
        if (Y) {
            const f32x4* yr = (const f32x4*)(Y + (size_t)m * DM) + lane;
            f32x4 y[4]; float ss = 0.f;
#pragma unroll
            for (int j = 0; j < 4; ++j) { y[j] = yr[64 * j]; ss += (y[j].x * y[j].x + y[j].y * y[j].y) + (y[j].z * y[j].z + y[j].w * y[j].w); }
            const float rstd = rsqrtf(wave_sum(ss) * (1.f / DM) + EPS);
            const f32x4* gy = (const f32x4*)gainY + lane; const f32x4* gt = (const f32x4*)(modsG + (size_t)v * 6144 + gate_off) + lane;
            f32x4* ro = (f32x4*)((m < MLAT ? rout_lat : rout_ctx) + roff) + lane;
#pragma unroll
            for (int j = 0; j < 4; ++j) { x[j] = x[j] + gt[64 * j] * (y[j] * rstd * gy[64 * j]); ro[64 * j] = x[j]; }
        }
        if (H) {
            float ss = 0.f;
#pragma unroll
            for (int j = 0; j < 4; ++j) ss += (x[j].x * x[j].x + x[j].y * x[j].y) + (x[j].z * x[j].z + x[j].w * x[j].w);
            const float rstd = rsqrtf(wave_sum(ss) * (1.f / DM) + EPS);
            const f32x4* gh = (const f32x4*)gainH + lane; const f32x4* sh = (const f32x4*)(modsH + (size_t)v * 6144 + shift_off) + lane; const f32x4* sc = (const f32x4*)(modsH + (size_t)v * 6144 + scale_off) + lane;
            u32x2* ho = (u32x2*)(H + (size_t)m * DM) + lane;
#pragma unroll
            for (int j = 0; j < 4; ++j) { const f32x4 h = (x[j] * rstd * gh[64 * j]) * (sc[64 * j] + 1.0f) + sh[64 * j]; u32x2 w; w.x = pk2(h.x, h.y); w.y = pk2(h.z, h.w); ho[64 * j] = w; }
        }
    }
}

__device__ __forceinline__ void post_phase(KAP ap, int l, int gw, int NGW, int lane) {
    bf16_t* Q = (bf16_t*)(ap->ws + WS_Q); bf16_t* KAB = (bf16_t*)(ap->ws + WS_KAB);
    const float* rope = (const float*)(ap->ws + WS_ROPE);
    const float* qn = ap->in[10] + l * 64; const float* kn = ap->in[11] + l * 64;
    const int p = lane & 31, hh = lane >> 5;
    for (int m = gw; m < MALL; m += NGW) {
        const bool lat = m < MLAT; const int s = m & (SEQ - 1);
        float cs = 1.f, sn = 0.f;
        if (lat) { const int pos = p < 16 ? (s >> 6) : (s & 63); const float* t = rope + (pos * 16 + (p & 15)) * 2; cs = t[0]; sn = t[1]; }
        const int kr = lat ? m + 256 * (m >> 13) + 256 : ((m - MLAT) >> 8) * KEYS + ((m - MLAT) & 255);
#pragma unroll 1
        for (int it = 0; it < 11; ++it) {
            const int head = it * 2 + hh;
            unsigned* ptr; bool norm, rot, scl; const float* gn;
            if (head < 18) { ptr = (unsigned*)(Q + (size_t)m * QW + head * 64) + p; norm = (head >= 6 && head < 12); rot = head < 12; scl = true; gn = qn; }
            else { ptr = (unsigned*)(KAB + (size_t)kr * 256 + (head - 18) * 64) + p; norm = head >= 20; rot = true; scl = false; gn = kn; }
            const unsigned w = *ptr; float x0 = bf2f(w & 0xffffu), x1 = bf2f(w >> 16);
            float ss = x0 * x0 + x1 * x1;
#pragma unroll
            for (int o = 1; o < 32; o <<= 1) ss += __shfl_xor(ss, o);
            if (norm) { const float rstd = rsqrtf(ss * (1.f / 64.f) + EPS); x0 = x0 * rstd * gn[2 * p]; x1 = x1 * rstd * gn[2 * p + 1]; }
            if (rot) { const float y0 = x0 * cs - x1 * sn, y1 = x0 * sn + x1 * cs; x0 = y0; x1 = y1; }
            if (scl) { x0 *= QSCALE; x1 *= QSCALE; }
            *ptr = pk2(x0, x1);
        }
    }
}

#include <hip/hip_bf16.h>
#include <cmath>
namespace attn_body {
using bf16=__hip_bfloat16;
using bf16x8=__attribute__((ext_vector_type(8)))short;
using s16x4=__attribute__((ext_vector_type(4)))short;
using f32x16=__attribute__((ext_vector_type(16)))float;
using u32x4=__attribute__((ext_vector_type(4)))unsigned;
constexpr int D=64,QP=1152,KP=256,VP=128;
constexpr int NW=8,QBLK=32,QB=QBLK*NW,KVBLK=64;
__device__ __forceinline__ int crow(int r,int hi){return (r&3)+8*(r>>2)+4*hi;}
#define SBAR() __builtin_amdgcn_sched_barrier(0)
constexpr int NSLOT=3, SLOTB=8192;
constexpr int LDS_K=0, LDS_V=NSLOT*SLOTB, LDS_WS=2*NSLOT*SLOTB, LDS_OST=LDS_WS+NW*64*4, LDS_BYTES=LDS_OST+NW*4096;
constexpr float C2=0.125f*1.4426950408889634f;
__device__ __forceinline__ void glds16(const void*gsrc,unsigned lds_dst){unsigned keep;
  asm volatile("s_mov_b32 %0, m0\n\ts_mov_b32 m0, %2\n\ts_nop 0\n\tglobal_load_lds_dwordx4 %1, off\n\ts_mov_b32 m0, %0":"=&s"(keep):"v"(gsrc),"s"(lds_dst):"memory");}
__device__ __forceinline__ float max3f(float a,float b,float c){float r;asm("v_max3_f32 %0, %1, %2, %3":"=v"(r):"v"(a),"v"(b),"v"(c));return r;}
__device__ __forceinline__ float max2f(float a,float b){float r;asm("v_max_f32_e32 %0, %1, %2":"=v"(r):"v"(a),"v"(b));return r;}
__device__ __forceinline__ float fadd_s(float a,float b){float r;asm("v_add_f32_e32 %0, %1, %2":"=v"(r):"v"(a),"v"(b));return r;}
__device__ __forceinline__ float fsub_s(float a,float b){float r;asm("v_sub_f32_e32 %0, %1, %2":"=v"(r):"v"(a),"v"(b));return r;}
typedef float f32x2_t __attribute__((ext_vector_type(2))); typedef __bf16 bf16x2_t __attribute__((ext_vector_type(2)));
__device__ __forceinline__ unsigned cvtpk_s(float lo,float hi){f32x2_t v={lo,hi};bf16x2_t b=__builtin_convertvector(v,bf16x2_t);return __builtin_bit_cast(unsigned,b);}
#define WAIT_BAR(N) asm volatile("s_waitcnt vmcnt(" #N ") lgkmcnt(0)\n\ts_barrier":::"memory")

__device__ __forceinline__ void qkt(f32x16&p0,f32x16&p1,const char*Kslot,const bf16x8*qr,int r32,int hi){ const f32x16 negm={};
  const char*kb=Kslot+hi*1024+r32*16;
  #pragma unroll
  for(int d0=0;d0<4;++d0){
    const bf16x8 b0=*reinterpret_cast<const bf16x8*>(kb+d0*2048);
    const bf16x8 b1=*reinterpret_cast<const bf16x8*>(kb+d0*2048+512);
    if(d0==0){p0=__builtin_amdgcn_mfma_f32_32x32x16_bf16(b0,qr[0],negm,0,0,0);p1=__builtin_amdgcn_mfma_f32_32x32x16_bf16(b1,qr[0],negm,0,0,0);}
    else{p0=__builtin_amdgcn_mfma_f32_32x32x16_bf16(b0,qr[d0],p0,0,0,0);p1=__builtin_amdgcn_mfma_f32_32x32x16_bf16(b1,qr[d0],p1,0,0,0);}}
}
typedef __attribute__((address_space(3))) const char* lds_cptr;
typedef short v4i16_t __attribute__((ext_vector_type(4)));
__device__ __forceinline__ void kload8(bf16x8*kf,lds_cptr kp){
  kf[0]=*(const __attribute__((address_space(3))) bf16x8*)(kp);      kf[1]=*(const __attribute__((address_space(3))) bf16x8*)(kp+512);
  kf[2]=*(const __attribute__((address_space(3))) bf16x8*)(kp+2048); kf[3]=*(const __attribute__((address_space(3))) bf16x8*)(kp+2560);
  kf[4]=*(const __attribute__((address_space(3))) bf16x8*)(kp+4096); kf[5]=*(const __attribute__((address_space(3))) bf16x8*)(kp+4608);
  kf[6]=*(const __attribute__((address_space(3))) bf16x8*)(kp+6144); kf[7]=*(const __attribute__((address_space(3))) bf16x8*)(kp+6656);
}
__device__ __forceinline__ void kload2(bf16x8*kf,lds_cptr kp,int j){ kf[2*j]=*(const __attribute__((address_space(3))) bf16x8*)(kp+j*2048); kf[2*j+1]=*(const __attribute__((address_space(3))) bf16x8*)(kp+j*2048+512); }
__device__ __forceinline__ s16x4 vtr(lds_cptr p){ return __builtin_bit_cast(s16x4,__builtin_amdgcn_ds_read_tr16_b64_v4i16((__attribute__((address_space(3))) v4i16_t*)p)); }
__device__ __forceinline__ float rowmax(const f32x16&p0,const f32x16&p1){
  float a=max3f(p0[0],p0[1],p1[0]),b=max3f(p0[2],p0[3],p1[1]);a=max3f(a,p1[2],p1[3]);
  #pragma unroll
  for(int r=4;r<16;r+=4){a=max3f(a,p0[r],p0[r+1]);b=max3f(b,p0[r+2],p0[r+3]);a=max3f(a,p1[r],p1[r+1]);b=max3f(b,p1[r+2],p1[r+3]);}
  const float m=max2f(a,b);
  auto rr=__builtin_amdgcn_permlane32_swap(__float_as_uint(m),__float_as_uint(m),false,false);
  return max2f(__uint_as_float(rr[0]),__uint_as_float(rr[1]));
}
__device__ __forceinline__ void pv(f32x16*o,int vb,bf16x8 pa0,bf16x8 pa1,bf16x8 pa2,bf16x8 pa3){
  #pragma unroll
  for(int d0=0;d0<2;++d0){s16x4 lo[4],hi[4];
    #pragma unroll
    for(int ks=0;ks<4;++ks){
      asm volatile("ds_read_b64_tr_b16 %0,%1 offset:%c2":"=&v"(lo[ks]):"v"(vb),"i"(d0*4096+ks*1024):"memory");
      asm volatile("ds_read_b64_tr_b16 %0,%1 offset:%c2":"=&v"(hi[ks]):"v"(vb),"i"(d0*4096+ks*1024+512):"memory");}
    asm volatile("s_waitcnt lgkmcnt(0)":::"memory");SBAR();
    #define PK(k) (bf16x8){lo[k][0],lo[k][1],lo[k][2],lo[k][3],hi[k][0],hi[k][1],hi[k][2],hi[k][3]}
    o[d0]=__builtin_amdgcn_mfma_f32_32x32x16_bf16(pa0,PK(0),o[d0],0,0,0);
    o[d0]=__builtin_amdgcn_mfma_f32_32x32x16_bf16(pa1,PK(1),o[d0],0,0,0);
    o[d0]=__builtin_amdgcn_mfma_f32_32x32x16_bf16(pa2,PK(2),o[d0],0,0,0);
    o[d0]=__builtin_amdgcn_mfma_f32_32x32x16_bf16(pa3,PK(3),o[d0],0,0,0);
    #undef PK
  }
}

#ifndef ATTN_STORE16
#define ATTN_STORE16(p,v) (*(u32x4*)(p)=(v))
#endif
template<int THRL> __device__ __forceinline__ void attn_unit(const bf16*Qb,const bf16*__restrict__ Kh,const bf16*__restrict__ Vh,bf16*Ob,int NT,char*shm){
  const int tid=threadIdx.x,lane=tid&63,r32=lane&31,hi=lane>>5; const int wid=__builtin_amdgcn_readfirstlane(tid>>6);
  const bf16*Qw=Qb+(long)(wid*QBLK)*QP;
  const unsigned lds0=(unsigned)(uintptr_t)shm;
  float*wsf=(float*)(shm+LDS_WS)+wid*64;
  const bf16*ksrc=Kh+(long)lane*KP+wid*8;
  const bf16*vsrc=Vh+(long)(16*(wid&3)+(lane>>2))*VP+(wid>>2)*32+(lane&3)*8;
  const unsigned kdst=lds0+LDS_K+wid*1024, vdst=lds0+LDS_V+wid*1024;
  #define DMA_K(t,slot) glds16(ksrc+(long)(t)*KVBLK*KP,(unsigned)__builtin_amdgcn_readfirstlane(kdst+(slot)))
  #define DMA_V(t,slot) glds16(vsrc+(long)(t)*KVBLK*VP,(unsigned)__builtin_amdgcn_readfirstlane(vdst+(slot)))
  const int vb0=(int)(lds0+LDS_V)+((lane>>4)&1)*32+(lane&3)*8+(4*hi+((lane&15)>>2))*64;
  const char*Kbase=shm+LDS_K; bf16x8 kf[8];
  const lds_cptr shm3=(lds_cptr)shm; const lds_cptr kp0=shm3+LDS_K+hi*1024+r32*16; const lds_cptr vp0=shm3+LDS_V+((lane>>4)&1)*32+(lane&3)*8+(4*hi+((lane&15)>>2))*64;
  DMA_K(0,0);DMA_V(0,0);DMA_K(1,SLOTB);
  bf16x8 qr[4];
  #pragma unroll
  for(int d0=0;d0<4;++d0)qr[d0]=*reinterpret_cast<const bf16x8*>(&Qw[(long)r32*QP+d0*16+hi*8]);
  float mhat=0.f,l_reg=0.f;f32x16 o[2];o[0]=f32x16{};o[1]=f32x16{};
  #define CMASK(P0,P1,t) do{}while(0)
  bool resc=false;
  #define START(P0,P1) do{ const float rm=rowmax(P0,P1); resc=false; \
    { const float dl=rm; mhat=fadd_s(mhat,dl); \
      _Pragma("unroll") for(int r=0;r<16;++r){P0[r]=fsub_s(P0[r],dl);P1[r]=fsub_s(P1[r],dl);} } \
    _Pragma("unroll") for(int r=0;r<16;++r)P0[r]=__builtin_amdgcn_exp2f(P0[r]); }while(0)
  #define RESC() do{ if(resc){ asm volatile("s_waitcnt lgkmcnt(0)":::"memory"); \
      _Pragma("unroll") for(int d_=0;d_<2;++d_) _Pragma("unroll") for(int r=0;r<16;++r)o[d_][r]*=wsf[crow(r,hi)]; } }while(0)
  f32x16 pA0,pA1,pB0,pB1;
  int sl_prev=0,sl_cur=0,sl_next=SLOTB;
  #define ROT() do{sl_prev=sl_cur;sl_cur=sl_next;sl_next=(sl_next==(NSLOT-1)*SLOTB)?0:sl_next+SLOTB;}while(0)
  DMA_K(2,2*SLOTB);
  WAIT_BAR(3);
  qkt(pA0,pA1,Kbase,qr,r32,hi);asm volatile("s_nop 15\n\ts_nop 7":"+v"(pA0),"+v"(pA1));CMASK(pA0,pA1,0);
  START(pA0,pA1);
  _Pragma("unroll") for(int r=0;r<16;++r)pA1[r]=__builtin_amdgcn_exp2f(pA1[r]);
  WAIT_BAR(0);
  DMA_K(3,0);DMA_V(1,SLOTB);
  ROT();
  kload8(kf,kp0+sl_cur);
  WAIT_BAR(2);
  s16x4 vlo[8],vhi[8]; u32x4 pw0,pw1,pw2,pw3;
  #define PKW(P,B) cvtpk_s(P[B],P[B+1])
  #define PAF(k) __builtin_bit_cast(bf16x8,pw##k)
  #define VFR(i) (bf16x8){vlo[i][0],vlo[i][1],vlo[i][2],vlo[i][3],vhi[i][0],vhi[i][1],vhi[i][2],vhi[i][3]}
  #define PIN(x) asm volatile("":"+v"(x))
  #define MX3(a,b,c) __builtin_fmaxf(__builtin_fmaxf((a),(b)),(c))
  #define GAPA(MF,A0,A1,A2,A3,W0,W1,PW) do{ MF; sacc+=A0; sacc+=A1; sacc+=A2; sacc+=A3; PIN(sacc); W0; W1; PIN(PW); SBAR(); }while(0)
  #define EX(v) __builtin_amdgcn_exp2f(v)
  #define GAPB(MF,X,B) do{ MF; X[B]=EX(X[B]); X[B+1]=EX(X[B+1]); X[B+2]=EX(X[B+2]); X[B+3]=EX(X[B+3]); PIN(X); SBAR(); }while(0)
  #define VRD(i) do{ vlo[i]=vtr(vp_+(((i)>>2)*4096+((i)&3)*1024)); vhi[i]=vtr(vp_+(((i)>>2)*4096+((i)&3)*1024+512)); }while(0)
  #define KRD(G,j) do{ if(G){ kload2(kf,kp0+sl_next,j); SBAR(); } }while(0)
  #define STEP(C0,C1,P0,P1,t,GK,GV,GL) do{ SBAR(); \
    const lds_cptr vp_=vp0+sl_prev; \
    VRD(0); SBAR(); float sacc=(P0[0]+P0[1]); \
    GAPA(C0=__builtin_amdgcn_mfma_f32_32x32x16_bf16(kf[0],qr[0],(f32x16){},0,0,0), P0[2],P0[3],P0[4],P0[5],     pw0[0]=PKW(P0,0), pw0[1]=PKW(P0,2), pw0); \
    VRD(4); SBAR(); GAPA(C1=__builtin_amdgcn_mfma_f32_32x32x16_bf16(kf[1],qr[0],(f32x16){},0,0,0), P0[6],P0[7],P0[8],P0[9],     pw0[2]=PKW(P0,4), pw0[3]=PKW(P0,6), pw0); \
    VRD(1); SBAR(); GAPA(C0=__builtin_amdgcn_mfma_f32_32x32x16_bf16(kf[2],qr[1],C0,0,0,0),   P0[10],P0[11],P0[12],P0[13], pw1[0]=PKW(P0,8), pw1[1]=PKW(P0,10), pw1); \
    VRD(5); SBAR(); GAPA(C1=__builtin_amdgcn_mfma_f32_32x32x16_bf16(kf[3],qr[1],C1,0,0,0),   P0[14],P0[15],P1[0],P1[1],   pw1[2]=PKW(P0,12),pw1[3]=PKW(P0,14), pw1); \
    VRD(2); SBAR(); GAPA(C0=__builtin_amdgcn_mfma_f32_32x32x16_bf16(kf[4],qr[2],C0,0,0,0),   P1[2],P1[3],P1[4],P1[5],     pw2[0]=PKW(P1,0), pw2[1]=PKW(P1,2), pw2); \
    VRD(6); SBAR(); GAPA(C1=__builtin_amdgcn_mfma_f32_32x32x16_bf16(kf[5],qr[2],C1,0,0,0),   P1[6],P1[7],P1[8],P1[9],     pw2[2]=PKW(P1,4), pw2[3]=PKW(P1,6), pw2); \
    VRD(3); SBAR(); GAPA(C0=__builtin_amdgcn_mfma_f32_32x32x16_bf16(kf[6],qr[3],C0,0,0,0),   P1[10],P1[11],P1[12],P1[13], pw3[0]=PKW(P1,8), pw3[1]=PKW(P1,10), pw3); \
    VRD(7); SBAR(); GAPA(C1=__builtin_amdgcn_mfma_f32_32x32x16_bf16(kf[7],qr[3],C1,0,0,0),   P1[14],P1[15],0.f,0.f,       pw3[2]=PKW(P1,12),pw3[3]=PKW(P1,14), pw3); \
    l_reg+=sacc; \
    { _Pragma("unroll") for(int r=0;r<16;++r){C0[r]-=mhat;C1[r]-=mhat;} } \
    if(GK){DMA_K((t)+3,sl_cur);} if(GV){DMA_V((t)+1,sl_next);} \
    CMASK(C0,C1,t); \
    { float a=MX3(C0[0],C0[1],C1[0]),b=MX3(C0[2],C0[3],C1[1]); a=MX3(a,C1[2],C1[3]); \
      _Pragma("unroll") for(int r=4;r<16;r+=4){a=MX3(a,C0[r],C0[r+1]);b=MX3(b,C0[r+2],C0[r+3]);a=MX3(a,C1[r],C1[r+1]);b=MX3(b,C1[r+2],C1[r+3]);} \
      float rm=__builtin_fmaxf(a,b); { auto rr=__builtin_amdgcn_permlane32_swap(__float_as_uint(rm),__float_as_uint(rm),false,false); rm=__builtin_fmaxf(__uint_as_float(rr[0]),__uint_as_float(rr[1])); } \
      resc=false; \
      if(__builtin_expect(__any(rm>(float)THRL),0)){ const float dl=__builtin_fmaxf(rm,0.f); mhat+=dl; \
        _Pragma("unroll") for(int r=0;r<16;++r){C0[r]-=dl;C1[r]-=dl;} \
        const float f=__builtin_amdgcn_exp2f(-dl); l_reg*=f; if(hi==0)wsf[r32]=f; resc=true; } } \
    SBAR(); \
    GAPB(o[0]=__builtin_amdgcn_mfma_f32_32x32x16_bf16(PAF(0),VFR(0),o[0],0,0,0), C0,0); \
    GAPB(o[1]=__builtin_amdgcn_mfma_f32_32x32x16_bf16(PAF(0),VFR(4),o[1],0,0,0), C0,4); \
    KRD(GL,0); GAPB(o[0]=__builtin_amdgcn_mfma_f32_32x32x16_bf16(PAF(1),VFR(1),o[0],0,0,0), C0,8); \
    KRD(GL,1); GAPB(o[1]=__builtin_amdgcn_mfma_f32_32x32x16_bf16(PAF(1),VFR(5),o[1],0,0,0), C0,12); \
    KRD(GL,2); GAPB(o[0]=__builtin_amdgcn_mfma_f32_32x32x16_bf16(PAF(2),VFR(2),o[0],0,0,0), C1,0); \
    KRD(GL,3); GAPB(o[1]=__builtin_amdgcn_mfma_f32_32x32x16_bf16(PAF(2),VFR(6),o[1],0,0,0), C1,4); \
    GAPB(o[0]=__builtin_amdgcn_mfma_f32_32x32x16_bf16(PAF(3),VFR(3),o[0],0,0,0), C1,8); \
    GAPB(o[1]=__builtin_amdgcn_mfma_f32_32x32x16_bf16(PAF(3),VFR(7),o[1],0,0,0), C1,12); \
    }while(0)
  int t=1;
  for(;t+5<NT;t+=2){
    STEP(pB0,pB1,pA0,pA1,t,true,true,true);     WAIT_BAR(2); RESC(); ROT();
    STEP(pA0,pA1,pB0,pB1,t+1,true,true,true);   WAIT_BAR(2); RESC(); ROT();
  }
  #define ENDW(tt) do{ if((tt)+3<NT){WAIT_BAR(2);} else if((tt)+2<NT){WAIT_BAR(1);} else {WAIT_BAR(0);} }while(0)
  for(;t+1<NT;t+=2){
    STEP(pB0,pB1,pA0,pA1,t,(t+3<NT),(t+1<NT),(t+1<NT));       ENDW(t);   RESC(); ROT();
    STEP(pA0,pA1,pB0,pB1,t+1,(t+4<NT),(t+2<NT),(t+2<NT));     ENDW(t+1); RESC(); ROT();
  }
  STEP(pB0,pB1,pA0,pA1,NT-1,false,false,false); RESC();
  { float sacc=pB0[0]+pB0[1]; _Pragma("unroll") for(int r=2;r<16;++r)sacc+=pB0[r]; _Pragma("unroll") for(int r=0;r<16;++r)sacc+=pB1[r]; l_reg+=sacc;
    pw0=(u32x4){PKW(pB0,0),PKW(pB0,2),PKW(pB0,4),PKW(pB0,6)};pw1=(u32x4){PKW(pB0,8),PKW(pB0,10),PKW(pB0,12),PKW(pB0,14)};pw2=(u32x4){PKW(pB1,0),PKW(pB1,2),PKW(pB1,4),PKW(pB1,6)};pw3=(u32x4){PKW(pB1,8),PKW(pB1,10),PKW(pB1,12),PKW(pB1,14)};
    SBAR(); pv(o,vb0+sl_cur,PAF(0),PAF(1),PAF(2),PAF(3)); }
  #undef PKW
  #undef PAF
  #undef VFR
  #undef PIN
  #undef MX3
  #undef GAPA
  #undef GAPB
  #undef EX
  #undef VRD
  #undef KRD
  #undef STEP
  #undef ENDW
  {auto rr=__builtin_amdgcn_permlane32_swap(__float_as_uint(l_reg),__float_as_uint(l_reg),false,false);l_reg=__uint_as_float(rr[0])+__uint_as_float(rr[1]);}
  if(hi==0)wsf[32+r32]=l_reg;asm volatile("s_waitcnt lgkmcnt(0)":::"memory");
  float rli[16];
  #pragma unroll
  for(int r=0;r<16;++r)rli[r]=__builtin_amdgcn_rcpf(wsf[32+crow(r,hi)]);
  bf16*Ow=Ob+(long)(wid*QBLK)*QP;
  { bf16*stg=(bf16*)(shm+LDS_OST)+wid*2048;
    #pragma unroll
    for(int r=0;r<16;++r){const int orow=crow(r,hi);
      #pragma unroll
      for(int d0=0;d0<2;++d0)stg[orow*64+d0*32+r32]=__float2bfloat16(o[d0][r]*rli[r]);}
    asm volatile("s_waitcnt lgkmcnt(0)":::"memory");
    #pragma unroll
    for(int i=0;i<4;++i){const int row=i*8+(lane>>3),ch=lane&7; const u32x4 v=*(const u32x4*)(stg+row*64+ch*8); ATTN_STORE16(Ow+(long)row*QP+ch*8,v);} }
  asm volatile("s_waitcnt lgkmcnt(0)\n\ts_barrier":::"memory");
  #undef DMA_K
  #undef DMA_V
  #undef CMASK
  #undef START
  #undef RESC
  #undef ROT
}
constexpr int ATTN_LDS_BYTES=LDS_BYTES;
#undef SBAR
#undef WAIT_BAR
}
__device__ __forceinline__ void attn_task(KAP ap, int l, int t, int lane) {
    const unsigned char* ws = ap->ws;
    int type, b, h, j; bool ctxq = false;
    if (t < 6144) { type = t < 3072 ? 2 : 0; const int u = t % 3072; b = u / 1536; h = (u / 256) % 6; j = u % 256; }
    else { const int u = t - 6144; type = u / 96; b = (u / 48) % 2; h = (u / 8) % 6; j = u % 8; ctxq = true; }
    const int r32 = lane & 31, hi = lane >> 5;
    const int m0 = ctxq ? MLAT + b * LCTX + 32 * j : b * SEQ + 32 * j;
    bf16_t* Qp = (bf16_t*)(ws + WS_Q) + (size_t)(m0 + r32) * QW + (type * 6 + h) * 64;
    const bf16_t* Kb; const bf16_t* Vb; int pitchK;
    if (type == 2) { Kb = (const bf16_t*)(ws + WS_KC) + (size_t)b * KEYS * 384 + h * 64; pitchK = 384; Vb = (const bf16_t*)(ws + WS_VTC) + (size_t)(b * 6 + h) * 64 * KEYS; }
    else { const int kvh = h / 3; Kb = (const bf16_t*)(ws + WS_KAB) + (size_t)b * KEYS * 256 + type * 128 + kvh * 64; pitchK = 256; Vb = (const bf16_t*)(ws + WS_VTAB) + (size_t)(b * 4 + type * 2 + kvh) * 64 * KEYS; }
    const int q0 = 32 * j; int nmain = 0, tlo = 0, rs = 0;
    if (!ctxq) {
        if (type == 1) nmain = 128;
        else if (type == 0) { tlo = (q0 - 128) >> 6; if (tlo < 0) tlo = 0; int thi = (q0 + 31 + 128) >> 6; if (thi > 127) thi = 127; nmain = thi - tlo + 1; }
        else { const int r = j >> 1; rs = r - 4; if (rs < 0) rs = 0; if (rs > 120) rs = 120; tlo = rs; nmain = 8; }
    }
    bf16x8 qr[4];
#pragma unroll
    for (int d0 = 0; d0 < 4; ++d0) qr[d0] = *(const bf16x8*)(Qp + d0 * 16 + hi * 8);
    float mrun = -INFINITY, lrun = 0.f;
    if (type == 0) { mrun = ap->in[9][l * 6 + h] * LOG2E; lrun = hi == 0 ? 1.f : 0.f; }
    f32x16 o0 = {}, o1 = {};
    const int rsw = (r32 & ~12) | ((r32 & 4) << 1) | ((r32 & 8) >> 1);
    const float* rpb = ap->in[12] + (size_t)(l * 6 + h) * 15 * 31;
    const int qc = 32 * (j & 1) + r32; int wsn = qc - 8; wsn = wsn < 0 ? 0 : (wsn > 48 ? 48 : wsn);
    const int ntile = 4 + nmain;
#pragma unroll 1
    for (int tt = 0; tt < ntile; ++tt) {
        const int key0 = tt < 4 ? 64 * tt : LCTX + 64 * (tlo + tt - 4);
        const bf16_t* kp = Kb + (size_t)(key0 + rsw) * pitchK + 8 * hi;
        bf16x8 kf0[4], kf1[4];
#pragma unroll
        for (int d0 = 0; d0 < 4; ++d0) { kf0[d0] = *(const bf16x8*)(kp + d0 * 16); kf1[d0] = *(const bf16x8*)(kp + (size_t)32 * pitchK + d0 * 16); }
        const bf16_t* vp = Vb + (size_t)r32 * KEYS + key0 + 8 * hi;
        bf16x8 vf0[4], vf1[4];
#pragma unroll
        for (int ks = 0; ks < 4; ++ks) { vf0[ks] = *(const bf16x8*)(vp + 16 * ks); vf1[ks] = *(const bf16x8*)(vp + (size_t)32 * KEYS + 16 * ks); }
        f32x16 p0 = {}, p1 = {};
#pragma unroll
        for (int d0 = 0; d0 < 4; ++d0) { p0 = __builtin_amdgcn_mfma_f32_32x32x16_bf16(kf0[d0], qr[d0], p0, 0, 0, 0); p1 = __builtin_amdgcn_mfma_f32_32x32x16_bf16(kf1[d0], qr[d0], p1, 0, 0, 0); }
        if (tt >= 4 && type == 0) {
            const int kpos0 = 64 * (tlo + tt - 4) + 8 * hi - (q0 + r32);
#pragma unroll
            for (int r = 0; r < 16; ++r) { const int d0_ = kpos0 + 16 * (r >> 3) + (r & 7); if (d0_ > 128 || d0_ < -128) p0[r] = -INFINITY; const int d1_ = d0_ + 32; if (d1_ > 128 || d1_ < -128) p1[r] = -INFINITY; }
        } else if (tt >= 4 && type == 2) {
            const int ro = (rs + tt - 4) - (j >> 1) + 7;
            const float* rb = rpb + ro * 31 + 15 - qc;
#pragma unroll
            for (int r = 0; r < 16; ++r) {
                const int kc0 = 16 * (r >> 3) + 8 * hi + (r & 7), kc1 = kc0 + 32;
                if (kc0 >= wsn && kc0 < wsn + 16) p0[r] += rb[kc0] * LOG2E; else p0[r] = -INFINITY;
                if (kc1 >= wsn && kc1 < wsn + 16) p1[r] += rb[kc1] * LOG2E; else p1[r] = -INFINITY;
            }
        }
        float rm = fmaxf(p0[0], p1[0]);
#pragma unroll
        for (int r = 1; r < 16; ++r) rm = fmaxf(rm, fmaxf(p0[r], p1[r]));
        rm = fmaxf(rm, __shfl_xor(rm, 32));
        const float mn = fmaxf(mrun, rm);
        const float alpha = __builtin_amdgcn_exp2f(mrun - mn);
        mrun = mn;
        float sum = 0.f;
#pragma unroll
        for (int r = 0; r < 16; ++r) { p0[r] = __builtin_amdgcn_exp2f(p0[r] - mn); p1[r] = __builtin_amdgcn_exp2f(p1[r] - mn); sum += p0[r] + p1[r]; }
        lrun = lrun * alpha + sum;
#pragma unroll
        for (int r = 0; r < 16; ++r) { o0[r] *= alpha; o1[r] *= alpha; }
        bf16x8 pk[4];
#pragma unroll
        for (int ks = 0; ks < 4; ++ks) {
            u32x4 w;
            if (ks < 2) { w.x = cvt_pk_bf16(p0[8 * ks + 0], p0[8 * ks + 1]); w.y = cvt_pk_bf16(p0[8 * ks + 2], p0[8 * ks + 3]); w.z = cvt_pk_bf16(p0[8 * ks + 4], p0[8 * ks + 5]); w.w = cvt_pk_bf16(p0[8 * ks + 6], p0[8 * ks + 7]); }
            else { const int k2 = ks - 2; w.x = cvt_pk_bf16(p1[8 * k2 + 0], p1[8 * k2 + 1]); w.y = cvt_pk_bf16(p1[8 * k2 + 2], p1[8 * k2 + 3]); w.z = cvt_pk_bf16(p1[8 * k2 + 4], p1[8 * k2 + 5]); w.w = cvt_pk_bf16(p1[8 * k2 + 6], p1[8 * k2 + 7]); }
            pk[ks] = __builtin_bit_cast(bf16x8, w);
        }
#pragma unroll
        for (int ks = 0; ks < 4; ++ks) { o0 = __builtin_amdgcn_mfma_f32_32x32x16_bf16(vf0[ks], pk[ks], o0, 0, 0, 0); o1 = __builtin_amdgcn_mfma_f32_32x32x16_bf16(vf1[ks], pk[ks], o1, 0, 0, 0); }
    }
    const float lt = lrun + __shfl_xor(lrun, 32);
    const float inv = 1.0f / lt;
#pragma unroll
    for (int g = 0; g < 4; ++g) {
        u32x2 w0, w1;
        w0.x = cvt_pk_bf16(o0[4 * g + 0] * inv, o0[4 * g + 1] * inv); w0.y = cvt_pk_bf16(o0[4 * g + 2] * inv, o0[4 * g + 3] * inv);
        w1.x = cvt_pk_bf16(o1[4 * g + 0] * inv, o1[4 * g + 1] * inv); w1.y = cvt_pk_bf16(o1[4 * g + 2] * inv, o1[4 * g + 3] * inv);
        *(u32x2*)(Qp + 8 * g + 4 * hi) = w0; *(u32x2*)(Qp + 32 + 8 * g + 4 * hi) = w1;
    }
}

__global__ void __launch_bounds__(512, 2) fwd_mega(Args a) {
    extern __shared__ __attribute__((aligned(16))) unsigned char lds_raw[];
    cg::grid_group grid = cg::this_grid();
    PG8_LAS unsigned char* lds = (PG8_LAS unsigned char*)lds_raw;
    const int tid = threadIdx.x, wave = __builtin_amdgcn_readfirstlane(tid >> 6);
    const int G = gridDim.x, gw = blockIdx.x * 8 + wave, NGW = G * 8;
#define LANE() ({ int l_ = threadIdx.x & 63; asm volatile("" : "+v"(l_)); l_; })
    unsigned char* ws; { KAP ap0 = KARGS(); ws = ap0->ws; }
    float* mods = (float*)(ws + WS_MODS);
    unsigned* ctl = (unsigned*)(ws + WS_CTL);

    conv_weights(KARGS(), 0, (LAS unsigned char*)lds_raw, gw, NGW, wave, LANE());
    ada_phase(KARGS(), gw, NGW, LANE());
    if (blockIdx.x == 0) {
        float* rope = (float*)(ws + WS_ROPE);
        for (int i = tid; i < 128 * 16; i += 512) { const int pos = i >> 4, f = i & 15; const float fr = powf(10000.0f, -(float)f / 16.0f); const float ang = (float)pos * fr; float s, c; sincosf(ang, &s, &c); rope[2 * i] = c; rope[2 * i + 1] = s; }
    }
    grid.sync();
    { KAP ap = KARGS();
      row_phase(gw, NGW, LANE(), MALL, nullptr, nullptr, nullptr, 0, ap->in[0], ap->in[2], nullptr, nullptr,
              (bf16_t*)(ws + WS_R1), ap->in[6], mods, 0, 1024); }
    grid.sync();

#pragma unroll 1
    for (int l = 0; l < DEPTH; ++l) {
        const bool last = (l == DEPTH - 1);
        const int MX = last ? MLAT : MALL;
        int bidl = blockIdx.x, Gl = gridDim.x; asm volatile("" : "+s"(bidl), "+s"(Gl));
        const float* modl = mods + (size_t)l * 3 * 6144;
        {
            pg8::Gemm g{(const bf16_t*)(ws + WS_R1), (const bf16_t*)(ws + WS_WIN), MALL, NINP, DM, DM, DM, 0, 0};
            pg8::StaticOrder S; S.init(MALL, NINP, Gl, bidl);
            EpiScatter E{(bf16_t*)(ws + WS_Q), (bf16_t*)(ws + WS_KAB), (bf16_t*)(ws + WS_KC), (bf16_t*)(ws + WS_VTAB), (bf16_t*)(ws + WS_VTC), (bf16_t*)(ws + WS_PG), (bf16_t*)(ws + WS_VB)};
            pg8::gemm_phase<EpiScatter, pg8::StaticOrder, true, true>(lds, g, S, E);
        }
        grid.sync();
        post_phase(KARGS(), l, gw, NGW, LANE());
        grid.sync();
        {
            KAP ap = KARGS(); const int lane = LANE();
            for (int uid = blockIdx.x; uid < 384; uid += G) {
                const int qb = uid & 31, bh = uid >> 5, b = bh / 6, h = bh % 6;
                const attn_body::bf16* Qb = (const attn_body::bf16*)(ws + WS_Q) + (size_t)(b * SEQ + qb * 256) * QW + (6 + h) * 64;
                const attn_body::bf16* Kh = (const attn_body::bf16*)(ws + WS_KAB) + (size_t)b * KEYS * 256 + 128 + (h / 3) * 64;
                const attn_body::bf16* Vh = (const attn_body::bf16*)(ws + WS_VB) + (size_t)b * KEYS * 128 + (h / 3) * 64;
                attn_body::attn_unit<8>(Qb, Kh, Vh, (attn_body::bf16*)Qb, KEYS / 64, (char*)lds_raw);
            }
            const int ntask = 6144 + (last ? 0 : 288);
            unsigned* ctr = ctl + 64 * l;
            for (;;) {
                int t = 0;
                if (lane == 0) t = (int)atomicAdd(ctr, 1u);
                t = __builtin_amdgcn_readfirstlane(t);
                if (t >= ntask) break;
                attn_task(ap, l, t, lane);
            }
        }
        grid.sync();
        {
            pg8::Gemm g{(const bf16_t*)(ws + WS_Q), (const bf16_t*)(ws + WS_WBR), MX, 3072, 384, QW, 384, 4, (size_t)384 * 2};
            pg8::StaticOrder S; S.init(MX, 3072, Gl, bidl);
            EpiGate E{(bf16_t*)(ws + WS_PG)};
            pg8::gemm_phase<EpiGate, pg8::StaticOrder, true, true>(lds, g, S, E);
        }
        grid.sync();
        {
            pg8::Gemm g{(const bf16_t*)(ws + WS_PG), (const bf16_t*)(ws + WS_WOUT), MX, DM, 3072, 3072, 3072, 0, 0};
            pg8::StaticOrder S; S.init(MX, DM, Gl, bidl);
            EpiF32 E{(float*)(ws + WS_Y), DM};
            pg8::gemm_phase<EpiF32, pg8::StaticOrder, true, true>(lds, g, S, E);
        }
        grid.sync();
        { KAP ap = KARGS();
          row_phase(gw, NGW, LANE(), MX, (const float*)(ws + WS_Y), ap->in[7] + l * DM, modl, 2048,
                  l == 0 ? ap->in[0] : ap->out, l == 0 ? ap->in[2] : (const float*)(ws + WS_XC), ap->out, (float*)(ws + WS_XC),
                  (bf16_t*)(ws + WS_Q), ap->in[17] + l * DM, modl, 3072, 4096); }
        grid.sync();
        {
            pg8::Gemm g{(const bf16_t*)(ws + WS_Q), (const bf16_t*)(ws + WS_W1), MX, FF, DM, DM, DM, 0, 0};
            pg8::StaticOrder S; S.init(MX, FF, Gl, bidl);
            EpiBf16<1> E{(bf16_t*)(ws + WS_A), FF};
            pg8::gemm_phase<EpiBf16<1>, pg8::StaticOrder, true, true>(lds, g, S, E);
        }
        grid.sync();
        {
            pg8::Gemm g{(const bf16_t*)(ws + WS_A), (const bf16_t*)(ws + WS_W2), MX, DM, FF, FF, FF, 0, 0};
            pg8::StaticOrder S; S.init(MX, DM, Gl, bidl);
            EpiF32 E{(float*)(ws + WS_Y2), DM};
            pg8::gemm_phase<EpiF32, pg8::StaticOrder, true, true>(lds, g, S, E);
        }
        grid.sync();
        if (!last) {
            { KAP ap = KARGS();
              row_phase(gw, NGW, LANE(), MX, (const float*)(ws + WS_Y2), ap->in[18] + l * DM, modl, 5120,
                      ap->out, (const float*)(ws + WS_XC), ap->out, (float*)(ws + WS_XC),
                      (bf16_t*)(ws + WS_R1), ap->in[6] + (l + 1) * DM, modl + 3 * 6144, 0, 1024); }
            conv_weights(KARGS(), l + 1, (LAS unsigned char*)lds_raw, gw, NGW, wave, LANE());
            grid.sync();
        } else {
            { KAP ap = KARGS();
              row_phase(gw, NGW, LANE(), MX, (const float*)(ws + WS_Y2), ap->in[18] + l * DM, modl, 5120,
                      ap->out, (const float*)(ws + WS_XC), ap->out, (float*)(ws + WS_XC),
                      nullptr, nullptr, nullptr, 0, 0); }
        }
    }
}

extern "C" void kernel_launch(void* const* d_in, const int* in_sizes, int n_in, void* d_out, int out_size, void* d_ws, size_t ws_size, hipStream_t stream) {
    static int grid = 0;
    if (grid == 0) {
        if (n_in != 21 || out_size != MLAT * DM || ws_size < WS_END) { fprintf(stderr, "kernel_launch: unexpected shapes (n_in %d, out %d, ws %zu need %zu)\n", n_in, out_size, ws_size, (size_t)WS_END); grid = -1; return; }
        int dev = 0, cus = 0, per_cu = 0;
        if (hipGetDevice(&dev) != hipSuccess || hipDeviceGetAttribute(&cus, hipDeviceAttributeMultiprocessorCount, dev) != hipSuccess) { grid = -1; return; }
        if (hipFuncSetAttribute((const void*)fwd_mega, hipFuncAttributeMaxDynamicSharedMemorySize, LDS_BYTES) != hipSuccess) { fprintf(stderr, "kernel_launch: hipFuncSetAttribute failed\n"); grid = -1; return; }
        if (hipOccupancyMaxActiveBlocksPerMultiprocessor(&per_cu, (const void*)fwd_mega, 512, LDS_BYTES) != hipSuccess || per_cu < 1) { fprintf(stderr, "kernel_launch: occupancy query says %d blocks per CU\n", per_cu); grid = -1; return; }
        grid = cus;
    }
    if (grid < 0) return;
    (void)hipMemsetAsync((char*)d_ws + WS_CTL, 0, CTL_ZERO_BYTES, stream);
    Args a{};
    for (int i = 0; i < 21; ++i) a.in[i] = (const float*)d_in[i];
    a.out = (float*)d_out; a.ws = (unsigned char*)d_ws;
    void* args[] = {&a};
    hipError_t e = hipLaunchCooperativeKernel((const void*)fwd_mega, dim3(grid), dim3(512), args, LDS_BYTES, stream);
    if (e != hipSuccess) fprintf(stderr, "cooperative launch failed: %s (grid %d)\n", hipGetErrorString(e), grid);
}
```

```cpp
#include <hip/hip_runtime.h>
#include <hip/hip_cooperative_groups.h>
#include <cstdio>
#include <cstdint>
namespace cg = cooperative_groups;

namespace pg8 {
#define PG8_LAS __attribute__((address_space(3)))
typedef unsigned short bf16_t;
typedef short bf16x8 __attribute__((ext_vector_type(8)));
typedef float f32x4 __attribute__((ext_vector_type(4)));
typedef unsigned u32x4 __attribute__((ext_vector_type(4)));
constexpr int BM = 256, BK = 64, HALF = 128, HTB = HALF * BK * 2, STAGE_BYTES = 8 * HTB, NXCD = 8, WGM = 8;

__host__ __device__ __forceinline__ int lds_byte(int r, int c) { const int st = (r >> 4) * 2 + (c >> 5), rr = r & 15, cc = c & 31, ob = rr * 64 + cc * 2; return st * 1024 + (ob ^ (((ob >> 9) & 1) << 5)); }
__host__ __device__ __forceinline__ void stage_rc(int b, int& R, int& C) { const int st = b / 1024, sb = b % 1024, swz = sb ^ (((sb >> 9) & 1) << 5); R = (st >> 1) * 16 + swz / 64; C = (st & 1) * 32 + (swz % 64) / 2; }
__host__ __device__ __forceinline__ int perm32(int rho) { const int n = rho >> 4, i = rho & 15; return 8 * (i >> 2) + 4 * n + (i & 3); }

struct Unit { int pm, pn; };
struct Gemm { const bf16_t* A; const bf16_t* Bt; int M, N, K, lda, ldb, a_split; size_t a_stride; };

struct StaticOrder {
    int nM, nN, nwg, G, c;
    __host__ __device__ void init(int M, int N, int G_, int c_) { nM = M / BM; nN = N / BM; nwg = nM * nN; G = G_; c = c_; }
    __host__ __device__ bool next(int i, Unit& u) const {
        const long L = (long)i * G + c; if (L >= nwg) return false;
        int wgid = (int)L; { const int q = nwg / NXCD, r = nwg % NXCD, xcd = wgid % NXCD, off = wgid / NXCD; wgid = (xcd < r ? xcd * (q + 1) : r * (q + 1) + (xcd - r) * q) + off; }
        const int nig = WGM * nN, gid = wgid / nig, fm = gid * WGM, gsz = (nM - fm) < WGM ? (nM - fm) : WGM;
        u.pm = fm + ((wgid % nig) % gsz); u.pn = (wgid % nig) / gsz; return true;
    }
};

__device__ __forceinline__ unsigned cvt_pk_bf16(float lo, float hi) { unsigned r; asm volatile("v_cvt_pk_bf16_f32 %0, %1, %2" : "=v"(r) : "v"(lo), "v"(hi)); return r; }


template <class Epi, class Sched, bool ALIGN_EPI = false, bool SP2 = false>
__device__ __forceinline__ void gemm_phase(PG8_LAS unsigned char* lds, const Gemm g, const Sched& S, const Epi& E) {
    int tid_ = threadIdx.x; asm volatile("" : "+v"(tid_));
    const int tid = tid_, wid = __builtin_amdgcn_readfirstlane(tid >> 6), lane = tid & 63, wr = wid >> 2, wc = wid & 3, fr = lane & 15, fq = lane >> 4;
    const int K = g.K, nt = K / BK;
    unsigned voffA[2], voffB[2];
#pragma unroll
    for (int i = 0; i < 2; ++i) { int R, C; stage_rc(tid * 16 + i * 8192, R, C); const int Rb = Epi::PERM ? ((R & ~31) + perm32(R & 31)) : R;
        voffA[i] = (unsigned)(R * g.lda + C) * 2u; voffB[i] = (unsigned)(Rb * g.ldb + C) * 2u; }
    const size_t kstep = (size_t)(BK * 2);
    const size_t hstepA = (size_t)HALF * g.lda * 2, hstepB = (size_t)HALF * g.ldb * 2;
    const size_t tstepA = 2 * hstepA, tstepB = 2 * hstepB;
    const unsigned ldsw = (unsigned)wid * 1024u;
    const int aoff = lds_byte(wr * 64 + fr, fq * 8), boff = lds_byte(wc * 32 + fr, fq * 8);
#define PG8_SA(b, h) (((b) * 2 + (h)) * HTB)
#define PG8_SB(b, h) ((4 + (b) * 2 + (h)) * HTB)
#define PG8_STAGE(bufoff, gbase, voff) do { _Pragma("unroll") for (int _i = 0; _i < 2; ++_i) \
        __builtin_amdgcn_global_load_lds((const unsigned*)((const char*)(gbase) + (voff)[_i]), (PG8_LAS unsigned*)(lds + (bufoff) + ldsw + _i * 8192), 16, 0, 0); } while (0)
#define PG8_LDA(dst, b, h) do { _Pragma("unroll") for (int m = 0; m < 4; ++m) _Pragma("unroll") for (int k = 0; k < 2; ++k) dst[m][k] = *(const PG8_LAS bf16x8*)(lds + PG8_SA(b, h) + aoff + m * 2048 + k * 1024); } while (0)
#define PG8_LDB(dst, b, h) do { _Pragma("unroll") for (int n = 0; n < 2; ++n) _Pragma("unroll") for (int k = 0; k < 2; ++k) dst[n][k] = *(const PG8_LAS bf16x8*)(lds + PG8_SB(b, h) + boff + n * 2048 + k * 1024); } while (0)
#define PG8_MMA(ai, bj, At, Bt) do { __builtin_amdgcn_s_setprio(1); _Pragma("unroll") for (int m = 0; m < 4; ++m) _Pragma("unroll") for (int n = 0; n < 2; ++n) _Pragma("unroll") for (int k = 0; k < 2; ++k) \
        acc[ai][bj][m][n] = __builtin_amdgcn_mfma_f32_16x16x32_bf16(Bt[n][k], At[m][k], acc[ai][bj][m][n], 0, 0, 0); __builtin_amdgcn_s_setprio(0); } while (0)
#define PG8_WAIT_V(n) asm volatile("s_waitcnt vmcnt(" #n ")" ::: "memory")
#define PG8_WAIT_L(n) asm volatile("s_waitcnt lgkmcnt(" #n ")" ::: "memory")
#define PG8_BAR __builtin_amdgcn_s_barrier()
#define PG8_SCHED __builtin_amdgcn_sched_barrier(0)
#define PG8_ABASE(u) ((const char*)g.A + (size_t)(u).pm * tstepA + (g.a_split ? (size_t)((u).pn / g.a_split) * g.a_stride : (size_t)0))
    Unit cur, nxt; int ui = 0;
    if (!S.next(0, cur)) return;
    f32x4 acc[2][2][4][2];
#pragma unroll
    for (int a = 0; a < 2; ++a)
#pragma unroll
        for (int b = 0; b < 2; ++b)
#pragma unroll
            for (int m = 0; m < 4; ++m)
#pragma unroll
                for (int n = 0; n < 2; ++n) acc[a][b][m][n] = (f32x4){0.f, 0.f, 0.f, 0.f};
    bf16x8 At[4][2], B0[2][2], B1[2][2];
    const char* cA = PG8_ABASE(cur); const char* cB = (const char*)g.Bt + (size_t)cur.pn * tstepB;
    if constexpr (SP2) {
        PG8_STAGE(PG8_SB(0, 0), cB, voffB); PG8_STAGE(PG8_SB(0, 1), cB + hstepB, voffB); PG8_STAGE(PG8_SA(0, 0), cA, voffA); PG8_STAGE(PG8_SA(0, 1), cA + hstepA, voffA);
        if (wr == 1) PG8_BAR;
        PG8_WAIT_V(2); PG8_BAR;
        PG8_STAGE(PG8_SB(1, 0), cB + kstep, voffB); PG8_STAGE(PG8_SA(1, 0), cA + kstep, voffA); PG8_STAGE(PG8_SB(1, 1), cB + hstepB + kstep, voffB);
        PG8_WAIT_V(6); PG8_BAR;
    } else {
        PG8_STAGE(PG8_SB(0, 0), cB, voffB); PG8_STAGE(PG8_SA(0, 0), cA, voffA); PG8_STAGE(PG8_SB(0, 1), cB + hstepB, voffB); PG8_STAGE(PG8_SA(0, 1), cA + hstepA, voffA);
        if (wr == 1) PG8_BAR;
        PG8_WAIT_V(4); PG8_BAR;
        PG8_STAGE(PG8_SB(1, 0), cB + kstep, voffB); PG8_STAGE(PG8_SA(1, 0), cA + kstep, voffA); PG8_STAGE(PG8_SB(1, 1), cB + hstepB + kstep, voffB);
        PG8_WAIT_V(6); PG8_BAR;
    }
    for (;;) {
        const bool has_next = S.next(ui + 1, nxt);
        const char* nA = has_next ? PG8_ABASE(nxt) : cA; const char* nB = has_next ? (const char*)g.Bt + (size_t)nxt.pn * tstepB : cB;
#pragma unroll 1
        for (int t = 0; t < nt; t += 2) {
            const bool last = (t == nt - 2);
            const char* a1 = cA + (size_t)(t + 1) * kstep;
            const char* a2 = last ? nA : cA + (size_t)(t + 2) * kstep; const char* b2 = last ? nB : cB + (size_t)(t + 2) * kstep;
            const char* a3 = a2 + kstep; const char* b3 = b2 + kstep;
            if constexpr (SP2) {
            PG8_LDB(B0, 0, 0); PG8_LDB(B1, 0, 1); PG8_SCHED; PG8_LDA(At, 0, 0); PG8_STAGE(PG8_SA(1, 1), a1 + hstepA, voffA);
            PG8_WAIT_V(8); PG8_WAIT_L(0); PG8_BAR; PG8_MMA(0, 0, At, B0); PG8_MMA(0, 1, At, B1); PG8_BAR; PG8_SCHED;
            PG8_LDA(At, 0, 1); PG8_STAGE(PG8_SB(0, 0), b2, voffB); PG8_STAGE(PG8_SB(0, 1), b2 + hstepB, voffB); PG8_STAGE(PG8_SA(0, 0), a2, voffA);
            PG8_WAIT_V(8); PG8_WAIT_L(0); PG8_BAR; PG8_MMA(1, 0, At, B0); PG8_MMA(1, 1, At, B1); PG8_BAR; PG8_SCHED;
            PG8_LDB(B0, 1, 0); PG8_LDB(B1, 1, 1); PG8_SCHED; PG8_LDA(At, 1, 0); PG8_STAGE(PG8_SA(0, 1), a2 + hstepA, voffA);
            PG8_WAIT_V(8); PG8_WAIT_L(0); PG8_BAR; PG8_MMA(0, 0, At, B0); PG8_MMA(0, 1, At, B1); PG8_BAR; PG8_SCHED;
            PG8_LDA(At, 1, 1); PG8_STAGE(PG8_SB(1, 0), b3, voffB); PG8_STAGE(PG8_SB(1, 1), b3 + hstepB, voffB); PG8_STAGE(PG8_SA(1, 0), a3, voffA);
            PG8_WAIT_V(8); PG8_WAIT_L(0); PG8_BAR; PG8_MMA(1, 0, At, B0); PG8_MMA(1, 1, At, B1); PG8_BAR; PG8_SCHED;
            } else {
            PG8_LDB(B0, 0, 0); PG8_SCHED; PG8_LDA(At, 0, 0); PG8_STAGE(PG8_SA(1, 1), a1 + hstepA, voffA);
            PG8_WAIT_L(8); PG8_BAR; PG8_WAIT_L(0); PG8_MMA(0, 0, At, B0); PG8_BAR; PG8_SCHED;
            PG8_LDB(B1, 0, 1); PG8_STAGE(PG8_SB(0, 0), b2, voffB);
            PG8_BAR; PG8_WAIT_L(0); PG8_MMA(0, 1, At, B1); PG8_BAR;
            PG8_LDA(At, 0, 1); PG8_STAGE(PG8_SA(0, 0), a2, voffA);
            PG8_BAR; PG8_WAIT_L(0); PG8_MMA(1, 0, At, B0); PG8_BAR; PG8_SCHED;
            PG8_STAGE(PG8_SB(0, 1), b2 + hstepB, voffB);
            PG8_WAIT_V(6); PG8_BAR; PG8_MMA(1, 1, At, B1); PG8_BAR;
            PG8_LDB(B0, 1, 0); PG8_SCHED; PG8_LDA(At, 1, 0); PG8_STAGE(PG8_SA(0, 1), a2 + hstepA, voffA);
            PG8_WAIT_L(8); PG8_BAR; PG8_WAIT_L(0); PG8_MMA(0, 0, At, B0); PG8_BAR; PG8_SCHED;
            PG8_LDB(B1, 1, 1); PG8_STAGE(PG8_SB(1, 0), b3, voffB);
            PG8_BAR; PG8_WAIT_L(0); PG8_MMA(0, 1, At, B1); PG8_BAR;
            PG8_LDA(At, 1, 1); PG8_STAGE(PG8_SA(1, 0), a3, voffA);
            PG8_BAR; PG8_WAIT_L(0); PG8_MMA(1, 0, At, B0); PG8_BAR; PG8_SCHED;
            PG8_STAGE(PG8_SB(1, 1), b3 + hstepB, voffB);
            PG8_WAIT_V(6); PG8_BAR; PG8_MMA(1, 1, At, B1); PG8_BAR;
            }
        }
        if constexpr (ALIGN_EPI) { if (wr == 0) PG8_BAR; }
        E(acc, cur, wr, wc, fr, fq);
        if (!has_next) break;
#pragma unroll
        for (int a = 0; a < 2; ++a)
#pragma unroll
            for (int b = 0; b < 2; ++b)
#pragma unroll
                for (int m = 0; m < 4; ++m)
#pragma unroll
                    for (int n = 0; n < 2; ++n) acc[a][b][m][n] = (f32x4){0.f, 0.f, 0.f, 0.f};
        cur = nxt; cA = nA; cB = nB; ++ui;
        if constexpr (ALIGN_EPI) { if (wr == 1) PG8_BAR; }
    }
    PG8_WAIT_V(0);
    if constexpr (!ALIGN_EPI) { if (wr == 0) PG8_BAR; }
    PG8_BAR;
#undef PG8_SA
#undef PG8_SB
#undef PG8_STAGE
#undef PG8_LDA
#undef PG8_LDB
#undef PG8_MMA
#undef PG8_WAIT_V
#undef PG8_WAIT_L
#undef PG8_BAR
#undef PG8_SCHED
#undef PG8_ABASE
}
}

using pg8::bf16_t; using pg8::f32x4; using pg8::u32x4; using pg8::Unit; using pg8::cvt_pk_bf16;
typedef short bf16x8 __attribute__((ext_vector_type(8)));
typedef float f32x16 __attribute__((ext_vector_type(16)));
typedef unsigned u32x2 __attribute__((ext_vector_type(2)));
#define LAS __attribute__((address_space(3)))

constexpr int DM = 1024, SEQ = 8192, NB = 2, LCTX = 256, DEPTH = 2;
constexpr int MLAT = NB * SEQ;
constexpr int MALL = MLAT + NB * LCTX;
constexpr int KEYS = LCTX + SEQ;
constexpr int NIN = 5504, NINP = 5632;
constexpr int FF = 4096;
constexpr int QW = 1152;
constexpr float EPS = 1e-6f;
constexpr float LOG2E = 1.4426950408889634f;
constexpr float QSCALE = 0.125f * LOG2E;

constexpr size_t MiB = 1u << 20;
constexpr size_t WS_CTL = 0, CTL_ZERO_BYTES = 256 * 1024;
constexpr size_t WS_MODS = 64 * 1024;
constexpr size_t WS_ROPE = 256 * 1024;
constexpr size_t WS_XC = 1 * MiB;
constexpr size_t WS_WIN = 4 * MiB;
constexpr size_t WS_WBR = WS_WIN + 11 * MiB;
constexpr size_t WS_WOUT = WS_WBR + 9 * MiB / 4;
constexpr size_t WS_W1 = WS_WOUT + 6 * MiB;
constexpr size_t WS_W2 = WS_W1 + 8 * MiB;
constexpr size_t WS_R1 = 40 * MiB;
constexpr size_t WS_KAB = WS_R1 + 33 * MiB;
constexpr size_t WS_KC = WS_KAB + (size_t)NB * KEYS * 256 * 2;
constexpr size_t WS_VTAB = WS_KC + (size_t)NB * KEYS * 384 * 2;
constexpr size_t WS_VTC = WS_VTAB + (size_t)NB * 4 * 64 * KEYS * 2;
constexpr size_t WS_PG = WS_VTC + (size_t)NB * 6 * 64 * KEYS * 2;
constexpr size_t WS_Q = WS_PG + (size_t)MALL * 3072 * 2;
constexpr size_t WS_VB = WS_Q + (size_t)MALL * QW * 2;
constexpr size_t WS_END = WS_VB + (size_t)NB * KEYS * 128 * 2;
constexpr size_t WS_Y = WS_R1;
constexpr size_t WS_A = WS_R1;
constexpr size_t WS_Y2 = WS_A + (size_t)MALL * FF * 2;
static_assert(WS_W2 + 8 * MiB <= WS_R1, "weights");
static_assert(WS_Y + (size_t)MALL * DM * 4 <= WS_PG, "Y overlay");
static_assert(WS_A + (size_t)MALL * FF * 2 <= WS_Q, "A overlay");
static_assert(WS_Y2 + (size_t)MALL * DM * 4 <= WS_END && WS_END <= 256 * MiB, "ws map");

constexpr int LDS_BYTES = 147456;

struct EpiScatter {
    static constexpr bool PERM = true;
    bf16_t *Q, *KAB, *KC, *VtAB, *VtC, *PG, *VB;
    __device__ __forceinline__ void operator()(const f32x4 (&acc)[2][2][4][2], const Unit& u, int wr, int wc, int fr, int fq) const {
        const int pm = u.pm; int b, kroff;
        if (pm < 64) { b = pm >> 5; kroff = 256 * b + 256; } else { b = pm - 64; kroff = -MLAT + SEQ * b; }
        const int row0 = pm * 256 + wr * 64 + fr, cin = wc * 32 + 8 * fq;
#pragma unroll
        for (int bj = 0; bj < 2; ++bj) {
            const int cb = 2 * u.pn + bj;
            if (cb >= 43) continue;
            int mode = 0, pitch = 0, col = 0, radd = 0, nhv = 0, hd = 0; bf16_t* base = nullptr;
            if (cb >= 19) { base = PG; pitch = 3072; col = 128 * (cb - 19) + cin; }
            else if (cb <= 2) { base = Q; pitch = QW; col = 128 * cb + cin; }
            else if (cb == 3) { base = KAB; pitch = 256; col = cin; radd = kroff; }
            else if (cb == 4) { mode = 1; base = VtAB; nhv = 4; hd = cin; }
            else if (cb <= 7) { base = Q; pitch = QW; col = 384 + 128 * (cb - 5) + cin; }
            else if (cb == 8) { base = KAB; pitch = 256; col = 128 + cin; radd = kroff; }
            else if (cb == 9) { mode = 1; base = VtAB; nhv = 4; hd = 128 + cin; }
            else if (cb <= 12) { base = Q; pitch = QW; col = 768 + 128 * (cb - 10) + cin; }
            else if (cb <= 15) { base = KC; pitch = 384; col = 128 * (cb - 13) + cin; radd = kroff; }
            else { mode = 1; base = VtC; nhv = 6; hd = 128 * (cb - 16) + cin; }
#pragma unroll
            for (int ai = 0; ai < 2; ++ai)
#pragma unroll
                for (int m = 0; m < 4; ++m) {
                    const int row = row0 + ai * 128 + m * 16;
                    const f32x4 v0 = acc[ai][bj][m][0], v1 = acc[ai][bj][m][1];
                    u32x4 w; w.x = cvt_pk_bf16(v0[0], v0[1]); w.y = cvt_pk_bf16(v0[2], v0[3]); w.z = cvt_pk_bf16(v1[0], v1[1]); w.w = cvt_pk_bf16(v1[2], v1[3]);
                    if (cb == 9) *(u32x4*)(VB + (size_t)(row + kroff) * 128 + cin) = w;
                    if (mode == 0) { *(u32x4*)(base + (size_t)(row + radd) * pitch + col) = w; }
                    else {
                        bf16_t* p = base + ((size_t)(b * nhv + (hd >> 6)) * 64 + (hd & 63)) * KEYS + (row + kroff - b * KEYS);
                        p[0 * KEYS] = (bf16_t)(w.x & 0xffffu); p[1 * KEYS] = (bf16_t)(w.x >> 16); p[2 * KEYS] = (bf16_t)(w.y & 0xffffu); p[3 * KEYS] = (bf16_t)(w.y >> 16);
                        p[4 * KEYS] = (bf16_t)(w.z & 0xffffu); p[5 * KEYS] = (bf16_t)(w.z >> 16); p[6 * KEYS] = (bf16_t)(w.w & 0xffffu); p[7 * KEYS] = (bf16_t)(w.w >> 16);
                    }
                }
        }
    }
};
__device__ __forceinline__ float bf2f(unsigned h) { return __uint_as_float(h << 16); }
struct EpiGate {
    static constexpr bool PERM = true;
    bf16_t* PG;
    static __device__ __forceinline__ unsigned gate2(unsigned g, float a0, float a1) {
        const float g0 = bf2f(g & 0xffffu), g1 = bf2f(g >> 16);
        const float s0 = __builtin_amdgcn_rcpf(1.0f + __builtin_amdgcn_exp2f(-LOG2E * g0)), s1 = __builtin_amdgcn_rcpf(1.0f + __builtin_amdgcn_exp2f(-LOG2E * g1));
        return cvt_pk_bf16(a0 * s0, a1 * s1);
    }
    __device__ __forceinline__ void operator()(const f32x4 (&acc)[2][2][4][2], const Unit& u, int wr, int wc, int fr, int fq) const {
        const int row0 = u.pm * 256 + wr * 64 + fr, col0 = u.pn * 256 + wc * 32 + 8 * fq;
        bf16_t* pb = PG + (size_t)row0 * 3072 + col0;
#pragma unroll
        for (int ai = 0; ai < 2; ++ai)
#pragma unroll
            for (int m = 0; m < 4; ++m)
#pragma unroll
                for (int bj = 0; bj < 2; ++bj) {
                    u32x4* p = (u32x4*)(pb + (size_t)(ai * 128 + m * 16) * 3072 + bj * 128);
                    const u32x4 gq = *p; const f32x4 v0 = acc[ai][bj][m][0], v1 = acc[ai][bj][m][1];
                    u32x4 w; w.x = gate2(gq.x, v0[0], v0[1]); w.y = gate2(gq.y, v0[2], v0[3]); w.z = gate2(gq.z, v1[0], v1[1]); w.w = gate2(gq.w, v1[2], v1[3]);
                    *p = w;
                    asm volatile("" ::: "memory");
                }
    }
};
template <int ACT  > struct EpiBf16 {
    static constexpr bool PERM = true;
    bf16_t* O; int ldc;
    __device__ __forceinline__ void operator()(const f32x4 (&acc)[2][2][4][2], const Unit& u, int wr, int wc, int fr, int fq) const {
        const int row0 = u.pm * 256 + wr * 64 + fr, col0 = u.pn * 256 + wc * 32 + 8 * fq;
#pragma unroll
        for (int ai = 0; ai < 2; ++ai)
#pragma unroll
            for (int m = 0; m < 4; ++m)
#pragma unroll
                for (int bj = 0; bj < 2; ++bj) {
                    f32x4 v0 = acc[ai][bj][m][0], v1 = acc[ai][bj][m][1];
                    if (ACT == 1) {
#pragma unroll
                        for (int e = 0; e < 4; ++e) { const float a = fmaxf(v0[e], 0.f), c = fmaxf(v1[e], 0.f); v0[e] = a * a; v1[e] = c * c; }
                    }
                    u32x4 w; w.x = cvt_pk_bf16(v0[0], v0[1]); w.y = cvt_pk_bf16(v0[2], v0[3]); w.z = cvt_pk_bf16(v1[0], v1[1]); w.w = cvt_pk_bf16(v1[2], v1[3]);
                    *(u32x4*)(O + (size_t)(row0 + ai * 128 + m * 16) * ldc + col0 + bj * 128) = w;
                }
    }
};
struct EpiF32 {
    static constexpr bool PERM = true;
    float* O; int ldc;
    __device__ __forceinline__ void operator()(const f32x4 (&acc)[2][2][4][2], const Unit& u, int wr, int wc, int fr, int fq) const {
        const int row0 = u.pm * 256 + wr * 64 + fr, col0 = u.pn * 256 + wc * 32 + 8 * fq;
#pragma unroll
        for (int ai = 0; ai < 2; ++ai)
#pragma unroll
            for (int m = 0; m < 4; ++m)
#pragma unroll
                for (int bj = 0; bj < 2; ++bj) {
                    float* p = O + (size_t)(row0 + ai * 128 + m * 16) * ldc + col0 + bj * 128;
                    *(f32x4*)p = acc[ai][bj][m][0]; *(f32x4*)(p + 4) = acc[ai][bj][m][1];
                }
    }
};

__device__ __forceinline__ float wave_sum(float v) {
#pragma unroll
    for (int o = 1; o < 64; o <<= 1) v += __shfl_xor(v, o);
    return v;
}
__device__ __forceinline__ unsigned f2bf(float f) { unsigned u = __builtin_bit_cast(unsigned, f); return (u + 0x7fffu + ((u >> 16) & 1u)) >> 16; }
__device__ __forceinline__ unsigned pk2(float lo, float hi) { return f2bf(lo) | (f2bf(hi) << 16); }

__device__ __forceinline__ void transpose_item(const float* W, int K, int N, bf16_t* WT, int ldk, int row_off, int copies, int copy_stride, LAS float* scr, int item, int lane) {
    const int nblk = N / 32, kb = item / nblk, nb = item % nblk, k0 = 64 * kb, n0 = 32 * nb;
#pragma unroll 8
    for (int i = 0; i < 32; ++i) { const int kk = 2 * i + (lane >> 5); scr[kk * 33 + (lane & 31)] = W[(size_t)(k0 + kk) * N + n0 + (lane & 31)]; }
    asm volatile("s_waitcnt lgkmcnt(0)" ::: "memory");
    const int c = lane & 7;
#pragma unroll
    for (int j = 0; j < 4; ++j) { const int n = (lane >> 3) + 8 * j; const LAS float* s = scr + (8 * c) * 33 + n;
        u32x4 o; o.x = pk2(s[0 * 33], s[1 * 33]); o.y = pk2(s[2 * 33], s[3 * 33]); o.z = pk2(s[4 * 33], s[5 * 33]); o.w = pk2(s[6 * 33], s[7 * 33]);
        for (int cc = 0; cc < copies; ++cc) *(u32x4*)(WT + (size_t)(row_off + n0 + n) * ldk + cc * copy_stride + k0 + 8 * c) = o; }
    asm volatile("s_waitcnt lgkmcnt(0)" ::: "memory");
}

struct Args { const float* in[21]; float* out; unsigned char* ws; int pad0, pad1; };
typedef const __attribute__((address_space(4))) Args* KAP;
#define KARGS() ({ KAP p_ = (KAP)__builtin_amdgcn_kernarg_segment_ptr(); asm volatile("" : "+s"(p_)); p_; })

__device__ __forceinline__ void conv_weights(KAP ap, int l, LAS unsigned char* lds, int gw, int NGW, int wave, int lane) {
    unsigned char* ws = ap->ws;
    LAS float* scr = (LAS float*)(lds + wave * 16384);
    constexpr int I_IN = 16 * (NIN / 32), I_BR = 6 * 32, I_OUT = 16 * 32, I_1 = 16 * (FF / 32), I_2 = (FF / 64) * 32;
    constexpr int NITEMS = I_IN + 3 * I_BR + I_OUT + I_1 + I_2;
    for (int it = gw; it < NITEMS; it += NGW) {
        int r = it;
        if (r < I_IN) { transpose_item(ap->in[8] + (size_t)l * DM * NIN, DM, NIN, (bf16_t*)(ws + WS_WIN), DM, 0, 1, 0, scr, r, lane); continue; } r -= I_IN;
        if (r < I_BR) { transpose_item(ap->in[13] + (size_t)l * 384 * DM, 384, DM, (bf16_t*)(ws + WS_WBR), 384, 0, 1, 0, scr, r, lane); continue; } r -= I_BR;
        if (r < I_BR) { transpose_item(ap->in[14] + (size_t)l * 384 * DM, 384, DM, (bf16_t*)(ws + WS_WBR), 384, 1024, 1, 0, scr, r, lane); continue; } r -= I_BR;
        if (r < I_BR) { transpose_item(ap->in[15] + (size_t)l * 384 * DM, 384, DM, (bf16_t*)(ws + WS_WBR), 384, 2048, 1, 0, scr, r, lane); continue; } r -= I_BR;
        if (r < I_OUT) { transpose_item(ap->in[16] + (size_t)l * DM * DM, DM, DM, (bf16_t*)(ws + WS_WOUT), 3072, 0, 3, 1024, scr, r, lane); continue; } r -= I_OUT;
        if (r < I_1) { transpose_item(ap->in[19] + (size_t)l * DM * FF, DM, FF, (bf16_t*)(ws + WS_W1), DM, 0, 1, 0, scr, r, lane); continue; } r -= I_1;
        transpose_item(ap->in[20] + (size_t)l * FF * DM, FF, DM, (bf16_t*)(ws + WS_W2), FF, 0, 1, 0, scr, r, lane);
    }
    u32x4* pad = (u32x4*)(ws + WS_WIN + (size_t)NIN * DM * 2);
    unsigned z0 = 0u; asm volatile("" : "+v"(z0));
    for (int i = gw * 64 + lane; i < (NINP - NIN) * DM * 2 / 16; i += NGW * 64) pad[i] = (u32x4){z0, z0, z0, z0};
}

__device__ __forceinline__ void ada_phase(KAP ap, int gw, int NGW, int lane) {
    float* mods = (float*)(ap->ws + WS_MODS);
    const float* c = ap->in[1]; const float* cc = ap->in[3];
    for (int t = gw; t < DEPTH * 16 * 24; t += NGW) {
        const int l = t / (16 * 24), kc = (t / 24) % 16, jc = t % 24, col = jc * 256 + lane * 4;
        const float* W = ap->in[4] + ((size_t)l * DM + kc * 64) * 6144 + col;
        f32x4 s0 = {0.f, 0.f, 0.f, 0.f}, s1 = s0, s2 = s0;
        for (int k = 0; k < 64; ++k) {
            const f32x4 w = *(const f32x4*)(W + (size_t)k * 6144);
            const float x0 = c[kc * 64 + k], x1 = c[DM + kc * 64 + k], x2 = cc[kc * 64 + k];
            const float a0 = x0 / (1.f + __expf(-x0)), a1 = x1 / (1.f + __expf(-x1)), a2 = x2 / (1.f + __expf(-x2));
            s0 += w * a0; s1 += w * a1; s2 += w * a2;
        }
        if (kc == 0) { const f32x4 bb = *(const f32x4*)(ap->in[5] + (size_t)l * 6144 + col); s0 += bb; s1 += bb; s2 += bb; }
        float* m0 = mods + (size_t)(l * 3) * 6144 + col;
#pragma unroll
        for (int e = 0; e < 4; ++e) { atomicAdd(m0 + e, s0[e]); atomicAdd(m0 + 6144 + e, s1[e]); atomicAdd(m0 + 2 * 6144 + e, s2[e]); }
    }
}

__device__ __forceinline__ void row_phase(int gw, int NGW, int lane, int nrows, const float* Y, const float* gainY, const float* modsG, int gate_off,
                                          const float* rin_lat, const float* rin_ctx, float* rout_lat, float* rout_ctx,
                                          bf16_t* H, const float* gainH, const float* modsH, int shift_off, int scale_off) {
    for (int m = gw; m < nrows; m += NGW) {
        const int v = m < MLAT ? (m >> 13) : 2;
        const size_t roff = m < MLAT ? (size_t)m * DM : (size_t)(m - MLAT) * DM;
        const f32x4* xr = (const f32x4*)((m < MLAT ? rin_lat : rin_ctx) + roff) + lane;
        f32x4 x[4];
#pragma unroll
        for (int j = 0; j < 4; ++j) x[j] = xr[64 * j];
        if (Y) {
            const f32x4* yr = (const f32x4*)(Y + (size_t)m * DM) + lane;
            f32x4 y[4]; float ss = 0.f;
#pragma unroll
            for (int j = 0; j < 4; ++j) { y[j] = yr[64 * j]; ss += (y[j].x * y[j].x + y[j].y * y[j].y) + (y[j].z * y[j].z + y[j].w * y[j].w); }
            const float rstd = rsqrtf(wave_sum(ss) * (1.f / DM) + EPS);
            const f32x4* gy = (const f32x4*)gainY + lane; const f32x4* gt = (const f32x4*)(modsG + (size_t)v * 6144 + gate_off) + lane;
            f32x4* ro = (f32x4*)((m < MLAT ? rout_lat : rout_ctx) + roff) + lane;
#pragma unroll
            for (int j = 0; j < 4; ++j) { x[j] = x[j] + gt[64 * j] * (y[j] * rstd * gy[64 * j]); ro[64 * j] = x[j]; }
        }
        if (H) {
            float ss = 0.f;
#pragma unroll
            for (int j = 0; j < 4; ++j) ss += (x[j].x * x[j].x + x[j].y * x[j].y) + (x[j].z * x[j].z + x[j].w * x[j].w);
            const float rstd = rsqrtf(wave_sum(ss) * (1.f / DM) + EPS);
            const f32x4* gh = (const f32x4*)gainH + lane; const f32x4* sh = (const f32x4*)(modsH + (size_t)v * 6144 + shift_off) + lane; const f32x4* sc = (const f32x4*)(modsH + (size_t)v * 6144 + scale_off) + lane;
            u32x2* ho = (u32x2*)(H + (size_t)m * DM) + lane;
#pragma unroll
            for (int j = 0; j < 4; ++j) { const f32x4 h = (x[j] * rstd * gh[64 * j]) * (sc[64 * j] + 1.0f) + sh[64 * j]; u32x2 w; w.x = pk2(h.x, h.y); w.y = pk2(h.z, h.w); ho[64 * j] = w; }
        }
    }
}

__device__ __forceinline__ void post_phase(KAP ap, int l, int gw, int NGW, int lane) {
    bf16_t* Q = (bf16_t*)(ap->ws + WS_Q); bf16_t* KAB = (bf16_t*)(ap->ws + WS_KAB);
    const float* rope = (const float*)(ap->ws + WS_ROPE);
    const float* qn = ap->in[10] + l * 64; const float* kn = ap->in[11] + l * 64;
    const int p = lane & 31, hh = lane >> 5;
    for (int m = gw; m < MALL; m += NGW) {
        const bool lat = m < MLAT; const int s = m & (SEQ - 1);
        float cs = 1.f, sn = 0.f;
        if (lat) { const int pos = p < 16 ? (s >> 6) : (s & 63); const float* t = rope + (pos * 16 + (p & 15)) * 2; cs = t[0]; sn = t[1]; }
        const int kr = lat ? m + 256 * (m >> 13) + 256 : ((m - MLAT) >> 8) * KEYS + ((m - MLAT) & 255);
#pragma unroll 1
        for (int it = 0; it < 11; ++it) {
            const int head = it * 2 + hh;
            unsigned* ptr; bool norm, rot, scl; const float* gn;
            if (head < 18) { ptr = (unsigned*)(Q + (size_t)m * QW + head * 64) + p; norm = (head >= 6 && head < 12); rot = head < 12; scl = true; gn = qn; }
            else { ptr = (unsigned*)(KAB + (size_t)kr * 256 + (head - 18) * 64) + p; norm = head >= 20; rot = true; scl = false; gn = kn; }
            const unsigned w = *ptr; float x0 = bf2f(w & 0xffffu), x1 = bf2f(w >> 16);
            float ss = x0 * x0 + x1 * x1;
#pragma unroll
            for (int o = 1; o < 32; o <<= 1) ss += __shfl_xor(ss, o);
            if (norm) { const float rstd = rsqrtf(ss * (1.f / 64.f) + EPS); x0 = x0 * rstd * gn[2 * p]; x1 = x1 * rstd * gn[2 * p + 1]; }
            if (rot) { const float y0 = x0 * cs - x1 * sn, y1 = x0 * sn + x1 * cs; x0 = y0; x1 = y1; }
            if (scl) { x0 *= QSCALE; x1 *= QSCALE; }
            *ptr = pk2(x0, x1);
        }
    }
}

#include <hip/hip_bf16.h>
#include <cmath>
namespace attn_body {
using bf16=__hip_bfloat16;
using bf16x8=__attribute__((ext_vector_type(8)))short;
using s16x4=__attribute__((ext_vector_type(4)))short;
using f32x16=__attribute__((ext_vector_type(16)))float;
using u32x4=__attribute__((ext_vector_type(4)))unsigned;
constexpr int D=64,QP=1152,KP=256,VP=128;
constexpr int NW=8,QBLK=32,QB=QBLK*NW,KVBLK=64;
__device__ __forceinline__ int crow(int r,int hi){return (r&3)+8*(r>>2)+4*hi;}
#define SBAR() __builtin_amdgcn_sched_barrier(0)
constexpr int NSLOT=3, SLOTB=8192;
constexpr int LDS_K=0, LDS_V=NSLOT*SLOTB, LDS_WS=2*NSLOT*SLOTB, LDS_OST=LDS_WS+NW*64*4, LDS_BYTES=LDS_OST+NW*4096;
constexpr float C2=0.125f*1.4426950408889634f;
__device__ __forceinline__ void glds16(const void*gsrc,unsigned lds_dst){unsigned keep;
  asm volatile("s_mov_b32 %0, m0\n\ts_mov_b32 m0, %2\n\ts_nop 0\n\tglobal_load_lds_dwordx4 %1, off\n\ts_mov_b32 m0, %0":"=&s"(keep):"v"(gsrc),"s"(lds_dst):"memory");}
__device__ __forceinline__ float max3f(float a,float b,float c){float r;asm("v_max3_f32 %0, %1, %2, %3":"=v"(r):"v"(a),"v"(b),"v"(c));return r;}
__device__ __forceinline__ float max2f(float a,float b){float r;asm("v_max_f32_e32 %0, %1, %2":"=v"(r):"v"(a),"v"(b));return r;}
__device__ __forceinline__ float fadd_s(float a,float b){float r;asm("v_add_f32_e32 %0, %1, %2":"=v"(r):"v"(a),"v"(b));return r;}
__device__ __forceinline__ float fsub_s(float a,float b){float r;asm("v_sub_f32_e32 %0, %1, %2":"=v"(r):"v"(a),"v"(b));return r;}
typedef float f32x2_t __attribute__((ext_vector_type(2))); typedef __bf16 bf16x2_t __attribute__((ext_vector_type(2)));
__device__ __forceinline__ unsigned cvtpk_s(float lo,float hi){f32x2_t v={lo,hi};bf16x2_t b=__builtin_convertvector(v,bf16x2_t);return __builtin_bit_cast(unsigned,b);}
#define WAIT_BAR(N) asm volatile("s_waitcnt vmcnt(" #N ") lgkmcnt(0)\n\ts_barrier":::"memory")

__device__ __forceinline__ void qkt(f32x16&p0,f32x16&p1,const char*Kslot,const bf16x8*qr,int r32,int hi){ const f32x16 negm={};
  const char*kb=Kslot+hi*1024+r32*16;
  #pragma unroll
  for(int d0=0;d0<4;++d0){
    const bf16x8 b0=*reinterpret_cast<const bf16x8*>(kb+d0*2048);
    const bf16x8 b1=*reinterpret_cast<const bf16x8*>(kb+d0*2048+512);
    if(d0==0){p0=__builtin_amdgcn_mfma_f32_32x32x16_bf16(b0,qr[0],negm,0,0,0);p1=__builtin_amdgcn_mfma_f32_32x32x16_bf16(b1,qr[0],negm,0,0,0);}
    else{p0=__builtin_amdgcn_mfma_f32_32x32x16_bf16(b0,qr[d0],p0,0,0,0);p1=__builtin_amdgcn_mfma_f32_32x32x16_bf16(b1,qr[d0],p1,0,0,0);}}
}
typedef __attribute__((address_space(3))) const char* lds_cptr;
typedef short v4i16_t __attribute__((ext_vector_type(4)));
__device__ __forceinline__ void kload8(bf16x8*kf,lds_cptr kp){
  kf[0]=*(const __attribute__((address_space(3))) bf16x8*)(kp);      kf[1]=*(const __attribute__((address_space(3))) bf16x8*)(kp+512);
  kf[2]=*(const __attribute__((address_space(3))) bf16x8*)(kp+2048); kf[3]=*(const __attribute__((address_space(3))) bf16x8*)(kp+2560);
  kf[4]=*(const __attribute__((address_space(3))) bf16x8*)(kp+4096); kf[5]=*(const __attribute__((address_space(3))) bf16x8*)(kp+4608);
  kf[6]=*(const __attribute__((address_space(3))) bf16x8*)(kp+6144); kf[7]=*(const __attribute__((address_space(3))) bf16x8*)(kp+6656);
}
__device__ __forceinline__ void kload2(bf16x8*kf,lds_cptr kp,int j){ kf[2*j]=*(const __attribute__((address_space(3))) bf16x8*)(kp+j*2048); kf[2*j+1]=*(const __attribute__((address_space(3))) bf16x8*)(kp+j*2048+512); }
__device__ __forceinline__ s16x4 vtr(lds_cptr p){ return __builtin_bit_cast(s16x4,__builtin_amdgcn_ds_read_tr16_b64_v4i16((__attribute__((address_space(3))) v4i16_t*)p)); }
__device__ __forceinline__ float rowmax(const f32x16&p0,const f32x16&p1){
  float a=max3f(p0[0],p0[1],p1[0]),b=max3f(p0[2],p0[3],p1[1]);a=max3f(a,p1[2],p1[3]);
  #pragma unroll
  for(int r=4;r<16;r+=4){a=max3f(a,p0[r],p0[r+1]);b=max3f(b,p0[r+2],p0[r+3]);a=max3f(a,p1[r],p1[r+1]);b=max3f(b,p1[r+2],p1[r+3]);}
  const float m=max2f(a,b);
  auto rr=__builtin_amdgcn_permlane32_swap(__float_as_uint(m),__float_as_uint(m),false,false);
  return max2f(__uint_as_float(rr[0]),__uint_as_float(rr[1]));
}
__device__ __forceinline__ void pv(f32x16*o,int vb,bf16x8 pa0,bf16x8 pa1,bf16x8 pa2,bf16x8 pa3){
  #pragma unroll
  for(int d0=0;d0<2;++d0){s16x4 lo[4],hi[4];
    #pragma unroll
    for(int ks=0;ks<4;++ks){
      asm volatile("ds_read_b64_tr_b16 %0,%1 offset:%c2":"=&v"(lo[ks]):"v"(vb),"i"(d0*4096+ks*1024):"memory");
      asm volatile("ds_read_b64_tr_b16 %0,%1 offset:%c2":"=&v"(hi[ks]):"v"(vb),"i"(d0*4096+ks*1024+512):"memory");}
    asm volatile("s_waitcnt lgkmcnt(0)":::"memory");SBAR();
    #define PK(k) (bf16x8){lo[k][0],lo[k][1],lo[k][2],lo[k][3],hi[k][0],hi[k][1],hi[k][2],hi[k][3]}
    o[d0]=__builtin_amdgcn_mfma_f32_32x32x16_bf16(pa0,PK(0),o[d0],0,0,0);
    o[d0]=__builtin_amdgcn_mfma_f32_32x32x16_bf16(pa1,PK(1),o[d0],0,0,0);
    o[d0]=__builtin_amdgcn_mfma_f32_32x32x16_bf16(pa2,PK(2),o[d0],0,0,0);
    o[d0]=__builtin_amdgcn_mfma_f32_32x32x16_bf16(pa3,PK(3),o[d0],0,0,0);
    #undef PK
  }
}

#ifndef ATTN_STORE16
#define ATTN_STORE16(p,v) (*(u32x4*)(p)=(v))
#endif
template<int THRL> __device__ __forceinline__ void attn_unit(const bf16*Qb,const bf16*__restrict__ Kh,const bf16*__restrict__ Vh,bf16*Ob,int NT,char*shm){
  const int tid=threadIdx.x,lane=tid&63,r32=lane&31,hi=lane>>5; const int wid=__builtin_amdgcn_readfirstlane(tid>>6);
  const bf16*Qw=Qb+(long)(wid*QBLK)*QP;
  const unsigned lds0=(unsigned)(uintptr_t)shm;
  float*wsf=(float*)(shm+LDS_WS)+wid*64;
  const bf16*ksrc=Kh+(long)lane*KP+wid*8;
  const bf16*vsrc=Vh+(long)(16*(wid&3)+(lane>>2))*VP+(wid>>2)*32+(lane&3)*8;
  const unsigned kdst=lds0+LDS_K+wid*1024, vdst=lds0+LDS_V+wid*1024;
  #define DMA_K(t,slot) glds16(ksrc+(long)(t)*KVBLK*KP,(unsigned)__builtin_amdgcn_readfirstlane(kdst+(slot)))
  #define DMA_V(t,slot) glds16(vsrc+(long)(t)*KVBLK*VP,(unsigned)__builtin_amdgcn_readfirstlane(vdst+(slot)))
  const int vb0=(int)(lds0+LDS_V)+((lane>>4)&1)*32+(lane&3)*8+(4*hi+((lane&15)>>2))*64;
  const char*Kbase=shm+LDS_K; bf16x8 kf[8];
  const lds_cptr shm3=(lds_cptr)shm; const lds_cptr kp0=shm3+LDS_K+hi*1024+r32*16; const lds_cptr vp0=shm3+LDS_V+((lane>>4)&1)*32+(lane&3)*8+(4*hi+((lane&15)>>2))*64;
  DMA_K(0,0);DMA_V(0,0);DMA_K(1,SLOTB);
  bf16x8 qr[4];
  #pragma unroll
  for(int d0=0;d0<4;++d0)qr[d0]=*reinterpret_cast<const bf16x8*>(&Qw[(long)r32*QP+d0*16+hi*8]);
  float mhat=0.f,l_reg=0.f;f32x16 o[2];o[0]=f32x16{};o[1]=f32x16{};
  #define CMASK(P0,P1,t) do{}while(0)
  bool resc=false;
  #define START(P0,P1) do{ const float rm=rowmax(P0,P1); resc=false; \
    { const float dl=rm; mhat=fadd_s(mhat,dl); \
      _Pragma("unroll") for(int r=0;r<16;++r){P0[r]=fsub_s(P0[r],dl);P1[r]=fsub_s(P1[r],dl);} } \
    _Pragma("unroll") for(int r=0;r<16;++r)P0[r]=__builtin_amdgcn_exp2f(P0[r]); }while(0)
  #define RESC() do{ if(resc){ asm volatile("s_waitcnt lgkmcnt(0)":::"memory"); \
      _Pragma("unroll") for(int d_=0;d_<2;++d_) _Pragma("unroll") for(int r=0;r<16;++r)o[d_][r]*=wsf[crow(r,hi)]; } }while(0)
  f32x16 pA0,pA1,pB0,pB1;
  int sl_prev=0,sl_cur=0,sl_next=SLOTB;
  #define ROT() do{sl_prev=sl_cur;sl_cur=sl_next;sl_next=(sl_next==(NSLOT-1)*SLOTB)?0:sl_next+SLOTB;}while(0)
  DMA_K(2,2*SLOTB);
  WAIT_BAR(3);
  qkt(pA0,pA1,Kbase,qr,r32,hi);asm volatile("s_nop 15\n\ts_nop 7":"+v"(pA0),"+v"(pA1));CMASK(pA0,pA1,0);
  START(pA0,pA1);
  _Pragma("unroll") for(int r=0;r<16;++r)pA1[r]=__builtin_amdgcn_exp2f(pA1[r]);
  WAIT_BAR(0);
  DMA_K(3,0);DMA_V(1,SLOTB);
  ROT();
  kload8(kf,kp0+sl_cur);
  WAIT_BAR(2);
  s16x4 vlo[8],vhi[8]; u32x4 pw0,pw1,pw2,pw3;
  #define PKW(P,B) cvtpk_s(P[B],P[B+1])
  #define PAF(k) __builtin_bit_cast(bf16x8,pw##k)
  #define VFR(i) (bf16x8){vlo[i][0],vlo[i][1],vlo[i][2],vlo[i][3],vhi[i][0],vhi[i][1],vhi[i][2],vhi[i][3]}
  #define PIN(x) asm volatile("":"+v"(x))
  #define MX3(a,b,c) __builtin_fmaxf(__builtin_fmaxf((a),(b)),(c))
  #define GAPA(MF,A0,A1,A2,A3,W0,W1,PW) do{ MF; sacc+=A0; sacc+=A1; sacc+=A2; sacc+=A3; PIN(sacc); W0; W1; PIN(PW); SBAR(); }while(0)
  #define EX(v) __builtin_amdgcn_exp2f(v)
  #define GAPB(MF,X,B) do{ MF; X[B]=EX(X[B]); X[B+1]=EX(X[B+1]); X[B+2]=EX(X[B+2]); X[B+3]=EX(X[B+3]); PIN(X); SBAR(); }while(0)
  #define VRD(i) do{ vlo[i]=vtr(vp_+(((i)>>2)*4096+((i)&3)*1024)); vhi[i]=vtr(vp_+(((i)>>2)*4096+((i)&3)*1024+512)); }while(0)
  #define KRD(G,j) do{ if(G){ kload2(kf,kp0+sl_next,j); SBAR(); } }while(0)
  #define STEP(C0,C1,P0,P1,t,GK,GV,GL) do{ SBAR(); \
    const lds_cptr vp_=vp0+sl_prev; \
    VRD(0); SBAR(); float sacc=(P0[0]+P0[1]); \
    GAPA(C0=__builtin_amdgcn_mfma_f32_32x32x16_bf16(kf[0],qr[0],(f32x16){},0,0,0), P0[2],P0[3],P0[4],P0[5],     pw0[0]=PKW(P0,0), pw0[1]=PKW(P0,2), pw0); \
    VRD(4); SBAR(); GAPA(C1=__builtin_amdgcn_mfma_f32_32x32x16_bf16(kf[1],qr[0],(f32x16){},0,0,0), P0[6],P0[7],P0[8],P0[9],     pw0[2]=PKW(P0,4), pw0[3]=PKW(P0,6), pw0); \
    VRD(1); SBAR(); GAPA(C0=__builtin_amdgcn_mfma_f32_32x32x16_bf16(kf[2],qr[1],C0,0,0,0),   P0[10],P0[11],P0[12],P0[13], pw1[0]=PKW(P0,8), pw1[1]=PKW(P0,10), pw1); \
    VRD(5); SBAR(); GAPA(C1=__builtin_amdgcn_mfma_f32_32x32x16_bf16(kf[3],qr[1],C1,0,0,0),   P0[14],P0[15],P1[0],P1[1],   pw1[2]=PKW(P0,12),pw1[3]=PKW(P0,14), pw1); \
    VRD(2); SBAR(); GAPA(C0=__builtin_amdgcn_mfma_f32_32x32x16_bf16(kf[4],qr[2],C0,0,0,0),   P1[2],P1[3],P1[4],P1[5],     pw2[0]=PKW(P1,0), pw2[1]=PKW(P1,2), pw2); \
    VRD(6); SBAR(); GAPA(C1=__builtin_amdgcn_mfma_f32_32x32x16_bf16(kf[5],qr[2],C1,0,0,0),   P1[6],P1[7],P1[8],P1[9],     pw2[2]=PKW(P1,4), pw2[3]=PKW(P1,6), pw2); \
    VRD(3); SBAR(); GAPA(C0=__builtin_amdgcn_mfma_f32_32x32x16_bf16(kf[6],qr[3],C0,0,0,0),   P1[10],P1[11],P1[12],P1[13], pw3[0]=PKW(P1,8), pw3[1]=PKW(P1,10), pw3); \
    VRD(7); SBAR(); GAPA(C1=__builtin_amdgcn_mfma_f32_32x32x16_bf16(kf[7],qr[3],C1,0,0,0),   P1[14],P1[15],0.f,0.f,       pw3[2]=PKW(P1,12),pw3[3]=PKW(P1,14), pw3); \
    l_reg+=sacc; \
    { _Pragma("unroll") for(int r=0;r<16;++r){C0[r]-=mhat;C1[r]-=mhat;} } \
    if(GK){DMA_K((t)+3,sl_cur);} if(GV){DMA_V((t)+1,sl_next);} \
    CMASK(C0,C1,t); \
    { float a=MX3(C0[0],C0[1],C1[0]),b=MX3(C0[2],C0[3],C1[1]); a=MX3(a,C1[2],C1[3]); \
      _Pragma("unroll") for(int r=4;r<16;r+=4){a=MX3(a,C0[r],C0[r+1]);b=MX3(b,C0[r+2],C0[r+3]);a=MX3(a,C1[r],C1[r+1]);b=MX3(b,C1[r+2],C1[r+3]);} \
      float rm=__builtin_fmaxf(a,b); { auto rr=__builtin_amdgcn_permlane32_swap(__float_as_uint(rm),__float_as_uint(rm),false,false); rm=__builtin_fmaxf(__uint_as_float(rr[0]),__uint_as_float(rr[1])); } \
      resc=false; \
      if(__builtin_expect(__any(rm>(float)THRL),0)){ const float dl=__builtin_fmaxf(rm,0.f); mhat+=dl; \
        _Pragma("unroll") for(int r=0;r<16;++r){C0[r]-=dl;C1[r]-=dl;} \
        const float f=__builtin_amdgcn_exp2f(-dl); l_reg*=f; if(hi==0)wsf[r32]=f; resc=true; } } \
    SBAR(); \
    GAPB(o[0]=__builtin_amdgcn_mfma_f32_32x32x16_bf16(PAF(0),VFR(0),o[0],0,0,0), C0,0); \
    GAPB(o[1]=__builtin_amdgcn_mfma_f32_32x32x16_bf16(PAF(0),VFR(4),o[1],0,0,0), C0,4); \
    KRD(GL,0); GAPB(o[0]=__builtin_amdgcn_mfma_f32_32x32x16_bf16(PAF(1),VFR(1),o[0],0,0,0), C0,8); \
    KRD(GL,1); GAPB(o[1]=__builtin_amdgcn_mfma_f32_32x32x16_bf16(PAF(1),VFR(5),o[1],0,0,0), C0,12); \
    KRD(GL,2); GAPB(o[0]=__builtin_amdgcn_mfma_f32_32x32x16_bf16(PAF(2),VFR(2),o[0],0,0,0), C1,0); \
    KRD(GL,3); GAPB(o[1]=__builtin_amdgcn_mfma_f32_32x32x16_bf16(PAF(2),VFR(6),o[1],0,0,0), C1,4); \
    GAPB(o[0]=__builtin_amdgcn_mfma_f32_32x32x16_bf16(PAF(3),VFR(3),o[0],0,0,0), C1,8); \
    GAPB(o[1]=__builtin_amdgcn_mfma_f32_32x32x16_bf16(PAF(3),VFR(7),o[1],0,0,0), C1,12); \
    }while(0)
  int t=1;
  for(;t+5<NT;t+=2){
    STEP(pB0,pB1,pA0,pA1,t,true,true,true);     WAIT_BAR(2); RESC(); ROT();
    STEP(pA0,pA1,pB0,pB1,t+1,true,true,true);   WAIT_BAR(2); RESC(); ROT();
  }
  #define ENDW(tt) do{ if((tt)+3<NT){WAIT_BAR(2);} else if((tt)+2<NT){WAIT_BAR(1);} else {WAIT_BAR(0);} }while(0)
  for(;t+1<NT;t+=2){
    STEP(pB0,pB1,pA0,pA1,t,(t+3<NT),(t+1<NT),(t+1<NT));       ENDW(t);   RESC(); ROT();
    STEP(pA0,pA1,pB0,pB1,t+1,(t+4<NT),(t+2<NT),(t+2<NT));     ENDW(t+1); RESC(); ROT();
  }
  STEP(pB0,pB1,pA0,pA1,NT-1,false,false,false); RESC();
  { float sacc=pB0[0]+pB0[1]; _Pragma("unroll") for(int r=2;r<16;++r)sacc+=pB0[r]; _Pragma("unroll") for(int r=0;r<16;++r)sacc+=pB1[r]; l_reg+=sacc;
    pw0=(u32x4){PKW(pB0,0),PKW(pB0,2),PKW(pB0,4),PKW(pB0,6)};pw1=(u32x4){PKW(pB0,8),PKW(pB0,10),PKW(pB0,12),PKW(pB0,14)};pw2=(u32x4){PKW(pB1,0),PKW(pB1,2),PKW(pB1,4),PKW(pB1,6)};pw3=(u32x4){PKW(pB1,8),PKW(pB1,10),PKW(pB1,12),PKW(pB1,14)};
    SBAR(); pv(o,vb0+sl_cur,PAF(0),PAF(1),PAF(2),PAF(3)); }
  #undef PKW
  #undef PAF
  #undef VFR
  #undef PIN
  #undef MX3
  #undef GAPA
  #undef GAPB
  #undef EX
  #undef VRD
  #undef KRD
  #undef STEP
  #undef ENDW
  {auto rr=__builtin_amdgcn_permlane32_swap(__float_as_uint(l_reg),__float_as_uint(l_reg),false,false);l_reg=__uint_as_float(rr[0])+__uint_as_float(rr[1]);}
  if(hi==0)wsf[32+r32]=l_reg;asm volatile("s_waitcnt lgkmcnt(0)":::"memory");
  float rli[16];
  #pragma unroll
  for(int r=0;r<16;++r)rli[r]=__builtin_amdgcn_rcpf(wsf[32+crow(r,hi)]);
  bf16*Ow=Ob+(long)(wid*QBLK)*QP;
  { bf16*stg=(bf16*)(shm+LDS_OST)+wid*2048;
    #pragma unroll
    for(int r=0;r<16;++r){const int orow=crow(r,hi);
      #pragma unroll
      for(int d0=0;d0<2;++d0)stg[orow*64+d0*32+r32]=__float2bfloat16(o[d0][r]*rli[r]);}
    asm volatile("s_waitcnt lgkmcnt(0)":::"memory");
    #pragma unroll
    for(int i=0;i<4;++i){const int row=i*8+(lane>>3),ch=lane&7; const u32x4 v=*(const u32x4*)(stg+row*64+ch*8); ATTN_STORE16(Ow+(long)row*QP+ch*8,v);} }
  asm volatile("s_waitcnt lgkmcnt(0)\n\ts_barrier":::"memory");
  #undef DMA_K
  #undef DMA_V
  #undef CMASK
  #undef START
  #undef RESC
  #undef ROT
}
constexpr int ATTN_LDS_BYTES=LDS_BYTES;
#undef SBAR
#undef WAIT_BAR
}
__device__ __forceinline__ void attn_task(KAP ap, int l, int t, int lane) {
    const unsigned char* ws = ap->ws;
    int type, b, h, j; bool ctxq = false;
    if (t < 6144) { type = t < 3072 ? 2 : 0; const int u = t % 3072; b = u / 1536; h = (u / 256) % 6; j = u % 256; }
    else { const int u = t - 6144; type = u / 96; b = (u / 48) % 2; h = (u / 8) % 6; j = u % 8; ctxq = true; }
    const int r32 = lane & 31, hi = lane >> 5;
    const int m0 = ctxq ? MLAT + b * LCTX + 32 * j : b * SEQ + 32 * j;
    bf16_t* Qp = (bf16_t*)(ws + WS_Q) + (size_t)(m0 + r32) * QW + (type * 6 + h) * 64;
    const bf16_t* Kb; const bf16_t* Vb; int pitchK;
    if (type == 2) { Kb = (const bf16_t*)(ws + WS_KC) + (size_t)b * KEYS * 384 + h * 64; pitchK = 384; Vb = (const bf16_t*)(ws + WS_VTC) + (size_t)(b * 6 + h) * 64 * KEYS; }
    else { const int kvh = h / 3; Kb = (const bf16_t*)(ws + WS_KAB) + (size_t)b * KEYS * 256 + type * 128 + kvh * 64; pitchK = 256; Vb = (const bf16_t*)(ws + WS_VTAB) + (size_t)(b * 4 + type * 2 + kvh) * 64 * KEYS; }
    const int q0 = 32 * j; int nmain = 0, tlo = 0, rs = 0;
    if (!ctxq) {
        if (type == 1) nmain = 128;
        else if (type == 0) { tlo = (q0 - 128) >> 6; if (tlo < 0) tlo = 0; int thi = (q0 + 31 + 128) >> 6; if (thi > 127) thi = 127; nmain = thi - tlo + 1; }
        else { const int r = j >> 1; rs = r - 4; if (rs < 0) rs = 0; if (rs > 120) rs = 120; tlo = rs; nmain = 8; }
    }
    bf16x8 qr[4];
#pragma unroll
    for (int d0 = 0; d0 < 4; ++d0) qr[d0] = *(const bf16x8*)(Qp + d0 * 16 + hi * 8);
    float mrun = -INFINITY, lrun = 0.f;
    if (type == 0) { mrun = ap->in[9][l * 6 + h] * LOG2E; lrun = hi == 0 ? 1.f : 0.f; }
    f32x16 o0 = {}, o1 = {};
    const int rsw = (r32 & ~12) | ((r32 & 4) << 1) | ((r32 & 8) >> 1);
    const float* rpb = ap->in[12] + (size_t)(l * 6 + h) * 15 * 31;
    const int qc = 32 * (j & 1) + r32; int wsn = qc - 8; wsn = wsn < 0 ? 0 : (wsn > 48 ? 48 : wsn);
    const int ntile = 4 + nmain;
#pragma unroll 1
    for (int tt = 0; tt < ntile; ++tt) {
        const int key0 = tt < 4 ? 64 * tt : LCTX + 64 * (tlo + tt - 4);
        const bf16_t* kp = Kb + (size_t)(key0 + rsw) * pitchK + 8 * hi;
        bf16x8 kf0[4], kf1[4];
#pragma unroll
        for (int d0 = 0; d0 < 4; ++d0) { kf0[d0] = *(const bf16x8*)(kp + d0 * 16); kf1[d0] = *(const bf16x8*)(kp + (size_t)32 * pitchK + d0 * 16); }
        const bf16_t* vp = Vb + (size_t)r32 * KEYS + key0 + 8 * hi;
        bf16x8 vf0[4], vf1[4];
#pragma unroll
        for (int ks = 0; ks < 4; ++ks) { vf0[ks] = *(const bf16x8*)(vp + 16 * ks); vf1[ks] = *(const bf16x8*)(vp + (size_t)32 * KEYS + 16 * ks); }
        f32x16 p0 = {}, p1 = {};
#pragma unroll
        for (int d0 = 0; d0 < 4; ++d0) { p0 = __builtin_amdgcn_mfma_f32_32x32x16_bf16(kf0[d0], qr[d0], p0, 0, 0, 0); p1 = __builtin_amdgcn_mfma_f32_32x32x16_bf16(kf1[d0], qr[d0], p1, 0, 0, 0); }
        if (tt >= 4 && type == 0) {
            const int kpos0 = 64 * (tlo + tt - 4) + 8 * hi - (q0 + r32);
#pragma unroll
            for (int r = 0; r < 16; ++r) { const int d0_ = kpos0 + 16 * (r >> 3) + (r & 7); if (d0_ > 128 || d0_ < -128) p0[r] = -INFINITY; const int d1_ = d0_ + 32; if (d1_ > 128 || d1_ < -128) p1[r] = -INFINITY; }
        } else if (tt >= 4 && type == 2) {
            const int ro = (rs + tt - 4) - (j >> 1) + 7;
            const float* rb = rpb + ro * 31 + 15 - qc;
#pragma unroll
            for (int r = 0; r < 16; ++r) {
                const int kc0 = 16 * (r >> 3) + 8 * hi + (r & 7), kc1 = kc0 + 32;
                if (kc0 >= wsn && kc0 < wsn + 16) p0[r] += rb[kc0] * LOG2E; else p0[r] = -INFINITY;
                if (kc1 >= wsn && kc1 < wsn + 16) p1[r] += rb[kc1] * LOG2E; else p1[r] = -INFINITY;
            }
        }
        float rm = fmaxf(p0[0], p1[0]);
#pragma unroll
        for (int r = 1; r < 16; ++r) rm = fmaxf(rm, fmaxf(p0[r], p1[r]));
        rm = fmaxf(rm, __shfl_xor(rm, 32));
        const float mn = fmaxf(mrun, rm);
        const float alpha = __builtin_amdgcn_exp2f(mrun - mn);
        mrun = mn;
        float sum = 0.f;
#pragma unroll
        for (int r = 0; r < 16; ++r) { p0[r] = __builtin_amdgcn_exp2f(p0[r] - mn); p1[r] = __builtin_amdgcn_exp2f(p1[r] - mn); sum += p0[r] + p1[r]; }
        lrun = lrun * alpha + sum;
#pragma unroll
        for (int r = 0; r < 16; ++r) { o0[r] *= alpha; o1[r] *= alpha; }
        bf16x8 pk[4];
#pragma unroll
        for (int ks = 0; ks < 4; ++ks) {
            u32x4 w;
            if (ks < 2) { w.x = cvt_pk_bf16(p0[8 * ks + 0], p0[8 * ks + 1]); w.y = cvt_pk_bf16(p0[8 * ks + 2], p0[8 * ks + 3]); w.z = cvt_pk_bf16(p0[8 * ks + 4], p0[8 * ks + 5]); w.w = cvt_pk_bf16(p0[8 * ks + 6], p0[8 * ks + 7]); }
            else { const int k2 = ks - 2; w.x = cvt_pk_bf16(p1[8 * k2 + 0], p1[8 * k2 + 1]); w.y = cvt_pk_bf16(p1[8 * k2 + 2], p1[8 * k2 + 3]); w.z = cvt_pk_bf16(p1[8 * k2 + 4], p1[8 * k2 + 5]); w.w = cvt_pk_bf16(p1[8 * k2 + 6], p1[8 * k2 + 7]); }
            pk[ks] = __builtin_bit_cast(bf16x8, w);
        }
#pragma unroll
        for (int ks = 0; ks < 4; ++ks) { o0 = __builtin_amdgcn_mfma_f32_32x32x16_bf16(vf0[ks], pk[ks], o0, 0, 0, 0); o1 = __builtin_amdgcn_mfma_f32_32x32x16_bf16(vf1[ks], pk[ks], o1, 0, 0, 0); }
    }
    const float lt = lrun + __shfl_xor(lrun, 32);
    const float inv = 1.0f / lt;
#pragma unroll
    for (int g = 0; g < 4; ++g) {
        u32x2 w0, w1;
        w0.x = cvt_pk_bf16(o0[4 * g + 0] * inv, o0[4 * g + 1] * inv); w0.y = cvt_pk_bf16(o0[4 * g + 2] * inv, o0[4 * g + 3] * inv);
        w1.x = cvt_pk_bf16(o1[4 * g + 0] * inv, o1[4 * g + 1] * inv); w1.y = cvt_pk_bf16(o1[4 * g + 2] * inv, o1[4 * g + 3] * inv);
        *(u32x2*)(Qp + 8 * g + 4 * hi) = w0; *(u32x2*)(Qp + 32 + 8 * g + 4 * hi) = w1;
    }
}

#define XB_TMO      128
#define XB_XCNT(j)  (256  + 64 * (j))
#define XB_XSUB(j)  (1280 + 64 * (j))
#define XB_XGEN(j)  (2304 + 64 * (j))
#define XB_TOP      3328
#define XB_TOPGEN   3392
#define XCD_BAR_WORDS 3456
#define XB_SPIN_CAP (1u << 18)

__device__ __forceinline__ unsigned xb_ld(unsigned* p)              { return __hip_atomic_load(p, __ATOMIC_RELAXED, __HIP_MEMORY_SCOPE_AGENT); }
__device__ __forceinline__ unsigned xb_add(unsigned* p, unsigned v) { return __hip_atomic_fetch_add(p, v, __ATOMIC_RELAXED, __HIP_MEMORY_SCOPE_AGENT); }
__device__ __forceinline__ unsigned xb_xcc_id() { return (unsigned)__builtin_amdgcn_s_getreg((3 << 11) | 20) & 0xFu; }
#define XB_SPIN(cond, bar) do { unsigned _sp = 0; while (cond) { __builtin_amdgcn_s_sleep(1); \
    if ((++_sp & 255u) == 0u) { if (xb_ld(&(bar)[XB_TMO])) break; if (_sp > XB_SPIN_CAP) { atomicAdd(&(bar)[XB_TMO], 1u); break; } } } } while (0)

struct XcdBarrier {
    unsigned* bar; unsigned x;
    volatile __attribute__((address_space(3))) unsigned* st;
};

__device__ __forceinline__ XcdBarrier xcd_barrier_post(unsigned* bar, volatile __attribute__((address_space(3))) unsigned* st) {
    XcdBarrier b; b.bar = bar; b.x = xb_xcc_id(); b.st = st;
    if (threadIdx.x == 0) (void)xb_add(&bar[XB_XCNT(b.x)], 1u);
    return b;
}
__device__ __forceinline__ void xcd_barrier_complete(unsigned* bar, unsigned x, unsigned& nloc, unsigned& nx) {
    const unsigned G = gridDim.x * gridDim.y * gridDim.z;
    unsigned sum, cnt, mine, sp = 0u;
    for (;;) {
        sum = 0u; cnt = 0u; mine = 0u;
#pragma unroll
        for (unsigned j = 0; j < 16; ++j) { const unsigned c = xb_ld(&bar[XB_XCNT(j)]); sum += c; cnt += (c > 0u) ? 1u : 0u; mine = (j == x) ? c : mine; }
        if (sum == G) break;
        __builtin_amdgcn_s_sleep(1);
        if ((++sp & 255u) == 0u) { if (xb_ld(&bar[XB_TMO])) break; if (sp > XB_SPIN_CAP) { atomicAdd(&bar[XB_TMO], 1u); break; } }
    }
    nloc = mine > 0u ? mine : 1u; nx = cnt > 0u ? cnt : 1u;
}

__device__ __forceinline__ void xcd_barrier(const XcdBarrier& b) {
    asm volatile("s_waitcnt vmcnt(0)" ::: "memory");
    __syncthreads();
    if (threadIdx.x == 0) {
        unsigned* bar = b.bar;
        __builtin_amdgcn_s_waitcnt(0);
        unsigned nloc = b.st[0], nx = b.st[1];
        if (nloc == 0u) { xcd_barrier_complete(bar, b.x, nloc, nx); b.st[0] = nloc; b.st[1] = nx; }
        const unsigned old = xb_add(&bar[XB_XSUB(b.x)], 1u);
        const unsigned gen = old / nloc;
        if (old + 1u == (gen + 1u) * nloc) {
            __builtin_amdgcn_fence(__ATOMIC_RELEASE, "agent");
            asm volatile("s_waitcnt vmcnt(0)" ::: "memory");
            const unsigned og = xb_add(&bar[XB_TOP], 1u);
            const unsigned tg = og / nx;
            if (og + 1u == (tg + 1u) * nx) xb_add(&bar[XB_TOPGEN], 1u);
            else XB_SPIN(xb_ld(&bar[XB_TOPGEN]) == tg, bar);
            __builtin_amdgcn_fence(__ATOMIC_ACQUIRE, "agent");
            xb_add(&bar[XB_XGEN(b.x)], 1u);
            asm volatile("s_waitcnt vmcnt(0)" ::: "memory");
        } else {
            XB_SPIN(xb_ld(&bar[XB_XGEN(b.x)]) == gen, bar);
            __builtin_amdgcn_fence(__ATOMIC_ACQUIRE, "agent");
            asm volatile("s_waitcnt vmcnt(0)" ::: "memory");
        }
    }
    __syncthreads();
}
__global__ void __launch_bounds__(512, 2) fwd_mega(Args a) {
    extern __shared__ __attribute__((aligned(16))) unsigned char lds_raw[];
    cg::grid_group grid = cg::this_grid();
    PG8_LAS unsigned char* lds = (PG8_LAS unsigned char*)lds_raw;
    const int tid = threadIdx.x, wave = __builtin_amdgcn_readfirstlane(tid >> 6);
    const int G = gridDim.x, gw = blockIdx.x * 8 + wave, NGW = G * 8;
#define LANE() ({ int l_ = threadIdx.x & 63; asm volatile("" : "+v"(l_)); l_; })
#define WSP() ((unsigned char*)KARGS()->ws)
#define MODS() ((float*)(WSP() + WS_MODS))
#define CTL() ((unsigned*)(WSP() + WS_CTL))
    volatile LAS unsigned* MISC = (volatile LAS unsigned*)((LAS unsigned char*)lds_raw + 131072);
    if (tid < 64) MISC[tid] = 0u;
    __syncthreads();
    { const XcdBarrier xb0 = xcd_barrier_post(CTL() + 4096, MISC + 8); (void)xb0; }
#define GRID_BAR() do { XcdBarrier xb_; xb_.bar = CTL() + 4096; xb_.x = xb_xcc_id(); xb_.st = MISC + 8; xcd_barrier(xb_); } while (0)

    conv_weights(KARGS(), 0, (LAS unsigned char*)lds_raw, gw, NGW, wave, LANE());
    ada_phase(KARGS(), gw, NGW, LANE());
    if (blockIdx.x == 0) {
        float* rope = (float*)(WSP() + WS_ROPE);
        for (int i = tid; i < 128 * 16; i += 512) { const int pos = i >> 4, f = i & 15; const float fr = powf(10000.0f, -(float)f / 16.0f); const float ang = (float)pos * fr; float s, c; sincosf(ang, &s, &c); rope[2 * i] = c; rope[2 * i + 1] = s; }
    }
    grid.sync();
    { KAP ap = KARGS();
      row_phase(gw, NGW, LANE(), MALL, nullptr, nullptr, nullptr, 0, ap->in[0], ap->in[2], nullptr, nullptr,
              (bf16_t*)(WSP() + WS_R1), ap->in[6], MODS(), 0, 1024); }
    GRID_BAR();

#pragma unroll 1
    for (int l = 0; l < DEPTH; ++l) {
        const bool last = (l == DEPTH - 1);
        const int MX = last ? MLAT : MALL;
        int bidl = blockIdx.x, Gl = gridDim.x; asm volatile("" : "+s"(bidl), "+s"(Gl));
#define MODL() (MODS() + (size_t)l * 3 * 6144)
        {
            pg8::Gemm g{(const bf16_t*)(WSP() + WS_R1), (const bf16_t*)(WSP() + WS_WIN), MALL, NINP, DM, DM, DM, 0, 0};
            pg8::StaticOrder S; S.init(MALL, NINP, Gl, bidl);
            EpiScatter E{(bf16_t*)(WSP() + WS_Q), (bf16_t*)(WSP() + WS_KAB), (bf16_t*)(WSP() + WS_KC), (bf16_t*)(WSP() + WS_VTAB), (bf16_t*)(WSP() + WS_VTC), (bf16_t*)(WSP() + WS_PG), (bf16_t*)(WSP() + WS_VB)};
            pg8::gemm_phase<EpiScatter, pg8::StaticOrder, true, true>(lds, g, S, E);
        }
        GRID_BAR();
        post_phase(KARGS(), l, gw, NGW, LANE());
        GRID_BAR();
        {
            KAP ap = KARGS(); const int lane = LANE();
            for (int uid = blockIdx.x; uid < 384; uid += G) {
                const int qb = uid & 31, bh = uid >> 5, b = bh / 6, h = bh % 6;
                const attn_body::bf16* Qb = (const attn_body::bf16*)(WSP() + WS_Q) + (size_t)(b * SEQ + qb * 256) * QW + (6 + h) * 64;
                const attn_body::bf16* Kh = (const attn_body::bf16*)(WSP() + WS_KAB) + (size_t)b * KEYS * 256 + 128 + (h / 3) * 64;
                const attn_body::bf16* Vh = (const attn_body::bf16*)(WSP() + WS_VB) + (size_t)b * KEYS * 128 + (h / 3) * 64;
                attn_body::attn_unit<8>(Qb, Kh, Vh, (attn_body::bf16*)Qb, KEYS / 64, (char*)lds_raw);
            }
            const int ntask = 6144 + (last ? 0 : 288);
            unsigned* ctr = CTL() + 64 * l;
            for (;;) {
                int t = 0;
                if (lane == 0) t = (int)atomicAdd(ctr, 1u);
                t = __builtin_amdgcn_readfirstlane(t);
                if (t >= ntask) break;
                attn_task(ap, l, t, lane);
            }
        }
        GRID_BAR();
        {
            pg8::Gemm g{(const bf16_t*)(WSP() + WS_Q), (const bf16_t*)(WSP() + WS_WBR), MX, 3072, 384, QW, 384, 4, (size_t)384 * 2};
            pg8::StaticOrder S; S.init(MX, 3072, Gl, bidl);
            EpiGate E{(bf16_t*)(WSP() + WS_PG)};
            pg8::gemm_phase<EpiGate, pg8::StaticOrder, true, true>(lds, g, S, E);
        }
        GRID_BAR();
        {
            pg8::Gemm g{(const bf16_t*)(WSP() + WS_PG), (const bf16_t*)(WSP() + WS_WOUT), MX, DM, 3072, 3072, 3072, 0, 0};
            pg8::StaticOrder S; S.init(MX, DM, Gl, bidl);
            EpiF32 E{(float*)(WSP() + WS_Y), DM};
            pg8::gemm_phase<EpiF32, pg8::StaticOrder, true, true>(lds, g, S, E);
        }
        GRID_BAR();
        { KAP ap = KARGS();
          row_phase(gw, NGW, LANE(), MX, (const float*)(WSP() + WS_Y), ap->in[7] + l * DM, MODL(), 2048,
                  l == 0 ? ap->in[0] : ap->out, l == 0 ? ap->in[2] : (const float*)(WSP() + WS_XC), ap->out, (float*)(WSP() + WS_XC),
                  (bf16_t*)(WSP() + WS_Q), ap->in[17] + l * DM, MODL(), 3072, 4096); }
        GRID_BAR();
        {
            pg8::Gemm g{(const bf16_t*)(WSP() + WS_Q), (const bf16_t*)(WSP() + WS_W1), MX, FF, DM, DM, DM, 0, 0};
            pg8::StaticOrder S; S.init(MX, FF, Gl, bidl);
            EpiBf16<1> E{(bf16_t*)(WSP() + WS_A), FF};
            pg8::gemm_phase<EpiBf16<1>, pg8::StaticOrder, true, true>(lds, g, S, E);
        }
        GRID_BAR();
        {
            pg8::Gemm g{(const bf16_t*)(WSP() + WS_A), (const bf16_t*)(WSP() + WS_W2), MX, DM, FF, FF, FF, 0, 0};
            pg8::StaticOrder S; S.init(MX, DM, Gl, bidl);
            EpiF32 E{(float*)(WSP() + WS_Y2), DM};
            pg8::gemm_phase<EpiF32, pg8::StaticOrder, true, true>(lds, g, S, E);
        }
        GRID_BAR();
        if (!last) {
            { KAP ap = KARGS();
              row_phase(gw, NGW, LANE(), MX, (const float*)(WSP() + WS_Y2), ap->in[18] + l * DM, MODL(), 5120,
                      ap->out, (const float*)(WSP() + WS_XC), ap->out, (float*)(WSP() + WS_XC),
                      (bf16_t*)(WSP() + WS_R1), ap->in[6] + (l + 1) * DM, MODL() + 3 * 6144, 0, 1024); }
            conv_weights(KARGS(), l + 1, (LAS unsigned char*)lds_raw, gw, NGW, wave, LANE());
            GRID_BAR();
        } else {
            { KAP ap = KARGS();
              row_phase(gw, NGW, LANE(), MX, (const float*)(WSP() + WS_Y2), ap->in[18] + l * DM, MODL(), 5120,
                      ap->out, (const float*)(WSP() + WS_XC), ap->out, (float*)(WSP() + WS_XC),
                      nullptr, nullptr, nullptr, 0, 0); }
        }
    }
}

extern "C" void kernel_launch(void* const* d_in, const int* in_sizes, int n_in, void* d_out, int out_size, void* d_ws, size_t ws_size, hipStream_t stream) {
    static int grid = 0;
    if (grid == 0) {
        if (n_in != 21 || out_size != MLAT * DM || ws_size < WS_END) { fprintf(stderr, "kernel_launch: unexpected shapes (n_in %d, out %d, ws %zu need %zu)\n", n_in, out_size, ws_size, (size_t)WS_END); grid = -1; return; }
        int dev = 0, cus = 0, per_cu = 0;
        if (hipGetDevice(&dev) != hipSuccess || hipDeviceGetAttribute(&cus, hipDeviceAttributeMultiprocessorCount, dev) != hipSuccess) { grid = -1; return; }
        if (hipFuncSetAttribute((const void*)fwd_mega, hipFuncAttributeMaxDynamicSharedMemorySize, LDS_BYTES) != hipSuccess) { fprintf(stderr, "kernel_launch: hipFuncSetAttribute failed\n"); grid = -1; return; }
        if (hipOccupancyMaxActiveBlocksPerMultiprocessor(&per_cu, (const void*)fwd_mega, 512, LDS_BYTES) != hipSuccess || per_cu < 1) { fprintf(stderr, "kernel_launch: occupancy query says %d blocks per CU\n", per_cu); grid = -1; return; }
        grid = cus;
    }
    if (grid < 0) return;
    (void)hipMemsetAsync((char*)d_ws + WS_CTL, 0, CTL_ZERO_BYTES, stream);
    Args a{};
    for (int i = 0; i < 21; ++i) a.in[i] = (const float*)d_in[i];
    a.out = (float*)d_out; a.ws = (unsigned char*)d_ws;
    void* args[] = {&a};
    hipError_t e = hipLaunchCooperativeKernel((const void*)fwd_mega, dim3(grid), dim3(512), args, LDS_BYTES, stream);
    if (e != hipSuccess) fprintf(stderr, "cooperative launch failed: %s (grid %d)\n", hipGetErrorString(e), grid);
}
```

```cpp
#include <hip/hip_runtime.h>
#include <hip/hip_cooperative_groups.h>
#include <cstdio>
#include <cstdint>
namespace cg = cooperative_groups;

namespace pg8 {
#define PG8_LAS __attribute__((address_space(3)))
typedef unsigned short bf16_t;
typedef short bf16x8 __attribute__((ext_vector_type(8)));
typedef float f32x4 __attribute__((ext_vector_type(4)));
typedef unsigned u32x4 __attribute__((ext_vector_type(4)));
constexpr int BM = 256, BK = 64, HALF = 128, HTB = HALF * BK * 2, STAGE_BYTES = 8 * HTB, NXCD = 8, WGM = 8;

__host__ __device__ __forceinline__ int lds_byte(int r, int c) { const int st = (r >> 4) * 2 + (c >> 5), rr = r & 15, cc = c & 31, ob = rr * 64 + cc * 2; return st * 1024 + (ob ^ (((ob >> 9) & 1) << 5)); }
__host__ __device__ __forceinline__ void stage_rc(int b, int& R, int& C) { const int st = b / 1024, sb = b % 1024, swz = sb ^ (((sb >> 9) & 1) << 5); R = (st >> 1) * 16 + swz / 64; C = (st & 1) * 32 + (swz % 64) / 2; }
__host__ __device__ __forceinline__ int perm32(int rho) { const int n = rho >> 4, i = rho & 15; return 8 * (i >> 2) + 4 * n + (i & 3); }

struct Unit { int pm, pn; };
struct Gemm { const bf16_t* A; const bf16_t* Bt; int M, N, K, lda, ldb, a_split; size_t a_stride; };

struct StaticOrder {
    int nM, nN, nwg, G, c;
    __host__ __device__ void init(int M, int N, int G_, int c_) { nM = M / BM; nN = N / BM; nwg = nM * nN; G = G_; c = c_; }
    __host__ __device__ bool next(int i, Unit& u) const {
        const long L = (long)i * G + c; if (L >= nwg) return false;
        int wgid = (int)L; { const int q = nwg / NXCD, r = nwg % NXCD, xcd = wgid % NXCD, off = wgid / NXCD; wgid = (xcd < r ? xcd * (q + 1) : r * (q + 1) + (xcd - r) * q) + off; }
        const int nig = WGM * nN, gid = wgid / nig, fm = gid * WGM, gsz = (nM - fm) < WGM ? (nM - fm) : WGM;
        u.pm = fm + ((wgid % nig) % gsz); u.pn = (wgid % nig) / gsz; return true;
    }
};

__device__ __forceinline__ unsigned cvt_pk_bf16(float lo, float hi) { unsigned r; asm volatile("v_cvt_pk_bf16_f32 %0, %1, %2" : "=v"(r) : "v"(lo), "v"(hi)); return r; }


template <class Epi, class Sched, bool ALIGN_EPI = false, bool SP2 = false, int SEG = 0>
__device__ __forceinline__ void gemm_phase(PG8_LAS unsigned char* lds, const Gemm g, const Sched& S, const Epi& E) {
    int tid_ = threadIdx.x; asm volatile("" : "+v"(tid_));
    const int tid = tid_, wid = __builtin_amdgcn_readfirstlane(tid >> 6), lane = tid & 63, wr = wid >> 2, wc = wid & 3, fr = lane & 15, fq = lane >> 4;
    const int K = g.K, nt = K / BK;
    unsigned voffA[2], voffB[2];
#pragma unroll
    for (int i = 0; i < 2; ++i) { int R, C; stage_rc(tid * 16 + i * 8192, R, C); const int Rb = Epi::PERM ? ((R & ~31) + perm32(R & 31)) : R;
        voffA[i] = (unsigned)(R * g.lda + C) * 2u; voffB[i] = (unsigned)(Rb * g.ldb + C) * 2u; }
    const size_t kstep = (size_t)(BK * 2);
    const size_t hstepA = (size_t)HALF * g.lda * 2, hstepB = (size_t)HALF * g.ldb * 2;
    const size_t tstepA = 2 * hstepA, tstepB = 2 * hstepB;
    const unsigned ldsw = (unsigned)wid * 1024u;
    const int aoff = lds_byte(wr * 64 + fr, fq * 8), boff = lds_byte(wc * 32 + fr, fq * 8);
#define PG8_SA(b, h) (((b) * 2 + (h)) * HTB)
#define PG8_SB(b, h) ((4 + (b) * 2 + (h)) * HTB)
#define PG8_STAGE(bufoff, gbase, voff) do { _Pragma("unroll") for (int _i = 0; _i < 2; ++_i) \
        __builtin_amdgcn_global_load_lds((const unsigned*)((const char*)(gbase) + (voff)[_i]), (PG8_LAS unsigned*)(lds + (bufoff) + ldsw + _i * 8192), 16, 0, 0); } while (0)
#define PG8_LDA(dst, b, h) do { _Pragma("unroll") for (int m = 0; m < 4; ++m) _Pragma("unroll") for (int k = 0; k < 2; ++k) dst[m][k] = *(const PG8_LAS bf16x8*)(lds + PG8_SA(b, h) + aoff + m * 2048 + k * 1024); } while (0)
#define PG8_LDB(dst, b, h) do { _Pragma("unroll") for (int n = 0; n < 2; ++n) _Pragma("unroll") for (int k = 0; k < 2; ++k) dst[n][k] = *(const PG8_LAS bf16x8*)(lds + PG8_SB(b, h) + boff + n * 2048 + k * 1024); } while (0)
#define PG8_MMA(ai, bj, At, Bt) do { __builtin_amdgcn_s_setprio(1); _Pragma("unroll") for (int m = 0; m < 4; ++m) _Pragma("unroll") for (int n = 0; n < 2; ++n) _Pragma("unroll") for (int k = 0; k < 2; ++k) \
        acc[ai][bj][m][n] = __builtin_amdgcn_mfma_f32_16x16x32_bf16(Bt[n][k], At[m][k], acc[ai][bj][m][n], 0, 0, 0); __builtin_amdgcn_s_setprio(0); } while (0)
#define PG8_WAIT_V(n) asm volatile("s_waitcnt vmcnt(" #n ")" ::: "memory")
#define PG8_WAIT_L(n) asm volatile("s_waitcnt lgkmcnt(" #n ")" ::: "memory")
#define PG8_BAR __builtin_amdgcn_s_barrier()
#define PG8_SCHED __builtin_amdgcn_sched_barrier(0)
#define PG8_ABASE(u) ((const char*)g.A + (size_t)(u).pm * tstepA + (g.a_split ? (size_t)((u).pn / g.a_split) * g.a_stride : (size_t)0))
    Unit cur, nxt; int ui = 0;
    if (!S.next(0, cur)) return;
    f32x4 acc[2][2][4][2];
#pragma unroll
    for (int a = 0; a < 2; ++a)
#pragma unroll
        for (int b = 0; b < 2; ++b)
#pragma unroll
            for (int m = 0; m < 4; ++m)
#pragma unroll
                for (int n = 0; n < 2; ++n) acc[a][b][m][n] = (f32x4){0.f, 0.f, 0.f, 0.f};
    bf16x8 At[4][2], B0[2][2], B1[2][2];
    const char* cA = PG8_ABASE(cur); const char* cB = (const char*)g.Bt + (size_t)cur.pn * tstepB;
    if constexpr (SP2) {
        PG8_STAGE(PG8_SB(0, 0), cB, voffB); PG8_STAGE(PG8_SB(0, 1), cB + hstepB, voffB); PG8_STAGE(PG8_SA(0, 0), cA, voffA); PG8_STAGE(PG8_SA(0, 1), cA + hstepA, voffA);
        if (wr == 1) PG8_BAR;
        PG8_WAIT_V(2); PG8_BAR;
        PG8_STAGE(PG8_SB(1, 0), cB + kstep, voffB); PG8_STAGE(PG8_SA(1, 0), cA + kstep, voffA); PG8_STAGE(PG8_SB(1, 1), cB + hstepB + kstep, voffB);
        PG8_WAIT_V(6); PG8_BAR;
    } else {
        PG8_STAGE(PG8_SB(0, 0), cB, voffB); PG8_STAGE(PG8_SA(0, 0), cA, voffA); PG8_STAGE(PG8_SB(0, 1), cB + hstepB, voffB); PG8_STAGE(PG8_SA(0, 1), cA + hstepA, voffA);
        if (wr == 1) PG8_BAR;
        PG8_WAIT_V(4); PG8_BAR;
        PG8_STAGE(PG8_SB(1, 0), cB + kstep, voffB); PG8_STAGE(PG8_SA(1, 0), cA + kstep, voffA); PG8_STAGE(PG8_SB(1, 1), cB + hstepB + kstep, voffB);
        PG8_WAIT_V(6); PG8_BAR;
    }
    for (;;) {
        const bool has_next = S.next(ui + 1, nxt);
        const char* nA = has_next ? PG8_ABASE(nxt) : cA; const char* nB = has_next ? (const char*)g.Bt + (size_t)nxt.pn * tstepB : cB;
#pragma unroll 1
        for (int t = 0; t < nt; t += 2) {
            const bool last = (t == nt - 2);
            const char* a1 = cA + (size_t)(t + 1) * kstep;
            const char* a2 = last ? nA : cA + (size_t)(t + 2) * kstep; const char* b2 = last ? nB : cB + (size_t)(t + 2) * kstep;
            const char* a3 = a2 + kstep; const char* b3 = b2 + kstep;
            if constexpr (SP2) {
            PG8_LDB(B0, 0, 0); PG8_LDB(B1, 0, 1); PG8_SCHED; PG8_LDA(At, 0, 0); PG8_STAGE(PG8_SA(1, 1), a1 + hstepA, voffA);
            PG8_WAIT_V(8); PG8_WAIT_L(0); PG8_BAR; PG8_MMA(0, 0, At, B0); PG8_MMA(0, 1, At, B1); PG8_BAR; PG8_SCHED;
            PG8_LDA(At, 0, 1); PG8_STAGE(PG8_SB(0, 0), b2, voffB); PG8_STAGE(PG8_SB(0, 1), b2 + hstepB, voffB); PG8_STAGE(PG8_SA(0, 0), a2, voffA);
            PG8_WAIT_V(8); PG8_WAIT_L(0); PG8_BAR; PG8_MMA(1, 0, At, B0); PG8_MMA(1, 1, At, B1); PG8_BAR; PG8_SCHED;
            PG8_LDB(B0, 1, 0); PG8_LDB(B1, 1, 1); PG8_SCHED; PG8_LDA(At, 1, 0); PG8_STAGE(PG8_SA(0, 1), a2 + hstepA, voffA);
            PG8_WAIT_V(8); PG8_WAIT_L(0); PG8_BAR; PG8_MMA(0, 0, At, B0); PG8_MMA(0, 1, At, B1); PG8_BAR; PG8_SCHED;
            PG8_LDA(At, 1, 1); PG8_STAGE(PG8_SB(1, 0), b3, voffB); PG8_STAGE(PG8_SB(1, 1), b3 + hstepB, voffB); PG8_STAGE(PG8_SA(1, 0), a3, voffA);
            PG8_WAIT_V(8); PG8_WAIT_L(0); PG8_BAR; PG8_MMA(1, 0, At, B0); PG8_MMA(1, 1, At, B1); PG8_BAR; PG8_SCHED;
            } else {
            PG8_LDB(B0, 0, 0); PG8_SCHED; PG8_LDA(At, 0, 0); PG8_STAGE(PG8_SA(1, 1), a1 + hstepA, voffA);
            PG8_WAIT_L(8); PG8_BAR; PG8_WAIT_L(0); PG8_MMA(0, 0, At, B0); PG8_BAR; PG8_SCHED;
            PG8_LDB(B1, 0, 1); PG8_STAGE(PG8_SB(0, 0), b2, voffB);
            PG8_BAR; PG8_WAIT_L(0); PG8_MMA(0, 1, At, B1); PG8_BAR;
            PG8_LDA(At, 0, 1); PG8_STAGE(PG8_SA(0, 0), a2, voffA);
            PG8_BAR; PG8_WAIT_L(0); PG8_MMA(1, 0, At, B0); PG8_BAR; PG8_SCHED;
            PG8_STAGE(PG8_SB(0, 1), b2 + hstepB, voffB);
            PG8_WAIT_V(6); PG8_BAR; PG8_MMA(1, 1, At, B1); PG8_BAR;
            PG8_LDB(B0, 1, 0); PG8_SCHED; PG8_LDA(At, 1, 0); PG8_STAGE(PG8_SA(0, 1), a2 + hstepA, voffA);
            PG8_WAIT_L(8); PG8_BAR; PG8_WAIT_L(0); PG8_MMA(0, 0, At, B0); PG8_BAR; PG8_SCHED;
            PG8_LDB(B1, 1, 1); PG8_STAGE(PG8_SB(1, 0), b3, voffB);
            PG8_BAR; PG8_WAIT_L(0); PG8_MMA(0, 1, At, B1); PG8_BAR;
            PG8_LDA(At, 1, 1); PG8_STAGE(PG8_SA(1, 0), a3, voffA);
            PG8_BAR; PG8_WAIT_L(0); PG8_MMA(1, 0, At, B0); PG8_BAR; PG8_SCHED;
            PG8_STAGE(PG8_SB(1, 1), b3 + hstepB, voffB);
            PG8_WAIT_V(6); PG8_BAR; PG8_MMA(1, 1, At, B1); PG8_BAR;
            }
            if constexpr (SEG > 0) {
                if (!last && (t + 2) % SEG == 0) {
                    E.segment(acc, (t + 2) / SEG - 1, cur, wr, wc, fr, fq);
#pragma unroll
                    for (int a = 0; a < 2; ++a)
#pragma unroll
                        for (int b = 0; b < 2; ++b)
#pragma unroll
                            for (int m = 0; m < 4; ++m)
#pragma unroll
                                for (int n = 0; n < 2; ++n) acc[a][b][m][n] = (f32x4){0.f, 0.f, 0.f, 0.f};
                }
            }
        }
        if constexpr (ALIGN_EPI) { if (wr == 0) PG8_BAR; }
        E(acc, cur, wr, wc, fr, fq);
        if (!has_next) break;
#pragma unroll
        for (int a = 0; a < 2; ++a)
#pragma unroll
            for (int b = 0; b < 2; ++b)
#pragma unroll
                for (int m = 0; m < 4; ++m)
#pragma unroll
                    for (int n = 0; n < 2; ++n) acc[a][b][m][n] = (f32x4){0.f, 0.f, 0.f, 0.f};
        cur = nxt; cA = nA; cB = nB; ++ui;
        if constexpr (ALIGN_EPI) { if (wr == 1) PG8_BAR; }
    }
    PG8_WAIT_V(0);
    if constexpr (!ALIGN_EPI) { if (wr == 0) PG8_BAR; }
    PG8_BAR;
#undef PG8_SA
#undef PG8_SB
#undef PG8_STAGE
#undef PG8_LDA
#undef PG8_LDB
#undef PG8_MMA
#undef PG8_WAIT_V
#undef PG8_WAIT_L
#undef PG8_BAR
#undef PG8_SCHED
#undef PG8_ABASE
}
}

using pg8::bf16_t; using pg8::f32x4; using pg8::u32x4; using pg8::Unit; using pg8::cvt_pk_bf16;
typedef short bf16x8 __attribute__((ext_vector_type(8)));
typedef float f32x16 __attribute__((ext_vector_type(16)));
typedef unsigned u32x2 __attribute__((ext_vector_type(2)));
#define LAS __attribute__((address_space(3)))

constexpr int DM = 1024, SEQ = 8192, NB = 2, LCTX = 256, DEPTH = 2;
constexpr int MLAT = NB * SEQ;
constexpr int MALL = MLAT + NB * LCTX;
constexpr int KEYS = LCTX + SEQ;
constexpr int NIN = 5504, NINP = 5632;
constexpr int FF = 4096;
constexpr int QW = 1152;
constexpr float EPS = 1e-6f;
constexpr float LOG2E = 1.4426950408889634f;
constexpr float QSCALE = 0.125f * LOG2E;

constexpr size_t MiB = 1u << 20;
constexpr size_t WS_CTL = 0, CTL_ZERO_BYTES = 256 * 1024;
constexpr size_t WS_MODS = 64 * 1024;
constexpr size_t WS_ROPE = 256 * 1024;
constexpr size_t WS_XC = 1 * MiB;
constexpr size_t WS_WIN = 4 * MiB;
constexpr size_t WS_WBR = WS_WIN + 11 * MiB;
constexpr size_t WS_WOUT = WS_WBR + 9 * MiB / 4;
constexpr size_t WS_W1 = WS_WOUT + 6 * MiB;
constexpr size_t WS_W2 = WS_W1 + 8 * MiB;
constexpr size_t WS_R1 = 40 * MiB;
constexpr size_t WS_KAB = WS_R1 + 33 * MiB;
constexpr size_t WS_KC = WS_KAB + (size_t)NB * KEYS * 256 * 2;
constexpr size_t WS_VTAB = WS_KC + (size_t)NB * KEYS * 384 * 2;
constexpr size_t WS_VTC = WS_VTAB + (size_t)NB * 4 * 64 * KEYS * 2;
constexpr size_t WS_PG = WS_VTC + (size_t)NB * 6 * 64 * KEYS * 2;
constexpr size_t WS_Q = WS_PG + (size_t)MALL * 3072 * 2;
constexpr size_t WS_VB = WS_Q + (size_t)MALL * QW * 2;
constexpr size_t WS_END = WS_VB + (size_t)NB * KEYS * 128 * 2;
constexpr size_t WS_Y = WS_R1;
constexpr size_t WS_A = WS_R1;
constexpr size_t WS_Y2 = WS_A + (size_t)MALL * FF * 2;
static_assert(WS_W2 + 8 * MiB <= WS_R1, "weights");
static_assert(WS_Y + (size_t)MALL * DM * 4 <= WS_PG, "Y overlay");
static_assert(WS_A + (size_t)MALL * FF * 2 <= WS_Q, "A overlay");
static_assert(WS_Y2 + (size_t)MALL * DM * 4 <= WS_END && WS_END <= 256 * MiB, "ws map");

constexpr int LDS_BYTES = 147456;

struct EpiScatter {
    static constexpr bool PERM = true;
    bf16_t *Q, *KAB, *KC, *VtAB, *VtC, *PG, *VB;
    __device__ __forceinline__ void operator()(const f32x4 (&acc)[2][2][4][2], const Unit& u, int wr, int wc, int fr, int fq) const {
        const int pm = u.pm; int b, kroff;
        if (pm < 64) { b = pm >> 5; kroff = 256 * b + 256; } else { b = pm - 64; kroff = -MLAT + SEQ * b; }
        const int row0 = pm * 256 + wr * 64 + fr, cin = wc * 32 + 8 * fq;
#pragma unroll
        for (int bj = 0; bj < 2; ++bj) {
            const int cb = 2 * u.pn + bj;
            if (cb >= 43) continue;
            int mode = 0, pitch = 0, col = 0, radd = 0, nhv = 0, hd = 0; bf16_t* base = nullptr;
            if (cb >= 19) { base = PG; pitch = 3072; col = 128 * (cb - 19) + cin; }
            else if (cb <= 2) { base = Q; pitch = QW; col = 128 * cb + cin; }
            else if (cb == 3) { base = KAB; pitch = 256; col = cin; radd = kroff; }
            else if (cb == 4) { mode = 1; base = VtAB; nhv = 4; hd = cin; }
            else if (cb <= 7) { base = Q; pitch = QW; col = 384 + 128 * (cb - 5) + cin; }
            else if (cb == 8) { base = KAB; pitch = 256; col = 128 + cin; radd = kroff; }
            else if (cb == 9) { mode = 1; base = VtAB; nhv = 4; hd = 128 + cin; }
            else if (cb <= 12) { base = Q; pitch = QW; col = 768 + 128 * (cb - 10) + cin; }
            else if (cb <= 15) { base = KC; pitch = 384; col = 128 * (cb - 13) + cin; radd = kroff; }
            else { mode = 1; base = VtC; nhv = 6; hd = 128 * (cb - 16) + cin; }
#pragma unroll
            for (int ai = 0; ai < 2; ++ai)
#pragma unroll
                for (int m = 0; m < 4; ++m) {
                    const int row = row0 + ai * 128 + m * 16;
                    const f32x4 v0 = acc[ai][bj][m][0], v1 = acc[ai][bj][m][1];
                    u32x4 w; w.x = cvt_pk_bf16(v0[0], v0[1]); w.y = cvt_pk_bf16(v0[2], v0[3]); w.z = cvt_pk_bf16(v1[0], v1[1]); w.w = cvt_pk_bf16(v1[2], v1[3]);
                    if (cb == 9) *(u32x4*)(VB + (size_t)(row + kroff) * 128 + cin) = w;
                    if (mode == 0) { *(u32x4*)(base + (size_t)(row + radd) * pitch + col) = w; }
                    else {
                        bf16_t* p = base + ((size_t)(b * nhv + (hd >> 6)) * 64 + (hd & 63)) * KEYS + (row + kroff - b * KEYS);
                        p[0 * KEYS] = (bf16_t)(w.x & 0xffffu); p[1 * KEYS] = (bf16_t)(w.x >> 16); p[2 * KEYS] = (bf16_t)(w.y & 0xffffu); p[3 * KEYS] = (bf16_t)(w.y >> 16);
                        p[4 * KEYS] = (bf16_t)(w.z & 0xffffu); p[5 * KEYS] = (bf16_t)(w.z >> 16); p[6 * KEYS] = (bf16_t)(w.w & 0xffffu); p[7 * KEYS] = (bf16_t)(w.w >> 16);
                    }
                }
        }
    }
};
__device__ __forceinline__ float bf2f(unsigned h) { return __uint_as_float(h << 16); }
struct EpiGateSum {
    static constexpr bool PERM = true;
    bf16_t* PG;
    static __device__ __forceinline__ unsigned gate2(unsigned g, unsigned sprev, float a0, float a1) {
        const float g0 = bf2f(g & 0xffffu), g1 = bf2f(g >> 16);
        const float s0 = __builtin_amdgcn_rcpf(1.0f + __builtin_amdgcn_exp2f(-LOG2E * g0)), s1 = __builtin_amdgcn_rcpf(1.0f + __builtin_amdgcn_exp2f(-LOG2E * g1));
        return cvt_pk_bf16(a0 * s0 + bf2f(sprev & 0xffffu), a1 * s1 + bf2f(sprev >> 16));
    }
    __device__ __forceinline__ void segment(const f32x4 (&acc)[2][2][4][2], int br, const Unit& u, int wr, int wc, int fr, int fq) const {
        const int row0 = u.pm * 256 + wr * 64 + fr, col0 = u.pn * 256 + wc * 32 + 8 * fq;
        bf16_t* pb = PG + (size_t)row0 * 3072 + col0;
#pragma unroll
        for (int ai = 0; ai < 2; ++ai)
#pragma unroll
            for (int m = 0; m < 4; ++m)
#pragma unroll
                for (int bj = 0; bj < 2; ++bj) {
                    u32x4* p = (u32x4*)(pb + (size_t)(ai * 128 + m * 16) * 3072 + bj * 128);
                    const u32x4 gq = *(const u32x4*)((const bf16_t*)p + br * 1024);
                    u32x4 sp = {0u, 0u, 0u, 0u}; if (br > 0) sp = *p;
                    const f32x4 v0 = acc[ai][bj][m][0], v1 = acc[ai][bj][m][1];
                    u32x4 w; w.x = gate2(gq.x, sp.x, v0[0], v0[1]); w.y = gate2(gq.y, sp.y, v0[2], v0[3]); w.z = gate2(gq.z, sp.z, v1[0], v1[1]); w.w = gate2(gq.w, sp.w, v1[2], v1[3]);
                    *p = w;
                    asm volatile("" ::: "memory");
                }
    }
    __device__ __forceinline__ void operator()(const f32x4 (&acc)[2][2][4][2], const Unit& u, int wr, int wc, int fr, int fq) const { segment(acc, 2, u, wr, wc, fr, fq); }
};
template <int ACT  > struct EpiBf16 {
    static constexpr bool PERM = true;
    bf16_t* O; int ldc;
    __device__ __forceinline__ void operator()(const f32x4 (&acc)[2][2][4][2], const Unit& u, int wr, int wc, int fr, int fq) const {
        const int row0 = u.pm * 256 + wr * 64 + fr, col0 = u.pn * 256 + wc * 32 + 8 * fq;
#pragma unroll
        for (int ai = 0; ai < 2; ++ai)
#pragma unroll
            for (int m = 0; m < 4; ++m)
#pragma unroll
                for (int bj = 0; bj < 2; ++bj) {
                    f32x4 v0 = acc[ai][bj][m][0], v1 = acc[ai][bj][m][1];
                    if (ACT == 1) {
#pragma unroll
                        for (int e = 0; e < 4; ++e) { const float a = fmaxf(v0[e], 0.f), c = fmaxf(v1[e], 0.f); v0[e] = a * a; v1[e] = c * c; }
                    }
                    u32x4 w; w.x = cvt_pk_bf16(v0[0], v0[1]); w.y = cvt_pk_bf16(v0[2], v0[3]); w.z = cvt_pk_bf16(v1[0], v1[1]); w.w = cvt_pk_bf16(v1[2], v1[3]);
                    *(u32x4*)(O + (size_t)(row0 + ai * 128 + m * 16) * ldc + col0 + bj * 128) = w;
                }
    }
};
struct EpiF32 {
    static constexpr bool PERM = true;
    float* O; int ldc;
    __device__ __forceinline__ void operator()(const f32x4 (&acc)[2][2][4][2], const Unit& u, int wr, int wc, int fr, int fq) const {
        const int row0 = u.pm * 256 + wr * 64 + fr, col0 = u.pn * 256 + wc * 32 + 8 * fq;
#pragma unroll
        for (int ai = 0; ai < 2; ++ai)
#pragma unroll
            for (int m = 0; m < 4; ++m)
#pragma unroll
                for (int bj = 0; bj < 2; ++bj) {
                    float* p = O + (size_t)(row0 + ai * 128 + m * 16) * ldc + col0 + bj * 128;
                    *(f32x4*)p = acc[ai][bj][m][0]; *(f32x4*)(p + 4) = acc[ai][bj][m][1];
                }
    }
};

__device__ __forceinline__ float wave_sum(float v) {
#pragma unroll
    for (int o = 1; o < 64; o <<= 1) v += __shfl_xor(v, o);
    return v;
}
__device__ __forceinline__ unsigned f2bf(float f) { unsigned u = __builtin_bit_cast(unsigned, f); return (u + 0x7fffu + ((u >> 16) & 1u)) >> 16; }
__device__ __forceinline__ unsigned pk2(float lo, float hi) { return f2bf(lo) | (f2bf(hi) << 16); }

__device__ __forceinline__ void transpose_item(const float* W, int K, int N, bf16_t* WT, int ldk, int row_off, int copies, int copy_stride, LAS float* scr, int item, int lane) {
    const int nblk = N / 32, kb = item / nblk, nb = item % nblk, k0 = 64 * kb, n0 = 32 * nb;
#pragma unroll 8
    for (int i = 0; i < 32; ++i) { const int kk = 2 * i + (lane >> 5); scr[kk * 33 + (lane & 31)] = W[(size_t)(k0 + kk) * N + n0 + (lane & 31)]; }
    asm volatile("s_waitcnt lgkmcnt(0)" ::: "memory");
    const int c = lane & 7;
#pragma unroll
    for (int j = 0; j < 4; ++j) { const int n = (lane >> 3) + 8 * j; const LAS float* s = scr + (8 * c) * 33 + n;
        u32x4 o; o.x = pk2(s[0 * 33], s[1 * 33]); o.y = pk2(s[2 * 33], s[3 * 33]); o.z = pk2(s[4 * 33], s[5 * 33]); o.w = pk2(s[6 * 33], s[7 * 33]);
        for (int cc = 0; cc < copies; ++cc) *(u32x4*)(WT + (size_t)(row_off + n0 + n) * ldk + cc * copy_stride + k0 + 8 * c) = o; }
    asm volatile("s_waitcnt lgkmcnt(0)" ::: "memory");
}

struct Args { const float* in[21]; float* out; unsigned char* ws; int pad0, pad1; };
typedef const __attribute__((address_space(4))) Args* KAP;
#define KARGS() ({ KAP p_ = (KAP)__builtin_amdgcn_kernarg_segment_ptr(); asm volatile("" : "+s"(p_)); p_; })

__device__ __forceinline__ void conv_weights(KAP ap, int l, LAS unsigned char* lds, int gw, int NGW, int wave, int lane) {
    unsigned char* ws = ap->ws;
    LAS float* scr = (LAS float*)(lds + wave * 16384);
    constexpr int I_IN = 16 * (NIN / 32), I_BR = 6 * 32, I_OUT = 16 * 32, I_1 = 16 * (FF / 32), I_2 = (FF / 64) * 32;
    constexpr int NITEMS = I_IN + 3 * I_BR + I_OUT + I_1 + I_2;
    for (int it = gw; it < NITEMS; it += NGW) {
        int r = it;
        if (r < I_IN) { transpose_item(ap->in[8] + (size_t)l * DM * NIN, DM, NIN, (bf16_t*)(ws + WS_WIN), DM, 0, 1, 0, scr, r, lane); continue; } r -= I_IN;
        if (r < I_BR) { transpose_item(ap->in[13] + (size_t)l * 384 * DM, 384, DM, (bf16_t*)(ws + WS_WBR), 1152, 0, 1, 0, scr, r, lane); continue; } r -= I_BR;
        if (r < I_BR) { transpose_item(ap->in[14] + (size_t)l * 384 * DM, 384, DM, (bf16_t*)(ws + WS_WBR) + 384, 1152, 0, 1, 0, scr, r, lane); continue; } r -= I_BR;
        if (r < I_BR) { transpose_item(ap->in[15] + (size_t)l * 384 * DM, 384, DM, (bf16_t*)(ws + WS_WBR) + 768, 1152, 0, 1, 0, scr, r, lane); continue; } r -= I_BR;
        if (r < I_OUT) { transpose_item(ap->in[16] + (size_t)l * DM * DM, DM, DM, (bf16_t*)(ws + WS_WOUT), DM, 0, 1, 0, scr, r, lane); continue; } r -= I_OUT;
        if (r < I_1) { transpose_item(ap->in[19] + (size_t)l * DM * FF, DM, FF, (bf16_t*)(ws + WS_W1), DM, 0, 1, 0, scr, r, lane); continue; } r -= I_1;
        transpose_item(ap->in[20] + (size_t)l * FF * DM, FF, DM, (bf16_t*)(ws + WS_W2), FF, 0, 1, 0, scr, r, lane);
    }
    u32x4* pad = (u32x4*)(ws + WS_WIN + (size_t)NIN * DM * 2);
    unsigned z0 = 0u; asm volatile("" : "+v"(z0));
    for (int i = gw * 64 + lane; i < (NINP - NIN) * DM * 2 / 16; i += NGW * 64) pad[i] = (u32x4){z0, z0, z0, z0};
}

__device__ __forceinline__ void ada_phase(KAP ap, int gw, int NGW, int lane) {
    float* mods = (float*)(ap->ws + WS_MODS);
    const float* c = ap->in[1]; const float* cc = ap->in[3];
    for (int t = gw; t < DEPTH * 16 * 24; t += NGW) {
        const int l = t / (16 * 24), kc = (t / 24) % 16, jc = t % 24, col = jc * 256 + lane * 4;
        const float* W = ap->in[4] + ((size_t)l * DM + kc * 64) * 6144 + col;
        f32x4 s0 = {0.f, 0.f, 0.f, 0.f}, s1 = s0, s2 = s0;
        for (int k = 0; k < 64; ++k) {
            const f32x4 w = *(const f32x4*)(W + (size_t)k * 6144);
            const float x0 = c[kc * 64 + k], x1 = c[DM + kc * 64 + k], x2 = cc[kc * 64 + k];
            const float a0 = x0 / (1.f + __expf(-x0)), a1 = x1 / (1.f + __expf(-x1)), a2 = x2 / (1.f + __expf(-x2));
            s0 += w * a0; s1 += w * a1; s2 += w * a2;
        }
        if (kc == 0) { const f32x4 bb = *(const f32x4*)(ap->in[5] + (size_t)l * 6144 + col); s0 += bb; s1 += bb; s2 += bb; }
        float* m0 = mods + (size_t)(l * 3) * 6144 + col;
#pragma unroll
        for (int e = 0; e < 4; ++e) { atomicAdd(m0 + e, s0[e]); atomicAdd(m0 + 6144 + e, s1[e]); atomicAdd(m0 + 2 * 6144 + e, s2[e]); }
    }
}

__device__ __forceinline__ void row_phase(int gw, int NGW, int lane, int nrows, const bf16_t* Y, const float* gainY, const float* modsG, int gate_off,
                                          const float* rin_lat, const float* rin_ctx, float* rout_lat, float* rout_ctx,
                                          bf16_t* H, const float* gainH, const float* modsH, int shift_off, int scale_off) {
    for (int m = gw; m < nrows; m += NGW) {
        const int v = m < MLAT ? (m >> 13) : 2;
        const size_t roff = m < MLAT ? (size_t)m * DM : (size_t)(m - MLAT) * DM;
        const f32x4* xr = (const f32x4*)((m < MLAT ? rin_lat : rin_ctx) + roff) + lane;
        f32x4 x[4];
#pragma unroll
        for (int j = 0; j < 4; ++j) x[j] = xr[64 * j];
        if (Y) {
            const u32x2* yr = (const u32x2*)(Y + (size_t)m * DM) + lane;
            f32x4 y[4]; float ss = 0.f;
#pragma unroll
            for (int j = 0; j < 4; ++j) { const u32x2 yw = yr[64 * j]; y[j] = (f32x4){bf2f(yw.x & 0xffffu), bf2f(yw.x >> 16), bf2f(yw.y & 0xffffu), bf2f(yw.y >> 16)}; ss += (y[j].x * y[j].x + y[j].y * y[j].y) + (y[j].z * y[j].z + y[j].w * y[j].w); }
            const float rstd = rsqrtf(wave_sum(ss) * (1.f / DM) + EPS);
            const f32x4* gy = (const f32x4*)gainY + lane; const f32x4* gt = (const f32x4*)(modsG + (size_t)v * 6144 + gate_off) + lane;
            f32x4* ro = (f32x4*)((m < MLAT ? rout_lat : rout_ctx) + roff) + lane;
#pragma unroll
            for (int j = 0; j < 4; ++j) { x[j] = x[j] + gt[64 * j] * (y[j] * rstd * gy[64 * j]); ro[64 * j] = x[j]; }
        }
        if (H) {
            float ss = 0.f;
#pragma unroll
            for (int j = 0; j < 4; ++j) ss += (x[j].x * x[j].x + x[j].y * x[j].y) + (x[j].z * x[j].z + x[j].w * x[j].w);
            const float rstd = rsqrtf(wave_sum(ss) * (1.f / DM) + EPS);
            const f32x4* gh = (const f32x4*)gainH + lane; const f32x4* sh = (const f32x4*)(modsH + (size_t)v * 6144 + shift_off) + lane; const f32x4* sc = (const f32x4*)(modsH + (size_t)v * 6144 + scale_off) + lane;
            u32x2* ho = (u32x2*)(H + (size_t)m * DM) + lane;
#pragma unroll
            for (int j = 0; j < 4; ++j) { const f32x4 h = (x[j] * rstd * gh[64 * j]) * (sc[64 * j] + 1.0f) + sh[64 * j]; u32x2 w; w.x = pk2(h.x, h.y); w.y = pk2(h.z, h.w); ho[64 * j] = w; }
        }
    }
}

__device__ __forceinline__ void post_phase(KAP ap, int l, int gw, int NGW, int lane) {
    bf16_t* Q = (bf16_t*)(ap->ws + WS_Q); bf16_t* KAB = (bf16_t*)(ap->ws + WS_KAB);
    const float* rope = (const float*)(ap->ws + WS_ROPE);
    const float* qn = ap->in[10] + l * 64; const float* kn = ap->in[11] + l * 64;
    const int p = lane & 31, hh = lane >> 5;
    for (int m = gw; m < MALL; m += NGW) {
        const bool lat = m < MLAT; const int s = m & (SEQ - 1);
        float cs = 1.f, sn = 0.f;
        if (lat) { const int pos = p < 16 ? (s >> 6) : (s & 63); const float* t = rope + (pos * 16 + (p & 15)) * 2; cs = t[0]; sn = t[1]; }
        const int kr = lat ? m + 256 * (m >> 13) + 256 : ((m - MLAT) >> 8) * KEYS + ((m - MLAT) & 255);
#pragma unroll 1
        for (int it = 0; it < 11; ++it) {
            const int head = it * 2 + hh;
            unsigned* ptr; bool norm, rot, scl; const float* gn;
            if (head < 18) { ptr = (unsigned*)(Q + (size_t)m * QW + head * 64) + p; norm = (head >= 6 && head < 12); rot = head < 12; scl = true; gn = qn; }
            else { ptr = (unsigned*)(KAB + (size_t)kr * 256 + (head - 18) * 64) + p; norm = head >= 20; rot = true; scl = false; gn = kn; }
            const unsigned w = *ptr; float x0 = bf2f(w & 0xffffu), x1 = bf2f(w >> 16);
            float ss = x0 * x0 + x1 * x1;
#pragma unroll
            for (int o = 1; o < 32; o <<= 1) ss += __shfl_xor(ss, o);
            if (norm) { const float rstd = rsqrtf(ss * (1.f / 64.f) + EPS); x0 = x0 * rstd * gn[2 * p]; x1 = x1 * rstd * gn[2 * p + 1]; }
            if (rot) { const float y0 = x0 * cs - x1 * sn, y1 = x0 * sn + x1 * cs; x0 = y0; x1 = y1; }
            if (scl) { x0 *= QSCALE; x1 *= QSCALE; }
            *ptr = pk2(x0, x1);
        }
    }
}

#include <hip/hip_bf16.h>
#include <cmath>
namespace attn_body {
using bf16=__hip_bfloat16;
using bf16x8=__attribute__((ext_vector_type(8)))short;
using s16x4=__attribute__((ext_vector_type(4)))short;
using f32x16=__attribute__((ext_vector_type(16)))float;
using u32x4=__attribute__((ext_vector_type(4)))unsigned;
constexpr int D=64,QP=1152,KP=256,VP=128;
constexpr int NW=8,QBLK=32,QB=QBLK*NW,KVBLK=64;
__device__ __forceinline__ int crow(int r,int hi){return (r&3)+8*(r>>2)+4*hi;}
#define SBAR() __builtin_amdgcn_sched_barrier(0)
constexpr int NSLOT=3, SLOTB=8192;
constexpr int LDS_K=0, LDS_V=NSLOT*SLOTB, LDS_WS=2*NSLOT*SLOTB, LDS_OST=LDS_WS+NW*64*4, LDS_BYTES=LDS_OST+NW*4096;
constexpr float C2=0.125f*1.4426950408889634f;
__device__ __forceinline__ void glds16(const void*gsrc,unsigned lds_dst){unsigned keep;
  asm volatile("s_mov_b32 %0, m0\n\ts_mov_b32 m0, %2\n\ts_nop 0\n\tglobal_load_lds_dwordx4 %1, off\n\ts_mov_b32 m0, %0":"=&s"(keep):"v"(gsrc),"s"(lds_dst):"memory");}
__device__ __forceinline__ float max3f(float a,float b,float c){float r;asm("v_max3_f32 %0, %1, %2, %3":"=v"(r):"v"(a),"v"(b),"v"(c));return r;}
__device__ __forceinline__ float max2f(float a,float b){float r;asm("v_max_f32_e32 %0, %1, %2":"=v"(r):"v"(a),"v"(b));return r;}
__device__ __forceinline__ float fadd_s(float a,float b){float r;asm("v_add_f32_e32 %0, %1, %2":"=v"(r):"v"(a),"v"(b));return r;}
__device__ __forceinline__ float fsub_s(float a,float b){float r;asm("v_sub_f32_e32 %0, %1, %2":"=v"(r):"v"(a),"v"(b));return r;}
typedef float f32x2_t __attribute__((ext_vector_type(2))); typedef __bf16 bf16x2_t __attribute__((ext_vector_type(2)));
__device__ __forceinline__ unsigned cvtpk_s(float lo,float hi){f32x2_t v={lo,hi};bf16x2_t b=__builtin_convertvector(v,bf16x2_t);return __builtin_bit_cast(unsigned,b);}
#define WAIT_BAR(N) asm volatile("s_waitcnt vmcnt(" #N ") lgkmcnt(0)\n\ts_barrier":::"memory")

__device__ __forceinline__ void qkt(f32x16&p0,f32x16&p1,const char*Kslot,const bf16x8*qr,int r32,int hi){ const f32x16 negm={};
  const char*kb=Kslot+hi*1024+r32*16;
  #pragma unroll
  for(int d0=0;d0<4;++d0){
    const bf16x8 b0=*reinterpret_cast<const bf16x8*>(kb+d0*2048);
    const bf16x8 b1=*reinterpret_cast<const bf16x8*>(kb+d0*2048+512);
    if(d0==0){p0=__builtin_amdgcn_mfma_f32_32x32x16_bf16(b0,qr[0],negm,0,0,0);p1=__builtin_amdgcn_mfma_f32_32x32x16_bf16(b1,qr[0],negm,0,0,0);}
    else{p0=__builtin_amdgcn_mfma_f32_32x32x16_bf16(b0,qr[d0],p0,0,0,0);p1=__builtin_amdgcn_mfma_f32_32x32x16_bf16(b1,qr[d0],p1,0,0,0);}}
}
typedef __attribute__((address_space(3))) const char* lds_cptr;
typedef short v4i16_t __attribute__((ext_vector_type(4)));
__device__ __forceinline__ void kload8(bf16x8*kf,lds_cptr kp){
  kf[0]=*(const __attribute__((address_space(3))) bf16x8*)(kp);      kf[1]=*(const __attribute__((address_space(3))) bf16x8*)(kp+512);
  kf[2]=*(const __attribute__((address_space(3))) bf16x8*)(kp+2048); kf[3]=*(const __attribute__((address_space(3))) bf16x8*)(kp+2560);
  kf[4]=*(const __attribute__((address_space(3))) bf16x8*)(kp+4096); kf[5]=*(const __attribute__((address_space(3))) bf16x8*)(kp+4608);
  kf[6]=*(const __attribute__((address_space(3))) bf16x8*)(kp+6144); kf[7]=*(const __attribute__((address_space(3))) bf16x8*)(kp+6656);
}
__device__ __forceinline__ void kload2(bf16x8*kf,lds_cptr kp,int j){ kf[2*j]=*(const __attribute__((address_space(3))) bf16x8*)(kp+j*2048); kf[2*j+1]=*(const __attribute__((address_space(3))) bf16x8*)(kp+j*2048+512); }
__device__ __forceinline__ s16x4 vtr(lds_cptr p){ return __builtin_bit_cast(s16x4,__builtin_amdgcn_ds_read_tr16_b64_v4i16((__attribute__((address_space(3))) v4i16_t*)p)); }
__device__ __forceinline__ float rowmax(const f32x16&p0,const f32x16&p1){
  float a=max3f(p0[0],p0[1],p1[0]),b=max3f(p0[2],p0[3],p1[1]);a=max3f(a,p1[2],p1[3]);
  #pragma unroll
  for(int r=4;r<16;r+=4){a=max3f(a,p0[r],p0[r+1]);b=max3f(b,p0[r+2],p0[r+3]);a=max3f(a,p1[r],p1[r+1]);b=max3f(b,p1[r+2],p1[r+3]);}
  const float m=max2f(a,b);
  auto rr=__builtin_amdgcn_permlane32_swap(__float_as_uint(m),__float_as_uint(m),false,false);
  return max2f(__uint_as_float(rr[0]),__uint_as_float(rr[1]));
}
__device__ __forceinline__ void pv(f32x16*o,int vb,bf16x8 pa0,bf16x8 pa1,bf16x8 pa2,bf16x8 pa3){
  #pragma unroll
  for(int d0=0;d0<2;++d0){s16x4 lo[4],hi[4];
    #pragma unroll
    for(int ks=0;ks<4;++ks){
      asm volatile("ds_read_b64_tr_b16 %0,%1 offset:%c2":"=&v"(lo[ks]):"v"(vb),"i"(d0*4096+ks*1024):"memory");
      asm volatile("ds_read_b64_tr_b16 %0,%1 offset:%c2":"=&v"(hi[ks]):"v"(vb),"i"(d0*4096+ks*1024+512):"memory");}
    asm volatile("s_waitcnt lgkmcnt(0)":::"memory");SBAR();
    #define PK(k) (bf16x8){lo[k][0],lo[k][1],lo[k][2],lo[k][3],hi[k][0],hi[k][1],hi[k][2],hi[k][3]}
    o[d0]=__builtin_amdgcn_mfma_f32_32x32x16_bf16(pa0,PK(0),o[d0],0,0,0);
    o[d0]=__builtin_amdgcn_mfma_f32_32x32x16_bf16(pa1,PK(1),o[d0],0,0,0);
    o[d0]=__builtin_amdgcn_mfma_f32_32x32x16_bf16(pa2,PK(2),o[d0],0,0,0);
    o[d0]=__builtin_amdgcn_mfma_f32_32x32x16_bf16(pa3,PK(3),o[d0],0,0,0);
    #undef PK
  }
}

#ifndef ATTN_STORE16
#define ATTN_STORE16(p,v) (*(u32x4*)(p)=(v))
#endif
template<int THRL> __device__ __forceinline__ void attn_unit(const bf16*Qb,const bf16*__restrict__ Kh,const bf16*__restrict__ Vh,bf16*Ob,int NT,char*shm){
  int tid_l=threadIdx.x; asm volatile("":"+v"(tid_l));
  const int tid=tid_l,lane=tid&63,r32=lane&31,hi=lane>>5; const int wid=__builtin_amdgcn_readfirstlane(tid>>6);
  const bf16*Qw=Qb+(long)(wid*QBLK)*QP;
  const unsigned lds0=(unsigned)(uintptr_t)shm;
  float*wsf=(float*)(shm+LDS_WS)+wid*64;
  const bf16*ksrc=Kh+(long)lane*KP+wid*8;
  const bf16*vsrc=Vh+(long)(16*(wid&3)+(lane>>2))*VP+(wid>>2)*32+(lane&3)*8;
  const unsigned kdst=lds0+LDS_K+wid*1024, vdst=lds0+LDS_V+wid*1024;
  #define DMA_K(t,slot) glds16(ksrc+(long)(t)*KVBLK*KP,(unsigned)__builtin_amdgcn_readfirstlane(kdst+(slot)))
  #define DMA_V(t,slot) glds16(vsrc+(long)(t)*KVBLK*VP,(unsigned)__builtin_amdgcn_readfirstlane(vdst+(slot)))
  const int vb0=(int)(lds0+LDS_V)+((lane>>4)&1)*32+(lane&3)*8+(4*hi+((lane&15)>>2))*64;
  const char*Kbase=shm+LDS_K; bf16x8 kf[8];
  const lds_cptr shm3=(lds_cptr)shm; const lds_cptr kp0=shm3+LDS_K+hi*1024+r32*16; const lds_cptr vp0=shm3+LDS_V+((lane>>4)&1)*32+(lane&3)*8+(4*hi+((lane&15)>>2))*64;
  DMA_K(0,0);DMA_V(0,0);DMA_K(1,SLOTB);
  bf16x8 qr[4];
  #pragma unroll
  for(int d0=0;d0<4;++d0)qr[d0]=*reinterpret_cast<const bf16x8*>(&Qw[(long)r32*QP+d0*16+hi*8]);
  float mhat=0.f,l_reg=0.f;f32x16 o[2];o[0]=f32x16{};o[1]=f32x16{};
  #define CMASK(P0,P1,t) do{}while(0)
  bool resc=false;
  #define START(P0,P1) do{ const float rm=rowmax(P0,P1); resc=false; \
    { const float dl=rm; mhat=fadd_s(mhat,dl); \
      _Pragma("unroll") for(int r=0;r<16;++r){P0[r]=fsub_s(P0[r],dl);P1[r]=fsub_s(P1[r],dl);} } \
    _Pragma("unroll") for(int r=0;r<16;++r)P0[r]=__builtin_amdgcn_exp2f(P0[r]); }while(0)
  #define RESC() do{ if(resc){ asm volatile("s_waitcnt lgkmcnt(0)":::"memory"); \
      _Pragma("unroll") for(int d_=0;d_<2;++d_) _Pragma("unroll") for(int r=0;r<16;++r)o[d_][r]*=wsf[crow(r,hi)]; } }while(0)
  f32x16 pA0,pA1,pB0,pB1;
  int sl_prev=0,sl_cur=0,sl_next=SLOTB;
  #define ROT() do{sl_prev=sl_cur;sl_cur=sl_next;sl_next=(sl_next==(NSLOT-1)*SLOTB)?0:sl_next+SLOTB;}while(0)
  DMA_K(2,2*SLOTB);
  WAIT_BAR(3);
  qkt(pA0,pA1,Kbase,qr,r32,hi);asm volatile("s_nop 15\n\ts_nop 7":"+v"(pA0),"+v"(pA1));CMASK(pA0,pA1,0);
  START(pA0,pA1);
  _Pragma("unroll") for(int r=0;r<16;++r)pA1[r]=__builtin_amdgcn_exp2f(pA1[r]);
  WAIT_BAR(0);
  DMA_K(3,0);DMA_V(1,SLOTB);
  ROT();
  kload8(kf,kp0+sl_cur);
  WAIT_BAR(2);
  s16x4 vlo[8],vhi[8]; u32x4 pw0,pw1,pw2,pw3;
  #define PKW(P,B) cvtpk_s(P[B],P[B+1])
  #define PAF(k) __builtin_bit_cast(bf16x8,pw##k)
  #define VFR(i) (bf16x8){vlo[i][0],vlo[i][1],vlo[i][2],vlo[i][3],vhi[i][0],vhi[i][1],vhi[i][2],vhi[i][3]}
  #define PIN(x) asm volatile("":"+v"(x))
  #define MX3(a,b,c) __builtin_fmaxf(__builtin_fmaxf((a),(b)),(c))
  #define GAPA(MF,A0,A1,A2,A3,W0,W1,PW) do{ MF; sacc+=A0; sacc+=A1; sacc+=A2; sacc+=A3; PIN(sacc); W0; W1; PIN(PW); SBAR(); }while(0)
  #define EX(v) __builtin_amdgcn_exp2f(v)
  #define GAPB(MF,X,B) do{ MF; X[B]=EX(X[B]); X[B+1]=EX(X[B+1]); X[B+2]=EX(X[B+2]); X[B+3]=EX(X[B+3]); PIN(X); SBAR(); }while(0)
  #define VRD(i) do{ vlo[i]=vtr(vp_+(((i)>>2)*4096+((i)&3)*1024)); vhi[i]=vtr(vp_+(((i)>>2)*4096+((i)&3)*1024+512)); }while(0)
  #define KRD(G,j) do{ if(G){ kload2(kf,kp0+sl_next,j); SBAR(); } }while(0)
  #define STEP(C0,C1,P0,P1,t,GK,GV,GL) do{ SBAR(); \
    const lds_cptr vp_=vp0+sl_prev; \
    VRD(0); SBAR(); float sacc=(P0[0]+P0[1]); \
    GAPA(C0=__builtin_amdgcn_mfma_f32_32x32x16_bf16(kf[0],qr[0],(f32x16){},0,0,0), P0[2],P0[3],P0[4],P0[5],     pw0[0]=PKW(P0,0), pw0[1]=PKW(P0,2), pw0); \
    VRD(4); SBAR(); GAPA(C1=__builtin_amdgcn_mfma_f32_32x32x16_bf16(kf[1],qr[0],(f32x16){},0,0,0), P0[6],P0[7],P0[8],P0[9],     pw0[2]=PKW(P0,4), pw0[3]=PKW(P0,6), pw0); \
    VRD(1); SBAR(); GAPA(C0=__builtin_amdgcn_mfma_f32_32x32x16_bf16(kf[2],qr[1],C0,0,0,0),   P0[10],P0[11],P0[12],P0[13], pw1[0]=PKW(P0,8), pw1[1]=PKW(P0,10), pw1); \
    VRD(5); SBAR(); GAPA(C1=__builtin_amdgcn_mfma_f32_32x32x16_bf16(kf[3],qr[1],C1,0,0,0),   P0[14],P0[15],P1[0],P1[1],   pw1[2]=PKW(P0,12),pw1[3]=PKW(P0,14), pw1); \
    VRD(2); SBAR(); GAPA(C0=__builtin_amdgcn_mfma_f32_32x32x16_bf16(kf[4],qr[2],C0,0,0,0),   P1[2],P1[3],P1[4],P1[5],     pw2[0]=PKW(P1,0), pw2[1]=PKW(P1,2), pw2); \
    VRD(6); SBAR(); GAPA(C1=__builtin_amdgcn_mfma_f32_32x32x16_bf16(kf[5],qr[2],C1,0,0,0),   P1[6],P1[7],P1[8],P1[9],     pw2[2]=PKW(P1,4), pw2[3]=PKW(P1,6), pw2); \
    VRD(3); SBAR(); GAPA(C0=__builtin_amdgcn_mfma_f32_32x32x16_bf16(kf[6],qr[3],C0,0,0,0),   P1[10],P1[11],P1[12],P1[13], pw3[0]=PKW(P1,8), pw3[1]=PKW(P1,10), pw3); \
    VRD(7); SBAR(); GAPA(C1=__builtin_amdgcn_mfma_f32_32x32x16_bf16(kf[7],qr[3],C1,0,0,0),   P1[14],P1[15],0.f,0.f,       pw3[2]=PKW(P1,12),pw3[3]=PKW(P1,14), pw3); \
    l_reg+=sacc; \
    { _Pragma("unroll") for(int r=0;r<16;++r){C0[r]-=mhat;C1[r]-=mhat;} } \
    if(GK){DMA_K((t)+3,sl_cur);} if(GV){DMA_V((t)+1,sl_next);} \
    CMASK(C0,C1,t); \
    { float a=MX3(C0[0],C0[1],C1[0]),b=MX3(C0[2],C0[3],C1[1]); a=MX3(a,C1[2],C1[3]); \
      _Pragma("unroll") for(int r=4;r<16;r+=4){a=MX3(a,C0[r],C0[r+1]);b=MX3(b,C0[r+2],C0[r+3]);a=MX3(a,C1[r],C1[r+1]);b=MX3(b,C1[r+2],C1[r+3]);} \
      float rm=__builtin_fmaxf(a,b); { auto rr=__builtin_amdgcn_permlane32_swap(__float_as_uint(rm),__float_as_uint(rm),false,false); rm=__builtin_fmaxf(__uint_as_float(rr[0]),__uint_as_float(rr[1])); } \
      resc=false; \
      if(__builtin_expect(__any(rm>(float)THRL),0)){ const float dl=__builtin_fmaxf(rm,0.f); mhat+=dl; \
        _Pragma("unroll") for(int r=0;r<16;++r){C0[r]-=dl;C1[r]-=dl;} \
        const float f=__builtin_amdgcn_exp2f(-dl); l_reg*=f; if(hi==0)wsf[r32]=f; resc=true; } } \
    SBAR(); \
    GAPB(o[0]=__builtin_amdgcn_mfma_f32_32x32x16_bf16(PAF(0),VFR(0),o[0],0,0,0), C0,0); \
    GAPB(o[1]=__builtin_amdgcn_mfma_f32_32x32x16_bf16(PAF(0),VFR(4),o[1],0,0,0), C0,4); \
    KRD(GL,0); GAPB(o[0]=__builtin_amdgcn_mfma_f32_32x32x16_bf16(PAF(1),VFR(1),o[0],0,0,0), C0,8); \
    KRD(GL,1); GAPB(o[1]=__builtin_amdgcn_mfma_f32_32x32x16_bf16(PAF(1),VFR(5),o[1],0,0,0), C0,12); \
    KRD(GL,2); GAPB(o[0]=__builtin_amdgcn_mfma_f32_32x32x16_bf16(PAF(2),VFR(2),o[0],0,0,0), C1,0); \
    KRD(GL,3); GAPB(o[1]=__builtin_amdgcn_mfma_f32_32x32x16_bf16(PAF(2),VFR(6),o[1],0,0,0), C1,4); \
    GAPB(o[0]=__builtin_amdgcn_mfma_f32_32x32x16_bf16(PAF(3),VFR(3),o[0],0,0,0), C1,8); \
    GAPB(o[1]=__builtin_amdgcn_mfma_f32_32x32x16_bf16(PAF(3),VFR(7),o[1],0,0,0), C1,12); \
    }while(0)
  int t=1;
  for(;t+5<NT;t+=2){
    STEP(pB0,pB1,pA0,pA1,t,true,true,true);     WAIT_BAR(2); RESC(); ROT();
    STEP(pA0,pA1,pB0,pB1,t+1,true,true,true);   WAIT_BAR(2); RESC(); ROT();
  }
  #define ENDW(tt) do{ if((tt)+3<NT){WAIT_BAR(2);} else if((tt)+2<NT){WAIT_BAR(1);} else {WAIT_BAR(0);} }while(0)
  for(;t+1<NT;t+=2){
    STEP(pB0,pB1,pA0,pA1,t,(t+3<NT),(t+1<NT),(t+1<NT));       ENDW(t);   RESC(); ROT();
    STEP(pA0,pA1,pB0,pB1,t+1,(t+4<NT),(t+2<NT),(t+2<NT));     ENDW(t+1); RESC(); ROT();
  }
  STEP(pB0,pB1,pA0,pA1,NT-1,false,false,false); RESC();
  { float sacc=pB0[0]+pB0[1]; _Pragma("unroll") for(int r=2;r<16;++r)sacc+=pB0[r]; _Pragma("unroll") for(int r=0;r<16;++r)sacc+=pB1[r]; l_reg+=sacc;
    pw0=(u32x4){PKW(pB0,0),PKW(pB0,2),PKW(pB0,4),PKW(pB0,6)};pw1=(u32x4){PKW(pB0,8),PKW(pB0,10),PKW(pB0,12),PKW(pB0,14)};pw2=(u32x4){PKW(pB1,0),PKW(pB1,2),PKW(pB1,4),PKW(pB1,6)};pw3=(u32x4){PKW(pB1,8),PKW(pB1,10),PKW(pB1,12),PKW(pB1,14)};
    SBAR(); pv(o,vb0+sl_cur,PAF(0),PAF(1),PAF(2),PAF(3)); }
  #undef PKW
  #undef PAF
  #undef VFR
  #undef PIN
  #undef MX3
  #undef GAPA
  #undef GAPB
  #undef EX
  #undef VRD
  #undef KRD
  #undef STEP
  #undef ENDW
  {auto rr=__builtin_amdgcn_permlane32_swap(__float_as_uint(l_reg),__float_as_uint(l_reg),false,false);l_reg=__uint_as_float(rr[0])+__uint_as_float(rr[1]);}
  if(hi==0)wsf[32+r32]=l_reg;asm volatile("s_waitcnt lgkmcnt(0)":::"memory");
  float rli[16];
  #pragma unroll
  for(int r=0;r<16;++r)rli[r]=__builtin_amdgcn_rcpf(wsf[32+crow(r,hi)]);
  bf16*Ow=Ob+(long)(wid*QBLK)*QP;
  { bf16*stg=(bf16*)(shm+LDS_OST)+wid*2048;
    #pragma unroll
    for(int r=0;r<16;++r){const int orow=crow(r,hi);
      #pragma unroll
      for(int d0=0;d0<2;++d0)stg[orow*64+d0*32+r32]=__float2bfloat16(o[d0][r]*rli[r]);}
    asm volatile("s_waitcnt lgkmcnt(0)":::"memory");
    #pragma unroll
    for(int i=0;i<4;++i){const int row=i*8+(lane>>3),ch=lane&7; const u32x4 v=*(const u32x4*)(stg+row*64+ch*8); ATTN_STORE16(Ow+(long)row*QP+ch*8,v);} }
  asm volatile("s_waitcnt lgkmcnt(0)\n\ts_barrier":::"memory");
  #undef DMA_K
  #undef DMA_V
  #undef CMASK
  #undef START
  #undef RESC
  #undef ROT
}
constexpr int ATTN_LDS_BYTES=LDS_BYTES;
#undef SBAR
#undef WAIT_BAR
}
__device__ __forceinline__ void attn_task(KAP ap, int l, int t, int lane) {
    const unsigned char* ws = ap->ws;
    int type, b, h, j; bool ctxq = false;
    if (t < 6144) { type = t < 3072 ? 2 : 0; const int u = t % 3072; b = u / 1536; h = (u / 256) % 6; j = u % 256; }
    else { const int u = t - 6144; type = u / 96; b = (u / 48) % 2; h = (u / 8) % 6; j = u % 8; ctxq = true; }
    const int r32 = lane & 31, hi = lane >> 5;
    const int m0 = ctxq ? MLAT + b * LCTX + 32 * j : b * SEQ + 32 * j;
    bf16_t* Qp = (bf16_t*)(ws + WS_Q) + (size_t)(m0 + r32) * QW + (type * 6 + h) * 64;
    const bf16_t* Kb; const bf16_t* Vb; int pitchK;
    if (type == 2) { Kb = (const bf16_t*)(ws + WS_KC) + (size_t)b * KEYS * 384 + h * 64; pitchK = 384; Vb = (const bf16_t*)(ws + WS_VTC) + (size_t)(b * 6 + h) * 64 * KEYS; }
    else { const int kvh = h / 3; Kb = (const bf16_t*)(ws + WS_KAB) + (size_t)b * KEYS * 256 + type * 128 + kvh * 64; pitchK = 256; Vb = (const bf16_t*)(ws + WS_VTAB) + (size_t)(b * 4 + type * 2 + kvh) * 64 * KEYS; }
    const int q0 = 32 * j; int nmain = 0, tlo = 0, rs = 0;
    if (!ctxq) {
        if (type == 1) nmain = 128;
        else if (type == 0) { tlo = (q0 - 128) >> 6; if (tlo < 0) tlo = 0; int thi = (q0 + 31 + 128) >> 6; if (thi > 127) thi = 127; nmain = thi - tlo + 1; }
        else { const int r = j >> 1; rs = r - 4; if (rs < 0) rs = 0; if (rs > 120) rs = 120; tlo = rs; nmain = 8; }
    }
    bf16x8 qr[4];
#pragma unroll
    for (int d0 = 0; d0 < 4; ++d0) qr[d0] = *(const bf16x8*)(Qp + d0 * 16 + hi * 8);
    float mrun = -INFINITY, lrun = 0.f;
    if (type == 0) { mrun = ap->in[9][l * 6 + h] * LOG2E; lrun = hi == 0 ? 1.f : 0.f; }
    f32x16 o0 = {}, o1 = {};
    const int rsw = (r32 & ~12) | ((r32 & 4) << 1) | ((r32 & 8) >> 1);
    const float* rpb = ap->in[12] + (size_t)(l * 6 + h) * 15 * 31;
    const int qc = 32 * (j & 1) + r32; int wsn = qc - 8; wsn = wsn < 0 ? 0 : (wsn > 48 ? 48 : wsn);
    const int ntile = 4 + nmain;
#pragma unroll 1
    for (int tt = 0; tt < ntile; ++tt) {
        const int key0 = tt < 4 ? 64 * tt : LCTX + 64 * (tlo + tt - 4);
        const bf16_t* kp = Kb + (size_t)(key0 + rsw) * pitchK + 8 * hi;
        bf16x8 kf0[4], kf1[4];
#pragma unroll
        for (int d0 = 0; d0 < 4; ++d0) { kf0[d0] = *(const bf16x8*)(kp + d0 * 16); kf1[d0] = *(const bf16x8*)(kp + (size_t)32 * pitchK + d0 * 16); }
        const bf16_t* vp = Vb + (size_t)r32 * KEYS + key0 + 8 * hi;
        bf16x8 vf0[4], vf1[4];
#pragma unroll
        for (int ks = 0; ks < 4; ++ks) { vf0[ks] = *(const bf16x8*)(vp + 16 * ks); vf1[ks] = *(const bf16x8*)(vp + (size_t)32 * KEYS + 16 * ks); }
        f32x16 p0 = {}, p1 = {};
#pragma unroll
        for (int d0 = 0; d0 < 4; ++d0) { p0 = __builtin_amdgcn_mfma_f32_32x32x16_bf16(kf0[d0], qr[d0], p0, 0, 0, 0); p1 = __builtin_amdgcn_mfma_f32_32x32x16_bf16(kf1[d0], qr[d0], p1, 0, 0, 0); }
        if (tt >= 4 && type == 0) {
            const int kpos0 = 64 * (tlo + tt - 4) + 8 * hi - (q0 + r32);
#pragma unroll
            for (int r = 0; r < 16; ++r) { const int d0_ = kpos0 + 16 * (r >> 3) + (r & 7); if (d0_ > 128 || d0_ < -128) p0[r] = -INFINITY; const int d1_ = d0_ + 32; if (d1_ > 128 || d1_ < -128) p1[r] = -INFINITY; }
        } else if (tt >= 4 && type == 2) {
            const int ro = (rs + tt - 4) - (j >> 1) + 7;
            const float* rb = rpb + ro * 31 + 15 - qc;
#pragma unroll
            for (int r = 0; r < 16; ++r) {
                const int kc0 = 16 * (r >> 3) + 8 * hi + (r & 7), kc1 = kc0 + 32;
                if (kc0 >= wsn && kc0 < wsn + 16) p0[r] += rb[kc0] * LOG2E; else p0[r] = -INFINITY;
                if (kc1 >= wsn && kc1 < wsn + 16) p1[r] += rb[kc1] * LOG2E; else p1[r] = -INFINITY;
            }
        }
        float rm = fmaxf(p0[0], p1[0]);
#pragma unroll
        for (int r = 1; r < 16; ++r) rm = fmaxf(rm, fmaxf(p0[r], p1[r]));
        rm = fmaxf(rm, __shfl_xor(rm, 32));
        const float mn = fmaxf(mrun, rm);
        const float alpha = __builtin_amdgcn_exp2f(mrun - mn);
        mrun = mn;
        float sum = 0.f;
#pragma unroll
        for (int r = 0; r < 16; ++r) { p0[r] = __builtin_amdgcn_exp2f(p0[r] - mn); p1[r] = __builtin_amdgcn_exp2f(p1[r] - mn); sum += p0[r] + p1[r]; }
        lrun = lrun * alpha + sum;
#pragma unroll
        for (int r = 0; r < 16; ++r) { o0[r] *= alpha; o1[r] *= alpha; }
        bf16x8 pk[4];
#pragma unroll
        for (int ks = 0; ks < 4; ++ks) {
            u32x4 w;
            if (ks < 2) { w.x = cvt_pk_bf16(p0[8 * ks + 0], p0[8 * ks + 1]); w.y = cvt_pk_bf16(p0[8 * ks + 2], p0[8 * ks + 3]); w.z = cvt_pk_bf16(p0[8 * ks + 4], p0[8 * ks + 5]); w.w = cvt_pk_bf16(p0[8 * ks + 6], p0[8 * ks + 7]); }
            else { const int k2 = ks - 2; w.x = cvt_pk_bf16(p1[8 * k2 + 0], p1[8 * k2 + 1]); w.y = cvt_pk_bf16(p1[8 * k2 + 2], p1[8 * k2 + 3]); w.z = cvt_pk_bf16(p1[8 * k2 + 4], p1[8 * k2 + 5]); w.w = cvt_pk_bf16(p1[8 * k2 + 6], p1[8 * k2 + 7]); }
            pk[ks] = __builtin_bit_cast(bf16x8, w);
        }
#pragma unroll
        for (int ks = 0; ks < 4; ++ks) { o0 = __builtin_amdgcn_mfma_f32_32x32x16_bf16(vf0[ks], pk[ks], o0, 0, 0, 0); o1 = __builtin_amdgcn_mfma_f32_32x32x16_bf16(vf1[ks], pk[ks], o1, 0, 0, 0); }
    }
    const float lt = lrun + __shfl_xor(lrun, 32);
    const float inv = 1.0f / lt;
#pragma unroll
    for (int g = 0; g < 4; ++g) {
        u32x2 w0, w1;
        w0.x = cvt_pk_bf16(o0[4 * g + 0] * inv, o0[4 * g + 1] * inv); w0.y = cvt_pk_bf16(o0[4 * g + 2] * inv, o0[4 * g + 3] * inv);
        w1.x = cvt_pk_bf16(o1[4 * g + 0] * inv, o1[4 * g + 1] * inv); w1.y = cvt_pk_bf16(o1[4 * g + 2] * inv, o1[4 * g + 3] * inv);
        *(u32x2*)(Qp + 8 * g + 4 * hi) = w0; *(u32x2*)(Qp + 32 + 8 * g + 4 * hi) = w1;
    }
}

#define XB_TMO      128
#define XB_XCNT(j)  (256  + 64 * (j))
#define XB_XSUB(j)  (1280 + 64 * (j))
#define XB_XGEN(j)  (2304 + 64 * (j))
#define XB_TOP      3328
#define XB_TOPGEN   3392
#define XCD_BAR_WORDS 3456
#define XB_SPIN_CAP (1u << 18)

__device__ __forceinline__ unsigned xb_ld(unsigned* p)              { return __hip_atomic_load(p, __ATOMIC_RELAXED, __HIP_MEMORY_SCOPE_AGENT); }
__device__ __forceinline__ unsigned xb_add(unsigned* p, unsigned v) { return __hip_atomic_fetch_add(p, v, __ATOMIC_RELAXED, __HIP_MEMORY_SCOPE_AGENT); }
__device__ __forceinline__ unsigned xb_xcc_id() { return (unsigned)__builtin_amdgcn_s_getreg((3 << 11) | 20) & 0xFu; }
#define XB_SPIN(cond, bar) do { unsigned _sp = 0; while (cond) { __builtin_amdgcn_s_sleep(1); \
    if ((++_sp & 255u) == 0u) { if (xb_ld(&(bar)[XB_TMO])) break; if (_sp > XB_SPIN_CAP) { atomicAdd(&(bar)[XB_TMO], 1u); break; } } } } while (0)

struct XcdBarrier {
    unsigned* bar; unsigned x;
    volatile __attribute__((address_space(3))) unsigned* st;
};

__device__ __forceinline__ XcdBarrier xcd_barrier_post(unsigned* bar, volatile __attribute__((address_space(3))) unsigned* st) {
    XcdBarrier b; b.bar = bar; b.x = xb_xcc_id(); b.st = st;
    if (threadIdx.x == 0) (void)xb_add(&bar[XB_XCNT(b.x)], 1u);
    return b;
}
__device__ __forceinline__ void xcd_barrier_complete(unsigned* bar, unsigned x, unsigned& nloc, unsigned& nx) {
    const unsigned G = gridDim.x * gridDim.y * gridDim.z;
    unsigned sum, cnt, mine, sp = 0u;
    for (;;) {
        sum = 0u; cnt = 0u; mine = 0u;
#pragma unroll
        for (unsigned j = 0; j < 16; ++j) { const unsigned c = xb_ld(&bar[XB_XCNT(j)]); sum += c; cnt += (c > 0u) ? 1u : 0u; mine = (j == x) ? c : mine; }
        if (sum == G) break;
        __builtin_amdgcn_s_sleep(1);
        if ((++sp & 255u) == 0u) { if (xb_ld(&bar[XB_TMO])) break; if (sp > XB_SPIN_CAP) { atomicAdd(&bar[XB_TMO], 1u); break; } }
    }
    nloc = mine > 0u ? mine : 1u; nx = cnt > 0u ? cnt : 1u;
}

__device__ __forceinline__ void xcd_barrier(const XcdBarrier& b) {
    asm volatile("s_waitcnt vmcnt(0)" ::: "memory");
    __syncthreads();
    if (threadIdx.x == 0) {
        unsigned* bar = b.bar;
        __builtin_amdgcn_s_waitcnt(0);
        unsigned nloc = b.st[0], nx = b.st[1];
        if (nloc == 0u) { xcd_barrier_complete(bar, b.x, nloc, nx); b.st[0] = nloc; b.st[1] = nx; }
        const unsigned old = xb_add(&bar[XB_XSUB(b.x)], 1u);
        const unsigned gen = old / nloc;
        if (old + 1u == (gen + 1u) * nloc) {
            __builtin_amdgcn_fence(__ATOMIC_RELEASE, "agent");
            asm volatile("s_waitcnt vmcnt(0)" ::: "memory");
            const unsigned og = xb_add(&bar[XB_TOP], 1u);
            const unsigned tg = og / nx;
            if (og + 1u == (tg + 1u) * nx) xb_add(&bar[XB_TOPGEN], 1u);
            else XB_SPIN(xb_ld(&bar[XB_TOPGEN]) == tg, bar);
            __builtin_amdgcn_fence(__ATOMIC_ACQUIRE, "agent");
            xb_add(&bar[XB_XGEN(b.x)], 1u);
            asm volatile("s_waitcnt vmcnt(0)" ::: "memory");
        } else {
            XB_SPIN(xb_ld(&bar[XB_XGEN(b.x)]) == gen, bar);
            __builtin_amdgcn_fence(__ATOMIC_ACQUIRE, "agent");
            asm volatile("s_waitcnt vmcnt(0)" ::: "memory");
        }
    }
    __syncthreads();
}
__global__ void __launch_bounds__(512, 2) fwd_mega(Args a) {
    extern __shared__ __attribute__((aligned(16))) unsigned char lds_raw[];
    cg::grid_group grid = cg::this_grid();
    PG8_LAS unsigned char* lds = (PG8_LAS unsigned char*)lds_raw;
    const int tid = threadIdx.x, wave = __builtin_amdgcn_readfirstlane(tid >> 6);
    const int G = gridDim.x, gw = blockIdx.x * 8 + wave, NGW = G * 8;
#define LANE() ({ int l_ = threadIdx.x & 63; asm volatile("" : "+v"(l_)); l_; })
#define WSP() ((unsigned char*)KARGS()->ws)
#define MODS() ((float*)(WSP() + WS_MODS))
#define CTL() ((unsigned*)(WSP() + WS_CTL))
    volatile LAS unsigned* MISC = (volatile LAS unsigned*)((LAS unsigned char*)lds_raw + 131072);
    if (tid < 64) MISC[tid] = 0u;
    __syncthreads();
    { const XcdBarrier xb0 = xcd_barrier_post(CTL() + 4096, MISC + 8); (void)xb0; }
#define GRID_BAR() do { XcdBarrier xb_; xb_.bar = CTL() + 4096; xb_.x = xb_xcc_id(); xb_.st = MISC + 8; xcd_barrier(xb_); } while (0)

    conv_weights(KARGS(), 0, (LAS unsigned char*)lds_raw, gw, NGW, wave, LANE());
    ada_phase(KARGS(), gw, NGW, LANE());
    if (blockIdx.x == 0) {
        float* rope = (float*)(WSP() + WS_ROPE);
        for (int i = tid; i < 128 * 16; i += 512) { const int pos = i >> 4, f = i & 15; const float fr = powf(10000.0f, -(float)f / 16.0f); const float ang = (float)pos * fr; float s, c; sincosf(ang, &s, &c); rope[2 * i] = c; rope[2 * i + 1] = s; }
    }
    grid.sync();
    { KAP ap = KARGS();
      row_phase(gw, NGW, LANE(), MALL, nullptr, nullptr, nullptr, 0, ap->in[0], ap->in[2], nullptr, nullptr,
              (bf16_t*)(WSP() + WS_R1), ap->in[6], MODS(), 0, 1024); }
    GRID_BAR();

#pragma unroll 1
    for (int l = 0; l < DEPTH; ++l) {
        const bool last = (l == DEPTH - 1);
        const int MX = last ? MLAT : MALL;
        int bidl = blockIdx.x, Gl = gridDim.x; asm volatile("" : "+s"(bidl), "+s"(Gl));
#define MODL() (MODS() + (size_t)l * 3 * 6144)
        {
            pg8::Gemm g{(const bf16_t*)(WSP() + WS_R1), (const bf16_t*)(WSP() + WS_WIN), MALL, NINP, DM, DM, DM, 0, 0};
            pg8::StaticOrder S; S.init(MALL, NINP, Gl, bidl);
            EpiScatter E{(bf16_t*)(WSP() + WS_Q), (bf16_t*)(WSP() + WS_KAB), (bf16_t*)(WSP() + WS_KC), (bf16_t*)(WSP() + WS_VTAB), (bf16_t*)(WSP() + WS_VTC), (bf16_t*)(WSP() + WS_PG), (bf16_t*)(WSP() + WS_VB)};
            pg8::gemm_phase<EpiScatter, pg8::StaticOrder, true, true>(lds, g, S, E);
        }
        GRID_BAR();
        post_phase(KARGS(), l, gw, NGW, LANE());
        GRID_BAR();
        {
            KAP ap = KARGS(); const int lane = LANE();
            for (int uid = blockIdx.x; uid < 384; uid += G) {
                const int qb = uid & 31, bh = uid >> 5, b = bh / 6, h = bh % 6;
                const attn_body::bf16* Qb = (const attn_body::bf16*)(WSP() + WS_Q) + (size_t)(b * SEQ + qb * 256) * QW + (6 + h) * 64;
                const attn_body::bf16* Kh = (const attn_body::bf16*)(WSP() + WS_KAB) + (size_t)b * KEYS * 256 + 128 + (h / 3) * 64;
                const attn_body::bf16* Vh = (const attn_body::bf16*)(WSP() + WS_VB) + (size_t)b * KEYS * 128 + (h / 3) * 64;
                attn_body::attn_unit<8>(Qb, Kh, Vh, (attn_body::bf16*)Qb, KEYS / 64, (char*)lds_raw);
            }
            const int ntask = 6144 + (last ? 0 : 288);
            unsigned* ctr = CTL() + 64 * l;
            for (;;) {
                int t = 0;
                if (lane == 0) t = (int)atomicAdd(ctr, 1u);
                t = __builtin_amdgcn_readfirstlane(t);
                if (t >= ntask) break;
                attn_task(ap, l, t, lane);
            }
        }
        GRID_BAR();
        {
            pg8::Gemm g{(const bf16_t*)(WSP() + WS_Q), (const bf16_t*)(WSP() + WS_WBR), MX, DM, QW, QW, QW, 0, 0};
            pg8::StaticOrder S; S.init(MX, DM, Gl, bidl);
            EpiGateSum E{(bf16_t*)(WSP() + WS_PG)};
            pg8::gemm_phase<EpiGateSum, pg8::StaticOrder, true, true, 6>(lds, g, S, E);
        }
        GRID_BAR();
        {
            pg8::Gemm g{(const bf16_t*)(WSP() + WS_PG), (const bf16_t*)(WSP() + WS_WOUT), MX, DM, DM, 3072, DM, 0, 0};
            pg8::StaticOrder S; S.init(MX, DM, Gl, bidl);
            EpiBf16<0> E{(bf16_t*)(WSP() + WS_Y), DM};
            pg8::gemm_phase<EpiBf16<0>, pg8::StaticOrder, true, true>(lds, g, S, E);
        }
        GRID_BAR();
        { KAP ap = KARGS();
          row_phase(gw, NGW, LANE(), MX, (const bf16_t*)(WSP() + WS_Y), ap->in[7] + l * DM, MODL(), 2048,
                  l == 0 ? ap->in[0] : ap->out, l == 0 ? ap->in[2] : (const float*)(WSP() + WS_XC), ap->out, (float*)(WSP() + WS_XC),
                  (bf16_t*)(WSP() + WS_Q), ap->in[17] + l * DM, MODL(), 3072, 4096); }
        GRID_BAR();
        {
            pg8::Gemm g{(const bf16_t*)(WSP() + WS_Q), (const bf16_t*)(WSP() + WS_W1), MX, FF, DM, DM, DM, 0, 0};
            pg8::StaticOrder S; S.init(MX, FF, Gl, bidl);
            EpiBf16<1> E{(bf16_t*)(WSP() + WS_A), FF};
            pg8::gemm_phase<EpiBf16<1>, pg8::StaticOrder, true, true>(lds, g, S, E);
        }
        GRID_BAR();
        {
            pg8::Gemm g{(const bf16_t*)(WSP() + WS_A), (const bf16_t*)(WSP() + WS_W2), MX, DM, FF, FF, FF, 0, 0};
            pg8::StaticOrder S; S.init(MX, DM, Gl, bidl);
            EpiBf16<0> E{(bf16_t*)(WSP() + WS_Y2), DM};
            pg8::gemm_phase<EpiBf16<0>, pg8::StaticOrder, true, true>(lds, g, S, E);
        }
        GRID_BAR();
        if (!last) {
            { KAP ap = KARGS();
              row_phase(gw, NGW, LANE(), MX, (const bf16_t*)(WSP() + WS_Y2), ap->in[18] + l * DM, MODL(), 5120,
                      ap->out, (const float*)(WSP() + WS_XC), ap->out, (float*)(WSP() + WS_XC),
                      (bf16_t*)(WSP() + WS_R1), ap->in[6] + (l + 1) * DM, MODL() + 3 * 6144, 0, 1024); }
            conv_weights(KARGS(), l + 1, (LAS unsigned char*)lds_raw, gw, NGW, wave, LANE());
            GRID_BAR();
        } else {
            { KAP ap = KARGS();
              row_phase(gw, NGW, LANE(), MX, (const bf16_t*)(WSP() + WS_Y2), ap->in[18] + l * DM, MODL(), 5120,
                      ap->out, (const float*)(WSP() + WS_XC), ap->out, (float*)(WSP() + WS_XC),
                      nullptr, nullptr, nullptr, 0, 0); }
        }
    }
}

extern "C" void kernel_launch(void* const* d_in, const int* in_sizes, int n_in, void* d_out, int out_size, void* d_ws, size_t ws_size, hipStream_t stream) {
    static int grid = 0;
    if (grid == 0) {
        if (n_in != 21 || out_size != MLAT * DM || ws_size < WS_END) { fprintf(stderr, "kernel_launch: unexpected shapes (n_in %d, out %d, ws %zu need %zu)\n", n_in, out_size, ws_size, (size_t)WS_END); grid = -1; return; }
        int dev = 0, cus = 0, per_cu = 0;
        if (hipGetDevice(&dev) != hipSuccess || hipDeviceGetAttribute(&cus, hipDeviceAttributeMultiprocessorCount, dev) != hipSuccess) { grid = -1; return; }
        if (hipFuncSetAttribute((const void*)fwd_mega, hipFuncAttributeMaxDynamicSharedMemorySize, LDS_BYTES) != hipSuccess) { fprintf(stderr, "kernel_launch: hipFuncSetAttribute failed\n"); grid = -1; return; }
        if (hipOccupancyMaxActiveBlocksPerMultiprocessor(&per_cu, (const void*)fwd_mega, 512, LDS_BYTES) != hipSuccess || per_cu < 1) { fprintf(stderr, "kernel_launch: occupancy query says %d blocks per CU\n", per_cu); grid = -1; return; }
        grid = cus;
    }
    if (grid < 0) return;
    (void)hipMemsetAsync((char*)d_ws + WS_CTL, 0, CTL_ZERO_BYTES, stream);
    Args a{};
    for (int i = 0; i < 21; ++i) a.in[i] = (const float*)d_in[i];
    a.out = (float*)d_out; a.ws = (unsigned char*)d_ws;
    void* args[] = {&a};
    hipError_t e = hipLaunchCooperativeKernel((const void*)fwd_mega, dim3(grid), dim3(512), args, LDS_BYTES, stream);
    if (e != hipSuccess) fprintf(stderr, "cooperative launch failed: %s (grid %d)\n", hipGetErrorString(e), grid);
}
```

```cpp
#include <hip/hip_runtime.h>
#include <hip/hip_cooperative_groups.h>
#include <cstdio>
#include <cstdint>
namespace cg = cooperative_groups;
#ifndef PROBE_MASK
#define PROBE_MASK 0
#endif

__device__ __forceinline__ int lane_id() { int l; asm volatile("v_mbcnt_lo_u32_b32 %0, -1, 0\n\tv_mbcnt_hi_u32_b32 %0, -1, %0" : "=v"(l)); return l; }
__device__ __forceinline__ int tid_of(int wave) { int t = wave * 64 + lane_id(); asm volatile("" : "+v"(t)); return t; }
namespace pg8 {
#define PG8_LAS __attribute__((address_space(3)))
typedef unsigned short bf16_t;
typedef short bf16x8 __attribute__((ext_vector_type(8)));
typedef float f32x4 __attribute__((ext_vector_type(4)));
typedef unsigned u32x4 __attribute__((ext_vector_type(4)));
constexpr int BM = 256, BK = 64, HALF = 128, HTB = HALF * BK * 2, STAGE_BYTES = 8 * HTB, NXCD = 8, WGM = 8;

__host__ __device__ __forceinline__ int lds_byte(int r, int c) { const int st = (r >> 4) * 2 + (c >> 5), rr = r & 15, cc = c & 31, ob = rr * 64 + cc * 2; return st * 1024 + (ob ^ (((ob >> 9) & 1) << 5)); }
__host__ __device__ __forceinline__ void stage_rc(int b, int& R, int& C) { const int st = b / 1024, sb = b % 1024, swz = sb ^ (((sb >> 9) & 1) << 5); R = (st >> 1) * 16 + swz / 64; C = (st & 1) * 32 + (swz % 64) / 2; }
__host__ __device__ __forceinline__ int perm32(int rho) { const int n = rho >> 4, i = rho & 15; return 8 * (i >> 2) + 4 * n + (i & 3); }

struct Unit { int pm, pn; };
struct Gemm { const bf16_t* A; const bf16_t* Bt; int M, N, K, lda, ldb, a_split; size_t a_stride; };

struct StaticOrder {
    int nM, nN, nwg, G, c;
    __host__ __device__ void init(int M, int N, int G_, int c_) { nM = M / BM; nN = N / BM; nwg = nM * nN; G = G_; c = c_; }
    __host__ __device__ bool next(int i, Unit& u) const {
        const long L = (long)i * G + c; if (L >= nwg) return false;
        int wgid = (int)L; { const int q = nwg / NXCD, r = nwg % NXCD, xcd = wgid % NXCD, off = wgid / NXCD; wgid = (xcd < r ? xcd * (q + 1) : r * (q + 1) + (xcd - r) * q) + off; }
        const int nig = WGM * nN, gid = wgid / nig, fm = gid * WGM, gsz = (nM - fm) < WGM ? (nM - fm) : WGM;
        u.pm = fm + ((wgid % nig) % gsz); u.pn = (wgid % nig) / gsz; return true;
    }
};

__device__ __forceinline__ unsigned cvt_pk_bf16(float lo, float hi) { unsigned r; asm volatile("v_cvt_pk_bf16_f32 %0, %1, %2" : "=v"(r) : "v"(lo), "v"(hi)); return r; }


template <class Epi, class Sched, bool ALIGN_EPI = false, bool SP2 = false, int SEG = 0>
__device__ __forceinline__ void gemm_phase(PG8_LAS unsigned char* lds, const Gemm g, const Sched& S, const Epi& E, int wave_id) {
    const int tid = tid_of(wave_id), wid = wave_id, lane = tid & 63, wr = wid >> 2, wc = wid & 3, fr = lane & 15, fq = lane >> 4;
    const int K = g.K, nt = K / BK;
    unsigned voffA[2], voffB[2];
#pragma unroll
    for (int i = 0; i < 2; ++i) { int R, C; stage_rc(tid * 16 + i * 8192, R, C); const int Rb = Epi::PERM ? ((R & ~31) + perm32(R & 31)) : R;
        voffA[i] = (unsigned)(R * g.lda + C) * 2u; voffB[i] = (unsigned)(Rb * g.ldb + C) * 2u; }
    const size_t kstep = (size_t)(BK * 2);
    const size_t hstepA = (size_t)HALF * g.lda * 2, hstepB = (size_t)HALF * g.ldb * 2;
    const size_t tstepA = 2 * hstepA, tstepB = 2 * hstepB;
    const unsigned ldsw = (unsigned)wid * 1024u;
    const int aoff = lds_byte(wr * 64 + fr, fq * 8), boff = lds_byte(wc * 32 + fr, fq * 8);
#define PG8_SA(b, h) (((b) * 2 + (h)) * HTB)
#define PG8_SB(b, h) ((4 + (b) * 2 + (h)) * HTB)
#define PG8_STAGE(bufoff, gbase, voff) do { _Pragma("unroll") for (int _i = 0; _i < 2; ++_i) \
        __builtin_amdgcn_global_load_lds((const unsigned*)((const char*)(gbase) + (voff)[_i]), (PG8_LAS unsigned*)(lds + (bufoff) + ldsw + _i * 8192), 16, 0, 0); } while (0)
#define PG8_LDA(dst, b, h) do { _Pragma("unroll") for (int m = 0; m < 4; ++m) _Pragma("unroll") for (int k = 0; k < 2; ++k) dst[m][k] = *(const PG8_LAS bf16x8*)(lds + PG8_SA(b, h) + aoff + m * 2048 + k * 1024); } while (0)
#define PG8_LDB(dst, b, h) do { _Pragma("unroll") for (int n = 0; n < 2; ++n) _Pragma("unroll") for (int k = 0; k < 2; ++k) dst[n][k] = *(const PG8_LAS bf16x8*)(lds + PG8_SB(b, h) + boff + n * 2048 + k * 1024); } while (0)
#define PG8_MMA(ai, bj, At, Bt) do { __builtin_amdgcn_s_setprio(1); _Pragma("unroll") for (int m = 0; m < 4; ++m) _Pragma("unroll") for (int n = 0; n < 2; ++n) _Pragma("unroll") for (int k = 0; k < 2; ++k) \
        acc[ai][bj][m][n] = __builtin_amdgcn_mfma_f32_16x16x32_bf16(Bt[n][k], At[m][k], acc[ai][bj][m][n], 0, 0, 0); __builtin_amdgcn_s_setprio(0); } while (0)
#define PG8_WAIT_V(n) asm volatile("s_waitcnt vmcnt(" #n ")" ::: "memory")
#define PG8_WAIT_L(n) asm volatile("s_waitcnt lgkmcnt(" #n ")" ::: "memory")
#define PG8_BAR __builtin_amdgcn_s_barrier()
#define PG8_SCHED __builtin_amdgcn_sched_barrier(0)
#define PG8_ABASE(u) ((const char*)g.A + (size_t)(u).pm * tstepA + (g.a_split ? (size_t)((u).pn / g.a_split) * g.a_stride : (size_t)0))
    Unit cur, nxt; int ui = 0;
    if (!S.next(0, cur)) return;
    f32x4 acc[2][2][4][2];
#pragma unroll
    for (int a = 0; a < 2; ++a)
#pragma unroll
        for (int b = 0; b < 2; ++b)
#pragma unroll
            for (int m = 0; m < 4; ++m)
#pragma unroll
                for (int n = 0; n < 2; ++n) acc[a][b][m][n] = (f32x4){0.f, 0.f, 0.f, 0.f};
    bf16x8 At[4][2], B0[2][2], B1[2][2];
    const char* cA = PG8_ABASE(cur); const char* cB = (const char*)g.Bt + (size_t)cur.pn * tstepB;
    if constexpr (SP2) {
        PG8_STAGE(PG8_SB(0, 0), cB, voffB); PG8_STAGE(PG8_SB(0, 1), cB + hstepB, voffB); PG8_STAGE(PG8_SA(0, 0), cA, voffA); PG8_STAGE(PG8_SA(0, 1), cA + hstepA, voffA);
        if (wr == 1) PG8_BAR;
        PG8_WAIT_V(2); PG8_BAR;
        PG8_STAGE(PG8_SB(1, 0), cB + kstep, voffB); PG8_STAGE(PG8_SA(1, 0), cA + kstep, voffA); PG8_STAGE(PG8_SB(1, 1), cB + hstepB + kstep, voffB);
        PG8_WAIT_V(6); PG8_BAR;
    } else {
        PG8_STAGE(PG8_SB(0, 0), cB, voffB); PG8_STAGE(PG8_SA(0, 0), cA, voffA); PG8_STAGE(PG8_SB(0, 1), cB + hstepB, voffB); PG8_STAGE(PG8_SA(0, 1), cA + hstepA, voffA);
        if (wr == 1) PG8_BAR;
        PG8_WAIT_V(4); PG8_BAR;
        PG8_STAGE(PG8_SB(1, 0), cB + kstep, voffB); PG8_STAGE(PG8_SA(1, 0), cA + kstep, voffA); PG8_STAGE(PG8_SB(1, 1), cB + hstepB + kstep, voffB);
        PG8_WAIT_V(6); PG8_BAR;
    }
    for (;;) {
        const bool has_next = S.next(ui + 1, nxt);
        const char* nA = has_next ? PG8_ABASE(nxt) : cA; const char* nB = has_next ? (const char*)g.Bt + (size_t)nxt.pn * tstepB : cB;
#pragma unroll 1
        for (int t = 0; t < nt; t += 2) {
            const bool last = (t == nt - 2);
            const char* a1 = cA + (size_t)(t + 1) * kstep;
            const char* a2 = last ? nA : cA + (size_t)(t + 2) * kstep; const char* b2 = last ? nB : cB + (size_t)(t + 2) * kstep;
            const char* a3 = a2 + kstep; const char* b3 = b2 + kstep;
            if constexpr (SP2) {
            PG8_LDB(B0, 0, 0); PG8_LDB(B1, 0, 1); PG8_SCHED; PG8_LDA(At, 0, 0); PG8_STAGE(PG8_SA(1, 1), a1 + hstepA, voffA);
            PG8_WAIT_V(8); PG8_WAIT_L(0); PG8_BAR; PG8_MMA(0, 0, At, B0); PG8_MMA(0, 1, At, B1); PG8_BAR; PG8_SCHED;
            PG8_LDA(At, 0, 1); PG8_STAGE(PG8_SB(0, 0), b2, voffB); PG8_STAGE(PG8_SB(0, 1), b2 + hstepB, voffB); PG8_STAGE(PG8_SA(0, 0), a2, voffA);
            PG8_WAIT_V(8); PG8_WAIT_L(0); PG8_BAR; PG8_MMA(1, 0, At, B0); PG8_MMA(1, 1, At, B1); PG8_BAR; PG8_SCHED;
            PG8_LDB(B0, 1, 0); PG8_LDB(B1, 1, 1); PG8_SCHED; PG8_LDA(At, 1, 0); PG8_STAGE(PG8_SA(0, 1), a2 + hstepA, voffA);
            PG8_WAIT_V(8); PG8_WAIT_L(0); PG8_BAR; PG8_MMA(0, 0, At, B0); PG8_MMA(0, 1, At, B1); PG8_BAR; PG8_SCHED;
            PG8_LDA(At, 1, 1); PG8_STAGE(PG8_SB(1, 0), b3, voffB); PG8_STAGE(PG8_SB(1, 1), b3 + hstepB, voffB); PG8_STAGE(PG8_SA(1, 0), a3, voffA);
            PG8_WAIT_V(8); PG8_WAIT_L(0); PG8_BAR; PG8_MMA(1, 0, At, B0); PG8_MMA(1, 1, At, B1); PG8_BAR; PG8_SCHED;
            } else {
            PG8_LDB(B0, 0, 0); PG8_SCHED; PG8_LDA(At, 0, 0); PG8_STAGE(PG8_SA(1, 1), a1 + hstepA, voffA);
            PG8_WAIT_L(8); PG8_BAR; PG8_WAIT_L(0); PG8_MMA(0, 0, At, B0); PG8_BAR; PG8_SCHED;
            PG8_LDB(B1, 0, 1); PG8_STAGE(PG8_SB(0, 0), b2, voffB);
            PG8_BAR; PG8_WAIT_L(0); PG8_MMA(0, 1, At, B1); PG8_BAR;
            PG8_LDA(At, 0, 1); PG8_STAGE(PG8_SA(0, 0), a2, voffA);
            PG8_BAR; PG8_WAIT_L(0); PG8_MMA(1, 0, At, B0); PG8_BAR; PG8_SCHED;
            PG8_STAGE(PG8_SB(0, 1), b2 + hstepB, voffB);
            PG8_WAIT_V(6); PG8_BAR; PG8_MMA(1, 1, At, B1); PG8_BAR;
            PG8_LDB(B0, 1, 0); PG8_SCHED; PG8_LDA(At, 1, 0); PG8_STAGE(PG8_SA(0, 1), a2 + hstepA, voffA);
            PG8_WAIT_L(8); PG8_BAR; PG8_WAIT_L(0); PG8_MMA(0, 0, At, B0); PG8_BAR; PG8_SCHED;
            PG8_LDB(B1, 1, 1); PG8_STAGE(PG8_SB(1, 0), b3, voffB);
            PG8_BAR; PG8_WAIT_L(0); PG8_MMA(0, 1, At, B1); PG8_BAR;
            PG8_LDA(At, 1, 1); PG8_STAGE(PG8_SA(1, 0), a3, voffA);
            PG8_BAR; PG8_WAIT_L(0); PG8_MMA(1, 0, At, B0); PG8_BAR; PG8_SCHED;
            PG8_STAGE(PG8_SB(1, 1), b3 + hstepB, voffB);
            PG8_WAIT_V(6); PG8_BAR; PG8_MMA(1, 1, At, B1); PG8_BAR;
            }
            if constexpr (SEG > 0) {
                if (!last && (t + 2) % SEG == 0) {
                    E.segment(acc, (t + 2) / SEG - 1, cur, wr, wc, fr, fq);
#pragma unroll
                    for (int a = 0; a < 2; ++a)
#pragma unroll
                        for (int b = 0; b < 2; ++b)
#pragma unroll
                            for (int m = 0; m < 4; ++m)
#pragma unroll
                                for (int n = 0; n < 2; ++n) acc[a][b][m][n] = (f32x4){0.f, 0.f, 0.f, 0.f};
                }
            }
        }
        if constexpr (ALIGN_EPI) { if (wr == 0) PG8_BAR; }
        E(acc, cur, wr, wc, fr, fq);
        if (!has_next) break;
#pragma unroll
        for (int a = 0; a < 2; ++a)
#pragma unroll
            for (int b = 0; b < 2; ++b)
#pragma unroll
                for (int m = 0; m < 4; ++m)
#pragma unroll
                    for (int n = 0; n < 2; ++n) acc[a][b][m][n] = (f32x4){0.f, 0.f, 0.f, 0.f};
        cur = nxt; cA = nA; cB = nB; ++ui;
        if constexpr (ALIGN_EPI) { if (wr == 1) PG8_BAR; }
    }
    PG8_WAIT_V(0);
    if constexpr (!ALIGN_EPI) { if (wr == 0) PG8_BAR; }
    PG8_BAR;
#undef PG8_SA
#undef PG8_SB
#undef PG8_STAGE
#undef PG8_LDA
#undef PG8_LDB
#undef PG8_MMA
#undef PG8_WAIT_V
#undef PG8_WAIT_L
#undef PG8_BAR
#undef PG8_SCHED
#undef PG8_ABASE
}
}

using pg8::bf16_t; using pg8::f32x4; using pg8::u32x4; using pg8::Unit; using pg8::cvt_pk_bf16;
typedef short bf16x8 __attribute__((ext_vector_type(8)));
typedef float f32x16 __attribute__((ext_vector_type(16)));
typedef unsigned u32x2 __attribute__((ext_vector_type(2)));
#define LAS __attribute__((address_space(3)))

constexpr int DM = 1024, SEQ = 8192, NB = 2, LCTX = 256, DEPTH = 2;
constexpr int MLAT = NB * SEQ;
constexpr int MALL = MLAT + NB * LCTX;
constexpr int KEYS = LCTX + SEQ;
constexpr int NIN = 5504, NINP = 5632;
constexpr int FF = 4096;
constexpr int QW = 1152;
constexpr float EPS = 1e-6f;
constexpr float LOG2E = 1.4426950408889634f;
constexpr float QSCALE = 0.125f * LOG2E;

constexpr size_t MiB = 1u << 20;
constexpr size_t WS_CTL = 0, CTL_ZERO_BYTES = 256 * 1024;
constexpr size_t WS_MODS = 64 * 1024;
constexpr size_t WS_ROPE = 256 * 1024;
constexpr size_t WS_XC = 1 * MiB;
constexpr size_t WS_WIN = 4 * MiB;
constexpr size_t WS_WBR = WS_WIN + 11 * MiB;
constexpr size_t WS_WOUT = WS_WBR + 9 * MiB / 4;
constexpr size_t WS_W1 = WS_WOUT + 6 * MiB;
constexpr size_t WS_W2 = WS_W1 + 8 * MiB;
constexpr size_t WS_R1 = 40 * MiB;
constexpr size_t WS_KAB = WS_R1 + 33 * MiB;
constexpr size_t WS_KC = WS_KAB + (size_t)NB * KEYS * 256 * 2;
constexpr size_t WS_VTAB = WS_KC + (size_t)NB * KEYS * 384 * 2;
constexpr size_t WS_VTC = WS_VTAB + (size_t)NB * 4 * 64 * KEYS * 2;
constexpr size_t WS_PG = WS_VTC + (size_t)NB * 6 * 64 * KEYS * 2;
constexpr size_t WS_Q = WS_PG + (size_t)MALL * 3072 * 2;
constexpr size_t WS_VB = WS_Q + (size_t)MALL * QW * 2;
constexpr size_t WS_END = WS_VB + (size_t)NB * KEYS * 128 * 2;
constexpr size_t WS_Y = WS_R1;
constexpr size_t WS_A = WS_R1;
constexpr size_t WS_Y2 = WS_A + (size_t)MALL * FF * 2;
static_assert(WS_W2 + 8 * MiB <= WS_R1, "weights");
static_assert(WS_Y + (size_t)MALL * DM * 4 <= WS_PG, "Y overlay");
static_assert(WS_A + (size_t)MALL * FF * 2 <= WS_Q, "A overlay");
static_assert(WS_Y2 + (size_t)MALL * DM * 4 <= WS_END && WS_END <= 256 * MiB, "ws map");

constexpr int LDS_BYTES = 147456;

struct EpiScatter {
    static constexpr bool PERM = true;
    bf16_t *Q, *KAB, *KC, *VAB, *VC, *PG;
    __device__ __forceinline__ void operator()(const f32x4 (&acc)[2][2][4][2], const Unit& u, int wr, int wc, int fr, int fq) const {
        const int pm = u.pm; int kroff;
        if (pm < 64) { const int b = pm >> 5; kroff = 256 * b + 256; } else { const int b = pm - 64; kroff = -MLAT + SEQ * b; }
        const int row0 = pm * 256 + wr * 64 + fr, cin = wc * 32 + 8 * fq;
#pragma unroll
        for (int bj = 0; bj < 2; ++bj) {
            const int cb = 2 * u.pn + bj;
            if (cb >= 43) continue;
            int pitch, col, radd = 0; bf16_t* base;
            if (cb >= 19) { base = PG; pitch = 3072; col = 128 * (cb - 19) + cin; }
            else if (cb <= 2) { base = Q; pitch = QW; col = 128 * cb + cin; }
            else if (cb == 3) { base = KAB; pitch = 256; col = cin; radd = kroff; }
            else if (cb == 4) { base = VAB; pitch = 256; col = cin; radd = kroff; }
            else if (cb <= 7) { base = Q; pitch = QW; col = 384 + 128 * (cb - 5) + cin; }
            else if (cb == 8) { base = KAB; pitch = 256; col = 128 + cin; radd = kroff; }
            else if (cb == 9) { base = VAB; pitch = 256; col = 128 + cin; radd = kroff; }
            else if (cb <= 12) { base = Q; pitch = QW; col = 768 + 128 * (cb - 10) + cin; }
            else if (cb <= 15) { base = KC; pitch = 384; col = 128 * (cb - 13) + cin; radd = kroff; }
            else { base = VC; pitch = 384; col = 128 * (cb - 16) + cin; radd = kroff; }
            bf16_t* pb = base + (size_t)(row0 + radd) * pitch + col;
#pragma unroll
            for (int ai = 0; ai < 2; ++ai)
#pragma unroll
                for (int m = 0; m < 4; ++m) {
                    const f32x4 v0 = acc[ai][bj][m][0], v1 = acc[ai][bj][m][1];
                    u32x4 w; w.x = cvt_pk_bf16(v0[0], v0[1]); w.y = cvt_pk_bf16(v0[2], v0[3]); w.z = cvt_pk_bf16(v1[0], v1[1]); w.w = cvt_pk_bf16(v1[2], v1[3]);
                    *(u32x4*)(pb + (size_t)(ai * 128 + m * 16) * pitch) = w;
                }
        }
    }
};
__device__ __forceinline__ float bf2f(unsigned h) { return __uint_as_float(h << 16); }
struct EpiGateSum {
    static constexpr bool PERM = true;
    bf16_t* PG;
    static __device__ __forceinline__ unsigned gate2(unsigned g, unsigned sprev, float a0, float a1) {
        const float g0 = bf2f(g & 0xffffu), g1 = bf2f(g >> 16);
        const float s0 = __builtin_amdgcn_rcpf(1.0f + __builtin_amdgcn_exp2f(-LOG2E * g0)), s1 = __builtin_amdgcn_rcpf(1.0f + __builtin_amdgcn_exp2f(-LOG2E * g1));
        return cvt_pk_bf16(a0 * s0 + bf2f(sprev & 0xffffu), a1 * s1 + bf2f(sprev >> 16));
    }
    __device__ __forceinline__ void segment(const f32x4 (&acc)[2][2][4][2], int br, const Unit& u, int wr, int wc, int fr, int fq) const {
        const int row0 = u.pm * 256 + wr * 64 + fr, col0 = u.pn * 256 + wc * 32 + 8 * fq;
        bf16_t* pb = PG + (size_t)row0 * 3072 + col0;
#pragma unroll
        for (int ai = 0; ai < 2; ++ai)
#pragma unroll
            for (int m = 0; m < 4; ++m)
#pragma unroll
                for (int bj = 0; bj < 2; ++bj) {
                    u32x4* p = (u32x4*)(pb + (size_t)(ai * 128 + m * 16) * 3072 + bj * 128);
                    const u32x4 gq = *(const u32x4*)((const bf16_t*)p + br * 1024);
                    u32x4 sp = {0u, 0u, 0u, 0u}; if (br > 0) sp = *p;
                    const f32x4 v0 = acc[ai][bj][m][0], v1 = acc[ai][bj][m][1];
                    u32x4 w; w.x = gate2(gq.x, sp.x, v0[0], v0[1]); w.y = gate2(gq.y, sp.y, v0[2], v0[3]); w.z = gate2(gq.z, sp.z, v1[0], v1[1]); w.w = gate2(gq.w, sp.w, v1[2], v1[3]);
                    *p = w;
                    asm volatile("" ::: "memory");
                }
    }
    __device__ __forceinline__ void operator()(const f32x4 (&acc)[2][2][4][2], const Unit& u, int wr, int wc, int fr, int fq) const { segment(acc, 2, u, wr, wc, fr, fq); }
};
template <int ACT  > struct EpiBf16 {
    static constexpr bool PERM = true;
    bf16_t* O; int ldc;
    __device__ __forceinline__ void operator()(const f32x4 (&acc)[2][2][4][2], const Unit& u, int wr, int wc, int fr, int fq) const {
        const int row0 = u.pm * 256 + wr * 64 + fr, col0 = u.pn * 256 + wc * 32 + 8 * fq;
#pragma unroll
        for (int ai = 0; ai < 2; ++ai)
#pragma unroll
            for (int m = 0; m < 4; ++m)
#pragma unroll
                for (int bj = 0; bj < 2; ++bj) {
                    f32x4 v0 = acc[ai][bj][m][0], v1 = acc[ai][bj][m][1];
                    if (ACT == 1) {
#pragma unroll
                        for (int e = 0; e < 4; ++e) { const float a = fmaxf(v0[e], 0.f), c = fmaxf(v1[e], 0.f); v0[e] = a * a; v1[e] = c * c; }
                    }
                    u32x4 w; w.x = cvt_pk_bf16(v0[0], v0[1]); w.y = cvt_pk_bf16(v0[2], v0[3]); w.z = cvt_pk_bf16(v1[0], v1[1]); w.w = cvt_pk_bf16(v1[2], v1[3]);
                    *(u32x4*)(O + (size_t)(row0 + ai * 128 + m * 16) * ldc + col0 + bj * 128) = w;
                }
    }
};
struct EpiF32 {
    static constexpr bool PERM = true;
    float* O; int ldc;
    __device__ __forceinline__ void operator()(const f32x4 (&acc)[2][2][4][2], const Unit& u, int wr, int wc, int fr, int fq) const {
        const int row0 = u.pm * 256 + wr * 64 + fr, col0 = u.pn * 256 + wc * 32 + 8 * fq;
#pragma unroll
        for (int ai = 0; ai < 2; ++ai)
#pragma unroll
            for (int m = 0; m < 4; ++m)
#pragma unroll
                for (int bj = 0; bj < 2; ++bj) {
                    float* p = O + (size_t)(row0 + ai * 128 + m * 16) * ldc + col0 + bj * 128;
                    *(f32x4*)p = acc[ai][bj][m][0]; *(f32x4*)(p + 4) = acc[ai][bj][m][1];
                }
    }
};

__device__ __forceinline__ float wave_sum(float v) {
#pragma unroll
    for (int o = 1; o < 64; o <<= 1) v += __shfl_xor(v, o);
    return v;
}
__device__ __forceinline__ unsigned f2bf(float f) { unsigned u = __builtin_bit_cast(unsigned, f); return (u + 0x7fffu + ((u >> 16) & 1u)) >> 16; }
__device__ __forceinline__ unsigned pk2(float lo, float hi) { return f2bf(lo) | (f2bf(hi) << 16); }

__device__ __forceinline__ void transpose_item(const float* W, int K, int N, bf16_t* WT, int ldk, int row_off, int copies, int copy_stride, LAS float* scr, int item, int lane) {
    const int nblk = N / 32, kb = item / nblk, nb = item % nblk, k0 = 64 * kb, n0 = 32 * nb;
#pragma unroll 8
    for (int i = 0; i < 32; ++i) { const int kk = 2 * i + (lane >> 5); scr[kk * 33 + (lane & 31)] = W[(size_t)(k0 + kk) * N + n0 + (lane & 31)]; }
    asm volatile("s_waitcnt lgkmcnt(0)" ::: "memory");
    const int c = lane & 7;
#pragma unroll
    for (int j = 0; j < 4; ++j) { const int n = (lane >> 3) + 8 * j; const LAS float* s = scr + (8 * c) * 33 + n;
        u32x4 o; o.x = pk2(s[0 * 33], s[1 * 33]); o.y = pk2(s[2 * 33], s[3 * 33]); o.z = pk2(s[4 * 33], s[5 * 33]); o.w = pk2(s[6 * 33], s[7 * 33]);
        for (int cc = 0; cc < copies; ++cc) *(u32x4*)(WT + (size_t)(row_off + n0 + n) * ldk + cc * copy_stride + k0 + 8 * c) = o; }
    asm volatile("s_waitcnt lgkmcnt(0)" ::: "memory");
}

struct Args { const float* in[21]; float* out; unsigned char* ws; int pad0, pad1; };
typedef const __attribute__((address_space(4))) Args* KAP;
#define KARGS() ({ KAP p_ = (KAP)__builtin_amdgcn_kernarg_segment_ptr(); asm volatile("" : "+s"(p_)); p_; })

__device__ __forceinline__ void conv_weights(KAP ap, int l, LAS unsigned char* lds, int gw, int NGW, int wave, int lane) {
    unsigned char* ws = ap->ws;
    LAS float* scr = (LAS float*)(lds + wave * 16384);
    constexpr int I_IN = 16 * (NIN / 32), I_BR = 6 * 32, I_OUT = 16 * 32, I_1 = 16 * (FF / 32), I_2 = (FF / 64) * 32;
    constexpr int NITEMS = I_IN + 3 * I_BR + I_OUT + I_1 + I_2;
    for (int it = gw; it < NITEMS; it += NGW) {
        int r = it;
        if (r < I_IN) { transpose_item(ap->in[8] + (size_t)l * DM * NIN, DM, NIN, (bf16_t*)(ws + WS_WIN), DM, 0, 1, 0, scr, r, lane); continue; } r -= I_IN;
        if (r < I_BR) { transpose_item(ap->in[13] + (size_t)l * 384 * DM, 384, DM, (bf16_t*)(ws + WS_WBR), 1152, 0, 1, 0, scr, r, lane); continue; } r -= I_BR;
        if (r < I_BR) { transpose_item(ap->in[14] + (size_t)l * 384 * DM, 384, DM, (bf16_t*)(ws + WS_WBR) + 384, 1152, 0, 1, 0, scr, r, lane); continue; } r -= I_BR;
        if (r < I_BR) { transpose_item(ap->in[15] + (size_t)l * 384 * DM, 384, DM, (bf16_t*)(ws + WS_WBR) + 768, 1152, 0, 1, 0, scr, r, lane); continue; } r -= I_BR;
        if (r < I_OUT) { transpose_item(ap->in[16] + (size_t)l * DM * DM, DM, DM, (bf16_t*)(ws + WS_WOUT), DM, 0, 1, 0, scr, r, lane); continue; } r -= I_OUT;
        if (r < I_1) { transpose_item(ap->in[19] + (size_t)l * DM * FF, DM, FF, (bf16_t*)(ws + WS_W1), DM, 0, 1, 0, scr, r, lane); continue; } r -= I_1;
        transpose_item(ap->in[20] + (size_t)l * FF * DM, FF, DM, (bf16_t*)(ws + WS_W2), FF, 0, 1, 0, scr, r, lane);
    }
    u32x4* pad = (u32x4*)(ws + WS_WIN + (size_t)NIN * DM * 2);
    unsigned z0 = 0u; asm volatile("" : "+v"(z0));
    for (int i = gw * 64 + lane; i < (NINP - NIN) * DM * 2 / 16; i += NGW * 64) pad[i] = (u32x4){z0, z0, z0, z0};
}

__device__ __forceinline__ void ada_phase(KAP ap, int gw, int NGW, int lane) {
    float* mods = (float*)(ap->ws + WS_MODS);
    const float* c = ap->in[1]; const float* cc = ap->in[3];
    for (int t = gw; t < DEPTH * 16 * 24; t += NGW) {
        const int l = t / (16 * 24), kc = (t / 24) % 16, jc = t % 24, col = jc * 256 + lane * 4;
        const float* W = ap->in[4] + ((size_t)l * DM + kc * 64) * 6144 + col;
        f32x4 s0 = {0.f, 0.f, 0.f, 0.f}, s1 = s0, s2 = s0;
        for (int k = 0; k < 64; ++k) {
            const f32x4 w = *(const f32x4*)(W + (size_t)k * 6144);
            const float x0 = c[kc * 64 + k], x1 = c[DM + kc * 64 + k], x2 = cc[kc * 64 + k];
            const float a0 = x0 / (1.f + __expf(-x0)), a1 = x1 / (1.f + __expf(-x1)), a2 = x2 / (1.f + __expf(-x2));
            s0 += w * a0; s1 += w * a1; s2 += w * a2;
        }
        if (kc == 0) { const f32x4 bb = *(const f32x4*)(ap->in[5] + (size_t)l * 6144 + col); s0 += bb; s1 += bb; s2 += bb; }
        float* m0 = mods + (size_t)(l * 3) * 6144 + col;
#pragma unroll
        for (int e = 0; e < 4; ++e) { atomicAdd(m0 + e, s0[e]); atomicAdd(m0 + 6144 + e, s1[e]); atomicAdd(m0 + 2 * 6144 + e, s2[e]); }
    }
}

__device__ __forceinline__ void row_phase(int gw, int NGW, int lane, int nrows, const bf16_t* Y, const float* gainY, const float* modsG, int gate_off,
                                          const float* rin_lat, const float* rin_ctx, float* rout_lat, float* rout_ctx,
                                          bf16_t* H, const float* gainH, const float* modsH, int shift_off, int scale_off) {
    for (int m = gw; m < nrows; m += NGW) {
        const int v = m < MLAT ? (m >> 13) : 2;
        const size_t roff = m < MLAT ? (size_t)m * DM : (size_t)(m - MLAT) * DM;
        const f32x4* xr = (const f32x4*)((m < MLAT ? rin_lat : rin_ctx) + roff) + lane;
        f32x4 x[4];
#pragma unroll
        for (int j = 0; j < 4; ++j) x[j] = xr[64 * j];
        if (Y) {
            const u32x2* yr = (const u32x2*)(Y + (size_t)m * DM) + lane;
            f32x4 y[4]; float ss = 0.f;
#pragma unroll
            for (int j = 0; j < 4; ++j) { const u32x2 yw = yr[64 * j]; y[j] = (f32x4){bf2f(yw.x & 0xffffu), bf2f(yw.x >> 16), bf2f(yw.y & 0xffffu), bf2f(yw.y >> 16)}; ss += (y[j].x * y[j].x + y[j].y * y[j].y) + (y[j].z * y[j].z + y[j].w * y[j].w); }
            const float rstd = rsqrtf(wave_sum(ss) * (1.f / DM) + EPS);
            const f32x4* gy = (const f32x4*)gainY + lane; const f32x4* gt = (const f32x4*)(modsG + (size_t)v * 6144 + gate_off) + lane;
            f32x4* ro = (f32x4*)((m < MLAT ? rout_lat : rout_ctx) + roff) + lane;
#pragma unroll
            for (int j = 0; j < 4; ++j) { x[j] = x[j] + gt[64 * j] * (y[j] * rstd * gy[64 * j]); ro[64 * j] = x[j]; }
        }
        if (H) {
            float ss = 0.f;
#pragma unroll
            for (int j = 0; j < 4; ++j) ss += (x[j].x * x[j].x + x[j].y * x[j].y) + (x[j].z * x[j].z + x[j].w * x[j].w);
            const float rstd = rsqrtf(wave_sum(ss) * (1.f / DM) + EPS);
            const f32x4* gh = (const f32x4*)gainH + lane; const f32x4* sh = (const f32x4*)(modsH + (size_t)v * 6144 + shift_off) + lane; const f32x4* sc = (const f32x4*)(modsH + (size_t)v * 6144 + scale_off) + lane;
            u32x2* ho = (u32x2*)(H + (size_t)m * DM) + lane;
#pragma unroll
            for (int j = 0; j < 4; ++j) { const f32x4 h = (x[j] * rstd * gh[64 * j]) * (sc[64 * j] + 1.0f) + sh[64 * j]; u32x2 w; w.x = pk2(h.x, h.y); w.y = pk2(h.z, h.w); ho[64 * j] = w; }
        }
    }
}

__device__ __forceinline__ void post_phase(KAP ap, int l, int gw, int NGW, int lane) {
    bf16_t* Q = (bf16_t*)(ap->ws + WS_Q); bf16_t* KAB = (bf16_t*)(ap->ws + WS_KAB);
    const float* rope = (const float*)(ap->ws + WS_ROPE);
    const float* qn = ap->in[10] + l * 64; const float* kn = ap->in[11] + l * 64;
    const int p = lane & 31, hh = lane >> 5;
    for (int m = gw; m < MALL; m += NGW) {
        const bool lat = m < MLAT; const int s = m & (SEQ - 1);
        float cs = 1.f, sn = 0.f;
        if (lat) { const int pos = p < 16 ? (s >> 6) : (s & 63); const float* t = rope + (pos * 16 + (p & 15)) * 2; cs = t[0]; sn = t[1]; }
        const int kr = lat ? m + 256 * (m >> 13) + 256 : ((m - MLAT) >> 8) * KEYS + ((m - MLAT) & 255);
#pragma unroll 1
        for (int it = 0; it < 11; ++it) {
            const int head = it * 2 + hh;
            unsigned* ptr; bool norm, rot, scl; const float* gn;
            if (head < 18) { ptr = (unsigned*)(Q + (size_t)m * QW + head * 64) + p; norm = (head >= 6 && head < 12); rot = head < 12; scl = true; gn = qn; }
            else { ptr = (unsigned*)(KAB + (size_t)kr * 256 + (head - 18) * 64) + p; norm = head >= 20; rot = true; scl = false; gn = kn; }
            const unsigned w = *ptr; float x0 = bf2f(w & 0xffffu), x1 = bf2f(w >> 16);
            float ss = x0 * x0 + x1 * x1;
#pragma unroll
            for (int o = 1; o < 32; o <<= 1) ss += __shfl_xor(ss, o);
            if (norm) { const float rstd = rsqrtf(ss * (1.f / 64.f) + EPS); x0 = x0 * rstd * gn[2 * p]; x1 = x1 * rstd * gn[2 * p + 1]; }
            if (rot) { const float y0 = x0 * cs - x1 * sn, y1 = x0 * sn + x1 * cs; x0 = y0; x1 = y1; }
            if (scl) { x0 *= QSCALE; x1 *= QSCALE; }
            *ptr = pk2(x0, x1);
        }
    }
}

#include <hip/hip_bf16.h>
#include <cmath>
namespace attn_body {
using bf16=__hip_bfloat16;
using bf16x8=__attribute__((ext_vector_type(8)))short;
using s16x4=__attribute__((ext_vector_type(4)))short;
using f32x16=__attribute__((ext_vector_type(16)))float;
using u32x4=__attribute__((ext_vector_type(4)))unsigned;
constexpr int D=64,QP=1152;
constexpr int BIAS_OFF=90112;
struct UnitCtx { int toff; int qpos0; int gr; int rs; int qc; unsigned vm; float sink2; };
constexpr int NW=8,QBLK=32,QB=QBLK*NW,KVBLK=64;
__device__ __forceinline__ int crow(int r,int hi){return (r&3)+8*(r>>2)+4*hi;}
#define SBAR() __builtin_amdgcn_sched_barrier(0)
constexpr int NSLOT=3, SLOTB=8192;
constexpr int LDS_K=0, LDS_V=NSLOT*SLOTB, LDS_WS=2*NSLOT*SLOTB, LDS_OST=LDS_WS+NW*64*4, LDS_BYTES=LDS_OST+NW*4096;
constexpr float C2=0.125f*1.4426950408889634f;
__device__ __forceinline__ void glds16(const void*gsrc,unsigned lds_dst){unsigned keep;
  asm volatile("s_mov_b32 %0, m0\n\ts_mov_b32 m0, %2\n\ts_nop 0\n\tglobal_load_lds_dwordx4 %1, off\n\ts_mov_b32 m0, %0":"=&s"(keep):"v"(gsrc),"s"(lds_dst):"memory");}
__device__ __forceinline__ float max3f(float a,float b,float c){float r;asm("v_max3_f32 %0, %1, %2, %3":"=v"(r):"v"(a),"v"(b),"v"(c));return r;}
__device__ __forceinline__ float max2f(float a,float b){float r;asm("v_max_f32_e32 %0, %1, %2":"=v"(r):"v"(a),"v"(b));return r;}
__device__ __forceinline__ float fadd_s(float a,float b){float r;asm("v_add_f32_e32 %0, %1, %2":"=v"(r):"v"(a),"v"(b));return r;}
__device__ __forceinline__ float fsub_s(float a,float b){float r;asm("v_sub_f32_e32 %0, %1, %2":"=v"(r):"v"(a),"v"(b));return r;}
typedef float f32x2_t __attribute__((ext_vector_type(2))); typedef __bf16 bf16x2_t __attribute__((ext_vector_type(2)));
__device__ __forceinline__ unsigned cvtpk_s(float lo,float hi){f32x2_t v={lo,hi};bf16x2_t b=__builtin_convertvector(v,bf16x2_t);return __builtin_bit_cast(unsigned,b);}
#define WAIT_BAR(N) asm volatile("s_waitcnt vmcnt(" #N ") lgkmcnt(0)\n\ts_barrier":::"memory")

__device__ __forceinline__ void qkt(f32x16&p0,f32x16&p1,const char*Kslot,const bf16x8*qr,int r32,int hi){ const f32x16 negm={};
  const char*kb=Kslot+hi*1024+r32*16;
  #pragma unroll
  for(int d0=0;d0<4;++d0){
    const bf16x8 b0=*reinterpret_cast<const bf16x8*>(kb+d0*2048);
    const bf16x8 b1=*reinterpret_cast<const bf16x8*>(kb+d0*2048+512);
    if(d0==0){p0=__builtin_amdgcn_mfma_f32_32x32x16_bf16(b0,qr[0],negm,0,0,0);p1=__builtin_amdgcn_mfma_f32_32x32x16_bf16(b1,qr[0],negm,0,0,0);}
    else{p0=__builtin_amdgcn_mfma_f32_32x32x16_bf16(b0,qr[d0],p0,0,0,0);p1=__builtin_amdgcn_mfma_f32_32x32x16_bf16(b1,qr[d0],p1,0,0,0);}}
}
typedef __attribute__((address_space(3))) const char* lds_cptr;
typedef short v4i16_t __attribute__((ext_vector_type(4)));
__device__ __forceinline__ void kload8(bf16x8*kf,lds_cptr kp){
  kf[0]=*(const __attribute__((address_space(3))) bf16x8*)(kp);      kf[1]=*(const __attribute__((address_space(3))) bf16x8*)(kp+512);
  kf[2]=*(const __attribute__((address_space(3))) bf16x8*)(kp+2048); kf[3]=*(const __attribute__((address_space(3))) bf16x8*)(kp+2560);
  kf[4]=*(const __attribute__((address_space(3))) bf16x8*)(kp+4096); kf[5]=*(const __attribute__((address_space(3))) bf16x8*)(kp+4608);
  kf[6]=*(const __attribute__((address_space(3))) bf16x8*)(kp+6144); kf[7]=*(const __attribute__((address_space(3))) bf16x8*)(kp+6656);
}
__device__ __forceinline__ void kload2(bf16x8*kf,lds_cptr kp,int j){ kf[2*j]=*(const __attribute__((address_space(3))) bf16x8*)(kp+j*2048); kf[2*j+1]=*(const __attribute__((address_space(3))) bf16x8*)(kp+j*2048+512); }
__device__ __forceinline__ s16x4 vtr(lds_cptr p){ return __builtin_bit_cast(s16x4,__builtin_amdgcn_ds_read_tr16_b64_v4i16((__attribute__((address_space(3))) v4i16_t*)p)); }
template<int MODE> __device__ __forceinline__ void amask(f32x16&c0,f32x16&c1,int t,const UnitCtx&uc,int hi,lds_cptr shm3){
  if(t<4)return;
  const float NEG=-INFINITY;
  if(MODE==1){ const int dq=64*(uc.toff+t-4)+4*hi-uc.qpos0;
    #pragma unroll
    for(int r=0;r<16;++r){ const int d=dq+(r&3)+8*(r>>2); if(d>128||d<-128)c0[r]=NEG; if(d+32>128||d+32<-128)c1[r]=NEG; } }
  else { const int kr=uc.toff+t-4;
    if(kr<uc.rs||kr>=uc.rs+8){
      #pragma unroll
      for(int r=0;r<16;++r){c0[r]=NEG;c1[r]=NEG;} }
    else { const __attribute__((address_space(3))) float*brow=(const __attribute__((address_space(3))) float*)(shm3+BIAS_OFF)+(kr-uc.gr+7)*31+15-uc.qc;
      unsigned vm=uc.vm; asm volatile("":"+v"(vm));
      #pragma unroll
      for(int r=0;r<16;++r){ const int kc=(r&3)+8*(r>>2)+4*hi; const float b0=brow[kc],b1=brow[kc+32];
        c0[r]=((vm>>r)&1u)?c0[r]+b0:NEG; c1[r]=((vm>>(16+r))&1u)?c1[r]+b1:NEG;
        if((r&3)==3)__builtin_amdgcn_sched_barrier(0); } } }
}
__device__ __forceinline__ float rowmax(const f32x16&p0,const f32x16&p1){
  float a=max3f(p0[0],p0[1],p1[0]),b=max3f(p0[2],p0[3],p1[1]);a=max3f(a,p1[2],p1[3]);
  #pragma unroll
  for(int r=4;r<16;r+=4){a=max3f(a,p0[r],p0[r+1]);b=max3f(b,p0[r+2],p0[r+3]);a=max3f(a,p1[r],p1[r+1]);b=max3f(b,p1[r+2],p1[r+3]);}
  const float m=max2f(a,b);
  auto rr=__builtin_amdgcn_permlane32_swap(__float_as_uint(m),__float_as_uint(m),false,false);
  return max2f(__uint_as_float(rr[0]),__uint_as_float(rr[1]));
}
__device__ __forceinline__ void pv(f32x16*o,int vb,bf16x8 pa0,bf16x8 pa1,bf16x8 pa2,bf16x8 pa3){
  #pragma unroll
  for(int d0=0;d0<2;++d0){s16x4 lo[4],hi[4];
    #pragma unroll
    for(int ks=0;ks<4;++ks){
      asm volatile("ds_read_b64_tr_b16 %0,%1 offset:%c2":"=&v"(lo[ks]):"v"(vb),"i"(d0*4096+ks*1024):"memory");
      asm volatile("ds_read_b64_tr_b16 %0,%1 offset:%c2":"=&v"(hi[ks]):"v"(vb),"i"(d0*4096+ks*1024+512):"memory");}
    asm volatile("s_waitcnt lgkmcnt(0)":::"memory");SBAR();
    #define PK(k) (bf16x8){lo[k][0],lo[k][1],lo[k][2],lo[k][3],hi[k][0],hi[k][1],hi[k][2],hi[k][3]}
    o[d0]=__builtin_amdgcn_mfma_f32_32x32x16_bf16(pa0,PK(0),o[d0],0,0,0);
    o[d0]=__builtin_amdgcn_mfma_f32_32x32x16_bf16(pa1,PK(1),o[d0],0,0,0);
    o[d0]=__builtin_amdgcn_mfma_f32_32x32x16_bf16(pa2,PK(2),o[d0],0,0,0);
    o[d0]=__builtin_amdgcn_mfma_f32_32x32x16_bf16(pa3,PK(3),o[d0],0,0,0);
    #undef PK
  }
}

#ifndef ATTN_STORE16
#define ATTN_STORE16(p,v) (*(u32x4*)(p)=(v))
#endif
template<int KP,int VP,int MODE,int THRL> __device__ __forceinline__ void attn_unit(const bf16*Qb,const bf16*__restrict__ Kh,const bf16*__restrict__ Vh,bf16*Ob,int NT,const UnitCtx uc,char*shm,int wave_id){
  const int tid=tid_of(wave_id),lane=tid&63,r32=lane&31,hi=lane>>5; const int wid=wave_id;
  const bf16*Qw=Qb+(long)(wid*QBLK)*QP;
  const unsigned lds0=(unsigned)(uintptr_t)shm;
  float*wsf=(float*)(shm+LDS_WS)+wid*64;
  const bf16*ksrc=Kh+(long)lane*KP+wid*8;
  const bf16*vsrc=Vh+(long)(16*(wid&3)+(lane>>2))*VP+(wid>>2)*32+(lane&3)*8;
  const unsigned kdst=lds0+LDS_K+wid*1024, vdst=lds0+LDS_V+wid*1024;
  #define KT(t) ((t)<4?(t):(t)+uc.toff)
  #define DMA_K(t,slot) glds16(ksrc+(long)KT(t)*KVBLK*KP,(unsigned)__builtin_amdgcn_readfirstlane(kdst+(slot)))
  #define DMA_V(t,slot) glds16(vsrc+(long)KT(t)*KVBLK*VP,(unsigned)__builtin_amdgcn_readfirstlane(vdst+(slot)))
  const int vb0=(int)(lds0+LDS_V)+((lane>>4)&1)*32+(lane&3)*8+(4*hi+((lane&15)>>2))*64;
  const char*Kbase=shm+LDS_K; bf16x8 kf[8];
  const lds_cptr shm3=(lds_cptr)shm; const lds_cptr kp0=shm3+LDS_K+hi*1024+r32*16; const lds_cptr vp0=shm3+LDS_V+((lane>>4)&1)*32+(lane&3)*8+(4*hi+((lane&15)>>2))*64;
  DMA_K(0,0);DMA_V(0,0);DMA_K(1,SLOTB);
  bf16x8 qr[4];
  #pragma unroll
  for(int d0=0;d0<4;++d0)qr[d0]=*reinterpret_cast<const bf16x8*>(&Qw[(long)r32*QP+d0*16+hi*8]);
  float mhat=0.f,l_reg=0.f;f32x16 o[2];o[0]=f32x16{};o[1]=f32x16{};
  #define CMASK(P0,P1,t) do{ if(MODE!=0) amask<MODE>(P0,P1,(t),uc,hi,(lds_cptr)shm); }while(0)
  bool resc=false;
  #define START(P0,P1) do{ const float rm=rowmax(P0,P1); resc=false; \
    { const float dl=rm; mhat=fadd_s(mhat,dl); \
      _Pragma("unroll") for(int r=0;r<16;++r){P0[r]=fsub_s(P0[r],dl);P1[r]=fsub_s(P1[r],dl);} } \
    _Pragma("unroll") for(int r=0;r<16;++r)P0[r]=__builtin_amdgcn_exp2f(P0[r]); }while(0)
  #define RESC() do{ if(resc){ asm volatile("s_waitcnt lgkmcnt(0)":::"memory"); \
      _Pragma("unroll") for(int d_=0;d_<2;++d_) _Pragma("unroll") for(int r=0;r<16;++r)o[d_][r]*=wsf[crow(r,hi)]; } }while(0)
  f32x16 pA0,pA1,pB0,pB1;
  int sl_prev=0,sl_cur=0,sl_next=SLOTB;
  #define ROT() do{sl_prev=sl_cur;sl_cur=sl_next;sl_next=(sl_next==(NSLOT-1)*SLOTB)?0:sl_next+SLOTB;}while(0)
  DMA_K(2,2*SLOTB);
  WAIT_BAR(3);
  qkt(pA0,pA1,Kbase,qr,r32,hi);asm volatile("s_nop 15\n\ts_nop 7":"+v"(pA0),"+v"(pA1));CMASK(pA0,pA1,0);
  START(pA0,pA1);
  if(uc.sink2>-1e30f){ l_reg=(hi==0)?__builtin_amdgcn_exp2f(uc.sink2-mhat):0.f; }
  _Pragma("unroll") for(int r=0;r<16;++r)pA1[r]=__builtin_amdgcn_exp2f(pA1[r]);
  WAIT_BAR(0);
  DMA_K(3,0);DMA_V(1,SLOTB);
  ROT();
  kload8(kf,kp0+sl_cur);
  WAIT_BAR(2);
  s16x4 vlo[8],vhi[8]; u32x4 pw0,pw1,pw2,pw3;
  #define PKW(P,B) cvtpk_s(P[B],P[B+1])
  #define PAF(k) __builtin_bit_cast(bf16x8,pw##k)
  #define VFR(i) (bf16x8){vlo[i][0],vlo[i][1],vlo[i][2],vlo[i][3],vhi[i][0],vhi[i][1],vhi[i][2],vhi[i][3]}
  #define PIN(x) asm volatile("":"+v"(x))
  #define MX3(a,b,c) __builtin_fmaxf(__builtin_fmaxf((a),(b)),(c))
  #define GAPA(MF,A0,A1,A2,A3,W0,W1,PW) do{ MF; sacc+=A0; sacc+=A1; sacc+=A2; sacc+=A3; PIN(sacc); W0; W1; PIN(PW); SBAR(); }while(0)
  #define EX(v) __builtin_amdgcn_exp2f(v)
  #define GAPB(MF,X,B) do{ MF; X[B]=EX(X[B]); X[B+1]=EX(X[B+1]); X[B+2]=EX(X[B+2]); X[B+3]=EX(X[B+3]); PIN(X); SBAR(); }while(0)
  #define VRD(i) do{ vlo[i]=vtr(vp_+(((i)>>2)*4096+((i)&3)*1024)); vhi[i]=vtr(vp_+(((i)>>2)*4096+((i)&3)*1024+512)); }while(0)
  #define KRD(G,j) do{ if(G){ kload2(kf,kp0+sl_next,j); SBAR(); } }while(0)
  #define STEP(C0,C1,P0,P1,t,GK,GV,GL) do{ SBAR(); \
    const lds_cptr vp_=vp0+sl_prev; \
    VRD(0); SBAR(); float sacc=(P0[0]+P0[1]); \
    GAPA(C0=__builtin_amdgcn_mfma_f32_32x32x16_bf16(kf[0],qr[0],(f32x16){},0,0,0), P0[2],P0[3],P0[4],P0[5],     pw0[0]=PKW(P0,0), pw0[1]=PKW(P0,2), pw0); \
    VRD(4); SBAR(); GAPA(C1=__builtin_amdgcn_mfma_f32_32x32x16_bf16(kf[1],qr[0],(f32x16){},0,0,0), P0[6],P0[7],P0[8],P0[9],     pw0[2]=PKW(P0,4), pw0[3]=PKW(P0,6), pw0); \
    VRD(1); SBAR(); GAPA(C0=__builtin_amdgcn_mfma_f32_32x32x16_bf16(kf[2],qr[1],C0,0,0,0),   P0[10],P0[11],P0[12],P0[13], pw1[0]=PKW(P0,8), pw1[1]=PKW(P0,10), pw1); \
    VRD(5); SBAR(); GAPA(C1=__builtin_amdgcn_mfma_f32_32x32x16_bf16(kf[3],qr[1],C1,0,0,0),   P0[14],P0[15],P1[0],P1[1],   pw1[2]=PKW(P0,12),pw1[3]=PKW(P0,14), pw1); \
    VRD(2); SBAR(); GAPA(C0=__builtin_amdgcn_mfma_f32_32x32x16_bf16(kf[4],qr[2],C0,0,0,0),   P1[2],P1[3],P1[4],P1[5],     pw2[0]=PKW(P1,0), pw2[1]=PKW(P1,2), pw2); \
    VRD(6); SBAR(); GAPA(C1=__builtin_amdgcn_mfma_f32_32x32x16_bf16(kf[5],qr[2],C1,0,0,0),   P1[6],P1[7],P1[8],P1[9],     pw2[2]=PKW(P1,4), pw2[3]=PKW(P1,6), pw2); \
    VRD(3); SBAR(); GAPA(C0=__builtin_amdgcn_mfma_f32_32x32x16_bf16(kf[6],qr[3],C0,0,0,0),   P1[10],P1[11],P1[12],P1[13], pw3[0]=PKW(P1,8), pw3[1]=PKW(P1,10), pw3); \
    VRD(7); SBAR(); GAPA(C1=__builtin_amdgcn_mfma_f32_32x32x16_bf16(kf[7],qr[3],C1,0,0,0),   P1[14],P1[15],0.f,0.f,       pw3[2]=PKW(P1,12),pw3[3]=PKW(P1,14), pw3); \
    l_reg+=sacc; \
    { _Pragma("unroll") for(int r=0;r<16;++r){C0[r]-=mhat;C1[r]-=mhat;} } \
    if(GK){DMA_K((t)+3,sl_cur);} if(GV){DMA_V((t)+1,sl_next);} \
    CMASK(C0,C1,t); \
    { float a=MX3(C0[0],C0[1],C1[0]),b=MX3(C0[2],C0[3],C1[1]); a=MX3(a,C1[2],C1[3]); \
      _Pragma("unroll") for(int r=4;r<16;r+=4){a=MX3(a,C0[r],C0[r+1]);b=MX3(b,C0[r+2],C0[r+3]);a=MX3(a,C1[r],C1[r+1]);b=MX3(b,C1[r+2],C1[r+3]);} \
      float rm=__builtin_fmaxf(a,b); { auto rr=__builtin_amdgcn_permlane32_swap(__float_as_uint(rm),__float_as_uint(rm),false,false); rm=__builtin_fmaxf(__uint_as_float(rr[0]),__uint_as_float(rr[1])); } \
      resc=false; \
      if(__builtin_expect(__any(rm>(float)THRL),0)){ const float dl=__builtin_fmaxf(rm,0.f); mhat+=dl; \
        _Pragma("unroll") for(int r=0;r<16;++r){C0[r]-=dl;C1[r]-=dl;} \
        const float f=__builtin_amdgcn_exp2f(-dl); l_reg*=f; if(hi==0)wsf[r32]=f; resc=true; } } \
    SBAR(); \
    GAPB(o[0]=__builtin_amdgcn_mfma_f32_32x32x16_bf16(PAF(0),VFR(0),o[0],0,0,0), C0,0); \
    GAPB(o[1]=__builtin_amdgcn_mfma_f32_32x32x16_bf16(PAF(0),VFR(4),o[1],0,0,0), C0,4); \
    KRD(GL,0); GAPB(o[0]=__builtin_amdgcn_mfma_f32_32x32x16_bf16(PAF(1),VFR(1),o[0],0,0,0), C0,8); \
    KRD(GL,1); GAPB(o[1]=__builtin_amdgcn_mfma_f32_32x32x16_bf16(PAF(1),VFR(5),o[1],0,0,0), C0,12); \
    KRD(GL,2); GAPB(o[0]=__builtin_amdgcn_mfma_f32_32x32x16_bf16(PAF(2),VFR(2),o[0],0,0,0), C1,0); \
    KRD(GL,3); GAPB(o[1]=__builtin_amdgcn_mfma_f32_32x32x16_bf16(PAF(2),VFR(6),o[1],0,0,0), C1,4); \
    GAPB(o[0]=__builtin_amdgcn_mfma_f32_32x32x16_bf16(PAF(3),VFR(3),o[0],0,0,0), C1,8); \
    GAPB(o[1]=__builtin_amdgcn_mfma_f32_32x32x16_bf16(PAF(3),VFR(7),o[1],0,0,0), C1,12); \
    }while(0)
  int t=1;
  for(;t+5<NT;t+=2){
    STEP(pB0,pB1,pA0,pA1,t,true,true,true);     WAIT_BAR(2); RESC(); ROT();
    STEP(pA0,pA1,pB0,pB1,t+1,true,true,true);   WAIT_BAR(2); RESC(); ROT();
  }
  #define ENDW(tt) do{ if((tt)+3<NT){WAIT_BAR(2);} else if((tt)+2<NT){WAIT_BAR(1);} else {WAIT_BAR(0);} }while(0)
  for(;t+1<NT;t+=2){
    STEP(pB0,pB1,pA0,pA1,t,(t+3<NT),(t+1<NT),(t+1<NT));       ENDW(t);   RESC(); ROT();
    STEP(pA0,pA1,pB0,pB1,t+1,(t+4<NT),(t+2<NT),(t+2<NT));     ENDW(t+1); RESC(); ROT();
  }
  STEP(pB0,pB1,pA0,pA1,NT-1,false,false,false); RESC();
  { float sacc=pB0[0]+pB0[1]; _Pragma("unroll") for(int r=2;r<16;++r)sacc+=pB0[r]; _Pragma("unroll") for(int r=0;r<16;++r)sacc+=pB1[r]; l_reg+=sacc;
    pw0=(u32x4){PKW(pB0,0),PKW(pB0,2),PKW(pB0,4),PKW(pB0,6)};pw1=(u32x4){PKW(pB0,8),PKW(pB0,10),PKW(pB0,12),PKW(pB0,14)};pw2=(u32x4){PKW(pB1,0),PKW(pB1,2),PKW(pB1,4),PKW(pB1,6)};pw3=(u32x4){PKW(pB1,8),PKW(pB1,10),PKW(pB1,12),PKW(pB1,14)};
    SBAR(); pv(o,vb0+sl_cur,PAF(0),PAF(1),PAF(2),PAF(3)); }
  #undef PKW
  #undef PAF
  #undef VFR
  #undef PIN
  #undef MX3
  #undef GAPA
  #undef GAPB
  #undef EX
  #undef VRD
  #undef KRD
  #undef STEP
  #undef ENDW
  {auto rr=__builtin_amdgcn_permlane32_swap(__float_as_uint(l_reg),__float_as_uint(l_reg),false,false);l_reg=__uint_as_float(rr[0])+__uint_as_float(rr[1]);}
  if(hi==0)wsf[32+r32]=l_reg;asm volatile("s_waitcnt lgkmcnt(0)":::"memory");
  float rli[16];
  #pragma unroll
  for(int r=0;r<16;++r)rli[r]=__builtin_amdgcn_rcpf(wsf[32+crow(r,hi)]);
  bf16*Ow=Ob+(long)(wid*QBLK)*QP;
  { bf16*stg=(bf16*)(shm+LDS_OST)+wid*2048;
    #pragma unroll
    for(int r=0;r<16;++r){const int orow=crow(r,hi);
      #pragma unroll
      for(int d0=0;d0<2;++d0)stg[orow*64+d0*32+r32]=__float2bfloat16(o[d0][r]*rli[r]);}
    asm volatile("s_waitcnt lgkmcnt(0)":::"memory");
    #pragma unroll
    for(int i=0;i<4;++i){const int row=i*8+(lane>>3),ch=lane&7; const u32x4 v=*(const u32x4*)(stg+row*64+ch*8); ATTN_STORE16(Ow+(long)row*QP+ch*8,v);} }
  asm volatile("s_waitcnt lgkmcnt(0)\n\ts_barrier":::"memory");
  #undef DMA_K
  #undef DMA_V
  #undef CMASK
  #undef KT
  #undef START
  #undef RESC
  #undef ROT
}
constexpr int ATTN_LDS_BYTES=LDS_BYTES;
#undef SBAR
#undef WAIT_BAR
}
__device__ __forceinline__ void attn_dispatch(KAP ap, int l, int uid, int wid, char* shm) {
    using namespace attn_body;
    unsigned char* ws = ap->ws;
    const int r32 = lane_id() & 31;
    const bf16* Qa = (const bf16*)(ws + WS_Q);
    UnitCtx uc; uc.toff = 0; uc.qpos0 = 0; uc.gr = 0; uc.rs = 0; uc.qc = 0; uc.vm = 0u; uc.sink2 = -INFINITY;
    if (uid < 384) {
        const int qb = uid & 31, bh = uid >> 5, b = bh / 6, h = bh % 6;
        const bf16* Qb = Qa + (size_t)(b * SEQ + qb * 256) * QW + (6 + h) * 64;
        const size_t ko = (size_t)b * KEYS * 256 + 128 + (h / 3) * 64;
        attn_unit<256, 256, 0, 8>(Qb, (const bf16*)(ws + WS_KAB) + ko, (const bf16*)(ws + WS_VTAB) + ko, (bf16*)Qb, KEYS / 64, uc, shm, wid);
    } else if (uid < 768) {
        const int u = uid - 384, qb = u & 31, bh = u >> 5, b = bh / 6, h = bh % 6;
        const bf16* Qb = Qa + (size_t)(b * SEQ + qb * 256) * QW + (12 + h) * 64;
        const size_t ko = (size_t)b * KEYS * 384 + h * 64;
        int klo = 4 * qb - 4; klo = klo < 0 ? 0 : (klo > 120 ? 120 : klo);
        int khi = 4 * qb + 3 - 4; khi = (khi < 0 ? 0 : (khi > 120 ? 120 : khi)) + 7;
        const int cnt = khi - klo + 1;
        uc.toff = klo; uc.gr = 4 * qb + (wid >> 1); uc.rs = uc.gr - 4 < 0 ? 0 : (uc.gr - 4 > 120 ? 120 : uc.gr - 4);
        uc.qc = 32 * (wid & 1) + r32;
        { const int wsn = uc.qc - 8 < 0 ? 0 : (uc.qc - 8 > 48 ? 48 : uc.qc - 8), hi = (lane_id() >> 5) & 1; unsigned vm = 0u;
#pragma unroll
          for (int r = 0; r < 16; ++r) { const int kc = (r & 3) + 8 * (r >> 2) + 4 * hi; if (kc >= wsn && kc < wsn + 16) vm |= 1u << r; if (kc + 32 >= wsn && kc + 32 < wsn + 16) vm |= 1u << (16 + r); }
          uc.vm = vm; }
        { const float* rpb = ap->in[12] + (size_t)(l * 6 + h) * 465; float* bl = (float*)(shm + BIAS_OFF); const int tb = tid_of(wid); if (tb < 465) bl[tb] = rpb[tb] * LOG2E; }
        attn_unit<384, 384, 2, 8>(Qb, (const bf16*)(ws + WS_KC) + ko, (const bf16*)(ws + WS_VTC) + ko, (bf16*)Qb, 4 + cnt + (cnt & 1), uc, shm, wid);
    } else if (uid < 1152) {
        const int u = uid - 768, qb = u & 31, bh = u >> 5, b = bh / 6, h = bh % 6;
        const bf16* Qb = Qa + (size_t)(b * SEQ + qb * 256) * QW + h * 64;
        const size_t ko = (size_t)b * KEYS * 256 + (h / 3) * 64;
        const int tlo = 4 * qb - 2 < 0 ? 0 : 4 * qb - 2, thi = 4 * qb + 5 > 127 ? 127 : 4 * qb + 5;
        uc.toff = tlo; uc.qpos0 = 256 * qb + 32 * wid + r32; uc.sink2 = ap->in[9][l * 6 + h] * LOG2E;
        attn_unit<256, 256, 1, 8>(Qb, (const bf16*)(ws + WS_KAB) + ko, (const bf16*)(ws + WS_VTAB) + ko, (bf16*)Qb, 4 + thi - tlo + 1, uc, shm, wid);
    } else {
        const int v = uid - 1152, type = v / 12, b = (v / 6) % 2, h = v % 6;
        const bf16* Qb = Qa + (size_t)(MLAT + b * LCTX) * QW + (type * 6 + h) * 64;
        if (type == 2) {
            const size_t ko = (size_t)b * KEYS * 384 + h * 64;
            attn_unit<384, 384, 0, 8>(Qb, (const bf16*)(ws + WS_KC) + ko, (const bf16*)(ws + WS_VTC) + ko, (bf16*)Qb, 4, uc, shm, wid);
        } else {
            const size_t ko = (size_t)b * KEYS * 256 + type * 128 + (h / 3) * 64;
            if (type == 0) uc.sink2 = ap->in[9][l * 6 + h] * LOG2E;
            attn_unit<256, 256, 0, 8>(Qb, (const bf16*)(ws + WS_KAB) + ko, (const bf16*)(ws + WS_VTAB) + ko, (bf16*)Qb, 4, uc, shm, wid);
        }
    }
}

#define XB_TMO      128
#define XB_XCNT(j)  (256  + 64 * (j))
#define XB_XSUB(j)  (1280 + 64 * (j))
#define XB_XGEN(j)  (2304 + 64 * (j))
#define XB_TOP      3328
#define XB_TOPGEN   3392
#define XCD_BAR_WORDS 3456
#define XB_SPIN_CAP (1u << 18)

__device__ __forceinline__ unsigned xb_ld(unsigned* p)              { return __hip_atomic_load(p, __ATOMIC_RELAXED, __HIP_MEMORY_SCOPE_AGENT); }
__device__ __forceinline__ unsigned xb_add(unsigned* p, unsigned v) { return __hip_atomic_fetch_add(p, v, __ATOMIC_RELAXED, __HIP_MEMORY_SCOPE_AGENT); }
__device__ __forceinline__ unsigned xb_xcc_id() { return (unsigned)__builtin_amdgcn_s_getreg((3 << 11) | 20) & 0xFu; }
#define XB_SPIN(cond, bar) do { unsigned _sp = 0; while (cond) { __builtin_amdgcn_s_sleep(1); \
    if ((++_sp & 255u) == 0u) { if (xb_ld(&(bar)[XB_TMO])) break; if (_sp > XB_SPIN_CAP) { atomicAdd(&(bar)[XB_TMO], 1u); break; } } } } while (0)

struct XcdBarrier {
    unsigned* bar; unsigned x;
    volatile __attribute__((address_space(3))) unsigned* st;
};

__device__ __forceinline__ XcdBarrier xcd_barrier_post(unsigned* bar, volatile __attribute__((address_space(3))) unsigned* st, bool leader) {
    XcdBarrier b; b.bar = bar; b.x = xb_xcc_id(); b.st = st;
    if (leader) (void)xb_add(&bar[XB_XCNT(b.x)], 1u);
    return b;
}
__device__ __forceinline__ void xcd_barrier_complete(unsigned* bar, unsigned x, unsigned& nloc, unsigned& nx) {
    const unsigned G = gridDim.x * gridDim.y * gridDim.z;
    unsigned sum, cnt, mine, sp = 0u;
    for (;;) {
        sum = 0u; cnt = 0u; mine = 0u;
#pragma unroll
        for (unsigned j = 0; j < 16; ++j) { const unsigned c = xb_ld(&bar[XB_XCNT(j)]); sum += c; cnt += (c > 0u) ? 1u : 0u; mine = (j == x) ? c : mine; }
        if (sum == G) break;
        __builtin_amdgcn_s_sleep(1);
        if ((++sp & 255u) == 0u) { if (xb_ld(&bar[XB_TMO])) break; if (sp > XB_SPIN_CAP) { atomicAdd(&bar[XB_TMO], 1u); break; } }
    }
    nloc = mine > 0u ? mine : 1u; nx = cnt > 0u ? cnt : 1u;
}

__device__ __forceinline__ void xcd_barrier(const XcdBarrier& b, bool leader) {
    asm volatile("s_waitcnt vmcnt(0)" ::: "memory");
    __syncthreads();
    if (leader) {
        unsigned* bar = b.bar;
        __builtin_amdgcn_s_waitcnt(0);
        unsigned nloc = b.st[0], nx = b.st[1];
        if (nloc == 0u) { xcd_barrier_complete(bar, b.x, nloc, nx); b.st[0] = nloc; b.st[1] = nx; }
        const unsigned old = xb_add(&bar[XB_XSUB(b.x)], 1u);
        const unsigned gen = old / nloc;
        if (old + 1u == (gen + 1u) * nloc) {
            __builtin_amdgcn_fence(__ATOMIC_RELEASE, "agent");
            asm volatile("s_waitcnt vmcnt(0)" ::: "memory");
            const unsigned og = xb_add(&bar[XB_TOP], 1u);
            const unsigned tg = og / nx;
            if (og + 1u == (tg + 1u) * nx) xb_add(&bar[XB_TOPGEN], 1u);
            else XB_SPIN(xb_ld(&bar[XB_TOPGEN]) == tg, bar);
            __builtin_amdgcn_fence(__ATOMIC_ACQUIRE, "agent");
            xb_add(&bar[XB_XGEN(b.x)], 1u);
            asm volatile("s_waitcnt vmcnt(0)" ::: "memory");
        } else {
            XB_SPIN(xb_ld(&bar[XB_XGEN(b.x)]) == gen, bar);
            __builtin_amdgcn_fence(__ATOMIC_ACQUIRE, "agent");
            asm volatile("s_waitcnt vmcnt(0)" ::: "memory");
        }
    }
    __syncthreads();
}
__global__ void __launch_bounds__(512, 2) fwd_mega(Args a) {
    extern __shared__ __attribute__((aligned(16))) unsigned char lds_raw[];
    cg::grid_group grid = cg::this_grid();
    PG8_LAS unsigned char* lds = (PG8_LAS unsigned char*)lds_raw;
    const int wave = __builtin_amdgcn_readfirstlane((int)threadIdx.x >> 6);
    const int tid = tid_of(wave);
    const int G = gridDim.x, gw = blockIdx.x * 8 + wave, NGW = G * 8;
#define LANE() ({ int l_ = lane_id(); asm volatile("" : "+v"(l_)); l_; })
#define LEADER() (wave == 0 && lane_id() == 0)
#define WSP() ((unsigned char*)KARGS()->ws)
#define MODS() ((float*)(WSP() + WS_MODS))
#define CTL() ((unsigned*)(WSP() + WS_CTL))
    volatile LAS unsigned* MISC = (volatile LAS unsigned*)((LAS unsigned char*)lds_raw + 131072);
    if (tid < 64) MISC[tid] = 0u;
    __syncthreads();
    { const XcdBarrier xb0 = xcd_barrier_post(CTL() + 4096, MISC + 8, LEADER()); (void)xb0; }
#if PROBE_MASK
    if (blockIdx.x == 0 && tid == 0) { const unsigned long long now = __builtin_amdgcn_s_memrealtime(); MISC[18] = (unsigned)now; MISC[19] = (unsigned)(now >> 32); }
#define TSTAMP(id) do { if (blockIdx.x == 0 && LEADER()) { const unsigned long long now_ = __builtin_amdgcn_s_memrealtime(); const unsigned long long st_ = ((unsigned long long)MISC[19] << 32) | MISC[18]; \
        if ((PROBE_MASK >> (id)) & 1) { const unsigned long long ac_ = (((unsigned long long)MISC[17] << 32) | MISC[16]) + (now_ - st_); MISC[16] = (unsigned)ac_; MISC[17] = (unsigned)(ac_ >> 32); } \
        MISC[18] = (unsigned)now_; MISC[19] = (unsigned)(now_ >> 32); } } while (0)
#else
#define TSTAMP(id) do {} while (0)
#endif
#define GRID_BAR() do { XcdBarrier xb_; xb_.bar = CTL() + 4096; xb_.x = xb_xcc_id(); xb_.st = MISC + 8; xcd_barrier(xb_, LEADER()); } while (0)

    conv_weights(KARGS(), 0, (LAS unsigned char*)lds_raw, gw, NGW, wave, LANE());
    ada_phase(KARGS(), gw, NGW, LANE());
    if (blockIdx.x == 0) {
        float* rope = (float*)(WSP() + WS_ROPE);
        for (int i = tid; i < 128 * 16; i += 512) { const int pos = i >> 4, f = i & 15; const float fr = powf(10000.0f, -(float)f / 16.0f); const float ang = (float)pos * fr; float s, c; sincosf(ang, &s, &c); rope[2 * i] = c; rope[2 * i + 1] = s; }
    }
    grid.sync(); TSTAMP(0);
    { KAP ap = KARGS();
      row_phase(gw, NGW, LANE(), MALL, nullptr, nullptr, nullptr, 0, ap->in[0], ap->in[2], nullptr, nullptr,
              (bf16_t*)(WSP() + WS_R1), ap->in[6], MODS(), 0, 1024); }
    GRID_BAR(); TSTAMP(1);

#pragma unroll 1
    for (int l = 0; l < DEPTH; ++l) {
        const bool last = (l == DEPTH - 1);
        const int MX = last ? MLAT : MALL;
        int bidl = blockIdx.x, Gl = gridDim.x; asm volatile("" : "+s"(bidl), "+s"(Gl));
#define MODL() (MODS() + (size_t)l * 3 * 6144)
        {
            pg8::Gemm g{(const bf16_t*)(WSP() + WS_R1), (const bf16_t*)(WSP() + WS_WIN), MALL, NINP, DM, DM, DM, 0, 0};
            pg8::StaticOrder S; S.init(MALL, NINP, Gl, bidl);
            EpiScatter E{(bf16_t*)(WSP() + WS_Q), (bf16_t*)(WSP() + WS_KAB), (bf16_t*)(WSP() + WS_KC), (bf16_t*)(WSP() + WS_VTAB), (bf16_t*)(WSP() + WS_VTC), (bf16_t*)(WSP() + WS_PG)};
            pg8::gemm_phase<EpiScatter, pg8::StaticOrder, true, true>(lds, g, S, E, wave);
        }
        GRID_BAR(); TSTAMP(2);
        post_phase(KARGS(), l, gw, NGW, LANE());
        GRID_BAR(); TSTAMP(3);
        {
            KAP ap = KARGS();
            const int nunit = 1152 + (last ? 0 : 36);
            unsigned* ctr = CTL() + 64 * l;
            for (;;) {
                if (LEADER()) MISC[24] = atomicAdd(ctr, 1u);
                __syncthreads();
                const int uid = (int)MISC[24];
                __syncthreads();
                if (uid >= nunit) break;
                attn_dispatch(ap, l, uid, wave, (char*)lds_raw);
            }
        }
        GRID_BAR(); TSTAMP(4);
        {
            pg8::Gemm g{(const bf16_t*)(WSP() + WS_Q), (const bf16_t*)(WSP() + WS_WBR), MX, DM, QW, QW, QW, 0, 0};
            pg8::StaticOrder S; S.init(MX, DM, Gl, bidl);
            EpiGateSum E{(bf16_t*)(WSP() + WS_PG)};
            pg8::gemm_phase<EpiGateSum, pg8::StaticOrder, true, true, 6>(lds, g, S, E, wave);
        }
        GRID_BAR(); TSTAMP(5);
        {
            pg8::Gemm g{(const bf16_t*)(WSP() + WS_PG), (const bf16_t*)(WSP() + WS_WOUT), MX, DM, DM, 3072, DM, 0, 0};
            pg8::StaticOrder S; S.init(MX, DM, Gl, bidl);
            EpiBf16<0> E{(bf16_t*)(WSP() + WS_Y), DM};
            pg8::gemm_phase<EpiBf16<0>, pg8::StaticOrder, true, true>(lds, g, S, E, wave);
        }
        GRID_BAR(); TSTAMP(6);
        { KAP ap = KARGS();
          row_phase(gw, NGW, LANE(), MX, (const bf16_t*)(WSP() + WS_Y), ap->in[7] + l * DM, MODL(), 2048,
                  l == 0 ? ap->in[0] : ap->out, l == 0 ? ap->in[2] : (const float*)(WSP() + WS_XC), ap->out, (float*)(WSP() + WS_XC),
                  (bf16_t*)(WSP() + WS_Q), ap->in[17] + l * DM, MODL(), 3072, 4096); }
        GRID_BAR(); TSTAMP(7);
        {
            pg8::Gemm g{(const bf16_t*)(WSP() + WS_Q), (const bf16_t*)(WSP() + WS_W1), MX, FF, DM, DM, DM, 0, 0};
            pg8::StaticOrder S; S.init(MX, FF, Gl, bidl);
            EpiBf16<1> E{(bf16_t*)(WSP() + WS_A), FF};
            pg8::gemm_phase<EpiBf16<1>, pg8::StaticOrder, true, true>(lds, g, S, E, wave);
        }
        GRID_BAR(); TSTAMP(8);
        {
            pg8::Gemm g{(const bf16_t*)(WSP() + WS_A), (const bf16_t*)(WSP() + WS_W2), MX, DM, FF, FF, FF, 0, 0};
            pg8::StaticOrder S; S.init(MX, DM, Gl, bidl);
            EpiBf16<0> E{(bf16_t*)(WSP() + WS_Y2), DM};
            pg8::gemm_phase<EpiBf16<0>, pg8::StaticOrder, true, true>(lds, g, S, E, wave);
        }
        GRID_BAR(); TSTAMP(9);
        if (!last) {
            { KAP ap = KARGS();
              row_phase(gw, NGW, LANE(), MX, (const bf16_t*)(WSP() + WS_Y2), ap->in[18] + l * DM, MODL(), 5120,
                      ap->out, (const float*)(WSP() + WS_XC), ap->out, (float*)(WSP() + WS_XC),
                      (bf16_t*)(WSP() + WS_R1), ap->in[6] + (l + 1) * DM, MODL() + 3 * 6144, 0, 1024); }
            conv_weights(KARGS(), l + 1, (LAS unsigned char*)lds_raw, gw, NGW, wave, LANE());
            GRID_BAR(); TSTAMP(10);
        } else {
            { KAP ap = KARGS();
              row_phase(gw, NGW, LANE(), MX, (const bf16_t*)(WSP() + WS_Y2), ap->in[18] + l * DM, MODL(), 5120,
                      ap->out, (const float*)(WSP() + WS_XC), ap->out, (float*)(WSP() + WS_XC),
                      nullptr, nullptr, nullptr, 0, 0); }
            TSTAMP(10);
        }
    }
#if PROBE_MASK
    if (blockIdx.x == 0 && LEADER()) {
        const unsigned long long t0 = __builtin_amdgcn_s_memrealtime(); const unsigned long long ac = ((unsigned long long)MISC[17] << 32) | MISC[16];
        while (__builtin_amdgcn_s_memrealtime() - t0 < 4ull * ac) __builtin_amdgcn_s_sleep(32);
    }
#endif
}

extern "C" void kernel_launch(void* const* d_in, const int* in_sizes, int n_in, void* d_out, int out_size, void* d_ws, size_t ws_size, hipStream_t stream) {
    static int grid = 0;
    if (grid == 0) {
        if (n_in != 21 || out_size != MLAT * DM || ws_size < WS_END) { fprintf(stderr, "kernel_launch: unexpected shapes (n_in %d, out %d, ws %zu need %zu)\n", n_in, out_size, ws_size, (size_t)WS_END); grid = -1; return; }
        int dev = 0, cus = 0, per_cu = 0;
        if (hipGetDevice(&dev) != hipSuccess || hipDeviceGetAttribute(&cus, hipDeviceAttributeMultiprocessorCount, dev) != hipSuccess) { grid = -1; return; }
        if (hipFuncSetAttribute((const void*)fwd_mega, hipFuncAttributeMaxDynamicSharedMemorySize, LDS_BYTES) != hipSuccess) { fprintf(stderr, "kernel_launch: hipFuncSetAttribute failed\n"); grid = -1; return; }
        if (hipOccupancyMaxActiveBlocksPerMultiprocessor(&per_cu, (const void*)fwd_mega, 512, LDS_BYTES) != hipSuccess || per_cu < 1) { fprintf(stderr, "kernel_launch: occupancy query says %d blocks per CU\n", per_cu); grid = -1; return; }
        grid = cus;
    }
    if (grid < 0) return;
    (void)hipMemsetAsync((char*)d_ws + WS_CTL, 0, CTL_ZERO_BYTES, stream);
    Args a{};
    for (int i = 0; i < 21; ++i) a.in[i] = (const float*)d_in[i];
    a.out = (float*)d_out; a.ws = (unsigned char*)d_ws;
    void* args[] = {&a};
    hipError_t e = hipLaunchCooperativeKernel((const void*)fwd_mega, dim3(grid), dim3(512), args, LDS_BYTES, stream);
    if (e != hipSuccess) fprintf(stderr, "cooperative launch failed: %s (grid %d)\n", hipGetErrorString(e), grid);
}
```

```cpp
#include <hip/hip_runtime.h>
#include <hip/hip_cooperative_groups.h>
#include <cstdio>
#include <cstdint>
namespace cg = cooperative_groups;
#ifndef PROBE_MASK
#define PROBE_MASK 0
#endif

__device__ __forceinline__ int lane_id() { int l; asm volatile("v_mbcnt_lo_u32_b32 %0, -1, 0\n\tv_mbcnt_hi_u32_b32 %0, -1, %0" : "=v"(l)); return l; }
__device__ __forceinline__ int tid_of(int wave) { int t = wave * 64 + lane_id(); asm volatile("" : "+v"(t)); return t; }
namespace pg8 {
#define PG8_LAS __attribute__((address_space(3)))
typedef unsigned short bf16_t;
typedef short bf16x8 __attribute__((ext_vector_type(8)));
typedef float f32x4 __attribute__((ext_vector_type(4)));
typedef unsigned u32x4 __attribute__((ext_vector_type(4)));
constexpr int BM = 256, BK = 64, HALF = 128, HTB = HALF * BK * 2, STAGE_BYTES = 8 * HTB, NXCD = 8, WGM = 8;

__host__ __device__ __forceinline__ int lds_byte(int r, int c) { const int st = (r >> 4) * 2 + (c >> 5), rr = r & 15, cc = c & 31, ob = rr * 64 + cc * 2; return st * 1024 + (ob ^ (((ob >> 9) & 1) << 5)); }
__host__ __device__ __forceinline__ void stage_rc(int b, int& R, int& C) { const int st = b / 1024, sb = b % 1024, swz = sb ^ (((sb >> 9) & 1) << 5); R = (st >> 1) * 16 + swz / 64; C = (st & 1) * 32 + (swz % 64) / 2; }
__host__ __device__ __forceinline__ int perm32(int rho) { const int n = rho >> 4, i = rho & 15; return 8 * (i >> 2) + 4 * n + (i & 3); }

struct Unit { int pm, pn; };
struct Gemm { const bf16_t* A; const bf16_t* Bt; int M, N, K, lda, ldb, a_split; size_t a_stride; };

struct StaticOrder {
    int nM, nN, nwg, G, c;
    __host__ __device__ void init(int M, int N, int G_, int c_) { nM = M / BM; nN = N / BM; nwg = nM * nN; G = G_; c = c_; }
    __host__ __device__ bool next(int i, Unit& u) const {
        const long L = (long)i * G + c; if (L >= nwg) return false;
        int wgid = (int)L; { const int q = nwg / NXCD, r = nwg % NXCD, xcd = wgid % NXCD, off = wgid / NXCD; wgid = (xcd < r ? xcd * (q + 1) : r * (q + 1) + (xcd - r) * q) + off; }
        const int nig = WGM * nN, gid = wgid / nig, fm = gid * WGM, gsz = (nM - fm) < WGM ? (nM - fm) : WGM;
        u.pm = fm + ((wgid % nig) % gsz); u.pn = (wgid % nig) / gsz; return true;
    }
};

__device__ __forceinline__ unsigned cvt_pk_bf16(float lo, float hi) { unsigned r; asm volatile("v_cvt_pk_bf16_f32 %0, %1, %2" : "=v"(r) : "v"(lo), "v"(hi)); return r; }


template <class Epi, class Sched, bool ALIGN_EPI = false, bool SP2 = false, int SEG = 0>
__device__ __forceinline__ void gemm_phase(PG8_LAS unsigned char* lds, const Gemm g, const Sched& S, const Epi& E, int wave_id) {
    const int tid = tid_of(wave_id), wid = wave_id, lane = tid & 63, wr = wid >> 2, wc = wid & 3, fr = lane & 15, fq = lane >> 4;
    const int K = g.K, nt = K / BK;
    unsigned voffA[2], voffB[2];
#pragma unroll
    for (int i = 0; i < 2; ++i) { int R, C; stage_rc(tid * 16 + i * 8192, R, C); const int Rb = Epi::PERM ? ((R & ~31) + perm32(R & 31)) : R;
        voffA[i] = (unsigned)(R * g.lda + C) * 2u; voffB[i] = (unsigned)(Rb * g.ldb + C) * 2u; }
    const size_t kstep = (size_t)(BK * 2);
    const size_t hstepA = (size_t)HALF * g.lda * 2, hstepB = (size_t)HALF * g.ldb * 2;
    const size_t tstepA = 2 * hstepA, tstepB = 2 * hstepB;
    const unsigned ldsw = (unsigned)wid * 1024u;
    const int aoff = lds_byte(wr * 64 + fr, fq * 8), boff = lds_byte(wc * 32 + fr, fq * 8);
#define PG8_SA(b, h) (((b) * 2 + (h)) * HTB)
#define PG8_SB(b, h) ((4 + (b) * 2 + (h)) * HTB)
#define PG8_STAGE(bufoff, gbase, voff) do { _Pragma("unroll") for (int _i = 0; _i < 2; ++_i) \
        __builtin_amdgcn_global_load_lds((const unsigned*)((const char*)(gbase) + (voff)[_i]), (PG8_LAS unsigned*)(lds + (bufoff) + ldsw + _i * 8192), 16, 0, 0); } while (0)
#define PG8_LDA(dst, b, h) do { _Pragma("unroll") for (int m = 0; m < 4; ++m) _Pragma("unroll") for (int k = 0; k < 2; ++k) dst[m][k] = *(const PG8_LAS bf16x8*)(lds + PG8_SA(b, h) + aoff + m * 2048 + k * 1024); } while (0)
#define PG8_LDB(dst, b, h) do { _Pragma("unroll") for (int n = 0; n < 2; ++n) _Pragma("unroll") for (int k = 0; k < 2; ++k) dst[n][k] = *(const PG8_LAS bf16x8*)(lds + PG8_SB(b, h) + boff + n * 2048 + k * 1024); } while (0)
#define PG8_MMA(ai, bj, At, Bt) do { __builtin_amdgcn_s_setprio(1); _Pragma("unroll") for (int m = 0; m < 4; ++m) _Pragma("unroll") for (int n = 0; n < 2; ++n) _Pragma("unroll") for (int k = 0; k < 2; ++k) \
        acc[ai][bj][m][n] = __builtin_amdgcn_mfma_f32_16x16x32_bf16(Bt[n][k], At[m][k], acc[ai][bj][m][n], 0, 0, 0); __builtin_amdgcn_s_setprio(0); } while (0)
#define PG8_WAIT_V(n) asm volatile("s_waitcnt vmcnt(" #n ")" ::: "memory")
#define PG8_WAIT_L(n) asm volatile("s_waitcnt lgkmcnt(" #n ")" ::: "memory")
#define PG8_BAR __builtin_amdgcn_s_barrier()
#define PG8_SCHED __builtin_amdgcn_sched_barrier(0)
#define PG8_ABASE(u) ((const char*)g.A + (size_t)(u).pm * tstepA + (g.a_split ? (size_t)((u).pn / g.a_split) * g.a_stride : (size_t)0))
    Unit cur, nxt; int ui = 0;
    if (!S.next(0, cur)) return;
    f32x4 acc[2][2][4][2];
#pragma unroll
    for (int a = 0; a < 2; ++a)
#pragma unroll
        for (int b = 0; b < 2; ++b)
#pragma unroll
            for (int m = 0; m < 4; ++m)
#pragma unroll
                for (int n = 0; n < 2; ++n) acc[a][b][m][n] = (f32x4){0.f, 0.f, 0.f, 0.f};
    bf16x8 At[4][2], B0[2][2], B1[2][2];
    const char* cA = PG8_ABASE(cur); const char* cB = (const char*)g.Bt + (size_t)cur.pn * tstepB;
    if constexpr (SP2) {
        PG8_STAGE(PG8_SB(0, 0), cB, voffB); PG8_STAGE(PG8_SB(0, 1), cB + hstepB, voffB); PG8_STAGE(PG8_SA(0, 0), cA, voffA); PG8_STAGE(PG8_SA(0, 1), cA + hstepA, voffA);
        if (wr == 1) PG8_BAR;
        PG8_WAIT_V(2); PG8_BAR;
        PG8_STAGE(PG8_SB(1, 0), cB + kstep, voffB); PG8_STAGE(PG8_SA(1, 0), cA + kstep, voffA); PG8_STAGE(PG8_SB(1, 1), cB + hstepB + kstep, voffB);
        PG8_WAIT_V(6); PG8_BAR;
    } else {
        PG8_STAGE(PG8_SB(0, 0), cB, voffB); PG8_STAGE(PG8_SA(0, 0), cA, voffA); PG8_STAGE(PG8_SB(0, 1), cB + hstepB, voffB); PG8_STAGE(PG8_SA(0, 1), cA + hstepA, voffA);
        if (wr == 1) PG8_BAR;
        PG8_WAIT_V(4); PG8_BAR;
        PG8_STAGE(PG8_SB(1, 0), cB + kstep, voffB); PG8_STAGE(PG8_SA(1, 0), cA + kstep, voffA); PG8_STAGE(PG8_SB(1, 1), cB + hstepB + kstep, voffB);
        PG8_WAIT_V(6); PG8_BAR;
    }
    for (;;) {
        const bool has_next = S.next(ui + 1, nxt);
        const char* nA = has_next ? PG8_ABASE(nxt) : cA; const char* nB = has_next ? (const char*)g.Bt + (size_t)nxt.pn * tstepB : cB;
#pragma unroll 1
        for (int t = 0; t < nt; t += 2) {
            const bool last = (t == nt - 2);
            const char* a1 = cA + (size_t)(t + 1) * kstep;
            const char* a2 = last ? nA : cA + (size_t)(t + 2) * kstep; const char* b2 = last ? nB : cB + (size_t)(t + 2) * kstep;
            const char* a3 = a2 + kstep; const char* b3 = b2 + kstep;
            if constexpr (SP2) {
            PG8_LDB(B0, 0, 0); PG8_LDB(B1, 0, 1); PG8_SCHED; PG8_LDA(At, 0, 0); PG8_STAGE(PG8_SA(1, 1), a1 + hstepA, voffA);
            PG8_WAIT_V(8); PG8_WAIT_L(0); PG8_BAR; PG8_MMA(0, 0, At, B0); PG8_MMA(0, 1, At, B1); PG8_BAR; PG8_SCHED;
            PG8_LDA(At, 0, 1); PG8_STAGE(PG8_SB(0, 0), b2, voffB); PG8_STAGE(PG8_SB(0, 1), b2 + hstepB, voffB); PG8_STAGE(PG8_SA(0, 0), a2, voffA);
            PG8_WAIT_V(8); PG8_WAIT_L(0); PG8_BAR; PG8_MMA(1, 0, At, B0); PG8_MMA(1, 1, At, B1); PG8_BAR; PG8_SCHED;
            PG8_LDB(B0, 1, 0); PG8_LDB(B1, 1, 1); PG8_SCHED; PG8_LDA(At, 1, 0); PG8_STAGE(PG8_SA(0, 1), a2 + hstepA, voffA);
            PG8_WAIT_V(8); PG8_WAIT_L(0); PG8_BAR; PG8_MMA(0, 0, At, B0); PG8_MMA(0, 1, At, B1); PG8_BAR; PG8_SCHED;
            PG8_LDA(At, 1, 1); PG8_STAGE(PG8_SB(1, 0), b3, voffB); PG8_STAGE(PG8_SB(1, 1), b3 + hstepB, voffB); PG8_STAGE(PG8_SA(1, 0), a3, voffA);
            PG8_WAIT_V(8); PG8_WAIT_L(0); PG8_BAR; PG8_MMA(1, 0, At, B0); PG8_MMA(1, 1, At, B1); PG8_BAR; PG8_SCHED;
            } else {
            PG8_LDB(B0, 0, 0); PG8_SCHED; PG8_LDA(At, 0, 0); PG8_STAGE(PG8_SA(1, 1), a1 + hstepA, voffA);
            PG8_WAIT_L(8); PG8_BAR; PG8_WAIT_L(0); PG8_MMA(0, 0, At, B0); PG8_BAR; PG8_SCHED;
            PG8_LDB(B1, 0, 1); PG8_STAGE(PG8_SB(0, 0), b2, voffB);
            PG8_BAR; PG8_WAIT_L(0); PG8_MMA(0, 1, At, B1); PG8_BAR;
            PG8_LDA(At, 0, 1); PG8_STAGE(PG8_SA(0, 0), a2, voffA);
            PG8_BAR; PG8_WAIT_L(0); PG8_MMA(1, 0, At, B0); PG8_BAR; PG8_SCHED;
            PG8_STAGE(PG8_SB(0, 1), b2 + hstepB, voffB);
            PG8_WAIT_V(6); PG8_BAR; PG8_MMA(1, 1, At, B1); PG8_BAR;
            PG8_LDB(B0, 1, 0); PG8_SCHED; PG8_LDA(At, 1, 0); PG8_STAGE(PG8_SA(0, 1), a2 + hstepA, voffA);
            PG8_WAIT_L(8); PG8_BAR; PG8_WAIT_L(0); PG8_MMA(0, 0, At, B0); PG8_BAR; PG8_SCHED;
            PG8_LDB(B1, 1, 1); PG8_STAGE(PG8_SB(1, 0), b3, voffB);
            PG8_BAR; PG8_WAIT_L(0); PG8_MMA(0, 1, At, B1); PG8_BAR;
            PG8_LDA(At, 1, 1); PG8_STAGE(PG8_SA(1, 0), a3, voffA);
            PG8_BAR; PG8_WAIT_L(0); PG8_MMA(1, 0, At, B0); PG8_BAR; PG8_SCHED;
            PG8_STAGE(PG8_SB(1, 1), b3 + hstepB, voffB);
            PG8_WAIT_V(6); PG8_BAR; PG8_MMA(1, 1, At, B1); PG8_BAR;
            }
            if constexpr (SEG > 0) {
                if (!last && (t + 2) % SEG == 0) {
                    E.segment(acc, (t + 2) / SEG - 1, cur, wr, wc, fr, fq);
#pragma unroll
                    for (int a = 0; a < 2; ++a)
#pragma unroll
                        for (int b = 0; b < 2; ++b)
#pragma unroll
                            for (int m = 0; m < 4; ++m)
#pragma unroll
                                for (int n = 0; n < 2; ++n) acc[a][b][m][n] = (f32x4){0.f, 0.f, 0.f, 0.f};
                }
            }
        }
        if constexpr (ALIGN_EPI) { if (wr == 0) PG8_BAR; }
        E(acc, cur, wr, wc, fr, fq);
        if (!has_next) break;
#pragma unroll
        for (int a = 0; a < 2; ++a)
#pragma unroll
            for (int b = 0; b < 2; ++b)
#pragma unroll
                for (int m = 0; m < 4; ++m)
#pragma unroll
                    for (int n = 0; n < 2; ++n) acc[a][b][m][n] = (f32x4){0.f, 0.f, 0.f, 0.f};
        cur = nxt; cA = nA; cB = nB; ++ui;
        if constexpr (ALIGN_EPI) { if (wr == 1) PG8_BAR; }
    }
    PG8_WAIT_V(0);
    if constexpr (!ALIGN_EPI) { if (wr == 0) PG8_BAR; }
    PG8_BAR;
#undef PG8_SA
#undef PG8_SB
#undef PG8_STAGE
#undef PG8_LDA
#undef PG8_LDB
#undef PG8_MMA
#undef PG8_WAIT_V
#undef PG8_WAIT_L
#undef PG8_BAR
#undef PG8_SCHED
#undef PG8_ABASE
}
}

using pg8::bf16_t; using pg8::f32x4; using pg8::u32x4; using pg8::Unit; using pg8::cvt_pk_bf16;
typedef short bf16x8 __attribute__((ext_vector_type(8)));
typedef float f32x16 __attribute__((ext_vector_type(16)));
typedef unsigned u32x2 __attribute__((ext_vector_type(2)));
#define LAS __attribute__((address_space(3)))

constexpr int DM = 1024, SEQ = 8192, NB = 2, LCTX = 256, DEPTH = 2;
constexpr int MLAT = NB * SEQ;
constexpr int MALL = MLAT + NB * LCTX;
constexpr int KEYS = LCTX + SEQ;
constexpr int NIN = 5504, NINP = 5632;
constexpr int FF = 4096;
constexpr int QW = 1152;
constexpr float EPS = 1e-6f;
constexpr float LOG2E = 1.4426950408889634f;
constexpr float QSCALE = 0.125f * LOG2E;

constexpr size_t MiB = 1u << 20;
constexpr size_t WS_CTL = 0, CTL_ZERO_BYTES = 256 * 1024;
constexpr size_t WS_MODS = 64 * 1024;
constexpr size_t WS_ROPE = 256 * 1024;
constexpr size_t WS_XC = 1 * MiB;
constexpr size_t WS_WIN = 4 * MiB;
constexpr size_t WS_WBR = WS_WIN + 11 * MiB;
constexpr size_t WS_WOUT = WS_WBR + 9 * MiB / 4;
constexpr size_t WS_W1 = WS_WOUT + 6 * MiB;
constexpr size_t WS_W2 = WS_W1 + 8 * MiB;
constexpr size_t WS_R1 = 40 * MiB;
constexpr size_t WS_KAB = WS_R1 + 33 * MiB;
constexpr size_t WS_KC = WS_KAB + (size_t)NB * KEYS * 256 * 2;
constexpr size_t WS_VTAB = WS_KC + (size_t)NB * KEYS * 384 * 2;
constexpr size_t WS_VTC = WS_VTAB + (size_t)NB * 4 * 64 * KEYS * 2;
constexpr size_t WS_PG = WS_VTC + (size_t)NB * 6 * 64 * KEYS * 2;
constexpr size_t WS_Q = WS_PG + (size_t)MALL * 3072 * 2;
constexpr size_t WS_VB = WS_Q + (size_t)MALL * QW * 2;
constexpr size_t WS_END = WS_VB + (size_t)NB * KEYS * 128 * 2;
constexpr size_t WS_Y = WS_R1;
constexpr size_t WS_A = WS_R1;
constexpr size_t WS_Y2 = WS_A + (size_t)MALL * FF * 2;
static_assert(WS_W2 + 8 * MiB <= WS_R1, "weights");
static_assert(WS_Y + (size_t)MALL * DM * 4 <= WS_PG, "Y overlay");
static_assert(WS_A + (size_t)MALL * FF * 2 <= WS_Q, "A overlay");
static_assert(WS_Y2 + (size_t)MALL * DM * 4 <= WS_END && WS_END <= 256 * MiB, "ws map");

constexpr int LDS_BYTES = 147456;

struct EpiScatter {
    static constexpr bool PERM = true;
    bf16_t *Q, *KAB, *KC, *VAB, *VC, *PG;
    __device__ __forceinline__ void operator()(const f32x4 (&acc)[2][2][4][2], const Unit& u, int wr, int wc, int fr, int fq) const {
        const int pm = u.pm; int kroff;
        if (pm < 64) { const int b = pm >> 5; kroff = 256 * b + 256; } else { const int b = pm - 64; kroff = -MLAT + SEQ * b; }
        const int row0 = pm * 256 + wr * 64 + fr, cin = wc * 32 + 8 * fq;
#pragma unroll
        for (int bj = 0; bj < 2; ++bj) {
            const int cb = 2 * u.pn + bj;
            if (cb >= 43) continue;
            int pitch, col, radd = 0; bf16_t* base;
            if (cb >= 19) { base = PG; pitch = 3072; col = 128 * (cb - 19) + cin; }
            else if (cb <= 2) { base = Q; pitch = QW; col = 128 * cb + cin; }
            else if (cb == 3) { base = KAB; pitch = 256; col = cin; radd = kroff; }
            else if (cb == 4) { base = VAB; pitch = 256; col = cin; radd = kroff; }
            else if (cb <= 7) { base = Q; pitch = QW; col = 384 + 128 * (cb - 5) + cin; }
            else if (cb == 8) { base = KAB; pitch = 256; col = 128 + cin; radd = kroff; }
            else if (cb == 9) { base = VAB; pitch = 256; col = 128 + cin; radd = kroff; }
            else if (cb <= 12) { base = Q; pitch = QW; col = 768 + 128 * (cb - 10) + cin; }
            else if (cb <= 15) { base = KC; pitch = 384; col = 128 * (cb - 13) + cin; radd = kroff; }
            else { base = VC; pitch = 384; col = 128 * (cb - 16) + cin; radd = kroff; }
            bf16_t* pb = base + (size_t)(row0 + radd) * pitch + col;
#pragma unroll
            for (int ai = 0; ai < 2; ++ai)
#pragma unroll
                for (int m = 0; m < 4; ++m) {
                    const f32x4 v0 = acc[ai][bj][m][0], v1 = acc[ai][bj][m][1];
                    u32x4 w; w.x = cvt_pk_bf16(v0[0], v0[1]); w.y = cvt_pk_bf16(v0[2], v0[3]); w.z = cvt_pk_bf16(v1[0], v1[1]); w.w = cvt_pk_bf16(v1[2], v1[3]);
                    *(u32x4*)(pb + (size_t)(ai * 128 + m * 16) * pitch) = w;
                }
        }
    }
};
__device__ __forceinline__ float bf2f(unsigned h) { return __uint_as_float(h << 16); }
struct EpiGateSum {
    static constexpr bool PERM = true;
    bf16_t* PG;
    static __device__ __forceinline__ unsigned gate2(unsigned g, unsigned sprev, float a0, float a1) {
        const float g0 = bf2f(g & 0xffffu), g1 = bf2f(g >> 16);
        const float s0 = __builtin_amdgcn_rcpf(1.0f + __builtin_amdgcn_exp2f(-LOG2E * g0)), s1 = __builtin_amdgcn_rcpf(1.0f + __builtin_amdgcn_exp2f(-LOG2E * g1));
        return cvt_pk_bf16(a0 * s0 + bf2f(sprev & 0xffffu), a1 * s1 + bf2f(sprev >> 16));
    }
    __device__ __forceinline__ void segment(const f32x4 (&acc)[2][2][4][2], int br, const Unit& u, int wr, int wc, int fr, int fq) const {
        const int row0 = u.pm * 256 + wr * 64 + fr, col0 = u.pn * 256 + wc * 32 + 8 * fq;
        bf16_t* pb = PG + (size_t)row0 * 3072 + col0;
#pragma unroll
        for (int ai = 0; ai < 2; ++ai)
#pragma unroll
            for (int mp = 0; mp < 2; ++mp) {
                u32x4 gq[4], sp[4];
#pragma unroll
                for (int q = 0; q < 4; ++q) { const int m = 2 * mp + (q >> 1), bj = q & 1;
                    const u32x4* p = (const u32x4*)(pb + (size_t)(ai * 128 + m * 16) * 3072 + bj * 128);
                    gq[q] = *(const u32x4*)((const bf16_t*)p + br * 1024);
                    sp[q] = (u32x4){0u, 0u, 0u, 0u}; if (br > 0) sp[q] = *p; }
#pragma unroll
                for (int q = 0; q < 4; ++q) { const int m = 2 * mp + (q >> 1), bj = q & 1;
                    u32x4* p = (u32x4*)(pb + (size_t)(ai * 128 + m * 16) * 3072 + bj * 128);
                    const f32x4 v0 = acc[ai][bj][m][0], v1 = acc[ai][bj][m][1];
                    u32x4 w; w.x = gate2(gq[q].x, sp[q].x, v0[0], v0[1]); w.y = gate2(gq[q].y, sp[q].y, v0[2], v0[3]); w.z = gate2(gq[q].z, sp[q].z, v1[0], v1[1]); w.w = gate2(gq[q].w, sp[q].w, v1[2], v1[3]);
                    *p = w; }
                asm volatile("" ::: "memory");
            }
    }
    __device__ __forceinline__ void operator()(const f32x4 (&acc)[2][2][4][2], const Unit& u, int wr, int wc, int fr, int fq) const { segment(acc, 2, u, wr, wc, fr, fq); }
};
template <int ACT  > struct EpiBf16 {
    static constexpr bool PERM = true;
    bf16_t* O; int ldc;
    __device__ __forceinline__ void operator()(const f32x4 (&acc)[2][2][4][2], const Unit& u, int wr, int wc, int fr, int fq) const {
        const int row0 = u.pm * 256 + wr * 64 + fr, col0 = u.pn * 256 + wc * 32 + 8 * fq;
#pragma unroll
        for (int ai = 0; ai < 2; ++ai)
#pragma unroll
            for (int m = 0; m < 4; ++m)
#pragma unroll
                for (int bj = 0; bj < 2; ++bj) {
                    f32x4 v0 = acc[ai][bj][m][0], v1 = acc[ai][bj][m][1];
                    if (ACT == 1) {
#pragma unroll
                        for (int e = 0; e < 4; ++e) { const float a = fmaxf(v0[e], 0.f), c = fmaxf(v1[e], 0.f); v0[e] = a * a; v1[e] = c * c; }
                    }
                    u32x4 w; w.x = cvt_pk_bf16(v0[0], v0[1]); w.y = cvt_pk_bf16(v0[2], v0[3]); w.z = cvt_pk_bf16(v1[0], v1[1]); w.w = cvt_pk_bf16(v1[2], v1[3]);
                    *(u32x4*)(O + (size_t)(row0 + ai * 128 + m * 16) * ldc + col0 + bj * 128) = w;
                }
    }
};
struct EpiF32 {
    static constexpr bool PERM = true;
    float* O; int ldc;
    __device__ __forceinline__ void operator()(const f32x4 (&acc)[2][2][4][2], const Unit& u, int wr, int wc, int fr, int fq) const {
        const int row0 = u.pm * 256 + wr * 64 + fr, col0 = u.pn * 256 + wc * 32 + 8 * fq;
#pragma unroll
        for (int ai = 0; ai < 2; ++ai)
#pragma unroll
            for (int m = 0; m < 4; ++m)
#pragma unroll
                for (int bj = 0; bj < 2; ++bj) {
                    float* p = O + (size_t)(row0 + ai * 128 + m * 16) * ldc + col0 + bj * 128;
                    *(f32x4*)p = acc[ai][bj][m][0]; *(f32x4*)(p + 4) = acc[ai][bj][m][1];
                }
    }
};

__device__ __forceinline__ float wave_sum(float v) {
#pragma unroll
    for (int o = 1; o < 64; o <<= 1) v += __shfl_xor(v, o);
    return v;
}
__device__ __forceinline__ unsigned f2bf(float f) { unsigned u = __builtin_bit_cast(unsigned, f); return (u + 0x7fffu + ((u >> 16) & 1u)) >> 16; }
__device__ __forceinline__ unsigned pk2(float lo, float hi) { return f2bf(lo) | (f2bf(hi) << 16); }

__device__ __forceinline__ void transpose_item(const float* W, int K, int N, bf16_t* WT, int ldk, int row_off, int copies, int copy_stride, LAS float* scr, int item, int lane) {
    const int nblk = N / 32, kb = item / nblk, nb = item % nblk, k0 = 64 * kb, n0 = 32 * nb;
#pragma unroll 8
    for (int i = 0; i < 32; ++i) { const int kk = 2 * i + (lane >> 5); scr[kk * 33 + (lane & 31)] = W[(size_t)(k0 + kk) * N + n0 + (lane & 31)]; }
    asm volatile("s_waitcnt lgkmcnt(0)" ::: "memory");
    const int c = lane & 7;
#pragma unroll
    for (int j = 0; j < 4; ++j) { const int n = (lane >> 3) + 8 * j; const LAS float* s = scr + (8 * c) * 33 + n;
        u32x4 o; o.x = pk2(s[0 * 33], s[1 * 33]); o.y = pk2(s[2 * 33], s[3 * 33]); o.z = pk2(s[4 * 33], s[5 * 33]); o.w = pk2(s[6 * 33], s[7 * 33]);
        for (int cc = 0; cc < copies; ++cc) *(u32x4*)(WT + (size_t)(row_off + n0 + n) * ldk + cc * copy_stride + k0 + 8 * c) = o; }
    asm volatile("s_waitcnt lgkmcnt(0)" ::: "memory");
}

struct Args { const float* in[21]; float* out; unsigned char* ws; int pad0, pad1; };
typedef const __attribute__((address_space(4))) Args* KAP;
#define KARGS() ({ KAP p_ = (KAP)__builtin_amdgcn_kernarg_segment_ptr(); asm volatile("" : "+s"(p_)); p_; })

__device__ __forceinline__ void conv_weights(KAP ap, int l, LAS unsigned char* lds, int gw, int NGW, int wave, int lane) {
    unsigned char* ws = ap->ws;
    LAS float* scr = (LAS float*)(lds + wave * 16384);
    constexpr int I_IN = 16 * (NIN / 32), I_BR = 6 * 32, I_OUT = 16 * 32, I_1 = 16 * (FF / 32), I_2 = (FF / 64) * 32;
    constexpr int NITEMS = I_IN + 3 * I_BR + I_OUT + I_1 + I_2;
    for (int it = gw; it < NITEMS; it += NGW) {
        int r = it;
        if (r < I_IN) { transpose_item(ap->in[8] + (size_t)l * DM * NIN, DM, NIN, (bf16_t*)(ws + WS_WIN), DM, 0, 1, 0, scr, r, lane); continue; } r -= I_IN;
        if (r < I_BR) { transpose_item(ap->in[13] + (size_t)l * 384 * DM, 384, DM, (bf16_t*)(ws + WS_WBR), 1152, 0, 1, 0, scr, r, lane); continue; } r -= I_BR;
        if (r < I_BR) { transpose_item(ap->in[14] + (size_t)l * 384 * DM, 384, DM, (bf16_t*)(ws + WS_WBR) + 384, 1152, 0, 1, 0, scr, r, lane); continue; } r -= I_BR;
        if (r < I_BR) { transpose_item(ap->in[15] + (size_t)l * 384 * DM, 384, DM, (bf16_t*)(ws + WS_WBR) + 768, 1152, 0, 1, 0, scr, r, lane); continue; } r -= I_BR;
        if (r < I_OUT) { transpose_item(ap->in[16] + (size_t)l * DM * DM, DM, DM, (bf16_t*)(ws + WS_WOUT), DM, 0, 1, 0, scr, r, lane); continue; } r -= I_OUT;
        if (r < I_1) { transpose_item(ap->in[19] + (size_t)l * DM * FF, DM, FF, (bf16_t*)(ws + WS_W1), DM, 0, 1, 0, scr, r, lane); continue; } r -= I_1;
        transpose_item(ap->in[20] + (size_t)l * FF * DM, FF, DM, (bf16_t*)(ws + WS_W2), FF, 0, 1, 0, scr, r, lane);
    }
    u32x4* pad = (u32x4*)(ws + WS_WIN + (size_t)NIN * DM * 2);
    unsigned z0 = 0u; asm volatile("" : "+v"(z0));
    for (int i = gw * 64 + lane; i < (NINP - NIN) * DM * 2 / 16; i += NGW * 64) pad[i] = (u32x4){z0, z0, z0, z0};
}

__device__ __forceinline__ void ada_phase(KAP ap, int gw, int NGW, int lane) {
    float* mods = (float*)(ap->ws + WS_MODS);
    const float* c = ap->in[1]; const float* cc = ap->in[3];
    for (int t = gw; t < DEPTH * 16 * 24; t += NGW) {
        const int l = t / (16 * 24), kc = (t / 24) % 16, jc = t % 24, col = jc * 256 + lane * 4;
        const float* W = ap->in[4] + ((size_t)l * DM + kc * 64) * 6144 + col;
        f32x4 s0 = {0.f, 0.f, 0.f, 0.f}, s1 = s0, s2 = s0;
        for (int k = 0; k < 64; ++k) {
            const f32x4 w = *(const f32x4*)(W + (size_t)k * 6144);
            const float x0 = c[kc * 64 + k], x1 = c[DM + kc * 64 + k], x2 = cc[kc * 64 + k];
            const float a0 = x0 / (1.f + __expf(-x0)), a1 = x1 / (1.f + __expf(-x1)), a2 = x2 / (1.f + __expf(-x2));
            s0 += w * a0; s1 += w * a1; s2 += w * a2;
        }
        if (kc == 0) { const f32x4 bb = *(const f32x4*)(ap->in[5] + (size_t)l * 6144 + col); s0 += bb; s1 += bb; s2 += bb; }
        float* m0 = mods + (size_t)(l * 3) * 6144 + col;
#pragma unroll
        for (int e = 0; e < 4; ++e) { atomicAdd(m0 + e, s0[e]); atomicAdd(m0 + 6144 + e, s1[e]); atomicAdd(m0 + 2 * 6144 + e, s2[e]); }
    }
}

__device__ __forceinline__ void row_phase(int gw, int NGW, int lane, int nrows, const bf16_t* Y, const float* gainY, const float* modsG, int gate_off,
                                          const float* rin_lat, const float* rin_ctx, float* rout_lat, float* rout_ctx,
                                          bf16_t* H, const float* gainH, const float* modsH, int shift_off, int scale_off) {
    for (int m = 2 * gw; m < nrows; m += 2 * NGW) {
        const int v = m < MLAT ? (m >> 13) : 2;
        const size_t roff = m < MLAT ? (size_t)m * DM : (size_t)(m - MLAT) * DM;
        const f32x4* xr = (const f32x4*)((m < MLAT ? rin_lat : rin_ctx) + roff) + lane;
        f32x4 x[2][4];
#pragma unroll
        for (int u = 0; u < 2; ++u)
#pragma unroll
            for (int j = 0; j < 4; ++j) x[u][j] = xr[256 * u + 64 * j];
        if (Y) {
            const u32x2* yr = (const u32x2*)(Y + (size_t)m * DM) + lane;
            u32x2 yw[2][4];
#pragma unroll
            for (int u = 0; u < 2; ++u)
#pragma unroll
                for (int j = 0; j < 4; ++j) yw[u][j] = yr[256 * u + 64 * j];
            const f32x4* gy = (const f32x4*)gainY + lane; const f32x4* gt = (const f32x4*)(modsG + (size_t)v * 6144 + gate_off) + lane;
            f32x4* ro = (f32x4*)((m < MLAT ? rout_lat : rout_ctx) + roff) + lane;
#pragma unroll
            for (int u = 0; u < 2; ++u) {
                f32x4 y[4]; float ss = 0.f;
#pragma unroll
                for (int j = 0; j < 4; ++j) { y[j] = (f32x4){bf2f(yw[u][j].x & 0xffffu), bf2f(yw[u][j].x >> 16), bf2f(yw[u][j].y & 0xffffu), bf2f(yw[u][j].y >> 16)}; ss += (y[j].x * y[j].x + y[j].y * y[j].y) + (y[j].z * y[j].z + y[j].w * y[j].w); }
                const float rstd = rsqrtf(wave_sum(ss) * (1.f / DM) + EPS);
#pragma unroll
                for (int j = 0; j < 4; ++j) { x[u][j] = x[u][j] + gt[64 * j] * (y[j] * rstd * gy[64 * j]); ro[256 * u + 64 * j] = x[u][j]; }
            }
        }
        if (H) {
            const f32x4* gh = (const f32x4*)gainH + lane; const f32x4* sh = (const f32x4*)(modsH + (size_t)v * 6144 + shift_off) + lane; const f32x4* sc = (const f32x4*)(modsH + (size_t)v * 6144 + scale_off) + lane;
            u32x2* ho = (u32x2*)(H + (size_t)m * DM) + lane;
#pragma unroll
            for (int u = 0; u < 2; ++u) {
                float ss = 0.f;
#pragma unroll
                for (int j = 0; j < 4; ++j) ss += (x[u][j].x * x[u][j].x + x[u][j].y * x[u][j].y) + (x[u][j].z * x[u][j].z + x[u][j].w * x[u][j].w);
                const float rstd = rsqrtf(wave_sum(ss) * (1.f / DM) + EPS);
#pragma unroll
                for (int j = 0; j < 4; ++j) { const f32x4 h = (x[u][j] * rstd * gh[64 * j]) * (sc[64 * j] + 1.0f) + sh[64 * j]; u32x2 w; w.x = pk2(h.x, h.y); w.y = pk2(h.z, h.w); ho[256 * u + 64 * j] = w; }
            }
        }
    }
}

__device__ __forceinline__ void post_phase(KAP ap, int l, int gw, int NGW, int lane) {
    bf16_t* Q = (bf16_t*)(ap->ws + WS_Q); bf16_t* KAB = (bf16_t*)(ap->ws + WS_KAB);
    const float* rope = (const float*)(ap->ws + WS_ROPE);
    const float* qn = ap->in[10] + l * 64; const float* kn = ap->in[11] + l * 64;
    const int p = lane & 31, hh = lane >> 5;
    for (int m = gw; m < MALL; m += NGW) {
        const bool lat = m < MLAT; const int s = m & (SEQ - 1);
        float cs = 1.f, sn = 0.f;
        if (lat) { const int pos = p < 16 ? (s >> 6) : (s & 63); const float* t = rope + (pos * 16 + (p & 15)) * 2; cs = t[0]; sn = t[1]; }
        const int kr = lat ? m + 256 * (m >> 13) + 256 : ((m - MLAT) >> 8) * KEYS + ((m - MLAT) & 255);
#pragma unroll 1
        for (int it = 0; it < 11; ++it) {
            const int head = it * 2 + hh;
            unsigned* ptr; bool norm, rot, scl; const float* gn;
            if (head < 18) { ptr = (unsigned*)(Q + (size_t)m * QW + head * 64) + p; norm = (head >= 6 && head < 12); rot = head < 12; scl = true; gn = qn; }
            else { ptr = (unsigned*)(KAB + (size_t)kr * 256 + (head - 18) * 64) + p; norm = head >= 20; rot = true; scl = false; gn = kn; }
            const unsigned w = *ptr; float x0 = bf2f(w & 0xffffu), x1 = bf2f(w >> 16);
            float ss = x0 * x0 + x1 * x1;
#pragma unroll
            for (int o = 1; o < 32; o <<= 1) ss += __shfl_xor(ss, o);
            if (norm) { const float rstd = rsqrtf(ss * (1.f / 64.f) + EPS); x0 = x0 * rstd * gn[2 * p]; x1 = x1 * rstd * gn[2 * p + 1]; }
            if (rot) { const float y0 = x0 * cs - x1 * sn, y1 = x0 * sn + x1 * cs; x0 = y0; x1 = y1; }
            if (scl) { x0 *= QSCALE; x1 *= QSCALE; }
            *ptr = pk2(x0, x1);
        }
    }
}

#include <hip/hip_bf16.h>
#include <cmath>
namespace attn_body {
using bf16=__hip_bfloat16;
using bf16x8=__attribute__((ext_vector_type(8)))short;
using s16x4=__attribute__((ext_vector_type(4)))short;
using f32x16=__attribute__((ext_vector_type(16)))float;
using u32x4=__attribute__((ext_vector_type(4)))unsigned;
constexpr int D=64,QP=1152;
constexpr int BIAS_OFF=90112;
struct UnitCtx { int toff; int qpos0; int gr; int rs; int qc; unsigned vm; float sink2; };
constexpr int NW=8,QBLK=32,QB=QBLK*NW,KVBLK=64;
__device__ __forceinline__ int crow(int r,int hi){return (r&3)+8*(r>>2)+4*hi;}
#define SBAR() __builtin_amdgcn_sched_barrier(0)
constexpr int NSLOT=3, SLOTB=8192;
constexpr int LDS_K=0, LDS_V=NSLOT*SLOTB, LDS_WS=2*NSLOT*SLOTB, LDS_OST=LDS_WS+NW*64*4, LDS_BYTES=LDS_OST+NW*4096;
constexpr float C2=0.125f*1.4426950408889634f;
__device__ __forceinline__ void glds16(const void*gsrc,unsigned lds_dst){unsigned keep;
  asm volatile("s_mov_b32 %0, m0\n\ts_mov_b32 m0, %2\n\ts_nop 0\n\tglobal_load_lds_dwordx4 %1, off\n\ts_mov_b32 m0, %0":"=&s"(keep):"v"(gsrc),"s"(lds_dst):"memory");}
__device__ __forceinline__ float max3f(float a,float b,float c){float r;asm("v_max3_f32 %0, %1, %2, %3":"=v"(r):"v"(a),"v"(b),"v"(c));return r;}
__device__ __forceinline__ float max2f(float a,float b){float r;asm("v_max_f32_e32 %0, %1, %2":"=v"(r):"v"(a),"v"(b));return r;}
__device__ __forceinline__ float fadd_s(float a,float b){float r;asm("v_add_f32_e32 %0, %1, %2":"=v"(r):"v"(a),"v"(b));return r;}
__device__ __forceinline__ float fsub_s(float a,float b){float r;asm("v_sub_f32_e32 %0, %1, %2":"=v"(r):"v"(a),"v"(b));return r;}
typedef float f32x2_t __attribute__((ext_vector_type(2))); typedef __bf16 bf16x2_t __attribute__((ext_vector_type(2)));
__device__ __forceinline__ unsigned cvtpk_s(float lo,float hi){f32x2_t v={lo,hi};bf16x2_t b=__builtin_convertvector(v,bf16x2_t);return __builtin_bit_cast(unsigned,b);}
#define WAIT_BAR(N) asm volatile("s_waitcnt vmcnt(" #N ") lgkmcnt(0)\n\ts_barrier":::"memory")

__device__ __forceinline__ void qkt(f32x16&p0,f32x16&p1,const char*Kslot,const bf16x8*qr,int r32,int hi){ const f32x16 negm={};
  const char*kb=Kslot+hi*1024+r32*16;
  #pragma unroll
  for(int d0=0;d0<4;++d0){
    const bf16x8 b0=*reinterpret_cast<const bf16x8*>(kb+d0*2048);
    const bf16x8 b1=*reinterpret_cast<const bf16x8*>(kb+d0*2048+512);
    if(d0==0){p0=__builtin_amdgcn_mfma_f32_32x32x16_bf16(b0,qr[0],negm,0,0,0);p1=__builtin_amdgcn_mfma_f32_32x32x16_bf16(b1,qr[0],negm,0,0,0);}
    else{p0=__builtin_amdgcn_mfma_f32_32x32x16_bf16(b0,qr[d0],p0,0,0,0);p1=__builtin_amdgcn_mfma_f32_32x32x16_bf16(b1,qr[d0],p1,0,0,0);}}
}
typedef __attribute__((address_space(3))) const char* lds_cptr;
typedef short v4i16_t __attribute__((ext_vector_type(4)));
__device__ __forceinline__ void kload8(bf16x8*kf,lds_cptr kp){
  kf[0]=*(const __attribute__((address_space(3))) bf16x8*)(kp);      kf[1]=*(const __attribute__((address_space(3))) bf16x8*)(kp+512);
  kf[2]=*(const __attribute__((address_space(3))) bf16x8*)(kp+2048); kf[3]=*(const __attribute__((address_space(3))) bf16x8*)(kp+2560);
  kf[4]=*(const __attribute__((address_space(3))) bf16x8*)(kp+4096); kf[5]=*(const __attribute__((address_space(3))) bf16x8*)(kp+4608);
  kf[6]=*(const __attribute__((address_space(3))) bf16x8*)(kp+6144); kf[7]=*(const __attribute__((address_space(3))) bf16x8*)(kp+6656);
}
__device__ __forceinline__ void kload2(bf16x8*kf,lds_cptr kp,int j){ kf[2*j]=*(const __attribute__((address_space(3))) bf16x8*)(kp+j*2048); kf[2*j+1]=*(const __attribute__((address_space(3))) bf16x8*)(kp+j*2048+512); }
__device__ __forceinline__ s16x4 vtr(lds_cptr p){ return __builtin_bit_cast(s16x4,__builtin_amdgcn_ds_read_tr16_b64_v4i16((__attribute__((address_space(3))) v4i16_t*)p)); }
template<int MODE> __device__ __forceinline__ void amask(f32x16&c0,f32x16&c1,int t,const UnitCtx&uc,int hi,lds_cptr shm3){
  if(t<4)return;
  const float NEG=-INFINITY;
  if(MODE==1){ const int dq=64*(uc.toff+t-4)+4*hi-uc.qpos0;
    #pragma unroll
    for(int r=0;r<16;++r){ const int d=dq+(r&3)+8*(r>>2); if(d>128||d<-128)c0[r]=NEG; if(d+32>128||d+32<-128)c1[r]=NEG; } }
  else { const int kr=uc.toff+t-4;
    if(kr<uc.rs||kr>=uc.rs+8){
      #pragma unroll
      for(int r=0;r<16;++r){c0[r]=NEG;c1[r]=NEG;} }
    else { const __attribute__((address_space(3))) float*brow=(const __attribute__((address_space(3))) float*)(shm3+BIAS_OFF)+(kr-uc.gr+7)*31+15-uc.qc;
      unsigned vm=uc.vm; asm volatile("":"+v"(vm));
      #pragma unroll
      for(int r=0;r<16;++r){ const int kc=(r&3)+8*(r>>2)+4*hi; const float b0=brow[kc],b1=brow[kc+32];
        c0[r]=((vm>>r)&1u)?c0[r]+b0:NEG; c1[r]=((vm>>(16+r))&1u)?c1[r]+b1:NEG;
        if((r&3)==3)__builtin_amdgcn_sched_barrier(0); } } }
}
__device__ __forceinline__ float rowmax(const f32x16&p0,const f32x16&p1){
  float a=max3f(p0[0],p0[1],p1[0]),b=max3f(p0[2],p0[3],p1[1]);a=max3f(a,p1[2],p1[3]);
  #pragma unroll
  for(int r=4;r<16;r+=4){a=max3f(a,p0[r],p0[r+1]);b=max3f(b,p0[r+2],p0[r+3]);a=max3f(a,p1[r],p1[r+1]);b=max3f(b,p1[r+2],p1[r+3]);}
  const float m=max2f(a,b);
  auto rr=__builtin_amdgcn_permlane32_swap(__float_as_uint(m),__float_as_uint(m),false,false);
  return max2f(__uint_as_float(rr[0]),__uint_as_float(rr[1]));
}
__device__ __forceinline__ void pv(f32x16*o,int vb,bf16x8 pa0,bf16x8 pa1,bf16x8 pa2,bf16x8 pa3){
  #pragma unroll
  for(int d0=0;d0<2;++d0){s16x4 lo[4],hi[4];
    #pragma unroll
    for(int ks=0;ks<4;++ks){
      asm volatile("ds_read_b64_tr_b16 %0,%1 offset:%c2":"=&v"(lo[ks]):"v"(vb),"i"(d0*4096+ks*1024):"memory");
      asm volatile("ds_read_b64_tr_b16 %0,%1 offset:%c2":"=&v"(hi[ks]):"v"(vb),"i"(d0*4096+ks*1024+512):"memory");}
    asm volatile("s_waitcnt lgkmcnt(0)":::"memory");SBAR();
    #define PK(k) (bf16x8){lo[k][0],lo[k][1],lo[k][2],lo[k][3],hi[k][0],hi[k][1],hi[k][2],hi[k][3]}
    o[d0]=__builtin_amdgcn_mfma_f32_32x32x16_bf16(pa0,PK(0),o[d0],0,0,0);
    o[d0]=__builtin_amdgcn_mfma_f32_32x32x16_bf16(pa1,PK(1),o[d0],0,0,0);
    o[d0]=__builtin_amdgcn_mfma_f32_32x32x16_bf16(pa2,PK(2),o[d0],0,0,0);
    o[d0]=__builtin_amdgcn_mfma_f32_32x32x16_bf16(pa3,PK(3),o[d0],0,0,0);
    #undef PK
  }
}

#ifndef ATTN_STORE16
#define ATTN_STORE16(p,v) (*(u32x4*)(p)=(v))
#endif
template<int KP,int VP,int MODE,int THRL> __device__ __forceinline__ void attn_unit(const bf16*Qb,const bf16*__restrict__ Kh,const bf16*__restrict__ Vh,bf16*Ob,int NT,const UnitCtx uc,char*shm,int wave_id){
  const int tid=tid_of(wave_id),lane=tid&63,r32=lane&31,hi=lane>>5; const int wid=wave_id;
  const bf16*Qw=Qb+(long)(wid*QBLK)*QP;
  const unsigned lds0=(unsigned)(uintptr_t)shm;
  float*wsf=(float*)(shm+LDS_WS)+wid*64;
  const bf16*ksrc=Kh+(long)lane*KP+wid*8;
  const bf16*vsrc=Vh+(long)(16*(wid&3)+(lane>>2))*VP+(wid>>2)*32+(lane&3)*8;
  const unsigned kdst=lds0+LDS_K+wid*1024, vdst=lds0+LDS_V+wid*1024;
  #define KT(t) ((t)<4?(t):(t)+uc.toff)
  #define DMA_K(t,slot) glds16(ksrc+(long)KT(t)*KVBLK*KP,(unsigned)__builtin_amdgcn_readfirstlane(kdst+(slot)))
  #define DMA_V(t,slot) glds16(vsrc+(long)KT(t)*KVBLK*VP,(unsigned)__builtin_amdgcn_readfirstlane(vdst+(slot)))
  const int vb0=(int)(lds0+LDS_V)+((lane>>4)&1)*32+(lane&3)*8+(4*hi+((lane&15)>>2))*64;
  const char*Kbase=shm+LDS_K; bf16x8 kf[8];
  const lds_cptr shm3=(lds_cptr)shm; const lds_cptr kp0=shm3+LDS_K+hi*1024+r32*16; const lds_cptr vp0=shm3+LDS_V+((lane>>4)&1)*32+(lane&3)*8+(4*hi+((lane&15)>>2))*64;
  DMA_K(0,0);DMA_V(0,0);DMA_K(1,SLOTB);
  bf16x8 qr[4];
  #pragma unroll
  for(int d0=0;d0<4;++d0)qr[d0]=*reinterpret_cast<const bf16x8*>(&Qw[(long)r32*QP+d0*16+hi*8]);
  float mhat=0.f,l_reg=0.f;f32x16 o[2];o[0]=f32x16{};o[1]=f32x16{};
  #define CMASK(P0,P1,t) do{ if(MODE!=0) amask<MODE>(P0,P1,(t),uc,hi,(lds_cptr)shm); }while(0)
  bool resc=false;
  #define START(P0,P1) do{ const float rm=rowmax(P0,P1); resc=false; \
    { const float dl=rm; mhat=fadd_s(mhat,dl); \
      _Pragma("unroll") for(int r=0;r<16;++r){P0[r]=fsub_s(P0[r],dl);P1[r]=fsub_s(P1[r],dl);} } \
    _Pragma("unroll") for(int r=0;r<16;++r)P0[r]=__builtin_amdgcn_exp2f(P0[r]); }while(0)
  #define RESC() do{ if(resc){ asm volatile("s_waitcnt lgkmcnt(0)":::"memory"); \
      _Pragma("unroll") for(int d_=0;d_<2;++d_) _Pragma("unroll") for(int r=0;r<16;++r)o[d_][r]*=wsf[crow(r,hi)]; } }while(0)
  f32x16 pA0,pA1,pB0,pB1;
  int sl_prev=0,sl_cur=0,sl_next=SLOTB;
  #define ROT() do{sl_prev=sl_cur;sl_cur=sl_next;sl_next=(sl_next==(NSLOT-1)*SLOTB)?0:sl_next+SLOTB;}while(0)
  DMA_K(2,2*SLOTB);
  WAIT_BAR(3);
  qkt(pA0,pA1,Kbase,qr,r32,hi);asm volatile("s_nop 15\n\ts_nop 7":"+v"(pA0),"+v"(pA1));CMASK(pA0,pA1,0);
  START(pA0,pA1);
  if(uc.sink2>-1e30f){ l_reg=(hi==0)?__builtin_amdgcn_exp2f(uc.sink2-mhat):0.f; }
  _Pragma("unroll") for(int r=0;r<16;++r)pA1[r]=__builtin_amdgcn_exp2f(pA1[r]);
  WAIT_BAR(0);
  DMA_K(3,0);DMA_V(1,SLOTB);
  ROT();
  kload8(kf,kp0+sl_cur);
  WAIT_BAR(2);
  s16x4 vlo[8],vhi[8]; u32x4 pw0,pw1,pw2,pw3;
  #define PKW(P,B) cvtpk_s(P[B],P[B+1])
  #define PAF(k) __builtin_bit_cast(bf16x8,pw##k)
  #define VFR(i) (bf16x8){vlo[i][0],vlo[i][1],vlo[i][2],vlo[i][3],vhi[i][0],vhi[i][1],vhi[i][2],vhi[i][3]}
  #define PIN(x) asm volatile("":"+v"(x))
  #define MX3(a,b,c) __builtin_fmaxf(__builtin_fmaxf((a),(b)),(c))
  #define GAPA(MF,A0,A1,A2,A3,W0,W1,PW) do{ MF; sacc+=A0; sacc+=A1; sacc+=A2; sacc+=A3; PIN(sacc); W0; W1; PIN(PW); SBAR(); }while(0)
  #define EX(v) __builtin_amdgcn_exp2f(v)
  #define GAPB(MF,X,B) do{ MF; X[B]=EX(X[B]); X[B+1]=EX(X[B+1]); X[B+2]=EX(X[B+2]); X[B+3]=EX(X[B+3]); PIN(X); SBAR(); }while(0)
  #define VRD(i) do{ vlo[i]=vtr(vp_+(((i)>>2)*4096+((i)&3)*1024)); vhi[i]=vtr(vp_+(((i)>>2)*4096+((i)&3)*1024+512)); }while(0)
  #define KRD(G,j) do{ if(G){ kload2(kf,kp0+sl_next,j); SBAR(); } }while(0)
  #define STEP(C0,C1,P0,P1,t,GK,GV,GL) do{ SBAR(); \
    const lds_cptr vp_=vp0+sl_prev; \
    VRD(0); SBAR(); float sacc=(P0[0]+P0[1]); \
    GAPA(C0=__builtin_amdgcn_mfma_f32_32x32x16_bf16(kf[0],qr[0],(f32x16){},0,0,0), P0[2],P0[3],P0[4],P0[5],     pw0[0]=PKW(P0,0), pw0[1]=PKW(P0,2), pw0); \
    VRD(4); SBAR(); GAPA(C1=__builtin_amdgcn_mfma_f32_32x32x16_bf16(kf[1],qr[0],(f32x16){},0,0,0), P0[6],P0[7],P0[8],P0[9],     pw0[2]=PKW(P0,4), pw0[3]=PKW(P0,6), pw0); \
    VRD(1); SBAR(); GAPA(C0=__builtin_amdgcn_mfma_f32_32x32x16_bf16(kf[2],qr[1],C0,0,0,0),   P0[10],P0[11],P0[12],P0[13], pw1[0]=PKW(P0,8), pw1[1]=PKW(P0,10), pw1); \
    VRD(5); SBAR(); GAPA(C1=__builtin_amdgcn_mfma_f32_32x32x16_bf16(kf[3],qr[1],C1,0,0,0),   P0[14],P0[15],P1[0],P1[1],   pw1[2]=PKW(P0,12),pw1[3]=PKW(P0,14), pw1); \
    VRD(2); SBAR(); GAPA(C0=__builtin_amdgcn_mfma_f32_32x32x16_bf16(kf[4],qr[2],C0,0,0,0),   P1[2],P1[3],P1[4],P1[5],     pw2[0]=PKW(P1,0), pw2[1]=PKW(P1,2), pw2); \
    VRD(6); SBAR(); GAPA(C1=__builtin_amdgcn_mfma_f32_32x32x16_bf16(kf[5],qr[2],C1,0,0,0),   P1[6],P1[7],P1[8],P1[9],     pw2[2]=PKW(P1,4), pw2[3]=PKW(P1,6), pw2); \
    VRD(3); SBAR(); GAPA(C0=__builtin_amdgcn_mfma_f32_32x32x16_bf16(kf[6],qr[3],C0,0,0,0),   P1[10],P1[11],P1[12],P1[13], pw3[0]=PKW(P1,8), pw3[1]=PKW(P1,10), pw3); \
    VRD(7); SBAR(); GAPA(C1=__builtin_amdgcn_mfma_f32_32x32x16_bf16(kf[7],qr[3],C1,0,0,0),   P1[14],P1[15],0.f,0.f,       pw3[2]=PKW(P1,12),pw3[3]=PKW(P1,14), pw3); \
    l_reg+=sacc; \
    { _Pragma("unroll") for(int r=0;r<16;++r){C0[r]-=mhat;C1[r]-=mhat;} } \
    if(GK){DMA_K((t)+3,sl_cur);} if(GV){DMA_V((t)+1,sl_next);} \
    CMASK(C0,C1,t); \
    { float a=MX3(C0[0],C0[1],C1[0]),b=MX3(C0[2],C0[3],C1[1]); a=MX3(a,C1[2],C1[3]); \
      _Pragma("unroll") for(int r=4;r<16;r+=4){a=MX3(a,C0[r],C0[r+1]);b=MX3(b,C0[r+2],C0[r+3]);a=MX3(a,C1[r],C1[r+1]);b=MX3(b,C1[r+2],C1[r+3]);} \
      float rm=__builtin_fmaxf(a,b); { auto rr=__builtin_amdgcn_permlane32_swap(__float_as_uint(rm),__float_as_uint(rm),false,false); rm=__builtin_fmaxf(__uint_as_float(rr[0]),__uint_as_float(rr[1])); } \
      resc=false; \
      if(__builtin_expect(__any(rm>(float)THRL),0)){ const float dl=__builtin_fmaxf(rm,0.f); mhat+=dl; \
        _Pragma("unroll") for(int r=0;r<16;++r){C0[r]-=dl;C1[r]-=dl;} \
        const float f=__builtin_amdgcn_exp2f(-dl); l_reg*=f; if(hi==0)wsf[r32]=f; resc=true; } } \
    SBAR(); \
    GAPB(o[0]=__builtin_amdgcn_mfma_f32_32x32x16_bf16(PAF(0),VFR(0),o[0],0,0,0), C0,0); \
    GAPB(o[1]=__builtin_amdgcn_mfma_f32_32x32x16_bf16(PAF(0),VFR(4),o[1],0,0,0), C0,4); \
    KRD(GL,0); GAPB(o[0]=__builtin_amdgcn_mfma_f32_32x32x16_bf16(PAF(1),VFR(1),o[0],0,0,0), C0,8); \
    KRD(GL,1); GAPB(o[1]=__builtin_amdgcn_mfma_f32_32x32x16_bf16(PAF(1),VFR(5),o[1],0,0,0), C0,12); \
    KRD(GL,2); GAPB(o[0]=__builtin_amdgcn_mfma_f32_32x32x16_bf16(PAF(2),VFR(2),o[0],0,0,0), C1,0); \
    KRD(GL,3); GAPB(o[1]=__builtin_amdgcn_mfma_f32_32x32x16_bf16(PAF(2),VFR(6),o[1],0,0,0), C1,4); \
    GAPB(o[0]=__builtin_amdgcn_mfma_f32_32x32x16_bf16(PAF(3),VFR(3),o[0],0,0,0), C1,8); \
    GAPB(o[1]=__builtin_amdgcn_mfma_f32_32x32x16_bf16(PAF(3),VFR(7),o[1],0,0,0), C1,12); \
    }while(0)
  int t=1;
  for(;t+5<NT;t+=2){
    STEP(pB0,pB1,pA0,pA1,t,true,true,true);     WAIT_BAR(2); RESC(); ROT();
    STEP(pA0,pA1,pB0,pB1,t+1,true,true,true);   WAIT_BAR(2); RESC(); ROT();
  }
  #define ENDW(tt) do{ if((tt)+3<NT){WAIT_BAR(2);} else if((tt)+2<NT){WAIT_BAR(1);} else {WAIT_BAR(0);} }while(0)
  for(;t+1<NT;t+=2){
    STEP(pB0,pB1,pA0,pA1,t,(t+3<NT),(t+1<NT),(t+1<NT));       ENDW(t);   RESC(); ROT();
    STEP(pA0,pA1,pB0,pB1,t+1,(t+4<NT),(t+2<NT),(t+2<NT));     ENDW(t+1); RESC(); ROT();
  }
  STEP(pB0,pB1,pA0,pA1,NT-1,false,false,false); RESC();
  { float sacc=pB0[0]+pB0[1]; _Pragma("unroll") for(int r=2;r<16;++r)sacc+=pB0[r]; _Pragma("unroll") for(int r=0;r<16;++r)sacc+=pB1[r]; l_reg+=sacc;
    pw0=(u32x4){PKW(pB0,0),PKW(pB0,2),PKW(pB0,4),PKW(pB0,6)};pw1=(u32x4){PKW(pB0,8),PKW(pB0,10),PKW(pB0,12),PKW(pB0,14)};pw2=(u32x4){PKW(pB1,0),PKW(pB1,2),PKW(pB1,4),PKW(pB1,6)};pw3=(u32x4){PKW(pB1,8),PKW(pB1,10),PKW(pB1,12),PKW(pB1,14)};
    SBAR(); pv(o,vb0+sl_cur,PAF(0),PAF(1),PAF(2),PAF(3)); }
  #undef PKW
  #undef PAF
  #undef VFR
  #undef PIN
  #undef MX3
  #undef GAPA
  #undef GAPB
  #undef EX
  #undef VRD
  #undef KRD
  #undef STEP
  #undef ENDW
  {auto rr=__builtin_amdgcn_permlane32_swap(__float_as_uint(l_reg),__float_as_uint(l_reg),false,false);l_reg=__uint_as_float(rr[0])+__uint_as_float(rr[1]);}
  if(hi==0)wsf[32+r32]=l_reg;asm volatile("s_waitcnt lgkmcnt(0)":::"memory");
  float rli[16];
  #pragma unroll
  for(int r=0;r<16;++r)rli[r]=__builtin_amdgcn_rcpf(wsf[32+crow(r,hi)]);
  bf16*Ow=Ob+(long)(wid*QBLK)*QP;
  { bf16*stg=(bf16*)(shm+LDS_OST)+wid*2048;
    #pragma unroll
    for(int r=0;r<16;++r){const int orow=crow(r,hi);
      #pragma unroll
      for(int d0=0;d0<2;++d0)stg[orow*64+d0*32+r32]=__float2bfloat16(o[d0][r]*rli[r]);}
    asm volatile("s_waitcnt lgkmcnt(0)":::"memory");
    #pragma unroll
    for(int i=0;i<4;++i){const int row=i*8+(lane>>3),ch=lane&7; const u32x4 v=*(const u32x4*)(stg+row*64+ch*8); ATTN_STORE16(Ow+(long)row*QP+ch*8,v);} }
  asm volatile("s_waitcnt lgkmcnt(0)\n\ts_barrier":::"memory");
  #undef DMA_K
  #undef DMA_V
  #undef CMASK
  #undef KT
  #undef START
  #undef RESC
  #undef ROT
}
constexpr int ATTN_LDS_BYTES=LDS_BYTES;
#undef SBAR
#undef WAIT_BAR
}
__device__ __forceinline__ void attn_dispatch(KAP ap, int l, int uid, int wid, char* shm) {
    using namespace attn_body;
    unsigned char* ws = ap->ws;
    const int r32 = lane_id() & 31;
    const bf16* Qa = (const bf16*)(ws + WS_Q);
    UnitCtx uc; uc.toff = 0; uc.qpos0 = 0; uc.gr = 0; uc.rs = 0; uc.qc = 0; uc.vm = 0u; uc.sink2 = -INFINITY;
    if (uid < 384) {
        const int qb = uid & 31, bh = uid >> 5, b = bh / 6, h = bh % 6;
        const bf16* Qb = Qa + (size_t)(b * SEQ + qb * 256) * QW + (6 + h) * 64;
        const size_t ko = (size_t)b * KEYS * 256 + 128 + (h / 3) * 64;
        attn_unit<256, 256, 0, 8>(Qb, (const bf16*)(ws + WS_KAB) + ko, (const bf16*)(ws + WS_VTAB) + ko, (bf16*)Qb, KEYS / 64, uc, shm, wid);
    } else if (uid < 768) {
        const int u = uid - 384, qb = u & 31, bh = u >> 5, b = bh / 6, h = bh % 6;
        const bf16* Qb = Qa + (size_t)(b * SEQ + qb * 256) * QW + (12 + h) * 64;
        const size_t ko = (size_t)b * KEYS * 384 + h * 64;
        int klo = 4 * qb - 4; klo = klo < 0 ? 0 : (klo > 120 ? 120 : klo);
        int khi = 4 * qb + 3 - 4; khi = (khi < 0 ? 0 : (khi > 120 ? 120 : khi)) + 7;
        const int cnt = khi - klo + 1;
        uc.toff = klo; uc.gr = 4 * qb + (wid >> 1); uc.rs = uc.gr - 4 < 0 ? 0 : (uc.gr - 4 > 120 ? 120 : uc.gr - 4);
        uc.qc = 32 * (wid & 1) + r32;
        { const int wsn = uc.qc - 8 < 0 ? 0 : (uc.qc - 8 > 48 ? 48 : uc.qc - 8), hi = (lane_id() >> 5) & 1; unsigned vm = 0u;
#pragma unroll
          for (int r = 0; r < 16; ++r) { const int kc = (r & 3) + 8 * (r >> 2) + 4 * hi; if (kc >= wsn && kc < wsn + 16) vm |= 1u << r; if (kc + 32 >= wsn && kc + 32 < wsn + 16) vm |= 1u << (16 + r); }
          uc.vm = vm; }
        { const float* rpb = ap->in[12] + (size_t)(l * 6 + h) * 465; float* bl = (float*)(shm + BIAS_OFF); const int tb = tid_of(wid); if (tb < 465) bl[tb] = rpb[tb] * LOG2E; }
        attn_unit<384, 384, 2, 8>(Qb, (const bf16*)(ws + WS_KC) + ko, (const bf16*)(ws + WS_VTC) + ko, (bf16*)Qb, 4 + cnt + (cnt & 1), uc, shm, wid);
    } else if (uid < 1152) {
        const int u = uid - 768, qb = u & 31, bh = u >> 5, b = bh / 6, h = bh % 6;
        const bf16* Qb = Qa + (size_t)(b * SEQ + qb * 256) * QW + h * 64;
        const size_t ko = (size_t)b * KEYS * 256 + (h / 3) * 64;
        const int tlo = 4 * qb - 2 < 0 ? 0 : 4 * qb - 2, thi = 4 * qb + 5 > 127 ? 127 : 4 * qb + 5;
        uc.toff = tlo; uc.qpos0 = 256 * qb + 32 * wid + r32; uc.sink2 = ap->in[9][l * 6 + h] * LOG2E;
        attn_unit<256, 256, 1, 8>(Qb, (const bf16*)(ws + WS_KAB) + ko, (const bf16*)(ws + WS_VTAB) + ko, (bf16*)Qb, 4 + thi - tlo + 1, uc, shm, wid);
    } else {
        const int v = uid - 1152, type = v / 12, b = (v / 6) % 2, h = v % 6;
        const bf16* Qb = Qa + (size_t)(MLAT + b * LCTX) * QW + (type * 6 + h) * 64;
        if (type == 2) {
            const size_t ko = (size_t)b * KEYS * 384 + h * 64;
            attn_unit<384, 384, 0, 8>(Qb, (const bf16*)(ws + WS_KC) + ko, (const bf16*)(ws + WS_VTC) + ko, (bf16*)Qb, 4, uc, shm, wid);
        } else {
            const size_t ko = (size_t)b * KEYS * 256 + type * 128 + (h / 3) * 64;
            if (type == 0) uc.sink2 = ap->in[9][l * 6 + h] * LOG2E;
            attn_unit<256, 256, 0, 8>(Qb, (const bf16*)(ws + WS_KAB) + ko, (const bf16*)(ws + WS_VTAB) + ko, (bf16*)Qb, 4, uc, shm, wid);
        }
    }
}

#define XB_TMO      128
#define XB_XCNT(j)  (256  + 64 * (j))
#define XB_XSUB(j)  (1280 + 64 * (j))
#define XB_XGEN(j)  (2304 + 64 * (j))
#define XB_TOP      3328
#define XB_TOPGEN   3392
#define XCD_BAR_WORDS 3456
#define XB_SPIN_CAP (1u << 18)

__device__ __forceinline__ unsigned xb_ld(unsigned* p)              { return __hip_atomic_load(p, __ATOMIC_RELAXED, __HIP_MEMORY_SCOPE_AGENT); }
__device__ __forceinline__ unsigned xb_add(unsigned* p, unsigned v) { return __hip_atomic_fetch_add(p, v, __ATOMIC_RELAXED, __HIP_MEMORY_SCOPE_AGENT); }
__device__ __forceinline__ unsigned xb_xcc_id() { return (unsigned)__builtin_amdgcn_s_getreg((3 << 11) | 20) & 0xFu; }
#define XB_SPIN(cond, bar) do { unsigned _sp = 0; while (cond) { __builtin_amdgcn_s_sleep(1); \
    if ((++_sp & 255u) == 0u) { if (xb_ld(&(bar)[XB_TMO])) break; if (_sp > XB_SPIN_CAP) { atomicAdd(&(bar)[XB_TMO], 1u); break; } } } } while (0)

struct XcdBarrier {
    unsigned* bar; unsigned x;
    volatile __attribute__((address_space(3))) unsigned* st;
};

__device__ __forceinline__ XcdBarrier xcd_barrier_post(unsigned* bar, volatile __attribute__((address_space(3))) unsigned* st, bool leader) {
    XcdBarrier b; b.bar = bar; b.x = xb_xcc_id(); b.st = st;
    if (leader) (void)xb_add(&bar[XB_XCNT(b.x)], 1u);
    return b;
}
__device__ __forceinline__ void xcd_barrier_complete(unsigned* bar, unsigned x, unsigned& nloc, unsigned& nx) {
    const unsigned G = gridDim.x * gridDim.y * gridDim.z;
    unsigned sum, cnt, mine, sp = 0u;
    for (;;) {
        sum = 0u; cnt = 0u; mine = 0u;
#pragma unroll
        for (unsigned j = 0; j < 16; ++j) { const unsigned c = xb_ld(&bar[XB_XCNT(j)]); sum += c; cnt += (c > 0u) ? 1u : 0u; mine = (j == x) ? c : mine; }
        if (sum == G) break;
        __builtin_amdgcn_s_sleep(1);
        if ((++sp & 255u) == 0u) { if (xb_ld(&bar[XB_TMO])) break; if (sp > XB_SPIN_CAP) { atomicAdd(&bar[XB_TMO], 1u); break; } }
    }
    nloc = mine > 0u ? mine : 1u; nx = cnt > 0u ? cnt : 1u;
}

__device__ __forceinline__ void xcd_barrier(const XcdBarrier& b, bool leader) {
    asm volatile("s_waitcnt vmcnt(0)" ::: "memory");
    __syncthreads();
    if (leader) {
        unsigned* bar = b.bar;
        __builtin_amdgcn_s_waitcnt(0);
        unsigned nloc = b.st[0], nx = b.st[1];
        if (nloc == 0u) { xcd_barrier_complete(bar, b.x, nloc, nx); b.st[0] = nloc; b.st[1] = nx; }
        const unsigned old = xb_add(&bar[XB_XSUB(b.x)], 1u);
        const unsigned gen = old / nloc;
        if (old + 1u == (gen + 1u) * nloc) {
            __builtin_amdgcn_fence(__ATOMIC_RELEASE, "agent");
            asm volatile("s_waitcnt vmcnt(0)" ::: "memory");
            const unsigned og = xb_add(&bar[XB_TOP], 1u);
            const unsigned tg = og / nx;
            if (og + 1u == (tg + 1u) * nx) xb_add(&bar[XB_TOPGEN], 1u);
            else XB_SPIN(xb_ld(&bar[XB_TOPGEN]) == tg, bar);
            __builtin_amdgcn_fence(__ATOMIC_ACQUIRE, "agent");
            xb_add(&bar[XB_XGEN(b.x)], 1u);
            asm volatile("s_waitcnt vmcnt(0)" ::: "memory");
        } else {
            XB_SPIN(xb_ld(&bar[XB_XGEN(b.x)]) == gen, bar);
            __builtin_amdgcn_fence(__ATOMIC_ACQUIRE, "agent");
            asm volatile("s_waitcnt vmcnt(0)" ::: "memory");
        }
    }
    __syncthreads();
}
__global__ void __launch_bounds__(512, 2) fwd_mega(Args a) {
    extern __shared__ __attribute__((aligned(16))) unsigned char lds_raw[];
    cg::grid_group grid = cg::this_grid();
    PG8_LAS unsigned char* lds = (PG8_LAS unsigned char*)lds_raw;
    const int wave = __builtin_amdgcn_readfirstlane((int)threadIdx.x >> 6);
    const int tid = tid_of(wave);
    const int G = gridDim.x, gw = blockIdx.x * 8 + wave, NGW = G * 8;
#define LANE() ({ int l_ = lane_id(); asm volatile("" : "+v"(l_)); l_; })
#define LEADER() (wave == 0 && lane_id() == 0)
#define WSP() ((unsigned char*)KARGS()->ws)
#define MODS() ((float*)(WSP() + WS_MODS))
#define CTL() ((unsigned*)(WSP() + WS_CTL))
    volatile LAS unsigned* MISC = (volatile LAS unsigned*)((LAS unsigned char*)lds_raw + 131072);
    if (tid < 64) MISC[tid] = 0u;
    __syncthreads();
    { const XcdBarrier xb0 = xcd_barrier_post(CTL() + 4096, MISC + 8, LEADER()); (void)xb0; }
#if PROBE_MASK
    if (blockIdx.x == 0 && tid == 0) { const unsigned long long now = __builtin_amdgcn_s_memrealtime(); MISC[18] = (unsigned)now; MISC[19] = (unsigned)(now >> 32); }
#define TSTAMP(id) do { if (blockIdx.x == 0 && LEADER()) { const unsigned long long now_ = __builtin_amdgcn_s_memrealtime(); const unsigned long long st_ = ((unsigned long long)MISC[19] << 32) | MISC[18]; \
        if ((PROBE_MASK >> (id)) & 1) { const unsigned long long ac_ = (((unsigned long long)MISC[17] << 32) | MISC[16]) + (now_ - st_); MISC[16] = (unsigned)ac_; MISC[17] = (unsigned)(ac_ >> 32); } \
        MISC[18] = (unsigned)now_; MISC[19] = (unsigned)(now_ >> 32); } } while (0)
#else
#define TSTAMP(id) do {} while (0)
#endif
#define GRID_BAR() do { XcdBarrier xb_; xb_.bar = CTL() + 4096; xb_.x = xb_xcc_id(); xb_.st = MISC + 8; xcd_barrier(xb_, LEADER()); } while (0)

    conv_weights(KARGS(), 0, (LAS unsigned char*)lds_raw, gw, NGW, wave, LANE());
    ada_phase(KARGS(), gw, NGW, LANE());
    if (blockIdx.x == 0) {
        float* rope = (float*)(WSP() + WS_ROPE);
        for (int i = tid; i < 128 * 16; i += 512) { const int pos = i >> 4, f = i & 15; const float fr = powf(10000.0f, -(float)f / 16.0f); const float ang = (float)pos * fr; float s, c; sincosf(ang, &s, &c); rope[2 * i] = c; rope[2 * i + 1] = s; }
    }
    grid.sync(); TSTAMP(0);
    { KAP ap = KARGS();
      row_phase(gw, NGW, LANE(), MALL, nullptr, nullptr, nullptr, 0, ap->in[0], ap->in[2], nullptr, nullptr,
              (bf16_t*)(WSP() + WS_R1), ap->in[6], MODS(), 0, 1024); }
    GRID_BAR(); TSTAMP(1);

    {
        constexpr int l = 0;
        const bool last = (l == DEPTH - 1);
        const int MX = last ? MLAT : MALL;
        int bidl = blockIdx.x, Gl = gridDim.x; asm volatile("" : "+s"(bidl), "+s"(Gl));
#define MODL() (MODS() + (size_t)l * 3 * 6144)
        {
            pg8::Gemm g{(const bf16_t*)(WSP() + WS_R1), (const bf16_t*)(WSP() + WS_WIN), MALL, NINP, DM, DM, DM, 0, 0};
            pg8::StaticOrder S; S.init(MALL, NINP, Gl, bidl);
            EpiScatter E{(bf16_t*)(WSP() + WS_Q), (bf16_t*)(WSP() + WS_KAB), (bf16_t*)(WSP() + WS_KC), (bf16_t*)(WSP() + WS_VTAB), (bf16_t*)(WSP() + WS_VTC), (bf16_t*)(WSP() + WS_PG)};
            pg8::gemm_phase<EpiScatter, pg8::StaticOrder, true, true>(lds, g, S, E, wave);
        }
        GRID_BAR(); TSTAMP(2);
        post_phase(KARGS(), l, gw, NGW, LANE());
        GRID_BAR(); TSTAMP(3);
        {
            KAP ap = KARGS();
            const int nunit = 1152 + (last ? 0 : 36);
            unsigned* ctr = CTL() + 64 * l;
            for (;;) {
                if (LEADER()) MISC[24] = atomicAdd(ctr, 1u);
                __syncthreads();
                const int uid = (int)MISC[24];
                __syncthreads();
                if (uid >= nunit) break;
                attn_dispatch(ap, l, uid, wave, (char*)lds_raw);
            }
        }
        GRID_BAR(); TSTAMP(4);
        {
            pg8::Gemm g{(const bf16_t*)(WSP() + WS_Q), (const bf16_t*)(WSP() + WS_WBR), MX, DM, QW, QW, QW, 0, 0};
            pg8::StaticOrder S; S.init(MX, DM, Gl, bidl);
            EpiGateSum E{(bf16_t*)(WSP() + WS_PG)};
            pg8::gemm_phase<EpiGateSum, pg8::StaticOrder, true, true, 6>(lds, g, S, E, wave);
        }
        GRID_BAR(); TSTAMP(5);
        {
            pg8::Gemm g{(const bf16_t*)(WSP() + WS_PG), (const bf16_t*)(WSP() + WS_WOUT), MX, DM, DM, 3072, DM, 0, 0};
            pg8::StaticOrder S; S.init(MX, DM, Gl, bidl);
            EpiBf16<0> E{(bf16_t*)(WSP() + WS_Y), DM};
            pg8::gemm_phase<EpiBf16<0>, pg8::StaticOrder, true, true>(lds, g, S, E, wave);
        }
        GRID_BAR(); TSTAMP(6);
        { KAP ap = KARGS();
          row_phase(gw, NGW, LANE(), MX, (const bf16_t*)(WSP() + WS_Y), ap->in[7] + l * DM, MODL(), 2048,
                  l == 0 ? ap->in[0] : ap->out, l == 0 ? ap->in[2] : (const float*)(WSP() + WS_XC), ap->out, (float*)(WSP() + WS_XC),
                  (bf16_t*)(WSP() + WS_Q), ap->in[17] + l * DM, MODL(), 3072, 4096); }
        GRID_BAR(); TSTAMP(7);
        {
            pg8::Gemm g{(const bf16_t*)(WSP() + WS_Q), (const bf16_t*)(WSP() + WS_W1), MX, FF, DM, DM, DM, 0, 0};
            pg8::StaticOrder S; S.init(MX, FF, Gl, bidl);
            EpiBf16<1> E{(bf16_t*)(WSP() + WS_A), FF};
            pg8::gemm_phase<EpiBf16<1>, pg8::StaticOrder, true, true>(lds, g, S, E, wave);
        }
        GRID_BAR(); TSTAMP(8);
        {
            pg8::Gemm g{(const bf16_t*)(WSP() + WS_A), (const bf16_t*)(WSP() + WS_W2), MX, DM, FF, FF, FF, 0, 0};
            pg8::StaticOrder S; S.init(MX, DM, Gl, bidl);
            EpiBf16<0> E{(bf16_t*)(WSP() + WS_Y2), DM};
            pg8::gemm_phase<EpiBf16<0>, pg8::StaticOrder, true, true>(lds, g, S, E, wave);
        }
        GRID_BAR(); TSTAMP(9);
        if (!last) {
            { KAP ap = KARGS();
              row_phase(gw, NGW, LANE(), MX, (const bf16_t*)(WSP() + WS_Y2), ap->in[18] + l * DM, MODL(), 5120,
                      ap->out, (const float*)(WSP() + WS_XC), ap->out, (float*)(WSP() + WS_XC),
                      (bf16_t*)(WSP() + WS_R1), ap->in[6] + (l + 1) * DM, MODL() + 3 * 6144, 0, 1024); }
            conv_weights(KARGS(), l + 1, (LAS unsigned char*)lds_raw, gw, NGW, wave, LANE());
            GRID_BAR(); TSTAMP(10);
        } else {
            { KAP ap = KARGS();
              row_phase(gw, NGW, LANE(), MX, (const bf16_t*)(WSP() + WS_Y2), ap->in[18] + l * DM, MODL(), 5120,
                      ap->out, (const float*)(WSP() + WS_XC), ap->out, (float*)(WSP() + WS_XC),
                      nullptr, nullptr, nullptr, 0, 0); }
            TSTAMP(10);
        }
    }
    {
        constexpr int l = 1;
        const bool last = (l == DEPTH - 1);
        const int MX = last ? MLAT : MALL;
        int bidl = blockIdx.x, Gl = gridDim.x; asm volatile("" : "+s"(bidl), "+s"(Gl));
#define MODL() (MODS() + (size_t)l * 3 * 6144)
        {
            pg8::Gemm g{(const bf16_t*)(WSP() + WS_R1), (const bf16_t*)(WSP() + WS_WIN), MALL, NINP, DM, DM, DM, 0, 0};
            pg8::StaticOrder S; S.init(MALL, NINP, Gl, bidl);
            EpiScatter E{(bf16_t*)(WSP() + WS_Q), (bf16_t*)(WSP() + WS_KAB), (bf16_t*)(WSP() + WS_KC), (bf16_t*)(WSP() + WS_VTAB), (bf16_t*)(WSP() + WS_VTC), (bf16_t*)(WSP() + WS_PG)};
            pg8::gemm_phase<EpiScatter, pg8::StaticOrder, true, true>(lds, g, S, E, wave);
        }
        GRID_BAR(); TSTAMP(2);
        post_phase(KARGS(), l, gw, NGW, LANE());
        GRID_BAR(); TSTAMP(3);
        {
            KAP ap = KARGS();
            const int nunit = 1152 + (last ? 0 : 36);
            unsigned* ctr = CTL() + 64 * l;
            for (;;) {
                if (LEADER()) MISC[24] = atomicAdd(ctr, 1u);
                __syncthreads();
                const int uid = (int)MISC[24];
                __syncthreads();
                if (uid >= nunit) break;
                attn_dispatch(ap, l, uid, wave, (char*)lds_raw);
            }
        }
        GRID_BAR(); TSTAMP(4);
        {
            pg8::Gemm g{(const bf16_t*)(WSP() + WS_Q), (const bf16_t*)(WSP() + WS_WBR), MX, DM, QW, QW, QW, 0, 0};
            pg8::StaticOrder S; S.init(MX, DM, Gl, bidl);
            EpiGateSum E{(bf16_t*)(WSP() + WS_PG)};
            pg8::gemm_phase<EpiGateSum, pg8::StaticOrder, true, true, 6>(lds, g, S, E, wave);
        }
        GRID_BAR(); TSTAMP(5);
        {
            pg8::Gemm g{(const bf16_t*)(WSP() + WS_PG), (const bf16_t*)(WSP() + WS_WOUT), MX, DM, DM, 3072, DM, 0, 0};
            pg8::StaticOrder S; S.init(MX, DM, Gl, bidl);
            EpiBf16<0> E{(bf16_t*)(WSP() + WS_Y), DM};
            pg8::gemm_phase<EpiBf16<0>, pg8::StaticOrder, true, true>(lds, g, S, E, wave);
        }
        GRID_BAR(); TSTAMP(6);
        { KAP ap = KARGS();
          row_phase(gw, NGW, LANE(), MX, (const bf16_t*)(WSP() + WS_Y), ap->in[7] + l * DM, MODL(), 2048,
                  l == 0 ? ap->in[0] : ap->out, l == 0 ? ap->in[2] : (const float*)(WSP() + WS_XC), ap->out, (float*)(WSP() + WS_XC),
                  (bf16_t*)(WSP() + WS_Q), ap->in[17] + l * DM, MODL(), 3072, 4096); }
        GRID_BAR(); TSTAMP(7);
        {
            pg8::Gemm g{(const bf16_t*)(WSP() + WS_Q), (const bf16_t*)(WSP() + WS_W1), MX, FF, DM, DM, DM, 0, 0};
            pg8::StaticOrder S; S.init(MX, FF, Gl, bidl);
            EpiBf16<1> E{(bf16_t*)(WSP() + WS_A), FF};
            pg8::gemm_phase<EpiBf16<1>, pg8::StaticOrder, true, true>(lds, g, S, E, wave);
        }
        GRID_BAR(); TSTAMP(8);
        {
            pg8::Gemm g{(const bf16_t*)(WSP() + WS_A), (const bf16_t*)(WSP() + WS_W2), MX, DM, FF, FF, FF, 0, 0};
            pg8::StaticOrder S; S.init(MX, DM, Gl, bidl);
            EpiBf16<0> E{(bf16_t*)(WSP() + WS_Y2), DM};
            pg8::gemm_phase<EpiBf16<0>, pg8::StaticOrder, true, true>(lds, g, S, E, wave);
        }
        GRID_BAR(); TSTAMP(9);
        if (!last) {
            { KAP ap = KARGS();
              row_phase(gw, NGW, LANE(), MX, (const bf16_t*)(WSP() + WS_Y2), ap->in[18] + l * DM, MODL(), 5120,
                      ap->out, (const float*)(WSP() + WS_XC), ap->out, (float*)(WSP() + WS_XC),
                      (bf16_t*)(WSP() + WS_R1), ap->in[6] + (l + 1) * DM, MODL() + 3 * 6144, 0, 1024); }
            conv_weights(KARGS(), l + 1, (LAS unsigned char*)lds_raw, gw, NGW, wave, LANE());
            GRID_BAR(); TSTAMP(10);
        } else {
            { KAP ap = KARGS();
              row_phase(gw, NGW, LANE(), MX, (const bf16_t*)(WSP() + WS_Y2), ap->in[18] + l * DM, MODL(), 5120,
                      ap->out, (const float*)(WSP() + WS_XC), ap->out, (float*)(WSP() + WS_XC),
                      nullptr, nullptr, nullptr, 0, 0); }
            TSTAMP(10);
        }
    }
#if PROBE_MASK
    if (blockIdx.x == 0 && LEADER()) {
        const unsigned long long t0 = __builtin_amdgcn_s_memrealtime(); const unsigned long long ac = ((unsigned long long)MISC[17] << 32) | MISC[16];
        while (__builtin_amdgcn_s_memrealtime() - t0 < 4ull * ac) __builtin_amdgcn_s_sleep(32);
    }
#endif
}

extern "C" void kernel_launch(void* const* d_in, const int* in_sizes, int n_in, void* d_out, int out_size, void* d_ws, size_t ws_size, hipStream_t stream) {
    static int grid = 0;
    if (grid == 0) {
        if (n_in != 21 || out_size != MLAT * DM || ws_size < WS_END) { fprintf(stderr, "kernel_launch: unexpected shapes (n_in %d, out %d, ws %zu need %zu)\n", n_in, out_size, ws_size, (size_t)WS_END); grid = -1; return; }
        int dev = 0, cus = 0, per_cu = 0;
        if (hipGetDevice(&dev) != hipSuccess || hipDeviceGetAttribute(&cus, hipDeviceAttributeMultiprocessorCount, dev) != hipSuccess) { grid = -1; return; }
        if (hipFuncSetAttribute((const void*)fwd_mega, hipFuncAttributeMaxDynamicSharedMemorySize, LDS_BYTES) != hipSuccess) { fprintf(stderr, "kernel_launch: hipFuncSetAttribute failed\n"); grid = -1; return; }
        if (hipOccupancyMaxActiveBlocksPerMultiprocessor(&per_cu, (const void*)fwd_mega, 512, LDS_BYTES) != hipSuccess || per_cu < 1) { fprintf(stderr, "kernel_launch: occupancy query says %d blocks per CU\n", per_cu); grid = -1; return; }
        grid = cus;
    }
    if (grid < 0) return;
    (void)hipMemsetAsync((char*)d_ws + WS_CTL, 0, CTL_ZERO_BYTES, stream);
    Args a{};
    for (int i = 0; i < 21; ++i) a.in[i] = (const float*)d_in[i];
    a.out = (float*)d_out; a.ws = (unsigned char*)d_ws;
    void* args[] = {&a};
    hipError_t e = hipLaunchCooperativeKernel((const void*)fwd_mega, dim3(grid), dim3(512), args, LDS_BYTES, stream);
    if (e != hipSuccess) fprintf(stderr, "cooperative launch failed: %s (grid %d)\n", hipGetErrorString(e), grid);
}
```

```cpp
#include <hip/hip_runtime.h>
#include <hip/hip_cooperative_groups.h>
#include <cstdio>
#include <cstdint>
namespace cg = cooperative_groups;
#ifndef PROBE_MASK
#define PROBE_MASK 0
#endif

__device__ __forceinline__ int lane_id() { int l; asm volatile("v_mbcnt_lo_u32_b32 %0, -1, 0\n\tv_mbcnt_hi_u32_b32 %0, -1, %0" : "=v"(l)); return l; }
__device__ __forceinline__ int tid_of(int wave) { int t = wave * 64 + lane_id(); asm volatile("" : "+v"(t)); return t; }
namespace pg8 {
#define PG8_LAS __attribute__((address_space(3)))
typedef unsigned short bf16_t;
typedef short bf16x8 __attribute__((ext_vector_type(8)));
typedef float f32x4 __attribute__((ext_vector_type(4)));
typedef unsigned u32x4 __attribute__((ext_vector_type(4)));
constexpr int BM = 256, BK = 64, HALF = 128, HTB = HALF * BK * 2, STAGE_BYTES = 8 * HTB, NXCD = 8, WGM = 8;

__host__ __device__ __forceinline__ int lds_byte(int r, int c) { const int st = (r >> 4) * 2 + (c >> 5), rr = r & 15, cc = c & 31, ob = rr * 64 + cc * 2; return st * 1024 + (ob ^ (((ob >> 9) & 1) << 5)); }
__host__ __device__ __forceinline__ void stage_rc(int b, int& R, int& C) { const int st = b / 1024, sb = b % 1024, swz = sb ^ (((sb >> 9) & 1) << 5); R = (st >> 1) * 16 + swz / 64; C = (st & 1) * 32 + (swz % 64) / 2; }
__host__ __device__ __forceinline__ int perm32(int rho) { const int n = rho >> 4, i = rho & 15; return 8 * (i >> 2) + 4 * n + (i & 3); }

struct Unit { int pm, pn; };
struct Gemm { const bf16_t* A; const bf16_t* Bt; int M, N, K, lda, ldb, a_split; size_t a_stride; };

struct StaticOrder {
    int nM, nN, nwg, G, c;
    __host__ __device__ void init(int M, int N, int G_, int c_) { nM = M / BM; nN = N / BM; nwg = nM * nN; G = G_; c = c_; }
    __host__ __device__ bool next(int i, Unit& u) const {
        const long L = (long)i * G + c; if (L >= nwg) return false;
        int wgid = (int)L; { const int q = nwg / NXCD, r = nwg % NXCD, xcd = wgid % NXCD, off = wgid / NXCD; wgid = (xcd < r ? xcd * (q + 1) : r * (q + 1) + (xcd - r) * q) + off; }
        const int nig = WGM * nN, gid = wgid / nig, fm = gid * WGM, gsz = (nM - fm) < WGM ? (nM - fm) : WGM;
        u.pm = fm + ((wgid % nig) % gsz); u.pn = (wgid % nig) / gsz; return true;
    }
};

__device__ __forceinline__ unsigned cvt_pk_bf16(float lo, float hi) { unsigned r; asm volatile("v_cvt_pk_bf16_f32 %0, %1, %2" : "=v"(r) : "v"(lo), "v"(hi)); return r; }


template <class Epi, class Sched, bool ALIGN_EPI = false, bool SP2 = false, int SEG = 0>
__device__ __forceinline__ void gemm_phase(PG8_LAS unsigned char* lds, const Gemm g, const Sched& S, const Epi& E, int wave_id) {
    const int tid = tid_of(wave_id), wid = wave_id, lane = tid & 63, wr = wid >> 2, wc = wid & 3, fr = lane & 15, fq = lane >> 4;
    const int K = g.K, nt = K / BK;
    unsigned voffA[2], voffB[2];
#pragma unroll
    for (int i = 0; i < 2; ++i) { int R, C; stage_rc(tid * 16 + i * 8192, R, C); const int Rb = Epi::PERM ? ((R & ~31) + perm32(R & 31)) : R;
        voffA[i] = (unsigned)(R * g.lda + C) * 2u; voffB[i] = (unsigned)(Rb * g.ldb + C) * 2u; }
    const size_t kstep = (size_t)(BK * 2);
    const size_t hstepA = (size_t)HALF * g.lda * 2, hstepB = (size_t)HALF * g.ldb * 2;
    const size_t tstepA = 2 * hstepA, tstepB = 2 * hstepB;
    const unsigned ldsw = (unsigned)wid * 1024u;
    const int aoff = lds_byte(wr * 64 + fr, fq * 8), boff = lds_byte(wc * 32 + fr, fq * 8);
#define PG8_SA(b, h) (((b) * 2 + (h)) * HTB)
#define PG8_SB(b, h) ((4 + (b) * 2 + (h)) * HTB)
#define PG8_STAGE(bufoff, gbase, voff) do { _Pragma("unroll") for (int _i = 0; _i < 2; ++_i) \
        __builtin_amdgcn_global_load_lds((const unsigned*)((const char*)(gbase) + (voff)[_i]), (PG8_LAS unsigned*)(lds + (bufoff) + ldsw + _i * 8192), 16, 0, 0); } while (0)
#define PG8_LDA(dst, b, h) do { _Pragma("unroll") for (int m = 0; m < 4; ++m) _Pragma("unroll") for (int k = 0; k < 2; ++k) dst[m][k] = *(const PG8_LAS bf16x8*)(lds + PG8_SA(b, h) + aoff + m * 2048 + k * 1024); } while (0)
#define PG8_LDB(dst, b, h) do { _Pragma("unroll") for (int n = 0; n < 2; ++n) _Pragma("unroll") for (int k = 0; k < 2; ++k) dst[n][k] = *(const PG8_LAS bf16x8*)(lds + PG8_SB(b, h) + boff + n * 2048 + k * 1024); } while (0)
#define PG8_MMA(ai, bj, At, Bt) do { __builtin_amdgcn_s_setprio(1); _Pragma("unroll") for (int m = 0; m < 4; ++m) _Pragma("unroll") for (int n = 0; n < 2; ++n) _Pragma("unroll") for (int k = 0; k < 2; ++k) \
        acc[ai][bj][m][n] = __builtin_amdgcn_mfma_f32_16x16x32_bf16(Bt[n][k], At[m][k], acc[ai][bj][m][n], 0, 0, 0); __builtin_amdgcn_s_setprio(0); } while (0)
#define PG8_WAIT_V(n) asm volatile("s_waitcnt vmcnt(" #n ")" ::: "memory")
#define PG8_WAIT_L(n) asm volatile("s_waitcnt lgkmcnt(" #n ")" ::: "memory")
#define PG8_BAR __builtin_amdgcn_s_barrier()
#define PG8_SCHED __builtin_amdgcn_sched_barrier(0)
#define PG8_ABASE(u) ((const char*)g.A + (size_t)(u).pm * tstepA + (g.a_split ? (size_t)((u).pn / g.a_split) * g.a_stride : (size_t)0))
    Unit cur, nxt; int ui = 0;
    if (!S.next(0, cur)) return;
    f32x4 acc[2][2][4][2];
#pragma unroll
    for (int a = 0; a < 2; ++a)
#pragma unroll
        for (int b = 0; b < 2; ++b)
#pragma unroll
            for (int m = 0; m < 4; ++m)
#pragma unroll
                for (int n = 0; n < 2; ++n) acc[a][b][m][n] = (f32x4){0.f, 0.f, 0.f, 0.f};
    bf16x8 At[4][2], B0[2][2], B1[2][2];
    const char* cA = PG8_ABASE(cur); const char* cB = (const char*)g.Bt + (size_t)cur.pn * tstepB;
    if constexpr (SP2) {
        PG8_STAGE(PG8_SB(0, 0), cB, voffB); PG8_STAGE(PG8_SB(0, 1), cB + hstepB, voffB); PG8_STAGE(PG8_SA(0, 0), cA, voffA); PG8_STAGE(PG8_SA(0, 1), cA + hstepA, voffA);
        if (wr == 1) PG8_BAR;
        PG8_WAIT_V(2); PG8_BAR;
        PG8_STAGE(PG8_SB(1, 0), cB + kstep, voffB); PG8_STAGE(PG8_SA(1, 0), cA + kstep, voffA); PG8_STAGE(PG8_SB(1, 1), cB + hstepB + kstep, voffB);
        PG8_WAIT_V(6); PG8_BAR;
    } else {
        PG8_STAGE(PG8_SB(0, 0), cB, voffB); PG8_STAGE(PG8_SA(0, 0), cA, voffA); PG8_STAGE(PG8_SB(0, 1), cB + hstepB, voffB); PG8_STAGE(PG8_SA(0, 1), cA + hstepA, voffA);
        if (wr == 1) PG8_BAR;
        PG8_WAIT_V(4); PG8_BAR;
        PG8_STAGE(PG8_SB(1, 0), cB + kstep, voffB); PG8_STAGE(PG8_SA(1, 0), cA + kstep, voffA); PG8_STAGE(PG8_SB(1, 1), cB + hstepB + kstep, voffB);
        PG8_WAIT_V(6); PG8_BAR;
    }
    for (;;) {
        const bool has_next = S.next(ui + 1, nxt);
        const char* nA = has_next ? PG8_ABASE(nxt) : cA; const char* nB = has_next ? (const char*)g.Bt + (size_t)nxt.pn * tstepB : cB;
#pragma unroll 1
        for (int t = 0; t < nt; t += 2) {
            const bool last = (t == nt - 2);
            const char* a1 = cA + (size_t)(t + 1) * kstep;
            const char* a2 = last ? nA : cA + (size_t)(t + 2) * kstep; const char* b2 = last ? nB : cB + (size_t)(t + 2) * kstep;
            const char* a3 = a2 + kstep; const char* b3 = b2 + kstep;
            if constexpr (SP2) {
            PG8_LDB(B0, 0, 0); PG8_LDB(B1, 0, 1); PG8_SCHED; PG8_LDA(At, 0, 0); PG8_STAGE(PG8_SA(1, 1), a1 + hstepA, voffA);
            PG8_WAIT_V(8); PG8_WAIT_L(0); PG8_BAR; PG8_MMA(0, 0, At, B0); PG8_MMA(0, 1, At, B1); PG8_BAR; PG8_SCHED;
            PG8_LDA(At, 0, 1); PG8_STAGE(PG8_SB(0, 0), b2, voffB); PG8_STAGE(PG8_SB(0, 1), b2 + hstepB, voffB); PG8_STAGE(PG8_SA(0, 0), a2, voffA);
            PG8_WAIT_V(8); PG8_WAIT_L(0); PG8_BAR; PG8_MMA(1, 0, At, B0); PG8_MMA(1, 1, At, B1); PG8_BAR; PG8_SCHED;
            PG8_LDB(B0, 1, 0); PG8_LDB(B1, 1, 1); PG8_SCHED; PG8_LDA(At, 1, 0); PG8_STAGE(PG8_SA(0, 1), a2 + hstepA, voffA);
            PG8_WAIT_V(8); PG8_WAIT_L(0); PG8_BAR; PG8_MMA(0, 0, At, B0); PG8_MMA(0, 1, At, B1); PG8_BAR; PG8_SCHED;
            PG8_LDA(At, 1, 1); PG8_STAGE(PG8_SB(1, 0), b3, voffB); PG8_STAGE(PG8_SB(1, 1), b3 + hstepB, voffB); PG8_STAGE(PG8_SA(1, 0), a3, voffA);
            PG8_WAIT_V(8); PG8_WAIT_L(0); PG8_BAR; PG8_MMA(1, 0, At, B0); PG8_MMA(1, 1, At, B1); PG8_BAR; PG8_SCHED;
            } else {
            PG8_LDB(B0, 0, 0); PG8_SCHED; PG8_LDA(At, 0, 0); PG8_STAGE(PG8_SA(1, 1), a1 + hstepA, voffA);
            PG8_WAIT_L(8); PG8_BAR; PG8_WAIT_L(0); PG8_MMA(0, 0, At, B0); PG8_BAR; PG8_SCHED;
            PG8_LDB(B1, 0, 1); PG8_STAGE(PG8_SB(0, 0), b2, voffB);
            PG8_BAR; PG8_WAIT_L(0); PG8_MMA(0, 1, At, B1); PG8_BAR;
            PG8_LDA(At, 0, 1); PG8_STAGE(PG8_SA(0, 0), a2, voffA);
            PG8_BAR; PG8_WAIT_L(0); PG8_MMA(1, 0, At, B0); PG8_BAR; PG8_SCHED;
            PG8_STAGE(PG8_SB(0, 1), b2 + hstepB, voffB);
            PG8_WAIT_V(6); PG8_BAR; PG8_MMA(1, 1, At, B1); PG8_BAR;
            PG8_LDB(B0, 1, 0); PG8_SCHED; PG8_LDA(At, 1, 0); PG8_STAGE(PG8_SA(0, 1), a2 + hstepA, voffA);
            PG8_WAIT_L(8); PG8_BAR; PG8_WAIT_L(0); PG8_MMA(0, 0, At, B0); PG8_BAR; PG8_SCHED;
            PG8_LDB(B1, 1, 1); PG8_STAGE(PG8_SB(1, 0), b3, voffB);
            PG8_BAR; PG8_WAIT_L(0); PG8_MMA(0, 1, At, B1); PG8_BAR;
            PG8_LDA(At, 1, 1); PG8_STAGE(PG8_SA(1, 0), a3, voffA);
            PG8_BAR; PG8_WAIT_L(0); PG8_MMA(1, 0, At, B0); PG8_BAR; PG8_SCHED;
            PG8_STAGE(PG8_SB(1, 1), b3 + hstepB, voffB);
            PG8_WAIT_V(6); PG8_BAR; PG8_MMA(1, 1, At, B1); PG8_BAR;
            }
            if constexpr (SEG > 0) {
                if (!last && (t + 2) % SEG == 0) {
                    E.segment(acc, (t + 2) / SEG - 1, cur, wr, wc, fr, fq);
#pragma unroll
                    for (int a = 0; a < 2; ++a)
#pragma unroll
                        for (int b = 0; b < 2; ++b)
#pragma unroll
                            for (int m = 0; m < 4; ++m)
#pragma unroll
                                for (int n = 0; n < 2; ++n) acc[a][b][m][n] = (f32x4){0.f, 0.f, 0.f, 0.f};
                }
            }
        }
        if constexpr (ALIGN_EPI) { if (wr == 0) PG8_BAR; }
        E(acc, cur, wr, wc, fr, fq);
        if (!has_next) break;
#pragma unroll
        for (int a = 0; a < 2; ++a)
#pragma unroll
            for (int b = 0; b < 2; ++b)
#pragma unroll
                for (int m = 0; m < 4; ++m)
#pragma unroll
                    for (int n = 0; n < 2; ++n) acc[a][b][m][n] = (f32x4){0.f, 0.f, 0.f, 0.f};
        cur = nxt; cA = nA; cB = nB; ++ui;
        if constexpr (ALIGN_EPI) { if (wr == 1) PG8_BAR; }
    }
    PG8_WAIT_V(0);
    if constexpr (!ALIGN_EPI) { if (wr == 0) PG8_BAR; }
    PG8_BAR;
#undef PG8_SA
#undef PG8_SB
#undef PG8_STAGE
#undef PG8_LDA
#undef PG8_LDB
#undef PG8_MMA
#undef PG8_WAIT_V
#undef PG8_WAIT_L
#undef PG8_BAR
#undef PG8_SCHED
#undef PG8_ABASE
}
}

using pg8::bf16_t; using pg8::f32x4; using pg8::u32x4; using pg8::Unit; using pg8::cvt_pk_bf16;
typedef short bf16x8 __attribute__((ext_vector_type(8)));
typedef float f32x16 __attribute__((ext_vector_type(16)));
typedef unsigned u32x2 __attribute__((ext_vector_type(2)));
#define LAS __attribute__((address_space(3)))

constexpr int DM = 1024, SEQ = 8192, NB = 2, LCTX = 256, DEPTH = 2;
constexpr int MLAT = NB * SEQ;
constexpr int MALL = MLAT + NB * LCTX;
constexpr int KEYS = LCTX + SEQ;
constexpr int NIN = 5504, NINP = 5632;
constexpr int FF = 4096;
constexpr int QW = 1152;
constexpr float EPS = 1e-6f;
constexpr float LOG2E = 1.4426950408889634f;
constexpr float QSCALE = 0.125f * LOG2E;

constexpr size_t MiB = 1u << 20;
constexpr size_t WS_CTL = 0, CTL_ZERO_BYTES = 256 * 1024;
constexpr size_t WS_MODS = 64 * 1024;
constexpr size_t WS_ROPE = 256 * 1024;
constexpr size_t WS_XC = 1 * MiB;
constexpr size_t WS_WIN = 4 * MiB;
constexpr size_t WS_WBR = WS_WIN + 11 * MiB;
constexpr size_t WS_WOUT = WS_WBR + 9 * MiB / 4;
constexpr size_t WS_W1 = WS_WOUT + 6 * MiB;
constexpr size_t WS_W2 = WS_W1 + 8 * MiB;
constexpr size_t WS_R1 = 40 * MiB;
constexpr size_t WS_KAB = WS_R1 + 33 * MiB;
constexpr size_t WS_KC = WS_KAB + (size_t)NB * KEYS * 256 * 2;
constexpr size_t WS_VTAB = WS_KC + (size_t)NB * KEYS * 384 * 2;
constexpr size_t WS_VTC = WS_VTAB + (size_t)NB * 4 * 64 * KEYS * 2;
constexpr size_t WS_PG = WS_VTC + (size_t)NB * 6 * 64 * KEYS * 2;
constexpr size_t WS_Q = WS_PG + (size_t)MALL * 3072 * 2;
constexpr size_t WS_VB = WS_Q + (size_t)MALL * QW * 2;
constexpr size_t WS_END = WS_VB + (size_t)NB * KEYS * 128 * 2;
constexpr size_t WS_Y = WS_R1;
constexpr size_t WS_A = WS_R1;
constexpr size_t WS_Y2 = WS_A + (size_t)MALL * FF * 2;
static_assert(WS_W2 + 8 * MiB <= WS_R1, "weights");
static_assert(WS_Y + (size_t)MALL * DM * 4 <= WS_PG, "Y overlay");
static_assert(WS_A + (size_t)MALL * FF * 2 <= WS_Q, "A overlay");
static_assert(WS_Y2 + (size_t)MALL * DM * 4 <= WS_END && WS_END <= 256 * MiB, "ws map");

constexpr int LDS_BYTES = 147456;

struct EpiProj {
    static constexpr bool PERM = true;
    bf16_t *Q, *KAB, *KC, *VAB, *VC, *PG; const float *rope, *qn, *kn;
    __device__ __forceinline__ void operator()(const f32x4 (&acc)[2][2][4][2], const Unit& u, int wr, int wc, int fr, int fq) const {
        const int pm = u.pm, hu = 4 * u.pn + wc;
        if (hu >= 86) return;
        const bool lat = pm < 64; int kroff;
        if (lat) { const int b = pm >> 5; kroff = 256 * b + 256; } else { const int b = pm - 64; kroff = -MLAT + SEQ * b; }
        const int row0 = pm * 256 + wr * 64 + fr;
        int pitch, col, radd = 0; bf16_t* base; bool norm = false, rot = false, scl = false; const float* gn = qn;
        if (hu >= 38) { base = PG; pitch = 3072; col = (hu - 38) * 64; }
        else if (hu < 6) { base = Q; pitch = QW; col = hu * 64; rot = true; scl = true; }
        else if (hu < 8) { base = KAB; pitch = 256; col = (hu - 6) * 64; radd = kroff; rot = true; }
        else if (hu < 10) { base = VAB; pitch = 256; col = (hu - 8) * 64; radd = kroff; }
        else if (hu < 16) { base = Q; pitch = QW; col = 384 + (hu - 10) * 64; norm = true; rot = true; scl = true; }
        else if (hu < 18) { base = KAB; pitch = 256; col = 128 + (hu - 16) * 64; radd = kroff; norm = true; rot = true; gn = kn; }
        else if (hu < 20) { base = VAB; pitch = 256; col = 128 + (hu - 18) * 64; radd = kroff; }
        else if (hu < 26) { base = Q; pitch = QW; col = 768 + (hu - 20) * 64; scl = true; }
        else if (hu < 32) { base = KC; pitch = 384; col = (hu - 26) * 64; radd = kroff; }
        else { base = VC; pitch = 384; col = (hu - 32) * 64; radd = kroff; }
        rot = rot && lat;
        bf16_t* pb = base + (size_t)(row0 + radd) * pitch + col + 8 * fq;
        f32x4 g0 = {1.f, 1.f, 1.f, 1.f}, g1 = g0, g2 = g0, g3 = g0;
        if (norm) { g0 = *(const f32x4*)(gn + 8 * fq); g1 = *(const f32x4*)(gn + 8 * fq + 4); g2 = *(const f32x4*)(gn + 32 + 8 * fq); g3 = *(const f32x4*)(gn + 32 + 8 * fq + 4); }
        const float sc = scl ? QSCALE : 1.0f;
#pragma unroll
        for (int ai = 0; ai < 2; ++ai)
#pragma unroll
            for (int m = 0; m < 4; ++m) {
                f32x4 a0 = acc[ai][0][m][0], a1 = acc[ai][0][m][1], b0 = acc[ai][1][m][0], b1 = acc[ai][1][m][1];
                if (norm) {
                    float ss = (a0[0] * a0[0] + a0[1] * a0[1]) + (a0[2] * a0[2] + a0[3] * a0[3]) + (a1[0] * a1[0] + a1[1] * a1[1]) + (a1[2] * a1[2] + a1[3] * a1[3])
                             + (b0[0] * b0[0] + b0[1] * b0[1]) + (b0[2] * b0[2] + b0[3] * b0[3]) + (b1[0] * b1[0] + b1[1] * b1[1]) + (b1[2] * b1[2] + b1[3] * b1[3]);
                    ss += __shfl_xor(ss, 16); ss += __shfl_xor(ss, 32);
                    const float rstd = rsqrtf(ss * (1.f / 64.f) + EPS);
                    a0 = a0 * rstd * g0; a1 = a1 * rstd * g1; b0 = b0 * rstd * g2; b1 = b1 * rstd * g3;
                }
                if (rot) {
                    const int sp = (row0 + ai * 128 + m * 16) & (SEQ - 1);
                    const float* tr = rope + ((sp >> 6) * 16 + 4 * fq) * 2; const float* tc = rope + ((sp & 63) * 16 + 4 * fq) * 2;
                    const f32x4 r0 = *(const f32x4*)tr, r1 = *(const f32x4*)(tr + 4), c0 = *(const f32x4*)tc, c1 = *(const f32x4*)(tc + 4);
                    a0 = (f32x4){a0[0] * r0[0] - a0[1] * r0[1], a0[0] * r0[1] + a0[1] * r0[0], a0[2] * r0[2] - a0[3] * r0[3], a0[2] * r0[3] + a0[3] * r0[2]};
                    a1 = (f32x4){a1[0] * r1[0] - a1[1] * r1[1], a1[0] * r1[1] + a1[1] * r1[0], a1[2] * r1[2] - a1[3] * r1[3], a1[2] * r1[3] + a1[3] * r1[2]};
                    b0 = (f32x4){b0[0] * c0[0] - b0[1] * c0[1], b0[0] * c0[1] + b0[1] * c0[0], b0[2] * c0[2] - b0[3] * c0[3], b0[2] * c0[3] + b0[3] * c0[2]};
                    b1 = (f32x4){b1[0] * c1[0] - b1[1] * c1[1], b1[0] * c1[1] + b1[1] * c1[0], b1[2] * c1[2] - b1[3] * c1[3], b1[2] * c1[3] + b1[3] * c1[2]};
                }
                a0 = a0 * sc; a1 = a1 * sc; b0 = b0 * sc; b1 = b1 * sc;
                u32x4 w0, w1; w0.x = cvt_pk_bf16(a0[0], a0[1]); w0.y = cvt_pk_bf16(a0[2], a0[3]); w0.z = cvt_pk_bf16(a1[0], a1[1]); w0.w = cvt_pk_bf16(a1[2], a1[3]);
                w1.x = cvt_pk_bf16(b0[0], b0[1]); w1.y = cvt_pk_bf16(b0[2], b0[3]); w1.z = cvt_pk_bf16(b1[0], b1[1]); w1.w = cvt_pk_bf16(b1[2], b1[3]);
                bf16_t* p = pb + (size_t)(ai * 128 + m * 16) * pitch;
                *(u32x4*)p = w0; *(u32x4*)(p + 32) = w1;
                if (rot && (m & 1)) asm volatile("" ::: "memory");
            }
    }
};
__device__ __forceinline__ float bf2f(unsigned h) { return __uint_as_float(h << 16); }
struct EpiGateSum {
    static constexpr bool PERM = true;
    bf16_t* PG;
    static __device__ __forceinline__ unsigned gate2(unsigned g, unsigned sprev, float a0, float a1) {
        const float g0 = bf2f(g & 0xffffu), g1 = bf2f(g >> 16);
        const float s0 = __builtin_amdgcn_rcpf(1.0f + __builtin_amdgcn_exp2f(-LOG2E * g0)), s1 = __builtin_amdgcn_rcpf(1.0f + __builtin_amdgcn_exp2f(-LOG2E * g1));
        return cvt_pk_bf16(a0 * s0 + bf2f(sprev & 0xffffu), a1 * s1 + bf2f(sprev >> 16));
    }
    __device__ __forceinline__ void segment(const f32x4 (&acc)[2][2][4][2], int br, const Unit& u, int wr, int wc, int fr, int fq) const {
        const int row0 = u.pm * 256 + wr * 64 + fr, col0 = u.pn * 256 + wc * 32 + 8 * fq;
        bf16_t* pb = PG + (size_t)row0 * 3072 + col0;
#pragma unroll
        for (int ai = 0; ai < 2; ++ai)
#pragma unroll
            for (int mp = 0; mp < 2; ++mp) {
                u32x4 gq[4], sp[4];
#pragma unroll
                for (int q = 0; q < 4; ++q) { const int m = 2 * mp + (q >> 1), bj = q & 1;
                    const u32x4* p = (const u32x4*)(pb + (size_t)(ai * 128 + m * 16) * 3072 + bj * 128);
                    gq[q] = *(const u32x4*)((const bf16_t*)p + br * 1024);
                    sp[q] = (u32x4){0u, 0u, 0u, 0u}; if (br > 0) sp[q] = *p; }
#pragma unroll
                for (int q = 0; q < 4; ++q) { const int m = 2 * mp + (q >> 1), bj = q & 1;
                    u32x4* p = (u32x4*)(pb + (size_t)(ai * 128 + m * 16) * 3072 + bj * 128);
                    const f32x4 v0 = acc[ai][bj][m][0], v1 = acc[ai][bj][m][1];
                    u32x4 w; w.x = gate2(gq[q].x, sp[q].x, v0[0], v0[1]); w.y = gate2(gq[q].y, sp[q].y, v0[2], v0[3]); w.z = gate2(gq[q].z, sp[q].z, v1[0], v1[1]); w.w = gate2(gq[q].w, sp[q].w, v1[2], v1[3]);
                    *p = w; }
                asm volatile("" ::: "memory");
            }
    }
    __device__ __forceinline__ void operator()(const f32x4 (&acc)[2][2][4][2], const Unit& u, int wr, int wc, int fr, int fq) const { segment(acc, 2, u, wr, wc, fr, fq); }
};
template <int ACT  > struct EpiBf16 {
    static constexpr bool PERM = true;
    bf16_t* O; int ldc;
    __device__ __forceinline__ void operator()(const f32x4 (&acc)[2][2][4][2], const Unit& u, int wr, int wc, int fr, int fq) const {
        const int row0 = u.pm * 256 + wr * 64 + fr, col0 = u.pn * 256 + wc * 32 + 8 * fq;
#pragma unroll
        for (int ai = 0; ai < 2; ++ai)
#pragma unroll
            for (int m = 0; m < 4; ++m)
#pragma unroll
                for (int bj = 0; bj < 2; ++bj) {
                    f32x4 v0 = acc[ai][bj][m][0], v1 = acc[ai][bj][m][1];
                    if (ACT == 1) {
#pragma unroll
                        for (int e = 0; e < 4; ++e) { const float a = fmaxf(v0[e], 0.f), c = fmaxf(v1[e], 0.f); v0[e] = a * a; v1[e] = c * c; }
                    }
                    u32x4 w; w.x = cvt_pk_bf16(v0[0], v0[1]); w.y = cvt_pk_bf16(v0[2], v0[3]); w.z = cvt_pk_bf16(v1[0], v1[1]); w.w = cvt_pk_bf16(v1[2], v1[3]);
                    *(u32x4*)(O + (size_t)(row0 + ai * 128 + m * 16) * ldc + col0 + bj * 128) = w;
                }
    }
};
struct EpiF32 {
    static constexpr bool PERM = true;
    float* O; int ldc;
    __device__ __forceinline__ void operator()(const f32x4 (&acc)[2][2][4][2], const Unit& u, int wr, int wc, int fr, int fq) const {
        const int row0 = u.pm * 256 + wr * 64 + fr, col0 = u.pn * 256 + wc * 32 + 8 * fq;
#pragma unroll
        for (int ai = 0; ai < 2; ++ai)
#pragma unroll
            for (int m = 0; m < 4; ++m)
#pragma unroll
                for (int bj = 0; bj < 2; ++bj) {
                    float* p = O + (size_t)(row0 + ai * 128 + m * 16) * ldc + col0 + bj * 128;
                    *(f32x4*)p = acc[ai][bj][m][0]; *(f32x4*)(p + 4) = acc[ai][bj][m][1];
                }
    }
};

__device__ __forceinline__ float wave_sum(float v) {
#pragma unroll
    for (int o = 1; o < 64; o <<= 1) v += __shfl_xor(v, o);
    return v;
}
__device__ __forceinline__ unsigned f2bf(float f) { unsigned u = __builtin_bit_cast(unsigned, f); return (u + 0x7fffu + ((u >> 16) & 1u)) >> 16; }
__device__ __forceinline__ unsigned pk2(float lo, float hi) { return f2bf(lo) | (f2bf(hi) << 16); }

__device__ __forceinline__ void transpose_item(const float* W, int K, int N, bf16_t* WT, int ldk, int row_off, int copies, int copy_stride, LAS float* scr, int item, int lane, bool headperm = false) {
    const int nblk = N / 32, kb = item / nblk, nb = item % nblk, k0 = 64 * kb, n0 = 32 * nb;
    const int r0 = headperm ? 256 * (nb >> 3) + 128 * (nb & 1) + 32 * ((nb & 7) >> 1) : n0;
#pragma unroll 8
    for (int i = 0; i < 32; ++i) { const int kk = 2 * i + (lane >> 5); scr[kk * 33 + (lane & 31)] = W[(size_t)(k0 + kk) * N + n0 + (lane & 31)]; }
    asm volatile("s_waitcnt lgkmcnt(0)" ::: "memory");
    const int c = lane & 7;
#pragma unroll
    for (int j = 0; j < 4; ++j) { const int n = (lane >> 3) + 8 * j; const LAS float* s = scr + (8 * c) * 33 + n;
        u32x4 o; o.x = pk2(s[0 * 33], s[1 * 33]); o.y = pk2(s[2 * 33], s[3 * 33]); o.z = pk2(s[4 * 33], s[5 * 33]); o.w = pk2(s[6 * 33], s[7 * 33]);
        for (int cc = 0; cc < copies; ++cc) *(u32x4*)(WT + (size_t)(row_off + r0 + n) * ldk + cc * copy_stride + k0 + 8 * c) = o; }
    asm volatile("s_waitcnt lgkmcnt(0)" ::: "memory");
}

struct Args { const float* in[21]; float* out; unsigned char* ws; int pad0, pad1; };
typedef const __attribute__((address_space(4))) Args* KAP;
#define KARGS() ({ KAP p_ = (KAP)__builtin_amdgcn_kernarg_segment_ptr(); asm volatile("" : "+s"(p_)); p_; })

__device__ __forceinline__ void conv_weights(KAP ap, int l, LAS unsigned char* lds, int gw, int NGW, int wave, int lane) {
    unsigned char* ws = ap->ws;
    LAS float* scr = (LAS float*)(lds + wave * 16384);
    constexpr int I_IN = 16 * (NIN / 32), I_BR = 6 * 32, I_OUT = 16 * 32, I_1 = 16 * (FF / 32), I_2 = (FF / 64) * 32;
    constexpr int NITEMS = I_IN + 3 * I_BR + I_OUT + I_1 + I_2;
    for (int it = gw; it < NITEMS; it += NGW) {
        int r = it;
        if (r < I_IN) { transpose_item(ap->in[8] + (size_t)l * DM * NIN, DM, NIN, (bf16_t*)(ws + WS_WIN), DM, 0, 1, 0, scr, r, lane, true); continue; } r -= I_IN;
        if (r < I_BR) { transpose_item(ap->in[13] + (size_t)l * 384 * DM, 384, DM, (bf16_t*)(ws + WS_WBR), 1152, 0, 1, 0, scr, r, lane); continue; } r -= I_BR;
        if (r < I_BR) { transpose_item(ap->in[14] + (size_t)l * 384 * DM, 384, DM, (bf16_t*)(ws + WS_WBR) + 384, 1152, 0, 1, 0, scr, r, lane); continue; } r -= I_BR;
        if (r < I_BR) { transpose_item(ap->in[15] + (size_t)l * 384 * DM, 384, DM, (bf16_t*)(ws + WS_WBR) + 768, 1152, 0, 1, 0, scr, r, lane); continue; } r -= I_BR;
        if (r < I_OUT) { transpose_item(ap->in[16] + (size_t)l * DM * DM, DM, DM, (bf16_t*)(ws + WS_WOUT), DM, 0, 1, 0, scr, r, lane); continue; } r -= I_OUT;
        if (r < I_1) { transpose_item(ap->in[19] + (size_t)l * DM * FF, DM, FF, (bf16_t*)(ws + WS_W1), DM, 0, 1, 0, scr, r, lane); continue; } r -= I_1;
        transpose_item(ap->in[20] + (size_t)l * FF * DM, FF, DM, (bf16_t*)(ws + WS_W2), FF, 0, 1, 0, scr, r, lane);
    }
    unsigned z0 = 0u; asm volatile("" : "+v"(z0));
    for (int i = gw * 64 + lane; i < (NINP - NIN) * DM * 2 / 16; i += NGW * 64) {
        const int prow = i / (DM * 2 / 16), pc = i % (DM * 2 / 16);
        const int row = 21 * 256 + (prow >> 6) * 128 + 64 + (prow & 63);
        *((u32x4*)(ws + WS_WIN + (size_t)row * DM * 2) + pc) = (u32x4){z0, z0, z0, z0};
    }
}

__device__ __forceinline__ void ada_phase(KAP ap, int gw, int NGW, int lane) {
    float* mods = (float*)(ap->ws + WS_MODS);
    const float* c = ap->in[1]; const float* cc = ap->in[3];
    for (int t = gw; t < DEPTH * 16 * 24; t += NGW) {
        const int l = t / (16 * 24), kc = (t / 24) % 16, jc = t % 24, col = jc * 256 + lane * 4;
        const float* W = ap->in[4] + ((size_t)l * DM + kc * 64) * 6144 + col;
        f32x4 s0 = {0.f, 0.f, 0.f, 0.f}, s1 = s0, s2 = s0;
        for (int k = 0; k < 64; ++k) {
            const f32x4 w = *(const f32x4*)(W + (size_t)k * 6144);
            const float x0 = c[kc * 64 + k], x1 = c[DM + kc * 64 + k], x2 = cc[kc * 64 + k];
            const float a0 = x0 / (1.f + __expf(-x0)), a1 = x1 / (1.f + __expf(-x1)), a2 = x2 / (1.f + __expf(-x2));
            s0 += w * a0; s1 += w * a1; s2 += w * a2;
        }
        if (kc == 0) { const f32x4 bb = *(const f32x4*)(ap->in[5] + (size_t)l * 6144 + col); s0 += bb; s1 += bb; s2 += bb; }
        float* m0 = mods + (size_t)(l * 3) * 6144 + col;
#pragma unroll
        for (int e = 0; e < 4; ++e) { atomicAdd(m0 + e, s0[e]); atomicAdd(m0 + 6144 + e, s1[e]); atomicAdd(m0 + 2 * 6144 + e, s2[e]); }
    }
}

__device__ __forceinline__ void row_phase(int gw, int NGW, int lane, int nrows, const bf16_t* Y, const float* gainY, const float* modsG, int gate_off,
                                          const float* rin_lat, const float* rin_ctx, float* rout_lat, float* rout_ctx,
                                          bf16_t* H, const float* gainH, const float* modsH, int shift_off, int scale_off) {
    for (int m = 2 * gw; m < nrows; m += 2 * NGW) {
        const int v = m < MLAT ? (m >> 13) : 2;
        const size_t roff = m < MLAT ? (size_t)m * DM : (size_t)(m - MLAT) * DM;
        const f32x4* xr = (const f32x4*)((m < MLAT ? rin_lat : rin_ctx) + roff) + lane;
        f32x4 x[2][4];
#pragma unroll
        for (int u = 0; u < 2; ++u)
#pragma unroll
            for (int j = 0; j < 4; ++j) x[u][j] = xr[256 * u + 64 * j];
        if (Y) {
            const u32x2* yr = (const u32x2*)(Y + (size_t)m * DM) + lane;
            u32x2 yw[2][4];
#pragma unroll
            for (int u = 0; u < 2; ++u)
#pragma unroll
                for (int j = 0; j < 4; ++j) yw[u][j] = yr[256 * u + 64 * j];
            const f32x4* gy = (const f32x4*)gainY + lane; const f32x4* gt = (const f32x4*)(modsG + (size_t)v * 6144 + gate_off) + lane;
            f32x4* ro = (f32x4*)((m < MLAT ? rout_lat : rout_ctx) + roff) + lane;
#pragma unroll
            for (int u = 0; u < 2; ++u) {
                f32x4 y[4]; float ss = 0.f;
#pragma unroll
                for (int j = 0; j < 4; ++j) { y[j] = (f32x4){bf2f(yw[u][j].x & 0xffffu), bf2f(yw[u][j].x >> 16), bf2f(yw[u][j].y & 0xffffu), bf2f(yw[u][j].y >> 16)}; ss += (y[j].x * y[j].x + y[j].y * y[j].y) + (y[j].z * y[j].z + y[j].w * y[j].w); }
                const float rstd = rsqrtf(wave_sum(ss) * (1.f / DM) + EPS);
#pragma unroll
                for (int j = 0; j < 4; ++j) { x[u][j] = x[u][j] + gt[64 * j] * (y[j] * rstd * gy[64 * j]); ro[256 * u + 64 * j] = x[u][j]; }
            }
        }
        if (H) {
            const f32x4* gh = (const f32x4*)gainH + lane; const f32x4* sh = (const f32x4*)(modsH + (size_t)v * 6144 + shift_off) + lane; const f32x4* sc = (const f32x4*)(modsH + (size_t)v * 6144 + scale_off) + lane;
            u32x2* ho = (u32x2*)(H + (size_t)m * DM) + lane;
#pragma unroll
            for (int u = 0; u < 2; ++u) {
                float ss = 0.f;
#pragma unroll
                for (int j = 0; j < 4; ++j) ss += (x[u][j].x * x[u][j].x + x[u][j].y * x[u][j].y) + (x[u][j].z * x[u][j].z + x[u][j].w * x[u][j].w);
                const float rstd = rsqrtf(wave_sum(ss) * (1.f / DM) + EPS);
#pragma unroll
                for (int j = 0; j < 4; ++j) { const f32x4 h = (x[u][j] * rstd * gh[64 * j]) * (sc[64 * j] + 1.0f) + sh[64 * j]; u32x2 w; w.x = pk2(h.x, h.y); w.y = pk2(h.z, h.w); ho[256 * u + 64 * j] = w; }
            }
        }
    }
}

#include <hip/hip_bf16.h>
#include <cmath>
namespace attn_body {
using bf16=__hip_bfloat16;
using bf16x8=__attribute__((ext_vector_type(8)))short;
using s16x4=__attribute__((ext_vector_type(4)))short;
using f32x16=__attribute__((ext_vector_type(16)))float;
using u32x4=__attribute__((ext_vector_type(4)))unsigned;
constexpr int D=64,QP=1152;
constexpr int BIAS_OFF=90112;
struct UnitCtx { int toff; int qpos0; int gr; int rs; int qc; unsigned vm; float sink2; };
constexpr int NW=8,QBLK=32,QB=QBLK*NW,KVBLK=64;
__device__ __forceinline__ int crow(int r,int hi){return (r&3)+8*(r>>2)+4*hi;}
#define SBAR() __builtin_amdgcn_sched_barrier(0)
constexpr int NSLOT=3, SLOTB=8192;
constexpr int LDS_K=0, LDS_V=NSLOT*SLOTB, LDS_WS=2*NSLOT*SLOTB, LDS_OST=LDS_WS+NW*64*4, LDS_BYTES=LDS_OST+NW*4096;
constexpr float C2=0.125f*1.4426950408889634f;
__device__ __forceinline__ void glds16(const void*gsrc,unsigned lds_dst){unsigned keep;
  asm volatile("s_mov_b32 %0, m0\n\ts_mov_b32 m0, %2\n\ts_nop 0\n\tglobal_load_lds_dwordx4 %1, off\n\ts_mov_b32 m0, %0":"=&s"(keep):"v"(gsrc),"s"(lds_dst):"memory");}
__device__ __forceinline__ float max3f(float a,float b,float c){float r;asm("v_max3_f32 %0, %1, %2, %3":"=v"(r):"v"(a),"v"(b),"v"(c));return r;}
__device__ __forceinline__ float max2f(float a,float b){float r;asm("v_max_f32_e32 %0, %1, %2":"=v"(r):"v"(a),"v"(b));return r;}
__device__ __forceinline__ float fadd_s(float a,float b){float r;asm("v_add_f32_e32 %0, %1, %2":"=v"(r):"v"(a),"v"(b));return r;}
__device__ __forceinline__ float fsub_s(float a,float b){float r;asm("v_sub_f32_e32 %0, %1, %2":"=v"(r):"v"(a),"v"(b));return r;}
typedef float f32x2_t __attribute__((ext_vector_type(2))); typedef __bf16 bf16x2_t __attribute__((ext_vector_type(2)));
__device__ __forceinline__ unsigned cvtpk_s(float lo,float hi){f32x2_t v={lo,hi};bf16x2_t b=__builtin_convertvector(v,bf16x2_t);return __builtin_bit_cast(unsigned,b);}
#define WAIT_BAR(N) asm volatile("s_waitcnt vmcnt(" #N ") lgkmcnt(0)\n\ts_barrier":::"memory")

__device__ __forceinline__ void qkt(f32x16&p0,f32x16&p1,const char*Kslot,const bf16x8*qr,int r32,int hi){ const f32x16 negm={};
  const char*kb=Kslot+hi*1024+r32*16;
  #pragma unroll
  for(int d0=0;d0<4;++d0){
    const bf16x8 b0=*reinterpret_cast<const bf16x8*>(kb+d0*2048);
    const bf16x8 b1=*reinterpret_cast<const bf16x8*>(kb+d0*2048+512);
    if(d0==0){p0=__builtin_amdgcn_mfma_f32_32x32x16_bf16(b0,qr[0],negm,0,0,0);p1=__builtin_amdgcn_mfma_f32_32x32x16_bf16(b1,qr[0],negm,0,0,0);}
    else{p0=__builtin_amdgcn_mfma_f32_32x32x16_bf16(b0,qr[d0],p0,0,0,0);p1=__builtin_amdgcn_mfma_f32_32x32x16_bf16(b1,qr[d0],p1,0,0,0);}}
}
typedef __attribute__((address_space(3))) const char* lds_cptr;
typedef short v4i16_t __attribute__((ext_vector_type(4)));
__device__ __forceinline__ void kload8(bf16x8*kf,lds_cptr kp){
  kf[0]=*(const __attribute__((address_space(3))) bf16x8*)(kp);      kf[1]=*(const __attribute__((address_space(3))) bf16x8*)(kp+512);
  kf[2]=*(const __attribute__((address_space(3))) bf16x8*)(kp+2048); kf[3]=*(const __attribute__((address_space(3))) bf16x8*)(kp+2560);
  kf[4]=*(const __attribute__((address_space(3))) bf16x8*)(kp+4096); kf[5]=*(const __attribute__((address_space(3))) bf16x8*)(kp+4608);
  kf[6]=*(const __attribute__((address_space(3))) bf16x8*)(kp+6144); kf[7]=*(const __attribute__((address_space(3))) bf16x8*)(kp+6656);
}
__device__ __forceinline__ void kload2(bf16x8*kf,lds_cptr kp,int j){ kf[2*j]=*(const __attribute__((address_space(3))) bf16x8*)(kp+j*2048); kf[2*j+1]=*(const __attribute__((address_space(3))) bf16x8*)(kp+j*2048+512); }
__device__ __forceinline__ s16x4 vtr(lds_cptr p){ return __builtin_bit_cast(s16x4,__builtin_amdgcn_ds_read_tr16_b64_v4i16((__attribute__((address_space(3))) v4i16_t*)p)); }
template<int MODE> __device__ __forceinline__ void amask(f32x16&c0,f32x16&c1,int t,const UnitCtx&uc,int hi,lds_cptr shm3){
  if(t<4)return;
  const float NEG=-INFINITY;
  if(MODE==1){ const int dq=64*(uc.toff+t-4)+4*hi-uc.qpos0;
    #pragma unroll
    for(int r=0;r<16;++r){ const int d=dq+(r&3)+8*(r>>2); if(d>128||d<-128)c0[r]=NEG; if(d+32>128||d+32<-128)c1[r]=NEG; } }
  else { const int kr=uc.toff+t-4;
    if(kr<uc.rs||kr>=uc.rs+8){
      #pragma unroll
      for(int r=0;r<16;++r){c0[r]=NEG;c1[r]=NEG;} }
    else { const __attribute__((address_space(3))) float*brow=(const __attribute__((address_space(3))) float*)(shm3+BIAS_OFF)+(kr-uc.gr+7)*31+15-uc.qc;
      unsigned vm=uc.vm; asm volatile("":"+v"(vm));
      #pragma unroll
      for(int r=0;r<16;++r){ const int kc=(r&3)+8*(r>>2)+4*hi; const float b0=brow[kc],b1=brow[kc+32];
        c0[r]=((vm>>r)&1u)?c0[r]+b0:NEG; c1[r]=((vm>>(16+r))&1u)?c1[r]+b1:NEG;
        if((r&3)==3)__builtin_amdgcn_sched_barrier(0); } } }
}
__device__ __forceinline__ float rowmax(const f32x16&p0,const f32x16&p1){
  float a=max3f(p0[0],p0[1],p1[0]),b=max3f(p0[2],p0[3],p1[1]);a=max3f(a,p1[2],p1[3]);
  #pragma unroll
  for(int r=4;r<16;r+=4){a=max3f(a,p0[r],p0[r+1]);b=max3f(b,p0[r+2],p0[r+3]);a=max3f(a,p1[r],p1[r+1]);b=max3f(b,p1[r+2],p1[r+3]);}
  const float m=max2f(a,b);
  auto rr=__builtin_amdgcn_permlane32_swap(__float_as_uint(m),__float_as_uint(m),false,false);
  return max2f(__uint_as_float(rr[0]),__uint_as_float(rr[1]));
}
__device__ __forceinline__ void pv(f32x16*o,int vb,bf16x8 pa0,bf16x8 pa1,bf16x8 pa2,bf16x8 pa3){
  #pragma unroll
  for(int d0=0;d0<2;++d0){s16x4 lo[4],hi[4];
    #pragma unroll
    for(int ks=0;ks<4;++ks){
      asm volatile("ds_read_b64_tr_b16 %0,%1 offset:%c2":"=&v"(lo[ks]):"v"(vb),"i"(d0*4096+ks*1024):"memory");
      asm volatile("ds_read_b64_tr_b16 %0,%1 offset:%c2":"=&v"(hi[ks]):"v"(vb),"i"(d0*4096+ks*1024+512):"memory");}
    asm volatile("s_waitcnt lgkmcnt(0)":::"memory");SBAR();
    #define PK(k) (bf16x8){lo[k][0],lo[k][1],lo[k][2],lo[k][3],hi[k][0],hi[k][1],hi[k][2],hi[k][3]}
    o[d0]=__builtin_amdgcn_mfma_f32_32x32x16_bf16(pa0,PK(0),o[d0],0,0,0);
    o[d0]=__builtin_amdgcn_mfma_f32_32x32x16_bf16(pa1,PK(1),o[d0],0,0,0);
    o[d0]=__builtin_amdgcn_mfma_f32_32x32x16_bf16(pa2,PK(2),o[d0],0,0,0);
    o[d0]=__builtin_amdgcn_mfma_f32_32x32x16_bf16(pa3,PK(3),o[d0],0,0,0);
    #undef PK
  }
}

#ifndef ATTN_STORE16
#define ATTN_STORE16(p,v) (*(u32x4*)(p)=(v))
#endif
template<int KP,int VP,int MODE,int THRL> __device__ __forceinline__ void attn_unit(const bf16*Qb,const bf16*__restrict__ Kh,const bf16*__restrict__ Vh,bf16*Ob,int NT,const UnitCtx uc,char*shm,int wave_id){
  const int tid=tid_of(wave_id),lane=tid&63,r32=lane&31,hi=lane>>5; const int wid=wave_id;
  const bf16*Qw=Qb+(long)(wid*QBLK)*QP;
  const unsigned lds0=(unsigned)(uintptr_t)shm;
  float*wsf=(float*)(shm+LDS_WS)+wid*64;
  const bf16*ksrc=Kh+(long)lane*KP+wid*8;
  const bf16*vsrc=Vh+(long)(16*(wid&3)+(lane>>2))*VP+(wid>>2)*32+(lane&3)*8;
  const unsigned kdst=lds0+LDS_K+wid*1024, vdst=lds0+LDS_V+wid*1024;
  #define KT(t) ((t)<4?(t):(t)+uc.toff)
  #define DMA_K(t,slot) glds16(ksrc+(long)KT(t)*KVBLK*KP,(unsigned)__builtin_amdgcn_readfirstlane(kdst+(slot)))
  #define DMA_V(t,slot) glds16(vsrc+(long)KT(t)*KVBLK*VP,(unsigned)__builtin_amdgcn_readfirstlane(vdst+(slot)))
  const int vb0=(int)(lds0+LDS_V)+((lane>>4)&1)*32+(lane&3)*8+(4*hi+((lane&15)>>2))*64;
  const char*Kbase=shm+LDS_K; bf16x8 kf[8];
  const lds_cptr shm3=(lds_cptr)shm; const lds_cptr kp0=shm3+LDS_K+hi*1024+r32*16; const lds_cptr vp0=shm3+LDS_V+((lane>>4)&1)*32+(lane&3)*8+(4*hi+((lane&15)>>2))*64;
  DMA_K(0,0);DMA_V(0,0);DMA_K(1,SLOTB);
  bf16x8 qr[4];
  #pragma unroll
  for(int d0=0;d0<4;++d0)qr[d0]=*reinterpret_cast<const bf16x8*>(&Qw[(long)r32*QP+d0*16+hi*8]);
  float mhat=0.f,l_reg=0.f;f32x16 o[2];o[0]=f32x16{};o[1]=f32x16{};
  #define CMASK(P0,P1,t) do{ if(MODE!=0) amask<MODE>(P0,P1,(t),uc,hi,(lds_cptr)shm); }while(0)
  bool resc=false;
  #define START(P0,P1) do{ const float rm=rowmax(P0,P1); resc=false; \
    { const float dl=rm; mhat=fadd_s(mhat,dl); \
      _Pragma("unroll") for(int r=0;r<16;++r){P0[r]=fsub_s(P0[r],dl);P1[r]=fsub_s(P1[r],dl);} } \
    _Pragma("unroll") for(int r=0;r<16;++r)P0[r]=__builtin_amdgcn_exp2f(P0[r]); }while(0)
  #define RESC() do{ if(resc){ asm volatile("s_waitcnt lgkmcnt(0)":::"memory"); \
      _Pragma("unroll") for(int d_=0;d_<2;++d_) _Pragma("unroll") for(int r=0;r<16;++r)o[d_][r]*=wsf[crow(r,hi)]; } }while(0)
  f32x16 pA0,pA1,pB0,pB1;
  int sl_prev=0,sl_cur=0,sl_next=SLOTB;
  #define ROT() do{sl_prev=sl_cur;sl_cur=sl_next;sl_next=(sl_next==(NSLOT-1)*SLOTB)?0:sl_next+SLOTB;}while(0)
  DMA_K(2,2*SLOTB);
  WAIT_BAR(3);
  qkt(pA0,pA1,Kbase,qr,r32,hi);asm volatile("s_nop 15\n\ts_nop 7":"+v"(pA0),"+v"(pA1));CMASK(pA0,pA1,0);
  START(pA0,pA1);
  if(uc.sink2>-1e30f){ l_reg=(hi==0)?__builtin_amdgcn_exp2f(uc.sink2-mhat):0.f; }
  _Pragma("unroll") for(int r=0;r<16;++r)pA1[r]=__builtin_amdgcn_exp2f(pA1[r]);
  WAIT_BAR(0);
  DMA_K(3,0);DMA_V(1,SLOTB);
  ROT();
  kload8(kf,kp0+sl_cur);
  WAIT_BAR(2);
  s16x4 vlo[8],vhi[8]; u32x4 pw0,pw1,pw2,pw3;
  #define PKW(P,B) cvtpk_s(P[B],P[B+1])
  #define PAF(k) __builtin_bit_cast(bf16x8,pw##k)
  #define VFR(i) (bf16x8){vlo[i][0],vlo[i][1],vlo[i][2],vlo[i][3],vhi[i][0],vhi[i][1],vhi[i][2],vhi[i][3]}
  #define PIN(x) asm volatile("":"+v"(x))
  #define MX3(a,b,c) __builtin_fmaxf(__builtin_fmaxf((a),(b)),(c))
  #define GAPA(MF,A0,A1,A2,A3,W0,W1,PW) do{ MF; sacc+=A0; sacc+=A1; sacc+=A2; sacc+=A3; PIN(sacc); W0; W1; PIN(PW); SBAR(); }while(0)
  #define EX(v) __builtin_amdgcn_exp2f(v)
  #define GAPB(MF,X,B) do{ MF; X[B]=EX(X[B]); X[B+1]=EX(X[B+1]); X[B+2]=EX(X[B+2]); X[B+3]=EX(X[B+3]); PIN(X); SBAR(); }while(0)
  #define VRD(i) do{ vlo[i]=vtr(vp_+(((i)>>2)*4096+((i)&3)*1024)); vhi[i]=vtr(vp_+(((i)>>2)*4096+((i)&3)*1024+512)); }while(0)
  #define KRD(G,j) do{ if(G){ kload2(kf,kp0+sl_next,j); SBAR(); } }while(0)
  #define STEP(C0,C1,P0,P1,t,GK,GV,GL) do{ SBAR(); \
    const lds_cptr vp_=vp0+sl_prev; \
    VRD(0); SBAR(); float sacc=(P0[0]+P0[1]); \
    GAPA(C0=__builtin_amdgcn_mfma_f32_32x32x16_bf16(kf[0],qr[0],(f32x16){},0,0,0), P0[2],P0[3],P0[4],P0[5],     pw0[0]=PKW(P0,0), pw0[1]=PKW(P0,2), pw0); \
    VRD(4); SBAR(); GAPA(C1=__builtin_amdgcn_mfma_f32_32x32x16_bf16(kf[1],qr[0],(f32x16){},0,0,0), P0[6],P0[7],P0[8],P0[9],     pw0[2]=PKW(P0,4), pw0[3]=PKW(P0,6), pw0); \
    VRD(1); SBAR(); GAPA(C0=__builtin_amdgcn_mfma_f32_32x32x16_bf16(kf[2],qr[1],C0,0,0,0),   P0[10],P0[11],P0[12],P0[13], pw1[0]=PKW(P0,8), pw1[1]=PKW(P0,10), pw1); \
    VRD(5); SBAR(); GAPA(C1=__builtin_amdgcn_mfma_f32_32x32x16_bf16(kf[3],qr[1],C1,0,0,0),   P0[14],P0[15],P1[0],P1[1],   pw1[2]=PKW(P0,12),pw1[3]=PKW(P0,14), pw1); \
    VRD(2); SBAR(); GAPA(C0=__builtin_amdgcn_mfma_f32_32x32x16_bf16(kf[4],qr[2],C0,0,0,0),   P1[2],P1[3],P1[4],P1[5],     pw2[0]=PKW(P1,0), pw2[1]=PKW(P1,2), pw2); \
    VRD(6); SBAR(); GAPA(C1=__builtin_amdgcn_mfma_f32_32x32x16_bf16(kf[5],qr[2],C1,0,0,0),   P1[6],P1[7],P1[8],P1[9],     pw2[2]=PKW(P1,4), pw2[3]=PKW(P1,6), pw2); \
    VRD(3); SBAR(); GAPA(C0=__builtin_amdgcn_mfma_f32_32x32x16_bf16(kf[6],qr[3],C0,0,0,0),   P1[10],P1[11],P1[12],P1[13], pw3[0]=PKW(P1,8), pw3[1]=PKW(P1,10), pw3); \
    VRD(7); SBAR(); GAPA(C1=__builtin_amdgcn_mfma_f32_32x32x16_bf16(kf[7],qr[3],C1,0,0,0),   P1[14],P1[15],0.f,0.f,       pw3[2]=PKW(P1,12),pw3[3]=PKW(P1,14), pw3); \
    l_reg+=sacc; \
    { _Pragma("unroll") for(int r=0;r<16;++r){C0[r]-=mhat;C1[r]-=mhat;} } \
    if(GK){DMA_K((t)+3,sl_cur);} if(GV){DMA_V((t)+1,sl_next);} \
    CMASK(C0,C1,t); \
    { float a=MX3(C0[0],C0[1],C1[0]),b=MX3(C0[2],C0[3],C1[1]); a=MX3(a,C1[2],C1[3]); \
      _Pragma("unroll") for(int r=4;r<16;r+=4){a=MX3(a,C0[r],C0[r+1]);b=MX3(b,C0[r+2],C0[r+3]);a=MX3(a,C1[r],C1[r+1]);b=MX3(b,C1[r+2],C1[r+3]);} \
      float rm=__builtin_fmaxf(a,b); { auto rr=__builtin_amdgcn_permlane32_swap(__float_as_uint(rm),__float_as_uint(rm),false,false); rm=__builtin_fmaxf(__uint_as_float(rr[0]),__uint_as_float(rr[1])); } \
      resc=false; \
      if(__builtin_expect(__any(rm>(float)THRL),0)){ const float dl=__builtin_fmaxf(rm,0.f); mhat+=dl; \
        _Pragma("unroll") for(int r=0;r<16;++r){C0[r]-=dl;C1[r]-=dl;} \
        const float f=__builtin_amdgcn_exp2f(-dl); l_reg*=f; if(hi==0)wsf[r32]=f; resc=true; } } \
    SBAR(); \
    GAPB(o[0]=__builtin_amdgcn_mfma_f32_32x32x16_bf16(PAF(0),VFR(0),o[0],0,0,0), C0,0); \
    GAPB(o[1]=__builtin_amdgcn_mfma_f32_32x32x16_bf16(PAF(0),VFR(4),o[1],0,0,0), C0,4); \
    KRD(GL,0); GAPB(o[0]=__builtin_amdgcn_mfma_f32_32x32x16_bf16(PAF(1),VFR(1),o[0],0,0,0), C0,8); \
    KRD(GL,1); GAPB(o[1]=__builtin_amdgcn_mfma_f32_32x32x16_bf16(PAF(1),VFR(5),o[1],0,0,0), C0,12); \
    KRD(GL,2); GAPB(o[0]=__builtin_amdgcn_mfma_f32_32x32x16_bf16(PAF(2),VFR(2),o[0],0,0,0), C1,0); \
    KRD(GL,3); GAPB(o[1]=__builtin_amdgcn_mfma_f32_32x32x16_bf16(PAF(2),VFR(6),o[1],0,0,0), C1,4); \
    GAPB(o[0]=__builtin_amdgcn_mfma_f32_32x32x16_bf16(PAF(3),VFR(3),o[0],0,0,0), C1,8); \
    GAPB(o[1]=__builtin_amdgcn_mfma_f32_32x32x16_bf16(PAF(3),VFR(7),o[1],0,0,0), C1,12); \
    }while(0)
  int t=1;
  for(;t+5<NT;t+=2){
    STEP(pB0,pB1,pA0,pA1,t,true,true,true);     WAIT_BAR(2); RESC(); ROT();
    STEP(pA0,pA1,pB0,pB1,t+1,true,true,true);   WAIT_BAR(2); RESC(); ROT();
  }
  #define ENDW(tt) do{ if((tt)+3<NT){WAIT_BAR(2);} else if((tt)+2<NT){WAIT_BAR(1);} else {WAIT_BAR(0);} }while(0)
  for(;t+1<NT;t+=2){
    STEP(pB0,pB1,pA0,pA1,t,(t+3<NT),(t+1<NT),(t+1<NT));       ENDW(t);   RESC(); ROT();
    STEP(pA0,pA1,pB0,pB1,t+1,(t+4<NT),(t+2<NT),(t+2<NT));     ENDW(t+1); RESC(); ROT();
  }
  STEP(pB0,pB1,pA0,pA1,NT-1,false,false,false); RESC();
  { float sacc=pB0[0]+pB0[1]; _Pragma("unroll") for(int r=2;r<16;++r)sacc+=pB0[r]; _Pragma("unroll") for(int r=0;r<16;++r)sacc+=pB1[r]; l_reg+=sacc;
    pw0=(u32x4){PKW(pB0,0),PKW(pB0,2),PKW(pB0,4),PKW(pB0,6)};pw1=(u32x4){PKW(pB0,8),PKW(pB0,10),PKW(pB0,12),PKW(pB0,14)};pw2=(u32x4){PKW(pB1,0),PKW(pB1,2),PKW(pB1,4),PKW(pB1,6)};pw3=(u32x4){PKW(pB1,8),PKW(pB1,10),PKW(pB1,12),PKW(pB1,14)};
    SBAR(); pv(o,vb0+sl_cur,PAF(0),PAF(1),PAF(2),PAF(3)); }
  #undef PKW
  #undef PAF
  #undef VFR
  #undef PIN
  #undef MX3
  #undef GAPA
  #undef GAPB
  #undef EX
  #undef VRD
  #undef KRD
  #undef STEP
  #undef ENDW
  {auto rr=__builtin_amdgcn_permlane32_swap(__float_as_uint(l_reg),__float_as_uint(l_reg),false,false);l_reg=__uint_as_float(rr[0])+__uint_as_float(rr[1]);}
  if(hi==0)wsf[32+r32]=l_reg;asm volatile("s_waitcnt lgkmcnt(0)":::"memory");
  float rli[16];
  #pragma unroll
  for(int r=0;r<16;++r)rli[r]=__builtin_amdgcn_rcpf(wsf[32+crow(r,hi)]);
  bf16*Ow=Ob+(long)(wid*QBLK)*QP;
  { bf16*stg=(bf16*)(shm+LDS_OST)+wid*2048;
    #pragma unroll
    for(int r=0;r<16;++r){const int orow=crow(r,hi);
      #pragma unroll
      for(int d0=0;d0<2;++d0)stg[orow*64+d0*32+r32]=__float2bfloat16(o[d0][r]*rli[r]);}
    asm volatile("s_waitcnt lgkmcnt(0)":::"memory");
    #pragma unroll
    for(int i=0;i<4;++i){const int row=i*8+(lane>>3),ch=lane&7; const u32x4 v=*(const u32x4*)(stg+row*64+ch*8); ATTN_STORE16(Ow+(long)row*QP+ch*8,v);} }
  asm volatile("s_waitcnt lgkmcnt(0)\n\ts_barrier":::"memory");
  #undef DMA_K
  #undef DMA_V
  #undef CMASK
  #undef KT
  #undef START
  #undef RESC
  #undef ROT
}
constexpr int ATTN_LDS_BYTES=LDS_BYTES;
#undef SBAR
#undef WAIT_BAR
}
__device__ __forceinline__ void attn_dispatch(KAP ap, int l, int uid, int wid, char* shm) {
    using namespace attn_body;
    unsigned char* ws = ap->ws;
    const int r32 = lane_id() & 31;
    const bf16* Qa = (const bf16*)(ws + WS_Q);
    UnitCtx uc; uc.toff = 0; uc.qpos0 = 0; uc.gr = 0; uc.rs = 0; uc.qc = 0; uc.vm = 0u; uc.sink2 = -INFINITY;
    if (uid < 384) {
        const int qb = uid & 31, bh = uid >> 5, b = bh / 6, h = bh % 6;
        const bf16* Qb = Qa + (size_t)(b * SEQ + qb * 256) * QW + (6 + h) * 64;
        const size_t ko = (size_t)b * KEYS * 256 + 128 + (h / 3) * 64;
        attn_unit<256, 256, 0, 8>(Qb, (const bf16*)(ws + WS_KAB) + ko, (const bf16*)(ws + WS_VTAB) + ko, (bf16*)Qb, KEYS / 64, uc, shm, wid);
    } else if (uid < 768) {
        const int u = uid - 384, qb = u & 31, bh = u >> 5, b = bh / 6, h = bh % 6;
        const bf16* Qb = Qa + (size_t)(b * SEQ + qb * 256) * QW + (12 + h) * 64;
        const size_t ko = (size_t)b * KEYS * 384 + h * 64;
        int klo = 4 * qb - 4; klo = klo < 0 ? 0 : (klo > 120 ? 120 : klo);
        int khi = 4 * qb + 3 - 4; khi = (khi < 0 ? 0 : (khi > 120 ? 120 : khi)) + 7;
        const int cnt = khi - klo + 1;
        uc.toff = klo; uc.gr = 4 * qb + (wid >> 1); uc.rs = uc.gr - 4 < 0 ? 0 : (uc.gr - 4 > 120 ? 120 : uc.gr - 4);
        uc.qc = 32 * (wid & 1) + r32;
        { const int wsn = uc.qc - 8 < 0 ? 0 : (uc.qc - 8 > 48 ? 48 : uc.qc - 8), hi = (lane_id() >> 5) & 1; unsigned vm = 0u;
#pragma unroll
          for (int r = 0; r < 16; ++r) { const int kc = (r & 3) + 8 * (r >> 2) + 4 * hi; if (kc >= wsn && kc < wsn + 16) vm |= 1u << r; if (kc + 32 >= wsn && kc + 32 < wsn + 16) vm |= 1u << (16 + r); }
          uc.vm = vm; }
        { const float* rpb = ap->in[12] + (size_t)(l * 6 + h) * 465; float* bl = (float*)(shm + BIAS_OFF); const int tb = tid_of(wid); if (tb < 465) bl[tb] = rpb[tb] * LOG2E; }
        attn_unit<384, 384, 2, 8>(Qb, (const bf16*)(ws + WS_KC) + ko, (const bf16*)(ws + WS_VTC) + ko, (bf16*)Qb, 4 + cnt + (cnt & 1), uc, shm, wid);
    } else if (uid < 1152) {
        const int u = uid - 768, qb = u & 31, bh = u >> 5, b = bh / 6, h = bh % 6;
        const bf16* Qb = Qa + (size_t)(b * SEQ + qb * 256) * QW + h * 64;
        const size_t ko = (size_t)b * KEYS * 256 + (h / 3) * 64;
        const int tlo = 4 * qb - 2 < 0 ? 0 : 4 * qb - 2, thi = 4 * qb + 5 > 127 ? 127 : 4 * qb + 5;
        uc.toff = tlo; uc.qpos0 = 256 * qb + 32 * wid + r32; uc.sink2 = ap->in[9][l * 6 + h] * LOG2E;
        attn_unit<256, 256, 1, 8>(Qb, (const bf16*)(ws + WS_KAB) + ko, (const bf16*)(ws + WS_VTAB) + ko, (bf16*)Qb, 4 + thi - tlo + 1, uc, shm, wid);
    } else {
        const int v = uid - 1152, type = v / 12, b = (v / 6) % 2, h = v % 6;
        const bf16* Qb = Qa + (size_t)(MLAT + b * LCTX) * QW + (type * 6 + h) * 64;
        if (type == 2) {
            const size_t ko = (size_t)b * KEYS * 384 + h * 64;
            attn_unit<384, 384, 0, 8>(Qb, (const bf16*)(ws + WS_KC) + ko, (const bf16*)(ws + WS_VTC) + ko, (bf16*)Qb, 4, uc, shm, wid);
        } else {
            const size_t ko = (size_t)b * KEYS * 256 + type * 128 + (h / 3) * 64;
            if (type == 0) uc.sink2 = ap->in[9][l * 6 + h] * LOG2E;
            attn_unit<256, 256, 0, 8>(Qb, (const bf16*)(ws + WS_KAB) + ko, (const bf16*)(ws + WS_VTAB) + ko, (bf16*)Qb, 4, uc, shm, wid);
        }
    }
}

#define XB_TMO      128
#define XB_XCNT(j)  (256  + 64 * (j))
#define XB_XSUB(j)  (1280 + 64 * (j))
#define XB_XGEN(j)  (2304 + 64 * (j))
#define XB_TOP      3328
#define XB_TOPGEN   3392
#define XCD_BAR_WORDS 3456
#define XB_SPIN_CAP (1u << 18)

__device__ __forceinline__ unsigned xb_ld(unsigned* p)              { return __hip_atomic_load(p, __ATOMIC_RELAXED, __HIP_MEMORY_SCOPE_AGENT); }
__device__ __forceinline__ unsigned xb_add(unsigned* p, unsigned v) { return __hip_atomic_fetch_add(p, v, __ATOMIC_RELAXED, __HIP_MEMORY_SCOPE_AGENT); }
__device__ __forceinline__ unsigned xb_xcc_id() { return (unsigned)__builtin_amdgcn_s_getreg((3 << 11) | 20) & 0xFu; }
#define XB_SPIN(cond, bar) do { unsigned _sp = 0; while (cond) { __builtin_amdgcn_s_sleep(1); \
    if ((++_sp & 255u) == 0u) { if (xb_ld(&(bar)[XB_TMO])) break; if (_sp > XB_SPIN_CAP) { atomicAdd(&(bar)[XB_TMO], 1u); break; } } } } while (0)

struct XcdBarrier {
    unsigned* bar; unsigned x;
    volatile __attribute__((address_space(3))) unsigned* st;
};

__device__ __forceinline__ XcdBarrier xcd_barrier_post(unsigned* bar, volatile __attribute__((address_space(3))) unsigned* st, bool leader) {
    XcdBarrier b; b.bar = bar; b.x = xb_xcc_id(); b.st = st;
    if (leader) (void)xb_add(&bar[XB_XCNT(b.x)], 1u);
    return b;
}
__device__ __forceinline__ void xcd_barrier_complete(unsigned* bar, unsigned x, unsigned& nloc, unsigned& nx) {
    const unsigned G = gridDim.x * gridDim.y * gridDim.z;
    unsigned sum, cnt, mine, sp = 0u;
    for (;;) {
        sum = 0u; cnt = 0u; mine = 0u;
#pragma unroll
        for (unsigned j = 0; j < 16; ++j) { const unsigned c = xb_ld(&bar[XB_XCNT(j)]); sum += c; cnt += (c > 0u) ? 1u : 0u; mine = (j == x) ? c : mine; }
        if (sum == G) break;
        __builtin_amdgcn_s_sleep(1);
        if ((++sp & 255u) == 0u) { if (xb_ld(&bar[XB_TMO])) break; if (sp > XB_SPIN_CAP) { atomicAdd(&bar[XB_TMO], 1u); break; } }
    }
    nloc = mine > 0u ? mine : 1u; nx = cnt > 0u ? cnt : 1u;
}

__device__ __forceinline__ void xcd_barrier(const XcdBarrier& b, bool leader) {
    asm volatile("s_waitcnt vmcnt(0)" ::: "memory");
    __syncthreads();
    if (leader) {
        unsigned* bar = b.bar;
        __builtin_amdgcn_s_waitcnt(0);
        unsigned nloc = b.st[0], nx = b.st[1];
        if (nloc == 0u) { xcd_barrier_complete(bar, b.x, nloc, nx); b.st[0] = nloc; b.st[1] = nx; }
        const unsigned old = xb_add(&bar[XB_XSUB(b.x)], 1u);
        const unsigned gen = old / nloc;
        if (old + 1u == (gen + 1u) * nloc) {
            __builtin_amdgcn_fence(__ATOMIC_RELEASE, "agent");
            asm volatile("s_waitcnt vmcnt(0)" ::: "memory");
            const unsigned og = xb_add(&bar[XB_TOP], 1u);
            const unsigned tg = og / nx;
            if (og + 1u == (tg + 1u) * nx) xb_add(&bar[XB_TOPGEN], 1u);
            else XB_SPIN(xb_ld(&bar[XB_TOPGEN]) == tg, bar);
            __builtin_amdgcn_fence(__ATOMIC_ACQUIRE, "agent");
            xb_add(&bar[XB_XGEN(b.x)], 1u);
            asm volatile("s_waitcnt vmcnt(0)" ::: "memory");
        } else {
            XB_SPIN(xb_ld(&bar[XB_XGEN(b.x)]) == gen, bar);
            __builtin_amdgcn_fence(__ATOMIC_ACQUIRE, "agent");
            asm volatile("s_waitcnt vmcnt(0)" ::: "memory");
        }
    }
    __syncthreads();
}
__global__ void __launch_bounds__(512, 2) fwd_mega(Args a) {
    extern __shared__ __attribute__((aligned(16))) unsigned char lds_raw[];
    cg::grid_group grid = cg::this_grid();
    PG8_LAS unsigned char* lds = (PG8_LAS unsigned char*)lds_raw;
    const int wave = __builtin_amdgcn_readfirstlane((int)threadIdx.x >> 6);
    const int tid = tid_of(wave);
    const int G = gridDim.x, gw = blockIdx.x * 8 + wave, NGW = G * 8;
#define LANE() ({ int l_ = lane_id(); asm volatile("" : "+v"(l_)); l_; })
#define LEADER() (wave == 0 && lane_id() == 0)
#define WSP() ((unsigned char*)KARGS()->ws)
#define MODS() ((float*)(WSP() + WS_MODS))
#define CTL() ((unsigned*)(WSP() + WS_CTL))
    volatile LAS unsigned* MISC = (volatile LAS unsigned*)((LAS unsigned char*)lds_raw + 131072);
    if (tid < 64) MISC[tid] = 0u;
    __syncthreads();
    { const XcdBarrier xb0 = xcd_barrier_post(CTL() + 4096, MISC + 8, LEADER()); (void)xb0; }
#if PROBE_MASK
    if (blockIdx.x == 0 && tid == 0) { const unsigned long long now = __builtin_amdgcn_s_memrealtime(); MISC[18] = (unsigned)now; MISC[19] = (unsigned)(now >> 32); }
#define TSTAMP(id) do { if (blockIdx.x == 0 && LEADER()) { const unsigned long long now_ = __builtin_amdgcn_s_memrealtime(); const unsigned long long st_ = ((unsigned long long)MISC[19] << 32) | MISC[18]; \
        if ((PROBE_MASK >> (id)) & 1) { const unsigned long long ac_ = (((unsigned long long)MISC[17] << 32) | MISC[16]) + (now_ - st_); MISC[16] = (unsigned)ac_; MISC[17] = (unsigned)(ac_ >> 32); } \
        MISC[18] = (unsigned)now_; MISC[19] = (unsigned)(now_ >> 32); } } while (0)
#else
#define TSTAMP(id) do {} while (0)
#endif
#define GRID_BAR() do { XcdBarrier xb_; xb_.bar = CTL() + 4096; xb_.x = xb_xcc_id(); xb_.st = MISC + 8; xcd_barrier(xb_, LEADER()); } while (0)

    conv_weights(KARGS(), 0, (LAS unsigned char*)lds_raw, gw, NGW, wave, LANE());
    ada_phase(KARGS(), gw, NGW, LANE());
    if (blockIdx.x == 0) {
        float* rope = (float*)(WSP() + WS_ROPE);
        for (int i = tid; i < 128 * 16; i += 512) { const int pos = i >> 4, f = i & 15; const float fr = powf(10000.0f, -(float)f / 16.0f); const float ang = (float)pos * fr; float s, c; sincosf(ang, &s, &c); rope[2 * i] = c; rope[2 * i + 1] = s; }
    }
    grid.sync(); TSTAMP(0);
    { KAP ap = KARGS();
      row_phase(gw, NGW, LANE(), MALL, nullptr, nullptr, nullptr, 0, ap->in[0], ap->in[2], nullptr, nullptr,
              (bf16_t*)(WSP() + WS_R1), ap->in[6], MODS(), 0, 1024); }
    GRID_BAR(); TSTAMP(1);

    {
        constexpr int l = 0;
        const bool last = (l == DEPTH - 1);
        const int MX = last ? MLAT : MALL;
        int bidl = blockIdx.x, Gl = gridDim.x; asm volatile("" : "+s"(bidl), "+s"(Gl));
#define MODL() (MODS() + (size_t)l * 3 * 6144)
        {
            pg8::Gemm g{(const bf16_t*)(WSP() + WS_R1), (const bf16_t*)(WSP() + WS_WIN), MALL, NINP, DM, DM, DM, 0, 0};
            pg8::StaticOrder S; S.init(MALL, NINP, Gl, bidl);
            KAP ap = KARGS();
            EpiProj E{(bf16_t*)(WSP() + WS_Q), (bf16_t*)(WSP() + WS_KAB), (bf16_t*)(WSP() + WS_KC), (bf16_t*)(WSP() + WS_VTAB), (bf16_t*)(WSP() + WS_VTC), (bf16_t*)(WSP() + WS_PG),
                      (const float*)(WSP() + WS_ROPE), ap->in[10] + l * 64, ap->in[11] + l * 64};
            pg8::gemm_phase<EpiProj, pg8::StaticOrder, true, true>(lds, g, S, E, wave);
        }
        GRID_BAR(); TSTAMP(2);
        {
            KAP ap = KARGS();
            const int nunit = 1152 + (last ? 0 : 36);
            unsigned* ctr = CTL() + 64 * l;
            for (;;) {
                if (LEADER()) MISC[24] = atomicAdd(ctr, 1u);
                __syncthreads();
                const int uid = (int)MISC[24];
                __syncthreads();
                if (uid >= nunit) break;
                attn_dispatch(ap, l, uid, wave, (char*)lds_raw);
            }
        }
        GRID_BAR(); TSTAMP(4);
        {
            pg8::Gemm g{(const bf16_t*)(WSP() + WS_Q), (const bf16_t*)(WSP() + WS_WBR), MX, DM, QW, QW, QW, 0, 0};
            pg8::StaticOrder S; S.init(MX, DM, Gl, bidl);
            EpiGateSum E{(bf16_t*)(WSP() + WS_PG)};
            pg8::gemm_phase<EpiGateSum, pg8::StaticOrder, true, true, 6>(lds, g, S, E, wave);
        }
        GRID_BAR(); TSTAMP(5);
        {
            pg8::Gemm g{(const bf16_t*)(WSP() + WS_PG), (const bf16_t*)(WSP() + WS_WOUT), MX, DM, DM, 3072, DM, 0, 0};
            pg8::StaticOrder S; S.init(MX, DM, Gl, bidl);
            EpiBf16<0> E{(bf16_t*)(WSP() + WS_Y), DM};
            pg8::gemm_phase<EpiBf16<0>, pg8::StaticOrder, true, true>(lds, g, S, E, wave);
        }
        GRID_BAR(); TSTAMP(6);
        { KAP ap = KARGS();
          row_phase(gw, NGW, LANE(), MX, (const bf16_t*)(WSP() + WS_Y), ap->in[7] + l * DM, MODL(), 2048,
                  l == 0 ? ap->in[0] : ap->out, l == 0 ? ap->in[2] : (const float*)(WSP() + WS_XC), ap->out, (float*)(WSP() + WS_XC),
                  (bf16_t*)(WSP() + WS_Q), ap->in[17] + l * DM, MODL(), 3072, 4096); }
        GRID_BAR(); TSTAMP(7);
        {
            pg8::Gemm g{(const bf16_t*)(WSP() + WS_Q), (const bf16_t*)(WSP() + WS_W1), MX, FF, DM, DM, DM, 0, 0};
            pg8::StaticOrder S; S.init(MX, FF, Gl, bidl);
            EpiBf16<1> E{(bf16_t*)(WSP() + WS_A), FF};
            pg8::gemm_phase<EpiBf16<1>, pg8::StaticOrder, true, true>(lds, g, S, E, wave);
        }
        GRID_BAR(); TSTAMP(8);
        {
            pg8::Gemm g{(const bf16_t*)(WSP() + WS_A), (const bf16_t*)(WSP() + WS_W2), MX, DM, FF, FF, FF, 0, 0};
            pg8::StaticOrder S; S.init(MX, DM, Gl, bidl);
            EpiBf16<0> E{(bf16_t*)(WSP() + WS_Y2), DM};
            pg8::gemm_phase<EpiBf16<0>, pg8::StaticOrder, true, true>(lds, g, S, E, wave);
        }
        GRID_BAR(); TSTAMP(9);
        if (!last) {
            { KAP ap = KARGS();
              row_phase(gw, NGW, LANE(), MX, (const bf16_t*)(WSP() + WS_Y2), ap->in[18] + l * DM, MODL(), 5120,
                      ap->out, (const float*)(WSP() + WS_XC), ap->out, (float*)(WSP() + WS_XC),
                      (bf16_t*)(WSP() + WS_R1), ap->in[6] + (l + 1) * DM, MODL() + 3 * 6144, 0, 1024); }
            conv_weights(KARGS(), l + 1, (LAS unsigned char*)lds_raw, gw, NGW, wave, LANE());
            GRID_BAR(); TSTAMP(10);
        } else {
            { KAP ap = KARGS();
              row_phase(gw, NGW, LANE(), MX, (const bf16_t*)(WSP() + WS_Y2), ap->in[18] + l * DM, MODL(), 5120,
                      ap->out, (const float*)(WSP() + WS_XC), ap->out, (float*)(WSP() + WS_XC),
                      nullptr, nullptr, nullptr, 0, 0); }
            TSTAMP(10);
        }
    }
    {
        constexpr int l = 1;
        const bool last = (l == DEPTH - 1);
        const int MX = last ? MLAT : MALL;
        int bidl = blockIdx.x, Gl = gridDim.x; asm volatile("" : "+s"(bidl), "+s"(Gl));
#define MODL() (MODS() + (size_t)l * 3 * 6144)
        {
            pg8::Gemm g{(const bf16_t*)(WSP() + WS_R1), (const bf16_t*)(WSP() + WS_WIN), MALL, NINP, DM, DM, DM, 0, 0};
            pg8::StaticOrder S; S.init(MALL, NINP, Gl, bidl);
            KAP ap = KARGS();
            EpiProj E{(bf16_t*)(WSP() + WS_Q), (bf16_t*)(WSP() + WS_KAB), (bf16_t*)(WSP() + WS_KC), (bf16_t*)(WSP() + WS_VTAB), (bf16_t*)(WSP() + WS_VTC), (bf16_t*)(WSP() + WS_PG),
                      (const float*)(WSP() + WS_ROPE), ap->in[10] + l * 64, ap->in[11] + l * 64};
            pg8::gemm_phase<EpiProj, pg8::StaticOrder, true, true>(lds, g, S, E, wave);
        }
        GRID_BAR(); TSTAMP(2);
        {
            KAP ap = KARGS();
            const int nunit = 1152 + (last ? 0 : 36);
            unsigned* ctr = CTL() + 64 * l;
            for (;;) {
                if (LEADER()) MISC[24] = atomicAdd(ctr, 1u);
                __syncthreads();
                const int uid = (int)MISC[24];
                __syncthreads();
                if (uid >= nunit) break;
                attn_dispatch(ap, l, uid, wave, (char*)lds_raw);
            }
        }
        GRID_BAR(); TSTAMP(4);
        {
            pg8::Gemm g{(const bf16_t*)(WSP() + WS_Q), (const bf16_t*)(WSP() + WS_WBR), MX, DM, QW, QW, QW, 0, 0};
            pg8::StaticOrder S; S.init(MX, DM, Gl, bidl);
            EpiGateSum E{(bf16_t*)(WSP() + WS_PG)};
            pg8::gemm_phase<EpiGateSum, pg8::StaticOrder, true, true, 6>(lds, g, S, E, wave);
        }
        GRID_BAR(); TSTAMP(5);
        {
            pg8::Gemm g{(const bf16_t*)(WSP() + WS_PG), (const bf16_t*)(WSP() + WS_WOUT), MX, DM, DM, 3072, DM, 0, 0};
            pg8::StaticOrder S; S.init(MX, DM, Gl, bidl);
            EpiBf16<0> E{(bf16_t*)(WSP() + WS_Y), DM};
            pg8::gemm_phase<EpiBf16<0>, pg8::StaticOrder, true, true>(lds, g, S, E, wave);
        }
        GRID_BAR(); TSTAMP(6);
        { KAP ap = KARGS();
          row_phase(gw, NGW, LANE(), MX, (const bf16_t*)(WSP() + WS_Y), ap->in[7] + l * DM, MODL(), 2048,
                  l == 0 ? ap->in[0] : ap->out, l == 0 ? ap->in[2] : (const float*)(WSP() + WS_XC), ap->out, (float*)(WSP() + WS_XC),
                  (bf16_t*)(WSP() + WS_Q), ap->in[17] + l * DM, MODL(), 3072, 4096); }
        GRID_BAR(); TSTAMP(7);
        {
            pg8::Gemm g{(const bf16_t*)(WSP() + WS_Q), (const bf16_t*)(WSP() + WS_W1), MX, FF, DM, DM, DM, 0, 0};
            pg8::StaticOrder S; S.init(MX, FF, Gl, bidl);
            EpiBf16<1> E{(bf16_t*)(WSP() + WS_A), FF};
            pg8::gemm_phase<EpiBf16<1>, pg8::StaticOrder, true, true>(lds, g, S, E, wave);
        }
        GRID_BAR(); TSTAMP(8);
        {
            pg8::Gemm g{(const bf16_t*)(WSP() + WS_A), (const bf16_t*)(WSP() + WS_W2), MX, DM, FF, FF, FF, 0, 0};
            pg8::StaticOrder S; S.init(MX, DM, Gl, bidl);
            EpiBf16<0> E{(bf16_t*)(WSP() + WS_Y2), DM};
            pg8::gemm_phase<EpiBf16<0>, pg8::StaticOrder, true, true>(lds, g, S, E, wave);
        }
        GRID_BAR(); TSTAMP(9);
        if (!last) {
            { KAP ap = KARGS();
              row_phase(gw, NGW, LANE(), MX, (const bf16_t*)(WSP() + WS_Y2), ap->in[18] + l * DM, MODL(), 5120,
                      ap->out, (const float*)(WSP() + WS_XC), ap->out, (float*)(WSP() + WS_XC),
                      (bf16_t*)(WSP() + WS_R1), ap->in[6] + (l + 1) * DM, MODL() + 3 * 6144, 0, 1024); }
            conv_weights(KARGS(), l + 1, (LAS unsigned char*)lds_raw, gw, NGW, wave, LANE());
            GRID_BAR(); TSTAMP(10);
        } else {
            { KAP ap = KARGS();
              row_phase(gw, NGW, LANE(), MX, (const bf16_t*)(WSP() + WS_Y2), ap->in[18] + l * DM, MODL(), 5120,
                      ap->out, (const float*)(WSP() + WS_XC), ap->out, (float*)(WSP() + WS_XC),
                      nullptr, nullptr, nullptr, 0, 0); }
            TSTAMP(10);
        }
    }
#if PROBE_MASK
    if (blockIdx.x == 0 && LEADER()) {
        const unsigned long long t0 = __builtin_amdgcn_s_memrealtime(); const unsigned long long ac = ((unsigned long long)MISC[17] << 32) | MISC[16];
        while (__builtin_amdgcn_s_memrealtime() - t0 < 4ull * ac) __builtin_amdgcn_s_sleep(32);
    }
#endif
}

extern "C" void kernel_launch(void* const* d_in, const int* in_sizes, int n_in, void* d_out, int out_size, void* d_ws, size_t ws_size, hipStream_t stream) {
    static int grid = 0;
    if (grid == 0) {
        if (n_in != 21 || out_size != MLAT * DM || ws_size < WS_END) { fprintf(stderr, "kernel_launch: unexpected shapes (n_in %d, out %d, ws %zu need %zu)\n", n_in, out_size, ws_size, (size_t)WS_END); grid = -1; return; }
        int dev = 0, cus = 0, per_cu = 0;
        if (hipGetDevice(&dev) != hipSuccess || hipDeviceGetAttribute(&cus, hipDeviceAttributeMultiprocessorCount, dev) != hipSuccess) { grid = -1; return; }
        if (hipFuncSetAttribute((const void*)fwd_mega, hipFuncAttributeMaxDynamicSharedMemorySize, LDS_BYTES) != hipSuccess) { fprintf(stderr, "kernel_launch: hipFuncSetAttribute failed\n"); grid = -1; return; }
        if (hipOccupancyMaxActiveBlocksPerMultiprocessor(&per_cu, (const void*)fwd_mega, 512, LDS_BYTES) != hipSuccess || per_cu < 1) { fprintf(stderr, "kernel_launch: occupancy query says %d blocks per CU\n", per_cu); grid = -1; return; }
        grid = cus;
    }
    if (grid < 0) return;
    (void)hipMemsetAsync((char*)d_ws + WS_CTL, 0, CTL_ZERO_BYTES, stream);
    Args a{};
    for (int i = 0; i < 21; ++i) a.in[i] = (const float*)d_in[i];
    a.out = (float*)d_out; a.ws = (unsigned char*)d_ws;
    void* args[] = {&a};
    hipError_t e = hipLaunchCooperativeKernel((const void*)fwd_mega, dim3(grid), dim3(512), args, LDS_BYTES, stream);
    if (e != hipSuccess) fprintf(stderr, "cooperative launch failed: %s (grid %d)\n", hipGetErrorString(e), grid);
}
```

```cpp
#include <hip/hip_runtime.h>
#include <hip/hip_cooperative_groups.h>
#include <cstdio>
#include <cstdint>
namespace cg = cooperative_groups;
#ifndef PROBE_MASK
#define PROBE_MASK 0
#endif

__device__ __forceinline__ int lane_id() { int l; asm volatile("v_mbcnt_lo_u32_b32 %0, -1, 0\n\tv_mbcnt_hi_u32_b32 %0, -1, %0" : "=v"(l)); return l; }
__device__ __forceinline__ int tid_of(int wave) { int t = wave * 64 + lane_id(); asm volatile("" : "+v"(t)); return t; }
namespace pg8 {
#define PG8_LAS __attribute__((address_space(3)))
typedef unsigned short bf16_t;
typedef short bf16x8 __attribute__((ext_vector_type(8)));
typedef float f32x4 __attribute__((ext_vector_type(4)));
typedef unsigned u32x4 __attribute__((ext_vector_type(4)));
constexpr int BM = 256, BK = 64, HALF = 128, HTB = HALF * BK * 2, STAGE_BYTES = 8 * HTB, NXCD = 8, WGM = 8;

__host__ __device__ __forceinline__ int lds_byte(int r, int c) { const int st = (r >> 4) * 2 + (c >> 5), rr = r & 15, cc = c & 31, ob = rr * 64 + cc * 2; return st * 1024 + (ob ^ (((ob >> 9) & 1) << 5)); }
__host__ __device__ __forceinline__ void stage_rc(int b, int& R, int& C) { const int st = b / 1024, sb = b % 1024, swz = sb ^ (((sb >> 9) & 1) << 5); R = (st >> 1) * 16 + swz / 64; C = (st & 1) * 32 + (swz % 64) / 2; }
__host__ __device__ __forceinline__ int perm32(int rho) { const int n = rho >> 4, i = rho & 15; return 8 * (i >> 2) + 4 * n + (i & 3); }

struct Unit { int pm, pn; };
struct Gemm { const bf16_t* A; const bf16_t* Bt; int M, N, K, lda, ldb, a_split; size_t a_stride; };

struct StaticOrder {
    int nM, nN, nwg, G, c;
    __host__ __device__ void init(int M, int N, int G_, int c_) { nM = M / BM; nN = N / BM; nwg = nM * nN; G = G_; c = c_; }
    __host__ __device__ bool next(int i, Unit& u) const {
        const long L = (long)i * G + c; if (L >= nwg) return false;
        int wgid = (int)L; { const int q = nwg / NXCD, r = nwg % NXCD, xcd = wgid % NXCD, off = wgid / NXCD; wgid = (xcd < r ? xcd * (q + 1) : r * (q + 1) + (xcd - r) * q) + off; }
        const int nig = WGM * nN, gid = wgid / nig, fm = gid * WGM, gsz = (nM - fm) < WGM ? (nM - fm) : WGM;
        u.pm = fm + ((wgid % nig) % gsz); u.pn = (wgid % nig) / gsz; return true;
    }
};

__device__ __forceinline__ unsigned cvt_pk_bf16(float lo, float hi) { unsigned r; asm volatile("v_cvt_pk_bf16_f32 %0, %1, %2" : "=v"(r) : "v"(lo), "v"(hi)); return r; }


template <class Epi, class Sched, bool ALIGN_EPI = false, bool SP2 = false, int SEG = 0>
__device__ __forceinline__ void gemm_phase(PG8_LAS unsigned char* lds, const Gemm g, const Sched& S, const Epi& E, int wave_id) {
    const int tid = tid_of(wave_id), wid = wave_id, lane = tid & 63, wr = wid >> 2, wc = wid & 3, fr = lane & 15, fq = lane >> 4;
    const int K = g.K, nt = K / BK;
    unsigned voffA[2], voffB[2];
#pragma unroll
    for (int i = 0; i < 2; ++i) { int R, C; stage_rc(tid * 16 + i * 8192, R, C); const int Rb = Epi::PERM ? ((R & ~31) + perm32(R & 31)) : R;
        voffA[i] = (unsigned)(R * g.lda + C) * 2u; voffB[i] = (unsigned)(Rb * g.ldb + C) * 2u; }
    const size_t kstep = (size_t)(BK * 2);
    const size_t hstepA = (size_t)HALF * g.lda * 2, hstepB = (size_t)HALF * g.ldb * 2;
    const size_t tstepA = 2 * hstepA, tstepB = 2 * hstepB;
    const unsigned ldsw = (unsigned)wid * 1024u;
    const int aoff = lds_byte(wr * 64 + fr, fq * 8), boff = lds_byte(wc * 32 + fr, fq * 8);
#define PG8_SA(b, h) (((b) * 2 + (h)) * HTB)
#define PG8_SB(b, h) ((4 + (b) * 2 + (h)) * HTB)
#define PG8_STAGE(bufoff, gbase, voff) do { _Pragma("unroll") for (int _i = 0; _i < 2; ++_i) \
        __builtin_amdgcn_global_load_lds((const unsigned*)((const char*)(gbase) + (voff)[_i]), (PG8_LAS unsigned*)(lds + (bufoff) + ldsw + _i * 8192), 16, 0, 0); } while (0)
#define PG8_LDA(dst, b, h) do { _Pragma("unroll") for (int m = 0; m < 4; ++m) _Pragma("unroll") for (int k = 0; k < 2; ++k) dst[m][k] = *(const PG8_LAS bf16x8*)(lds + PG8_SA(b, h) + aoff + m * 2048 + k * 1024); } while (0)
#define PG8_LDB(dst, b, h) do { _Pragma("unroll") for (int n = 0; n < 2; ++n) _Pragma("unroll") for (int k = 0; k < 2; ++k) dst[n][k] = *(const PG8_LAS bf16x8*)(lds + PG8_SB(b, h) + boff + n * 2048 + k * 1024); } while (0)
#define PG8_MMA(ai, bj, At, Bt) do { __builtin_amdgcn_s_setprio(1); _Pragma("unroll") for (int m = 0; m < 4; ++m) _Pragma("unroll") for (int n = 0; n < 2; ++n) _Pragma("unroll") for (int k = 0; k < 2; ++k) \
        acc[ai][bj][m][n] = __builtin_amdgcn_mfma_f32_16x16x32_bf16(Bt[n][k], At[m][k], acc[ai][bj][m][n], 0, 0, 0); __builtin_amdgcn_s_setprio(0); } while (0)
#define PG8_WAIT_V(n) asm volatile("s_waitcnt vmcnt(" #n ")" ::: "memory")
#define PG8_WAIT_L(n) asm volatile("s_waitcnt lgkmcnt(" #n ")" ::: "memory")
#define PG8_BAR __builtin_amdgcn_s_barrier()
#define PG8_SCHED __builtin_amdgcn_sched_barrier(0)
#define PG8_ABASE(u) ((const char*)g.A + (size_t)(u).pm * tstepA + (g.a_split ? (size_t)((u).pn / g.a_split) * g.a_stride : (size_t)0))
    Unit cur, nxt; int ui = 0;
    if (!S.next(0, cur)) return;
    f32x4 acc[2][2][4][2];
#pragma unroll
    for (int a = 0; a < 2; ++a)
#pragma unroll
        for (int b = 0; b < 2; ++b)
#pragma unroll
            for (int m = 0; m < 4; ++m)
#pragma unroll
                for (int n = 0; n < 2; ++n) acc[a][b][m][n] = (f32x4){0.f, 0.f, 0.f, 0.f};
    bf16x8 At[4][2], B0[2][2], B1[2][2];
    const char* cA = PG8_ABASE(cur); const char* cB = (const char*)g.Bt + (size_t)cur.pn * tstepB;
    if constexpr (SP2) {
        PG8_STAGE(PG8_SB(0, 0), cB, voffB); PG8_STAGE(PG8_SB(0, 1), cB + hstepB, voffB); PG8_STAGE(PG8_SA(0, 0), cA, voffA); PG8_STAGE(PG8_SA(0, 1), cA + hstepA, voffA);
        if (wr == 1) PG8_BAR;
        PG8_WAIT_V(2); PG8_BAR;
        PG8_STAGE(PG8_SB(1, 0), cB + kstep, voffB); PG8_STAGE(PG8_SA(1, 0), cA + kstep, voffA); PG8_STAGE(PG8_SB(1, 1), cB + hstepB + kstep, voffB);
        PG8_WAIT_V(6); PG8_BAR;
    } else {
        PG8_STAGE(PG8_SB(0, 0), cB, voffB); PG8_STAGE(PG8_SA(0, 0), cA, voffA); PG8_STAGE(PG8_SB(0, 1), cB + hstepB, voffB); PG8_STAGE(PG8_SA(0, 1), cA + hstepA, voffA);
        if (wr == 1) PG8_BAR;
        PG8_WAIT_V(4); PG8_BAR;
        PG8_STAGE(PG8_SB(1, 0), cB + kstep, voffB); PG8_STAGE(PG8_SA(1, 0), cA + kstep, voffA); PG8_STAGE(PG8_SB(1, 1), cB + hstepB + kstep, voffB);
        PG8_WAIT_V(6); PG8_BAR;
    }
    for (;;) {
        const bool has_next = S.next(ui + 1, nxt);
        const char* nA = has_next ? PG8_ABASE(nxt) : cA; const char* nB = has_next ? (const char*)g.Bt + (size_t)nxt.pn * tstepB : cB;
#pragma unroll 1
        for (int t = 0; t < nt; t += 2) {
            const bool last = (t == nt - 2);
            const char* a1 = cA + (size_t)(t + 1) * kstep;
            const char* a2 = last ? nA : cA + (size_t)(t + 2) * kstep; const char* b2 = last ? nB : cB + (size_t)(t + 2) * kstep;
            const char* a3 = a2 + kstep; const char* b3 = b2 + kstep;
            if constexpr (SP2) {
            PG8_LDB(B0, 0, 0); PG8_LDB(B1, 0, 1); PG8_SCHED; PG8_LDA(At, 0, 0); PG8_STAGE(PG8_SA(1, 1), a1 + hstepA, voffA);
            PG8_WAIT_V(8); PG8_WAIT_L(0); PG8_BAR; PG8_MMA(0, 0, At, B0); PG8_MMA(0, 1, At, B1); PG8_BAR; PG8_SCHED;
            PG8_LDA(At, 0, 1); PG8_STAGE(PG8_SB(0, 0), b2, voffB); PG8_STAGE(PG8_SB(0, 1), b2 + hstepB, voffB); PG8_STAGE(PG8_SA(0, 0), a2, voffA);
            PG8_WAIT_V(8); PG8_WAIT_L(0); PG8_BAR; PG8_MMA(1, 0, At, B0); PG8_MMA(1, 1, At, B1); PG8_BAR; PG8_SCHED;
            PG8_LDB(B0, 1, 0); PG8_LDB(B1, 1, 1); PG8_SCHED; PG8_LDA(At, 1, 0); PG8_STAGE(PG8_SA(0, 1), a2 + hstepA, voffA);
            PG8_WAIT_V(8); PG8_WAIT_L(0); PG8_BAR; PG8_MMA(0, 0, At, B0); PG8_MMA(0, 1, At, B1); PG8_BAR; PG8_SCHED;
            PG8_LDA(At, 1, 1); PG8_STAGE(PG8_SB(1, 0), b3, voffB); PG8_STAGE(PG8_SB(1, 1), b3 + hstepB, voffB); PG8_STAGE(PG8_SA(1, 0), a3, voffA);
            PG8_WAIT_V(8); PG8_WAIT_L(0); PG8_BAR; PG8_MMA(1, 0, At, B0); PG8_MMA(1, 1, At, B1); PG8_BAR; PG8_SCHED;
            } else {
            PG8_LDB(B0, 0, 0); PG8_SCHED; PG8_LDA(At, 0, 0); PG8_STAGE(PG8_SA(1, 1), a1 + hstepA, voffA);
            PG8_WAIT_L(8); PG8_BAR; PG8_WAIT_L(0); PG8_MMA(0, 0, At, B0); PG8_BAR; PG8_SCHED;
            PG8_LDB(B1, 0, 1); PG8_STAGE(PG8_SB(0, 0), b2, voffB);
            PG8_BAR; PG8_WAIT_L(0); PG8_MMA(0, 1, At, B1); PG8_BAR;
            PG8_LDA(At, 0, 1); PG8_STAGE(PG8_SA(0, 0), a2, voffA);
            PG8_BAR; PG8_WAIT_L(0); PG8_MMA(1, 0, At, B0); PG8_BAR; PG8_SCHED;
            PG8_STAGE(PG8_SB(0, 1), b2 + hstepB, voffB);
            PG8_WAIT_V(6); PG8_BAR; PG8_MMA(1, 1, At, B1); PG8_BAR;
            PG8_LDB(B0, 1, 0); PG8_SCHED; PG8_LDA(At, 1, 0); PG8_STAGE(PG8_SA(0, 1), a2 + hstepA, voffA);
            PG8_WAIT_L(8); PG8_BAR; PG8_WAIT_L(0); PG8_MMA(0, 0, At, B0); PG8_BAR; PG8_SCHED;
            PG8_LDB(B1, 1, 1); PG8_STAGE(PG8_SB(1, 0), b3, voffB);
            PG8_BAR; PG8_WAIT_L(0); PG8_MMA(0, 1, At, B1); PG8_BAR;
            PG8_LDA(At, 1, 1); PG8_STAGE(PG8_SA(1, 0), a3, voffA);
            PG8_BAR; PG8_WAIT_L(0); PG8_MMA(1, 0, At, B0); PG8_BAR; PG8_SCHED;
            PG8_STAGE(PG8_SB(1, 1), b3 + hstepB, voffB);
            PG8_WAIT_V(6); PG8_BAR; PG8_MMA(1, 1, At, B1); PG8_BAR;
            }
            if constexpr (SEG > 0) {
                if (!last && (t + 2) % SEG == 0) {
                    E.segment(acc, (t + 2) / SEG - 1, cur, wr, wc, fr, fq);
#pragma unroll
                    for (int a = 0; a < 2; ++a)
#pragma unroll
                        for (int b = 0; b < 2; ++b)
#pragma unroll
                            for (int m = 0; m < 4; ++m)
#pragma unroll
                                for (int n = 0; n < 2; ++n) acc[a][b][m][n] = (f32x4){0.f, 0.f, 0.f, 0.f};
                }
            }
        }
        if constexpr (ALIGN_EPI) { if (wr == 0) PG8_BAR; }
        E(acc, cur, wr, wc, fr, fq);
        if (!has_next) break;
#pragma unroll
        for (int a = 0; a < 2; ++a)
#pragma unroll
            for (int b = 0; b < 2; ++b)
#pragma unroll
                for (int m = 0; m < 4; ++m)
#pragma unroll
                    for (int n = 0; n < 2; ++n) acc[a][b][m][n] = (f32x4){0.f, 0.f, 0.f, 0.f};
        cur = nxt; cA = nA; cB = nB; ++ui;
        if constexpr (ALIGN_EPI) { if (wr == 1) PG8_BAR; }
    }
    PG8_WAIT_V(0);
    if constexpr (!ALIGN_EPI) { if (wr == 0) PG8_BAR; }
    PG8_BAR;
#undef PG8_SA
#undef PG8_SB
#undef PG8_STAGE
#undef PG8_LDA
#undef PG8_LDB
#undef PG8_MMA
#undef PG8_WAIT_V
#undef PG8_WAIT_L
#undef PG8_BAR
#undef PG8_SCHED
#undef PG8_ABASE
}
}

using pg8::bf16_t; using pg8::f32x4; using pg8::u32x4; using pg8::Unit; using pg8::cvt_pk_bf16;
typedef short bf16x8 __attribute__((ext_vector_type(8)));
typedef float f32x16 __attribute__((ext_vector_type(16)));
typedef unsigned u32x2 __attribute__((ext_vector_type(2)));
#define LAS __attribute__((address_space(3)))

constexpr int DM = 1024, SEQ = 8192, NB = 2, LCTX = 256, DEPTH = 2;
constexpr int MLAT = NB * SEQ;
constexpr int MALL = MLAT + NB * LCTX;
constexpr int KEYS = LCTX + SEQ;
constexpr int NIN = 5504, NINP = 5632;
constexpr int FF = 4096;
constexpr int QW = 1152;
constexpr float EPS = 1e-6f;
constexpr float LOG2E = 1.4426950408889634f;
constexpr float QSCALE = 0.125f * LOG2E;

constexpr size_t MiB = 1u << 20;
constexpr size_t WS_CTL = 0, CTL_ZERO_BYTES = 256 * 1024;
constexpr size_t WS_MODS = 64 * 1024;
constexpr size_t WS_ROPE = 256 * 1024;
constexpr size_t WS_XC = 1 * MiB;
constexpr size_t WS_WIN = 4 * MiB;
constexpr size_t WS_WBR = WS_WIN + 11 * MiB;
constexpr size_t WS_WOUT = WS_WBR + 9 * MiB / 4;
constexpr size_t WS_W1 = WS_WOUT + 6 * MiB;
constexpr size_t WS_W2 = WS_W1 + 8 * MiB;
constexpr size_t WS_R1 = 40 * MiB;
constexpr size_t WS_KAB = WS_R1 + 33 * MiB;
constexpr size_t WS_KC = WS_KAB + (size_t)NB * KEYS * 256 * 2;
constexpr size_t WS_VTAB = WS_KC + (size_t)NB * KEYS * 384 * 2;
constexpr size_t WS_VTC = WS_VTAB + (size_t)NB * 4 * 64 * KEYS * 2;
constexpr size_t WS_PG = WS_VTC + (size_t)NB * 6 * 64 * KEYS * 2;
constexpr size_t WS_Q = WS_PG + (size_t)MALL * 3072 * 2;
constexpr size_t WS_VB = WS_Q + (size_t)MALL * QW * 2;
constexpr size_t WS_END = WS_VB + (size_t)NB * KEYS * 128 * 2;
constexpr size_t WS_Y = WS_R1;
constexpr size_t WS_A = WS_R1;
constexpr size_t WS_Y2 = WS_A + (size_t)MALL * FF * 2;
static_assert(WS_W2 + 8 * MiB <= WS_R1, "weights");
static_assert(WS_Y + (size_t)MALL * DM * 4 <= WS_PG, "Y overlay");
static_assert(WS_A + (size_t)MALL * FF * 2 <= WS_Q, "A overlay");
static_assert(WS_Y2 + (size_t)MALL * DM * 4 <= WS_END && WS_END <= 256 * MiB, "ws map");

constexpr int LDS_BYTES = 147456;

struct EpiProj {
    static constexpr bool PERM = true;
    bf16_t *Q, *KAB, *KC, *VAB, *VC, *PG; const float *rope, *qn, *kn;
    __device__ __forceinline__ void operator()(const f32x4 (&acc)[2][2][4][2], const Unit& u, int wr, int wc, int fr, int fq) const {
        const int pm = u.pm, hu = 4 * u.pn + wc;
        if (hu >= 86) return;
        const bool lat = pm < 64; int kroff;
        if (lat) { const int b = pm >> 5; kroff = 256 * b + 256; } else { const int b = pm - 64; kroff = -MLAT + SEQ * b; }
        const int row0 = pm * 256 + wr * 64 + fr;
        int pitch, col, radd = 0; bf16_t* base; bool norm = false, rot = false, scl = false; const float* gn = qn;
        if (hu >= 38) { base = PG; pitch = 3072; col = (hu - 38) * 64; }
        else if (hu < 6) { base = Q; pitch = QW; col = hu * 64; rot = true; scl = true; }
        else if (hu < 8) { base = KAB; pitch = 256; col = (hu - 6) * 64; radd = kroff; rot = true; }
        else if (hu < 10) { base = VAB; pitch = 256; col = (hu - 8) * 64; radd = kroff; }
        else if (hu < 16) { base = Q; pitch = QW; col = 384 + (hu - 10) * 64; norm = true; rot = true; scl = true; }
        else if (hu < 18) { base = KAB; pitch = 256; col = 128 + (hu - 16) * 64; radd = kroff; norm = true; rot = true; gn = kn; }
        else if (hu < 20) { base = VAB; pitch = 256; col = 128 + (hu - 18) * 64; radd = kroff; }
        else if (hu < 26) { base = Q; pitch = QW; col = 768 + (hu - 20) * 64; scl = true; }
        else if (hu < 32) { base = KC; pitch = 384; col = (hu - 26) * 64; radd = kroff; }
        else { base = VC; pitch = 384; col = (hu - 32) * 64; radd = kroff; }
        rot = rot && lat;
        bf16_t* pb = base + (size_t)(row0 + radd) * pitch + col + 8 * fq;
        f32x4 g0 = {1.f, 1.f, 1.f, 1.f}, g1 = g0, g2 = g0, g3 = g0;
        if (norm) { g0 = *(const f32x4*)(gn + 8 * fq); g1 = *(const f32x4*)(gn + 8 * fq + 4); g2 = *(const f32x4*)(gn + 32 + 8 * fq); g3 = *(const f32x4*)(gn + 32 + 8 * fq + 4); }
        const float sc = scl ? QSCALE : 1.0f;
#pragma unroll
        for (int ai = 0; ai < 2; ++ai)
#pragma unroll
            for (int m = 0; m < 4; ++m) {
                f32x4 a0 = acc[ai][0][m][0], a1 = acc[ai][0][m][1], b0 = acc[ai][1][m][0], b1 = acc[ai][1][m][1];
                if (norm) {
                    float ss = (a0[0] * a0[0] + a0[1] * a0[1]) + (a0[2] * a0[2] + a0[3] * a0[3]) + (a1[0] * a1[0] + a1[1] * a1[1]) + (a1[2] * a1[2] + a1[3] * a1[3])
                             + (b0[0] * b0[0] + b0[1] * b0[1]) + (b0[2] * b0[2] + b0[3] * b0[3]) + (b1[0] * b1[0] + b1[1] * b1[1]) + (b1[2] * b1[2] + b1[3] * b1[3]);
                    ss += __shfl_xor(ss, 16); ss += __shfl_xor(ss, 32);
                    const float rstd = rsqrtf(ss * (1.f / 64.f) + EPS);
                    a0 = a0 * rstd * g0; a1 = a1 * rstd * g1; b0 = b0 * rstd * g2; b1 = b1 * rstd * g3;
                }
                if (rot) {
                    const int sp = (row0 + ai * 128 + m * 16) & (SEQ - 1);
                    const float* tr = rope + ((sp >> 6) * 16 + 4 * fq) * 2; const float* tc = rope + ((sp & 63) * 16 + 4 * fq) * 2;
                    const f32x4 r0 = *(const f32x4*)tr, r1 = *(const f32x4*)(tr + 4), c0 = *(const f32x4*)tc, c1 = *(const f32x4*)(tc + 4);
                    a0 = (f32x4){a0[0] * r0[0] - a0[1] * r0[1], a0[0] * r0[1] + a0[1] * r0[0], a0[2] * r0[2] - a0[3] * r0[3], a0[2] * r0[3] + a0[3] * r0[2]};
                    a1 = (f32x4){a1[0] * r1[0] - a1[1] * r1[1], a1[0] * r1[1] + a1[1] * r1[0], a1[2] * r1[2] - a1[3] * r1[3], a1[2] * r1[3] + a1[3] * r1[2]};
                    b0 = (f32x4){b0[0] * c0[0] - b0[1] * c0[1], b0[0] * c0[1] + b0[1] * c0[0], b0[2] * c0[2] - b0[3] * c0[3], b0[2] * c0[3] + b0[3] * c0[2]};
                    b1 = (f32x4){b1[0] * c1[0] - b1[1] * c1[1], b1[0] * c1[1] + b1[1] * c1[0], b1[2] * c1[2] - b1[3] * c1[3], b1[2] * c1[3] + b1[3] * c1[2]};
                }
                a0 = a0 * sc; a1 = a1 * sc; b0 = b0 * sc; b1 = b1 * sc;
                u32x4 w0, w1; w0.x = cvt_pk_bf16(a0[0], a0[1]); w0.y = cvt_pk_bf16(a0[2], a0[3]); w0.z = cvt_pk_bf16(a1[0], a1[1]); w0.w = cvt_pk_bf16(a1[2], a1[3]);
                w1.x = cvt_pk_bf16(b0[0], b0[1]); w1.y = cvt_pk_bf16(b0[2], b0[3]); w1.z = cvt_pk_bf16(b1[0], b1[1]); w1.w = cvt_pk_bf16(b1[2], b1[3]);
                bf16_t* p = pb + (size_t)(ai * 128 + m * 16) * pitch;
                *(u32x4*)p = w0; *(u32x4*)(p + 32) = w1;
                if (rot && (m & 1)) asm volatile("" ::: "memory");
            }
    }
};
__device__ __forceinline__ float bf2f(unsigned h) { return __uint_as_float(h << 16); }
struct EpiGateSum {
    static constexpr bool PERM = true;
    bf16_t* PG;
    static __device__ __forceinline__ unsigned gate2(unsigned g, unsigned sprev, float a0, float a1) {
        const float g0 = bf2f(g & 0xffffu), g1 = bf2f(g >> 16);
        const float s0 = __builtin_amdgcn_rcpf(1.0f + __builtin_amdgcn_exp2f(-LOG2E * g0)), s1 = __builtin_amdgcn_rcpf(1.0f + __builtin_amdgcn_exp2f(-LOG2E * g1));
        return cvt_pk_bf16(a0 * s0 + bf2f(sprev & 0xffffu), a1 * s1 + bf2f(sprev >> 16));
    }
    __device__ __forceinline__ void segment(const f32x4 (&acc)[2][2][4][2], int br, const Unit& u, int wr, int wc, int fr, int fq) const {
        const int row0 = u.pm * 256 + wr * 64 + fr, col0 = u.pn * 256 + wc * 32 + 8 * fq;
        bf16_t* pb = PG + (size_t)row0 * 3072 + col0;
#pragma unroll
        for (int ai = 0; ai < 2; ++ai)
#pragma unroll
            for (int mp = 0; mp < 2; ++mp) {
                u32x4 gq[4], sp[4];
#pragma unroll
                for (int q = 0; q < 4; ++q) { const int m = 2 * mp + (q >> 1), bj = q & 1;
                    const u32x4* p = (const u32x4*)(pb + (size_t)(ai * 128 + m * 16) * 3072 + bj * 128);
                    gq[q] = *(const u32x4*)((const bf16_t*)p + br * 1024);
                    sp[q] = (u32x4){0u, 0u, 0u, 0u}; if (br > 0) sp[q] = *p; }
#pragma unroll
                for (int q = 0; q < 4; ++q) { const int m = 2 * mp + (q >> 1), bj = q & 1;
                    u32x4* p = (u32x4*)(pb + (size_t)(ai * 128 + m * 16) * 3072 + bj * 128);
                    const f32x4 v0 = acc[ai][bj][m][0], v1 = acc[ai][bj][m][1];
                    u32x4 w; w.x = gate2(gq[q].x, sp[q].x, v0[0], v0[1]); w.y = gate2(gq[q].y, sp[q].y, v0[2], v0[3]); w.z = gate2(gq[q].z, sp[q].z, v1[0], v1[1]); w.w = gate2(gq[q].w, sp[q].w, v1[2], v1[3]);
                    *p = w; }
                asm volatile("" ::: "memory");
            }
    }
    __device__ __forceinline__ void operator()(const f32x4 (&acc)[2][2][4][2], const Unit& u, int wr, int wc, int fr, int fq) const { segment(acc, 2, u, wr, wc, fr, fq); }
};
template <int ACT  > struct EpiBf16 {
    static constexpr bool PERM = true;
    bf16_t* O; int ldc;
    __device__ __forceinline__ void operator()(const f32x4 (&acc)[2][2][4][2], const Unit& u, int wr, int wc, int fr, int fq) const {
        const int row0 = u.pm * 256 + wr * 64 + fr, col0 = u.pn * 256 + wc * 32 + 8 * fq;
#pragma unroll
        for (int ai = 0; ai < 2; ++ai)
#pragma unroll
            for (int m = 0; m < 4; ++m)
#pragma unroll
                for (int bj = 0; bj < 2; ++bj) {
                    f32x4 v0 = acc[ai][bj][m][0], v1 = acc[ai][bj][m][1];
                    if (ACT == 1) {
#pragma unroll
                        for (int e = 0; e < 4; ++e) { const float a = fmaxf(v0[e], 0.f), c = fmaxf(v1[e], 0.f); v0[e] = a * a; v1[e] = c * c; }
                    }
                    u32x4 w; w.x = cvt_pk_bf16(v0[0], v0[1]); w.y = cvt_pk_bf16(v0[2], v0[3]); w.z = cvt_pk_bf16(v1[0], v1[1]); w.w = cvt_pk_bf16(v1[2], v1[3]);
                    *(u32x4*)(O + (size_t)(row0 + ai * 128 + m * 16) * ldc + col0 + bj * 128) = w;
                }
    }
};
struct EpiF32 {
    static constexpr bool PERM = true;
    float* O; int ldc;
    __device__ __forceinline__ void operator()(const f32x4 (&acc)[2][2][4][2], const Unit& u, int wr, int wc, int fr, int fq) const {
        const int row0 = u.pm * 256 + wr * 64 + fr, col0 = u.pn * 256 + wc * 32 + 8 * fq;
#pragma unroll
        for (int ai = 0; ai < 2; ++ai)
#pragma unroll
            for (int m = 0; m < 4; ++m)
#pragma unroll
                for (int bj = 0; bj < 2; ++bj) {
                    float* p = O + (size_t)(row0 + ai * 128 + m * 16) * ldc + col0 + bj * 128;
                    *(f32x4*)p = acc[ai][bj][m][0]; *(f32x4*)(p + 4) = acc[ai][bj][m][1];
                }
    }
};

__device__ __forceinline__ float wave_sum(float v) {
#pragma unroll
    for (int o = 1; o < 64; o <<= 1) v += __shfl_xor(v, o);
    return v;
}
__device__ __forceinline__ unsigned f2bf(float f) { unsigned u = __builtin_bit_cast(unsigned, f); return (u + 0x7fffu + ((u >> 16) & 1u)) >> 16; }
__device__ __forceinline__ unsigned pk2(float lo, float hi) { return f2bf(lo) | (f2bf(hi) << 16); }

__device__ __forceinline__ void transpose_item(const float* W, int K, int N, bf16_t* WT, int ldk, int row_off, int copies, int copy_stride, LAS float* scr, int item, int lane, bool headperm = false) {
    const int nblk = N / 32, kb = item / nblk, nb = item % nblk, k0 = 64 * kb, n0 = 32 * nb;
    const int r0 = headperm ? 256 * (nb >> 3) + 128 * (nb & 1) + 32 * ((nb & 7) >> 1) : n0;
#pragma unroll 8
    for (int i = 0; i < 32; ++i) { const int kk = 2 * i + (lane >> 5); scr[kk * 33 + (lane & 31)] = W[(size_t)(k0 + kk) * N + n0 + (lane & 31)]; }
    asm volatile("s_waitcnt lgkmcnt(0)" ::: "memory");
    const int c = lane & 7;
#pragma unroll
    for (int j = 0; j < 4; ++j) { const int n = (lane >> 3) + 8 * j; const LAS float* s = scr + (8 * c) * 33 + n;
        u32x4 o; o.x = pk2(s[0 * 33], s[1 * 33]); o.y = pk2(s[2 * 33], s[3 * 33]); o.z = pk2(s[4 * 33], s[5 * 33]); o.w = pk2(s[6 * 33], s[7 * 33]);
        for (int cc = 0; cc < copies; ++cc) *(u32x4*)(WT + (size_t)(row_off + r0 + n) * ldk + cc * copy_stride + k0 + 8 * c) = o; }
    asm volatile("s_waitcnt lgkmcnt(0)" ::: "memory");
}

struct Args { const float* in[21]; float* out; unsigned char* ws; int pad0, pad1; };
typedef const __attribute__((address_space(4))) Args* KAP;
#define KARGS() ({ KAP p_ = (KAP)__builtin_amdgcn_kernarg_segment_ptr(); asm volatile("" : "+s"(p_)); p_; })

__device__ __forceinline__ void conv_weights(KAP ap, int l, LAS unsigned char* lds, int gw, int NGW, int wave, int lane) {
    unsigned char* ws = ap->ws;
    LAS float* scr = (LAS float*)(lds + wave * 16384);
    constexpr int I_IN = 16 * (NIN / 32), I_BR = 6 * 32, I_OUT = 16 * 32, I_1 = 16 * (FF / 32), I_2 = (FF / 64) * 32;
    constexpr int NITEMS = I_IN + 3 * I_BR + I_OUT + I_1 + I_2;
    for (int it = gw; it < NITEMS; it += NGW) {
        int r = it;
        if (r < I_IN) { transpose_item(ap->in[8] + (size_t)l * DM * NIN, DM, NIN, (bf16_t*)(ws + WS_WIN), DM, 0, 1, 0, scr, r, lane, true); continue; } r -= I_IN;
        if (r < I_BR) { transpose_item(ap->in[13] + (size_t)l * 384 * DM, 384, DM, (bf16_t*)(ws + WS_WBR), 1152, 0, 1, 0, scr, r, lane); continue; } r -= I_BR;
        if (r < I_BR) { transpose_item(ap->in[14] + (size_t)l * 384 * DM, 384, DM, (bf16_t*)(ws + WS_WBR) + 384, 1152, 0, 1, 0, scr, r, lane); continue; } r -= I_BR;
        if (r < I_BR) { transpose_item(ap->in[15] + (size_t)l * 384 * DM, 384, DM, (bf16_t*)(ws + WS_WBR) + 768, 1152, 0, 1, 0, scr, r, lane); continue; } r -= I_BR;
        if (r < I_OUT) { transpose_item(ap->in[16] + (size_t)l * DM * DM, DM, DM, (bf16_t*)(ws + WS_WOUT), DM, 0, 1, 0, scr, r, lane); continue; } r -= I_OUT;
        if (r < I_1) { transpose_item(ap->in[19] + (size_t)l * DM * FF, DM, FF, (bf16_t*)(ws + WS_W1), DM, 0, 1, 0, scr, r, lane); continue; } r -= I_1;
        transpose_item(ap->in[20] + (size_t)l * FF * DM, FF, DM, (bf16_t*)(ws + WS_W2), FF, 0, 1, 0, scr, r, lane);
    }
    unsigned z0 = 0u; asm volatile("" : "+v"(z0));
    for (int i = gw * 64 + lane; i < (NINP - NIN) * DM * 2 / 16; i += NGW * 64) {
        const int prow = i / (DM * 2 / 16), pc = i % (DM * 2 / 16);
        const int row = 21 * 256 + (prow >> 6) * 128 + 64 + (prow & 63);
        *((u32x4*)(ws + WS_WIN + (size_t)row * DM * 2) + pc) = (u32x4){z0, z0, z0, z0};
    }
}

__device__ __forceinline__ void ada_phase(KAP ap, int gw, int NGW, int lane) {
    float* mods = (float*)(ap->ws + WS_MODS);
    const float* c = ap->in[1]; const float* cc = ap->in[3];
    for (int t = gw; t < DEPTH * 16 * 24; t += NGW) {
        const int l = t / (16 * 24), kc = (t / 24) % 16, jc = t % 24, col = jc * 256 + lane * 4;
        const float* W = ap->in[4] + ((size_t)l * DM + kc * 64) * 6144 + col;
        f32x4 s0 = {0.f, 0.f, 0.f, 0.f}, s1 = s0, s2 = s0;
        for (int k = 0; k < 64; ++k) {
            const f32x4 w = *(const f32x4*)(W + (size_t)k * 6144);
            const float x0 = c[kc * 64 + k], x1 = c[DM + kc * 64 + k], x2 = cc[kc * 64 + k];
            const float a0 = x0 / (1.f + __expf(-x0)), a1 = x1 / (1.f + __expf(-x1)), a2 = x2 / (1.f + __expf(-x2));
            s0 += w * a0; s1 += w * a1; s2 += w * a2;
        }
        if (kc == 0) { const f32x4 bb = *(const f32x4*)(ap->in[5] + (size_t)l * 6144 + col); s0 += bb; s1 += bb; s2 += bb; }
        float* m0 = mods + (size_t)(l * 3) * 6144 + col;
#pragma unroll
        for (int e = 0; e < 4; ++e) { atomicAdd(m0 + e, s0[e]); atomicAdd(m0 + 6144 + e, s1[e]); atomicAdd(m0 + 2 * 6144 + e, s2[e]); }
    }
}

__device__ __forceinline__ void row_phase(int gw, int NGW, int lane, int nrows, const bf16_t* Y, const float* gainY, const float* modsG, int gate_off,
                                          const float* rin_lat, const float* rin_ctx, float* rout_lat, float* rout_ctx,
                                          bf16_t* H, const float* gainH, const float* modsH, int shift_off, int scale_off) {
    for (int m = 2 * gw; m < nrows; m += 2 * NGW) {
        const int v = m < MLAT ? (m >> 13) : 2;
        const size_t roff = m < MLAT ? (size_t)m * DM : (size_t)(m - MLAT) * DM;
        const f32x4* xr = (const f32x4*)((m < MLAT ? rin_lat : rin_ctx) + roff) + lane;
        f32x4 x[2][4];
#pragma unroll
        for (int u = 0; u < 2; ++u)
#pragma unroll
            for (int j = 0; j < 4; ++j) x[u][j] = xr[256 * u + 64 * j];
        if (Y) {
            const u32x2* yr = (const u32x2*)(Y + (size_t)m * DM) + lane;
            u32x2 yw[2][4];
#pragma unroll
            for (int u = 0; u < 2; ++u)
#pragma unroll
                for (int j = 0; j < 4; ++j) yw[u][j] = yr[256 * u + 64 * j];
            const f32x4* gy = (const f32x4*)gainY + lane; const f32x4* gt = (const f32x4*)(modsG + (size_t)v * 6144 + gate_off) + lane;
            f32x4* ro = (f32x4*)((m < MLAT ? rout_lat : rout_ctx) + roff) + lane;
#pragma unroll
            for (int u = 0; u < 2; ++u) {
                f32x4 y[4]; float ss = 0.f;
#pragma unroll
                for (int j = 0; j < 4; ++j) { y[j] = (f32x4){bf2f(yw[u][j].x & 0xffffu), bf2f(yw[u][j].x >> 16), bf2f(yw[u][j].y & 0xffffu), bf2f(yw[u][j].y >> 16)}; ss += (y[j].x * y[j].x + y[j].y * y[j].y) + (y[j].z * y[j].z + y[j].w * y[j].w); }
                const float rstd = rsqrtf(wave_sum(ss) * (1.f / DM) + EPS);
#pragma unroll
                for (int j = 0; j < 4; ++j) { x[u][j] = x[u][j] + gt[64 * j] * (y[j] * rstd * gy[64 * j]); ro[256 * u + 64 * j] = x[u][j]; }
            }
        }
        if (H) {
            const f32x4* gh = (const f32x4*)gainH + lane; const f32x4* sh = (const f32x4*)(modsH + (size_t)v * 6144 + shift_off) + lane; const f32x4* sc = (const f32x4*)(modsH + (size_t)v * 6144 + scale_off) + lane;
            u32x2* ho = (u32x2*)(H + (size_t)m * DM) + lane;
#pragma unroll
            for (int u = 0; u < 2; ++u) {
                float ss = 0.f;
#pragma unroll
                for (int j = 0; j < 4; ++j) ss += (x[u][j].x * x[u][j].x + x[u][j].y * x[u][j].y) + (x[u][j].z * x[u][j].z + x[u][j].w * x[u][j].w);
                const float rstd = rsqrtf(wave_sum(ss) * (1.f / DM) + EPS);
#pragma unroll
                for (int j = 0; j < 4; ++j) { const f32x4 h = (x[u][j] * rstd * gh[64 * j]) * (sc[64 * j] + 1.0f) + sh[64 * j]; u32x2 w; w.x = pk2(h.x, h.y); w.y = pk2(h.z, h.w); ho[256 * u + 64 * j] = w; }
            }
        }
    }
}

#include <hip/hip_bf16.h>
#include <cmath>
namespace attn_body {
using bf16=__hip_bfloat16;
using bf16x8=__attribute__((ext_vector_type(8)))short;
using s16x4=__attribute__((ext_vector_type(4)))short;
using f32x16=__attribute__((ext_vector_type(16)))float;
using u32x4=__attribute__((ext_vector_type(4)))unsigned;
constexpr int D=64,QP=1152;
constexpr int BIAS_OFF=90112;
struct UnitCtx { int toff; int qpos0; int gr; int rs; int qc; unsigned vm; float sink2; };
constexpr int NW=8,QBLK=32,QB=QBLK*NW,KVBLK=64;
__device__ __forceinline__ int crow(int r,int hi){return (r&3)+8*(r>>2)+4*hi;}
#define SBAR() __builtin_amdgcn_sched_barrier(0)
constexpr int NSLOT=3, SLOTB=8192;
constexpr int LDS_K=0, LDS_V=NSLOT*SLOTB, LDS_WS=2*NSLOT*SLOTB, LDS_OST=LDS_WS+NW*64*4, LDS_BYTES=LDS_OST+NW*4096;
constexpr float C2=0.125f*1.4426950408889634f;
__device__ __forceinline__ void glds16(const void*gsrc,unsigned lds_dst){unsigned keep;
  asm volatile("s_mov_b32 %0, m0\n\ts_mov_b32 m0, %2\n\ts_nop 0\n\tglobal_load_lds_dwordx4 %1, off\n\ts_mov_b32 m0, %0":"=&s"(keep):"v"(gsrc),"s"(lds_dst):"memory");}
__device__ __forceinline__ float max3f(float a,float b,float c){float r;asm("v_max3_f32 %0, %1, %2, %3":"=v"(r):"v"(a),"v"(b),"v"(c));return r;}
__device__ __forceinline__ float max2f(float a,float b){float r;asm("v_max_f32_e32 %0, %1, %2":"=v"(r):"v"(a),"v"(b));return r;}
__device__ __forceinline__ float fadd_s(float a,float b){float r;asm("v_add_f32_e32 %0, %1, %2":"=v"(r):"v"(a),"v"(b));return r;}
__device__ __forceinline__ float fsub_s(float a,float b){float r;asm("v_sub_f32_e32 %0, %1, %2":"=v"(r):"v"(a),"v"(b));return r;}
typedef float f32x2_t __attribute__((ext_vector_type(2))); typedef __bf16 bf16x2_t __attribute__((ext_vector_type(2)));
__device__ __forceinline__ unsigned cvtpk_s(float lo,float hi){f32x2_t v={lo,hi};bf16x2_t b=__builtin_convertvector(v,bf16x2_t);return __builtin_bit_cast(unsigned,b);}
#define WAIT_BAR(N) asm volatile("s_waitcnt vmcnt(" #N ") lgkmcnt(0)\n\ts_barrier":::"memory")

__device__ __forceinline__ void qkt(f32x16&p0,f32x16&p1,const char*Kslot,const bf16x8*qr,int r32,int hi){ const f32x16 negm={};
  const char*kb=Kslot+hi*1024+r32*16;
  #pragma unroll
  for(int d0=0;d0<4;++d0){
    const bf16x8 b0=*reinterpret_cast<const bf16x8*>(kb+d0*2048);
    const bf16x8 b1=*reinterpret_cast<const bf16x8*>(kb+d0*2048+512);
    if(d0==0){p0=__builtin_amdgcn_mfma_f32_32x32x16_bf16(b0,qr[0],negm,0,0,0);p1=__builtin_amdgcn_mfma_f32_32x32x16_bf16(b1,qr[0],negm,0,0,0);}
    else{p0=__builtin_amdgcn_mfma_f32_32x32x16_bf16(b0,qr[d0],p0,0,0,0);p1=__builtin_amdgcn_mfma_f32_32x32x16_bf16(b1,qr[d0],p1,0,0,0);}}
}
typedef __attribute__((address_space(3))) const char* lds_cptr;
typedef short v4i16_t __attribute__((ext_vector_type(4)));
__device__ __forceinline__ void kload8(bf16x8*kf,lds_cptr kp){
  kf[0]=*(const __attribute__((address_space(3))) bf16x8*)(kp);      kf[1]=*(const __attribute__((address_space(3))) bf16x8*)(kp+512);
  kf[2]=*(const __attribute__((address_space(3))) bf16x8*)(kp+2048); kf[3]=*(const __attribute__((address_space(3))) bf16x8*)(kp+2560);
  kf[4]=*(const __attribute__((address_space(3))) bf16x8*)(kp+4096); kf[5]=*(const __attribute__((address_space(3))) bf16x8*)(kp+4608);
  kf[6]=*(const __attribute__((address_space(3))) bf16x8*)(kp+6144); kf[7]=*(const __attribute__((address_space(3))) bf16x8*)(kp+6656);
}
__device__ __forceinline__ void kload2(bf16x8*kf,lds_cptr kp,int j){ kf[2*j]=*(const __attribute__((address_space(3))) bf16x8*)(kp+j*2048); kf[2*j+1]=*(const __attribute__((address_space(3))) bf16x8*)(kp+j*2048+512); }
__device__ __forceinline__ s16x4 vtr(lds_cptr p){ return __builtin_bit_cast(s16x4,__builtin_amdgcn_ds_read_tr16_b64_v4i16((__attribute__((address_space(3))) v4i16_t*)p)); }
template<int MODE> __device__ __forceinline__ void amask(f32x16&c0,f32x16&c1,int t,const UnitCtx&uc,int hi,lds_cptr shm3){
  if(t<4)return;
  const float NEG=-INFINITY;
  if(MODE==1){ const int dq=64*(uc.toff+t-4)+4*hi-uc.qpos0;
    #pragma unroll
    for(int r=0;r<16;++r){ const int d=dq+(r&3)+8*(r>>2); if(d>128||d<-128)c0[r]=NEG; if(d+32>128||d+32<-128)c1[r]=NEG; } }
  else { const int kr=uc.toff+t-4;
    if(kr<uc.rs||kr>=uc.rs+8){
      #pragma unroll
      for(int r=0;r<16;++r){c0[r]=NEG;c1[r]=NEG;} }
    else { const __attribute__((address_space(3))) float*brow=(const __attribute__((address_space(3))) float*)(shm3+BIAS_OFF)+(kr-uc.gr+7)*31+15-uc.qc;
      unsigned vm=uc.vm; asm volatile("":"+v"(vm));
      #pragma unroll
      for(int r=0;r<16;++r){ const int kc=(r&3)+8*(r>>2)+4*hi; const float b0=brow[kc],b1=brow[kc+32];
        c0[r]=((vm>>r)&1u)?c0[r]+b0:NEG; c1[r]=((vm>>(16+r))&1u)?c1[r]+b1:NEG;
        if((r&3)==3)__builtin_amdgcn_sched_barrier(0); } } }
}
__device__ __forceinline__ float rowmax(const f32x16&p0,const f32x16&p1){
  float a=max3f(p0[0],p0[1],p1[0]),b=max3f(p0[2],p0[3],p1[1]);a=max3f(a,p1[2],p1[3]);
  #pragma unroll
  for(int r=4;r<16;r+=4){a=max3f(a,p0[r],p0[r+1]);b=max3f(b,p0[r+2],p0[r+3]);a=max3f(a,p1[r],p1[r+1]);b=max3f(b,p1[r+2],p1[r+3]);}
  const float m=max2f(a,b);
  auto rr=__builtin_amdgcn_permlane32_swap(__float_as_uint(m),__float_as_uint(m),false,false);
  return max2f(__uint_as_float(rr[0]),__uint_as_float(rr[1]));
}
__device__ __forceinline__ void pv(f32x16*o,int vb,bf16x8 pa0,bf16x8 pa1,bf16x8 pa2,bf16x8 pa3){
  #pragma unroll
  for(int d0=0;d0<2;++d0){s16x4 lo[4],hi[4];
    #pragma unroll
    for(int ks=0;ks<4;++ks){
      asm volatile("ds_read_b64_tr_b16 %0,%1 offset:%c2":"=&v"(lo[ks]):"v"(vb),"i"(d0*4096+ks*1024):"memory");
      asm volatile("ds_read_b64_tr_b16 %0,%1 offset:%c2":"=&v"(hi[ks]):"v"(vb),"i"(d0*4096+ks*1024+512):"memory");}
    asm volatile("s_waitcnt lgkmcnt(0)":::"memory");SBAR();
    #define PK(k) (bf16x8){lo[k][0],lo[k][1],lo[k][2],lo[k][3],hi[k][0],hi[k][1],hi[k][2],hi[k][3]}
    o[d0]=__builtin_amdgcn_mfma_f32_32x32x16_bf16(pa0,PK(0),o[d0],0,0,0);
    o[d0]=__builtin_amdgcn_mfma_f32_32x32x16_bf16(pa1,PK(1),o[d0],0,0,0);
    o[d0]=__builtin_amdgcn_mfma_f32_32x32x16_bf16(pa2,PK(2),o[d0],0,0,0);
    o[d0]=__builtin_amdgcn_mfma_f32_32x32x16_bf16(pa3,PK(3),o[d0],0,0,0);
    #undef PK
  }
}

#ifndef ATTN_STORE16
#define ATTN_STORE16(p,v) (*(u32x4*)(p)=(v))
#endif
template<int KP,int VP,int MODE,int THRL> __device__ __forceinline__ void attn_unit(const bf16*Qb,const bf16*__restrict__ Kh,const bf16*__restrict__ Vh,bf16*Ob,int NT,const UnitCtx uc,char*shm,int wave_id){
  const int tid=tid_of(wave_id),lane=tid&63,r32=lane&31,hi=lane>>5; const int wid=wave_id;
  const bf16*Qw=Qb+(long)(wid*QBLK)*QP;
  const unsigned lds0=(unsigned)(uintptr_t)shm;
  float*wsf=(float*)(shm+LDS_WS)+wid*64;
  const bf16*ksrc=Kh+(long)lane*KP+wid*8;
  const bf16*vsrc=Vh+(long)(16*(wid&3)+(lane>>2))*VP+(wid>>2)*32+(lane&3)*8;
  const unsigned kdst=lds0+LDS_K+wid*1024, vdst=lds0+LDS_V+wid*1024;
  #define KT(t) ((t)<4?(t):(t)+uc.toff)
  #define DMA_K(t,slot) glds16(ksrc+(long)KT(t)*KVBLK*KP,(unsigned)__builtin_amdgcn_readfirstlane(kdst+(slot)))
  #define DMA_V(t,slot) glds16(vsrc+(long)KT(t)*KVBLK*VP,(unsigned)__builtin_amdgcn_readfirstlane(vdst+(slot)))
  const int vb0=(int)(lds0+LDS_V)+((lane>>4)&1)*32+(lane&3)*8+(4*hi+((lane&15)>>2))*64;
  const char*Kbase=shm+LDS_K; bf16x8 kf[8];
  const lds_cptr shm3=(lds_cptr)shm; const lds_cptr kp0=shm3+LDS_K+hi*1024+r32*16; const lds_cptr vp0=shm3+LDS_V+((lane>>4)&1)*32+(lane&3)*8+(4*hi+((lane&15)>>2))*64;
  DMA_K(0,0);DMA_V(0,0);DMA_K(1,SLOTB);
  bf16x8 qr[4];
  #pragma unroll
  for(int d0=0;d0<4;++d0)qr[d0]=*reinterpret_cast<const bf16x8*>(&Qw[(long)r32*QP+d0*16+hi*8]);
  float mhat=0.f,l_reg=0.f;f32x16 o[2];o[0]=f32x16{};o[1]=f32x16{};
  constexpr bool NEGM=(MODE==0);
  f32x16 negm=f32x16{}; const f32x16 zero16=f32x16{}; if(NEGM)asm volatile("":"+v"(negm));
  #define CINIT (NEGM?negm:zero16)
  #define NEGM_SET() do{ if(NEGM){ _Pragma("unroll") for(int r_=0;r_<16;++r_)negm[r_]=-mhat; asm volatile("":"+v"(negm)); } }while(0)
  #define CMASK(P0,P1,t) do{ if(MODE!=0) amask<MODE>(P0,P1,(t),uc,hi,(lds_cptr)shm); }while(0)
  bool resc=false;
  #define START(P0,P1) do{ const float rm=rowmax(P0,P1); resc=false; \
    { const float dl=rm; mhat=fadd_s(mhat,dl); \
      _Pragma("unroll") for(int r=0;r<16;++r){P0[r]=fsub_s(P0[r],dl);P1[r]=fsub_s(P1[r],dl);} NEGM_SET(); } \
    _Pragma("unroll") for(int r=0;r<16;++r)P0[r]=__builtin_amdgcn_exp2f(P0[r]); }while(0)
  #define RESC() do{ if(resc){ asm volatile("s_waitcnt lgkmcnt(0)":::"memory"); \
      _Pragma("unroll") for(int d_=0;d_<2;++d_) _Pragma("unroll") for(int r=0;r<16;++r)o[d_][r]*=wsf[crow(r,hi)]; } }while(0)
  f32x16 pA0,pA1,pB0,pB1;
  int sl_prev=0,sl_cur=0,sl_next=SLOTB;
  #define ROT() do{sl_prev=sl_cur;sl_cur=sl_next;sl_next=(sl_next==(NSLOT-1)*SLOTB)?0:sl_next+SLOTB;}while(0)
  DMA_K(2,2*SLOTB);
  WAIT_BAR(3);
  qkt(pA0,pA1,Kbase,qr,r32,hi);asm volatile("s_nop 15\n\ts_nop 7":"+v"(pA0),"+v"(pA1));CMASK(pA0,pA1,0);
  START(pA0,pA1);
  if(uc.sink2>-1e30f){ l_reg=(hi==0)?__builtin_amdgcn_exp2f(uc.sink2-mhat):0.f; }
  _Pragma("unroll") for(int r=0;r<16;++r)pA1[r]=__builtin_amdgcn_exp2f(pA1[r]);
  WAIT_BAR(0);
  DMA_K(3,0);DMA_V(1,SLOTB);
  ROT();
  kload8(kf,kp0+sl_cur);
  WAIT_BAR(2);
  s16x4 vlo[8],vhi[8]; u32x4 pw0,pw1,pw2,pw3;
  #define PKW(P,B) cvtpk_s(P[B],P[B+1])
  #define PAF(k) __builtin_bit_cast(bf16x8,pw##k)
  #define VFR(i) (bf16x8){vlo[i][0],vlo[i][1],vlo[i][2],vlo[i][3],vhi[i][0],vhi[i][1],vhi[i][2],vhi[i][3]}
  #define PIN(x) asm volatile("":"+v"(x))
  #define MX3(a,b,c) __builtin_fmaxf(__builtin_fmaxf((a),(b)),(c))
  #define GAPA(MF,A0,A1,A2,A3,W0,W1,PW) do{ MF; sacc+=A0; sacc+=A1; sacc+=A2; sacc+=A3; PIN(sacc); W0; W1; PIN(PW); SBAR(); }while(0)
  #define EX(v) __builtin_amdgcn_exp2f(v)
  #define GAPB(MF,X,B) do{ MF; X[B]=EX(X[B]); X[B+1]=EX(X[B+1]); X[B+2]=EX(X[B+2]); X[B+3]=EX(X[B+3]); PIN(X); SBAR(); }while(0)
  #define VRD(i) do{ vlo[i]=vtr(vp_+(((i)>>2)*4096+((i)&3)*1024)); vhi[i]=vtr(vp_+(((i)>>2)*4096+((i)&3)*1024+512)); }while(0)
  #define KRD(G,j) do{ if(G){ kload2(kf,kp0+sl_next,j); SBAR(); } }while(0)
  #define STEP(C0,C1,P0,P1,t,GK,GV,GL) do{ SBAR(); \
    const lds_cptr vp_=vp0+sl_prev; \
    VRD(0); SBAR(); float sacc=(P0[0]+P0[1]); \
    GAPA(C0=__builtin_amdgcn_mfma_f32_32x32x16_bf16(kf[0],qr[0],CINIT,0,0,0), P0[2],P0[3],P0[4],P0[5],     pw0[0]=PKW(P0,0), pw0[1]=PKW(P0,2), pw0); \
    VRD(4); SBAR(); GAPA(C1=__builtin_amdgcn_mfma_f32_32x32x16_bf16(kf[1],qr[0],CINIT,0,0,0), P0[6],P0[7],P0[8],P0[9],     pw0[2]=PKW(P0,4), pw0[3]=PKW(P0,6), pw0); \
    VRD(1); SBAR(); GAPA(C0=__builtin_amdgcn_mfma_f32_32x32x16_bf16(kf[2],qr[1],C0,0,0,0),   P0[10],P0[11],P0[12],P0[13], pw1[0]=PKW(P0,8), pw1[1]=PKW(P0,10), pw1); \
    VRD(5); SBAR(); GAPA(C1=__builtin_amdgcn_mfma_f32_32x32x16_bf16(kf[3],qr[1],C1,0,0,0),   P0[14],P0[15],P1[0],P1[1],   pw1[2]=PKW(P0,12),pw1[3]=PKW(P0,14), pw1); \
    VRD(2); SBAR(); GAPA(C0=__builtin_amdgcn_mfma_f32_32x32x16_bf16(kf[4],qr[2],C0,0,0,0),   P1[2],P1[3],P1[4],P1[5],     pw2[0]=PKW(P1,0), pw2[1]=PKW(P1,2), pw2); \
    VRD(6); SBAR(); GAPA(C1=__builtin_amdgcn_mfma_f32_32x32x16_bf16(kf[5],qr[2],C1,0,0,0),   P1[6],P1[7],P1[8],P1[9],     pw2[2]=PKW(P1,4), pw2[3]=PKW(P1,6), pw2); \
    VRD(3); SBAR(); GAPA(C0=__builtin_amdgcn_mfma_f32_32x32x16_bf16(kf[6],qr[3],C0,0,0,0),   P1[10],P1[11],P1[12],P1[13], pw3[0]=PKW(P1,8), pw3[1]=PKW(P1,10), pw3); \
    VRD(7); SBAR(); GAPA(C1=__builtin_amdgcn_mfma_f32_32x32x16_bf16(kf[7],qr[3],C1,0,0,0),   P1[14],P1[15],0.f,0.f,       pw3[2]=PKW(P1,12),pw3[3]=PKW(P1,14), pw3); \
    l_reg+=sacc; \
    if(!NEGM){ _Pragma("unroll") for(int r=0;r<16;++r){C0[r]-=mhat;C1[r]-=mhat;} } \
    if(GK){DMA_K((t)+3,sl_cur);} if(GV){DMA_V((t)+1,sl_next);} \
    CMASK(C0,C1,t); \
    { float a=MX3(C0[0],C0[1],C1[0]),b=MX3(C0[2],C0[3],C1[1]); a=MX3(a,C1[2],C1[3]); \
      _Pragma("unroll") for(int r=4;r<16;r+=4){a=MX3(a,C0[r],C0[r+1]);b=MX3(b,C0[r+2],C0[r+3]);a=MX3(a,C1[r],C1[r+1]);b=MX3(b,C1[r+2],C1[r+3]);} \
      float rm=__builtin_fmaxf(a,b); { auto rr=__builtin_amdgcn_permlane32_swap(__float_as_uint(rm),__float_as_uint(rm),false,false); rm=__builtin_fmaxf(__uint_as_float(rr[0]),__uint_as_float(rr[1])); } \
      resc=false; \
      if(__builtin_expect(__any(rm>(float)THRL),0)){ const float dl=__builtin_fmaxf(rm,0.f); mhat+=dl; \
        _Pragma("unroll") for(int r=0;r<16;++r){C0[r]-=dl;C1[r]-=dl;} NEGM_SET(); \
        const float f=__builtin_amdgcn_exp2f(-dl); l_reg*=f; if(hi==0)wsf[r32]=f; resc=true; } } \
    SBAR(); \
    GAPB(o[0]=__builtin_amdgcn_mfma_f32_32x32x16_bf16(PAF(0),VFR(0),o[0],0,0,0), C0,0); \
    GAPB(o[1]=__builtin_amdgcn_mfma_f32_32x32x16_bf16(PAF(0),VFR(4),o[1],0,0,0), C0,4); \
    KRD(GL,0); GAPB(o[0]=__builtin_amdgcn_mfma_f32_32x32x16_bf16(PAF(1),VFR(1),o[0],0,0,0), C0,8); \
    KRD(GL,1); GAPB(o[1]=__builtin_amdgcn_mfma_f32_32x32x16_bf16(PAF(1),VFR(5),o[1],0,0,0), C0,12); \
    KRD(GL,2); GAPB(o[0]=__builtin_amdgcn_mfma_f32_32x32x16_bf16(PAF(2),VFR(2),o[0],0,0,0), C1,0); \
    KRD(GL,3); GAPB(o[1]=__builtin_amdgcn_mfma_f32_32x32x16_bf16(PAF(2),VFR(6),o[1],0,0,0), C1,4); \
    GAPB(o[0]=__builtin_amdgcn_mfma_f32_32x32x16_bf16(PAF(3),VFR(3),o[0],0,0,0), C1,8); \
    GAPB(o[1]=__builtin_amdgcn_mfma_f32_32x32x16_bf16(PAF(3),VFR(7),o[1],0,0,0), C1,12); \
    }while(0)
  int t=1;
  for(;t+5<NT;t+=2){
    STEP(pB0,pB1,pA0,pA1,t,true,true,true);     WAIT_BAR(2); RESC(); ROT();
    STEP(pA0,pA1,pB0,pB1,t+1,true,true,true);   WAIT_BAR(2); RESC(); ROT();
  }
  #define ENDW(tt) do{ if((tt)+3<NT){WAIT_BAR(2);} else if((tt)+2<NT){WAIT_BAR(1);} else {WAIT_BAR(0);} }while(0)
  for(;t+1<NT;t+=2){
    STEP(pB0,pB1,pA0,pA1,t,(t+3<NT),(t+1<NT),(t+1<NT));       ENDW(t);   RESC(); ROT();
    STEP(pA0,pA1,pB0,pB1,t+1,(t+4<NT),(t+2<NT),(t+2<NT));     ENDW(t+1); RESC(); ROT();
  }
  STEP(pB0,pB1,pA0,pA1,NT-1,false,false,false); RESC();
  { float sacc=pB0[0]+pB0[1]; _Pragma("unroll") for(int r=2;r<16;++r)sacc+=pB0[r]; _Pragma("unroll") for(int r=0;r<16;++r)sacc+=pB1[r]; l_reg+=sacc;
    pw0=(u32x4){PKW(pB0,0),PKW(pB0,2),PKW(pB0,4),PKW(pB0,6)};pw1=(u32x4){PKW(pB0,8),PKW(pB0,10),PKW(pB0,12),PKW(pB0,14)};pw2=(u32x4){PKW(pB1,0),PKW(pB1,2),PKW(pB1,4),PKW(pB1,6)};pw3=(u32x4){PKW(pB1,8),PKW(pB1,10),PKW(pB1,12),PKW(pB1,14)};
    SBAR(); pv(o,vb0+sl_cur,PAF(0),PAF(1),PAF(2),PAF(3)); }
  #undef PKW
  #undef PAF
  #undef VFR
  #undef PIN
  #undef MX3
  #undef GAPA
  #undef GAPB
  #undef EX
  #undef VRD
  #undef KRD
  #undef STEP
  #undef ENDW
  {auto rr=__builtin_amdgcn_permlane32_swap(__float_as_uint(l_reg),__float_as_uint(l_reg),false,false);l_reg=__uint_as_float(rr[0])+__uint_as_float(rr[1]);}
  if(hi==0)wsf[32+r32]=l_reg;asm volatile("s_waitcnt lgkmcnt(0)":::"memory");
  float rli[16];
  #pragma unroll
  for(int r=0;r<16;++r)rli[r]=__builtin_amdgcn_rcpf(wsf[32+crow(r,hi)]);
  bf16*Ow=Ob+(long)(wid*QBLK)*QP;
  { bf16*stg=(bf16*)(shm+LDS_OST)+wid*2048;
    #pragma unroll
    for(int r=0;r<16;++r){const int orow=crow(r,hi);
      #pragma unroll
      for(int d0=0;d0<2;++d0)stg[orow*64+d0*32+r32]=__float2bfloat16(o[d0][r]*rli[r]);}
    asm volatile("s_waitcnt lgkmcnt(0)":::"memory");
    #pragma unroll
    for(int i=0;i<4;++i){const int row=i*8+(lane>>3),ch=lane&7; const u32x4 v=*(const u32x4*)(stg+row*64+ch*8); ATTN_STORE16(Ow+(long)row*QP+ch*8,v);} }
  asm volatile("s_waitcnt lgkmcnt(0)\n\ts_barrier":::"memory");
  #undef DMA_K
  #undef DMA_V
  #undef CMASK
  #undef KT
  #undef CINIT
  #undef NEGM_SET
  #undef START
  #undef RESC
  #undef ROT
}
constexpr int ATTN_LDS_BYTES=LDS_BYTES;
#undef SBAR
#undef WAIT_BAR
}
__device__ __forceinline__ void attn_dispatch(KAP ap, int l, int uid, int wid, char* shm) {
    using namespace attn_body;
    unsigned char* ws = ap->ws;
    const int r32 = lane_id() & 31;
    const bf16* Qa = (const bf16*)(ws + WS_Q);
    UnitCtx uc; uc.toff = 0; uc.qpos0 = 0; uc.gr = 0; uc.rs = 0; uc.qc = 0; uc.vm = 0u; uc.sink2 = -INFINITY;
    if (uid < 384) {
        const int qb = uid & 31, bh = uid >> 5, b = bh / 6, h = bh % 6;
        const bf16* Qb = Qa + (size_t)(b * SEQ + qb * 256) * QW + (6 + h) * 64;
        const size_t ko = (size_t)b * KEYS * 256 + 128 + (h / 3) * 64;
        attn_unit<256, 256, 0, 8>(Qb, (const bf16*)(ws + WS_KAB) + ko, (const bf16*)(ws + WS_VTAB) + ko, (bf16*)Qb, KEYS / 64, uc, shm, wid);
    } else if (uid < 768) {
        const int u = uid - 384, qb = u & 31, bh = u >> 5, b = bh / 6, h = bh % 6;
        const bf16* Qb = Qa + (size_t)(b * SEQ + qb * 256) * QW + (12 + h) * 64;
        const size_t ko = (size_t)b * KEYS * 384 + h * 64;
        int klo = 4 * qb - 4; klo = klo < 0 ? 0 : (klo > 120 ? 120 : klo);
        int khi = 4 * qb + 3 - 4; khi = (khi < 0 ? 0 : (khi > 120 ? 120 : khi)) + 7;
        const int cnt = khi - klo + 1;
        uc.toff = klo; uc.gr = 4 * qb + (wid >> 1); uc.rs = uc.gr - 4 < 0 ? 0 : (uc.gr - 4 > 120 ? 120 : uc.gr - 4);
        uc.qc = 32 * (wid & 1) + r32;
        { const int wsn = uc.qc - 8 < 0 ? 0 : (uc.qc - 8 > 48 ? 48 : uc.qc - 8), hi = (lane_id() >> 5) & 1; unsigned vm = 0u;
#pragma unroll
          for (int r = 0; r < 16; ++r) { const int kc = (r & 3) + 8 * (r >> 2) + 4 * hi; if (kc >= wsn && kc < wsn + 16) vm |= 1u << r; if (kc + 32 >= wsn && kc + 32 < wsn + 16) vm |= 1u << (16 + r); }
          uc.vm = vm; }
        { const float* rpb = ap->in[12] + (size_t)(l * 6 + h) * 465; float* bl = (float*)(shm + BIAS_OFF); const int tb = tid_of(wid); if (tb < 465) bl[tb] = rpb[tb] * LOG2E; }
        attn_unit<384, 384, 2, 8>(Qb, (const bf16*)(ws + WS_KC) + ko, (const bf16*)(ws + WS_VTC) + ko, (bf16*)Qb, 4 + cnt + (cnt & 1), uc, shm, wid);
    } else if (uid < 1152) {
        const int u = uid - 768, qb = u & 31, bh = u >> 5, b = bh / 6, h = bh % 6;
        const bf16* Qb = Qa + (size_t)(b * SEQ + qb * 256) * QW + h * 64;
        const size_t ko = (size_t)b * KEYS * 256 + (h / 3) * 64;
        const int tlo = 4 * qb - 2 < 0 ? 0 : 4 * qb - 2, thi = 4 * qb + 5 > 127 ? 127 : 4 * qb + 5;
        uc.toff = tlo; uc.qpos0 = 256 * qb + 32 * wid + r32; uc.sink2 = ap->in[9][l * 6 + h] * LOG2E;
        attn_unit<256, 256, 1, 8>(Qb, (const bf16*)(ws + WS_KAB) + ko, (const bf16*)(ws + WS_VTAB) + ko, (bf16*)Qb, 4 + thi - tlo + 1, uc, shm, wid);
    } else {
        const int v = uid - 1152, type = v / 12, b = (v / 6) % 2, h = v % 6;
        const bf16* Qb = Qa + (size_t)(MLAT + b * LCTX) * QW + (type * 6 + h) * 64;
        if (type == 2) {
            const size_t ko = (size_t)b * KEYS * 384 + h * 64;
            attn_unit<384, 384, 0, 8>(Qb, (const bf16*)(ws + WS_KC) + ko, (const bf16*)(ws + WS_VTC) + ko, (bf16*)Qb, 4, uc, shm, wid);
        } else {
            const size_t ko = (size_t)b * KEYS * 256 + type * 128 + (h / 3) * 64;
            if (type == 0) uc.sink2 = ap->in[9][l * 6 + h] * LOG2E;
            attn_unit<256, 256, 0, 8>(Qb, (const bf16*)(ws + WS_KAB) + ko, (const bf16*)(ws + WS_VTAB) + ko, (bf16*)Qb, 4, uc, shm, wid);
        }
    }
}

#define XB_TMO      128
#define XB_XCNT(j)  (256  + 64 * (j))
#define XB_XSUB(j)  (1280 + 64 * (j))
#define XB_XGEN(j)  (2304 + 64 * (j))
#define XB_TOP      3328
#define XB_TOPGEN   3392
#define XCD_BAR_WORDS 3456
#define XB_SPIN_CAP (1u << 18)

__device__ __forceinline__ unsigned xb_ld(unsigned* p)              { return __hip_atomic_load(p, __ATOMIC_RELAXED, __HIP_MEMORY_SCOPE_AGENT); }
__device__ __forceinline__ unsigned xb_add(unsigned* p, unsigned v) { return __hip_atomic_fetch_add(p, v, __ATOMIC_RELAXED, __HIP_MEMORY_SCOPE_AGENT); }
__device__ __forceinline__ unsigned xb_xcc_id() { return (unsigned)__builtin_amdgcn_s_getreg((3 << 11) | 20) & 0xFu; }
#define XB_SPIN(cond, bar) do { unsigned _sp = 0; while (cond) { __builtin_amdgcn_s_sleep(1); \
    if ((++_sp & 255u) == 0u) { if (xb_ld(&(bar)[XB_TMO])) break; if (_sp > XB_SPIN_CAP) { atomicAdd(&(bar)[XB_TMO], 1u); break; } } } } while (0)

struct XcdBarrier {
    unsigned* bar; unsigned x;
    volatile __attribute__((address_space(3))) unsigned* st;
};

__device__ __forceinline__ XcdBarrier xcd_barrier_post(unsigned* bar, volatile __attribute__((address_space(3))) unsigned* st, bool leader) {
    XcdBarrier b; b.bar = bar; b.x = xb_xcc_id(); b.st = st;
    if (leader) (void)xb_add(&bar[XB_XCNT(b.x)], 1u);
    return b;
}
__device__ __forceinline__ void xcd_barrier_complete(unsigned* bar, unsigned x, unsigned& nloc, unsigned& nx) {
    const unsigned G = gridDim.x * gridDim.y * gridDim.z;
    unsigned sum, cnt, mine, sp = 0u;
    for (;;) {
        sum = 0u; cnt = 0u; mine = 0u;
#pragma unroll
        for (unsigned j = 0; j < 16; ++j) { const unsigned c = xb_ld(&bar[XB_XCNT(j)]); sum += c; cnt += (c > 0u) ? 1u : 0u; mine = (j == x) ? c : mine; }
        if (sum == G) break;
        __builtin_amdgcn_s_sleep(1);
        if ((++sp & 255u) == 0u) { if (xb_ld(&bar[XB_TMO])) break; if (sp > XB_SPIN_CAP) { atomicAdd(&bar[XB_TMO], 1u); break; } }
    }
    nloc = mine > 0u ? mine : 1u; nx = cnt > 0u ? cnt : 1u;
}

__device__ __forceinline__ void xcd_barrier(const XcdBarrier& b, bool leader) {
    asm volatile("s_waitcnt vmcnt(0)" ::: "memory");
    __syncthreads();
    if (leader) {
        unsigned* bar = b.bar;
        __builtin_amdgcn_s_waitcnt(0);
        unsigned nloc = b.st[0], nx = b.st[1];
        if (nloc == 0u) { xcd_barrier_complete(bar, b.x, nloc, nx); b.st[0] = nloc; b.st[1] = nx; }
        const unsigned old = xb_add(&bar[XB_XSUB(b.x)], 1u);
        const unsigned gen = old / nloc;
        if (old + 1u == (gen + 1u) * nloc) {
            __builtin_amdgcn_fence(__ATOMIC_RELEASE, "agent");
            asm volatile("s_waitcnt vmcnt(0)" ::: "memory");
            const unsigned og = xb_add(&bar[XB_TOP], 1u);
            const unsigned tg = og / nx;
            if (og + 1u == (tg + 1u) * nx) xb_add(&bar[XB_TOPGEN], 1u);
            else XB_SPIN(xb_ld(&bar[XB_TOPGEN]) == tg, bar);
            __builtin_amdgcn_fence(__ATOMIC_ACQUIRE, "agent");
            xb_add(&bar[XB_XGEN(b.x)], 1u);
            asm volatile("s_waitcnt vmcnt(0)" ::: "memory");
        } else {
            XB_SPIN(xb_ld(&bar[XB_XGEN(b.x)]) == gen, bar);
            __builtin_amdgcn_fence(__ATOMIC_ACQUIRE, "agent");
            asm volatile("s_waitcnt vmcnt(0)" ::: "memory");
        }
    }
    __syncthreads();
}
__global__ void __launch_bounds__(512, 2) fwd_mega(Args a) {
    extern __shared__ __attribute__((aligned(16))) unsigned char lds_raw[];
    cg::grid_group grid = cg::this_grid();
    PG8_LAS unsigned char* lds = (PG8_LAS unsigned char*)lds_raw;
    const int wave = __builtin_amdgcn_readfirstlane((int)threadIdx.x >> 6);
    const int tid = tid_of(wave);
    const int G = gridDim.x, gw = blockIdx.x * 8 + wave, NGW = G * 8;
#define LANE() ({ int l_ = lane_id(); asm volatile("" : "+v"(l_)); l_; })
#define LEADER() (wave == 0 && lane_id() == 0)
#define WSP() ((unsigned char*)KARGS()->ws)
#define MODS() ((float*)(WSP() + WS_MODS))
#define CTL() ((unsigned*)(WSP() + WS_CTL))
    volatile LAS unsigned* MISC = (volatile LAS unsigned*)((LAS unsigned char*)lds_raw + 131072);
    if (tid < 64) MISC[tid] = 0u;
    __syncthreads();
    { const XcdBarrier xb0 = xcd_barrier_post(CTL() + 4096, MISC + 8, LEADER()); (void)xb0; }
#if PROBE_MASK
    if (blockIdx.x == 0 && tid == 0) { const unsigned long long now = __builtin_amdgcn_s_memrealtime(); MISC[18] = (unsigned)now; MISC[19] = (unsigned)(now >> 32); }
#define TSTAMP(id) do { if (blockIdx.x == 0 && LEADER()) { const unsigned long long now_ = __builtin_amdgcn_s_memrealtime(); const unsigned long long st_ = ((unsigned long long)MISC[19] << 32) | MISC[18]; \
        if ((PROBE_MASK >> (id)) & 1) { const unsigned long long ac_ = (((unsigned long long)MISC[17] << 32) | MISC[16]) + (now_ - st_); MISC[16] = (unsigned)ac_; MISC[17] = (unsigned)(ac_ >> 32); } \
        MISC[18] = (unsigned)now_; MISC[19] = (unsigned)(now_ >> 32); } } while (0)
#else
#define TSTAMP(id) do {} while (0)
#endif
#define GRID_BAR() do { XcdBarrier xb_; xb_.bar = CTL() + 4096; xb_.x = xb_xcc_id(); xb_.st = MISC + 8; xcd_barrier(xb_, LEADER()); } while (0)

    conv_weights(KARGS(), 0, (LAS unsigned char*)lds_raw, gw, NGW, wave, LANE());
    ada_phase(KARGS(), gw, NGW, LANE());
    if (blockIdx.x == 0) {
        float* rope = (float*)(WSP() + WS_ROPE);
        for (int i = tid; i < 128 * 16; i += 512) { const int pos = i >> 4, f = i & 15; const float fr = powf(10000.0f, -(float)f / 16.0f); const float ang = (float)pos * fr; float s, c; sincosf(ang, &s, &c); rope[2 * i] = c; rope[2 * i + 1] = s; }
    }
    grid.sync(); TSTAMP(0);
    { KAP ap = KARGS();
      row_phase(gw, NGW, LANE(), MALL, nullptr, nullptr, nullptr, 0, ap->in[0], ap->in[2], nullptr, nullptr,
              (bf16_t*)(WSP() + WS_R1), ap->in[6], MODS(), 0, 1024); }
    GRID_BAR(); TSTAMP(1);

    {
        constexpr int l = 0;
        const bool last = (l == DEPTH - 1);
        const int MX = last ? MLAT : MALL;
        int bidl = blockIdx.x, Gl = gridDim.x; asm volatile("" : "+s"(bidl), "+s"(Gl));
#define MODL() (MODS() + (size_t)l * 3 * 6144)
        {
            pg8::Gemm g{(const bf16_t*)(WSP() + WS_R1), (const bf16_t*)(WSP() + WS_WIN), MALL, NINP, DM, DM, DM, 0, 0};
            pg8::StaticOrder S; S.init(MALL, NINP, Gl, bidl);
            KAP ap = KARGS();
            EpiProj E{(bf16_t*)(WSP() + WS_Q), (bf16_t*)(WSP() + WS_KAB), (bf16_t*)(WSP() + WS_KC), (bf16_t*)(WSP() + WS_VTAB), (bf16_t*)(WSP() + WS_VTC), (bf16_t*)(WSP() + WS_PG),
                      (const float*)(WSP() + WS_ROPE), ap->in[10] + l * 64, ap->in[11] + l * 64};
            pg8::gemm_phase<EpiProj, pg8::StaticOrder, true, true>(lds, g, S, E, wave);
        }
        GRID_BAR(); TSTAMP(2);
        {
            KAP ap = KARGS();
            const int nunit = 1152 + (last ? 0 : 36);
            unsigned* ctr = CTL() + 64 * l;
            for (;;) {
                if (LEADER()) MISC[24] = atomicAdd(ctr, 1u);
                __syncthreads();
                const int uid = (int)MISC[24];
                __syncthreads();
                if (uid >= nunit) break;
                attn_dispatch(ap, l, uid, wave, (char*)lds_raw);
            }
        }
        GRID_BAR(); TSTAMP(4);
        {
            pg8::Gemm g{(const bf16_t*)(WSP() + WS_Q), (const bf16_t*)(WSP() + WS_WBR), MX, DM, QW, QW, QW, 0, 0};
            pg8::StaticOrder S; S.init(MX, DM, Gl, bidl);
            EpiGateSum E{(bf16_t*)(WSP() + WS_PG)};
            pg8::gemm_phase<EpiGateSum, pg8::StaticOrder, true, true, 6>(lds, g, S, E, wave);
        }
        GRID_BAR(); TSTAMP(5);
        {
            pg8::Gemm g{(const bf16_t*)(WSP() + WS_PG), (const bf16_t*)(WSP() + WS_WOUT), MX, DM, DM, 3072, DM, 0, 0};
            pg8::StaticOrder S; S.init(MX, DM, Gl, bidl);
            EpiBf16<0> E{(bf16_t*)(WSP() + WS_Y), DM};
            pg8::gemm_phase<EpiBf16<0>, pg8::StaticOrder, true, true>(lds, g, S, E, wave);
        }
        GRID_BAR(); TSTAMP(6);
        { KAP ap = KARGS();
          row_phase(gw, NGW, LANE(), MX, (const bf16_t*)(WSP() + WS_Y), ap->in[7] + l * DM, MODL(), 2048,
                  l == 0 ? ap->in[0] : ap->out, l == 0 ? ap->in[2] : (const float*)(WSP() + WS_XC), ap->out, (float*)(WSP() + WS_XC),
                  (bf16_t*)(WSP() + WS_Q), ap->in[17] + l * DM, MODL(), 3072, 4096); }
        GRID_BAR(); TSTAMP(7);
        {
            pg8::Gemm g{(const bf16_t*)(WSP() + WS_Q), (const bf16_t*)(WSP() + WS_W1), MX, FF, DM, DM, DM, 0, 0};
            pg8::StaticOrder S; S.init(MX, FF, Gl, bidl);
            EpiBf16<1> E{(bf16_t*)(WSP() + WS_A), FF};
            pg8::gemm_phase<EpiBf16<1>, pg8::StaticOrder, true, true>(lds, g, S, E, wave);
        }
        GRID_BAR(); TSTAMP(8);
        {
            pg8::Gemm g{(const bf16_t*)(WSP() + WS_A), (const bf16_t*)(WSP() + WS_W2), MX, DM, FF, FF, FF, 0, 0};
            pg8::StaticOrder S; S.init(MX, DM, Gl, bidl);
            EpiBf16<0> E{(bf16_t*)(WSP() + WS_Y2), DM};
            pg8::gemm_phase<EpiBf16<0>, pg8::StaticOrder, true, true>(lds, g, S, E, wave);
        }
        GRID_BAR(); TSTAMP(9);
        if (!last) {
            { KAP ap = KARGS();
              row_phase(gw, NGW, LANE(), MX, (const bf16_t*)(WSP() + WS_Y2), ap->in[18] + l * DM, MODL(), 5120,
                      ap->out, (const float*)(WSP() + WS_XC), ap->out, (float*)(WSP() + WS_XC),
                      (bf16_t*)(WSP() + WS_R1), ap->in[6] + (l + 1) * DM, MODL() + 3 * 6144, 0, 1024); }
            conv_weights(KARGS(), l + 1, (LAS unsigned char*)lds_raw, gw, NGW, wave, LANE());
            GRID_BAR(); TSTAMP(10);
        } else {
            { KAP ap = KARGS();
              row_phase(gw, NGW, LANE(), MX, (const bf16_t*)(WSP() + WS_Y2), ap->in[18] + l * DM, MODL(), 5120,
                      ap->out, (const float*)(WSP() + WS_XC), ap->out, (float*)(WSP() + WS_XC),
                      nullptr, nullptr, nullptr, 0, 0); }
            TSTAMP(10);
        }
    }
    {
        constexpr int l = 1;
        const bool last = (l == DEPTH - 1);
        const int MX = last ? MLAT : MALL;
        int bidl = blockIdx.x, Gl = gridDim.x; asm volatile("" : "+s"(bidl), "+s"(Gl));
#define MODL() (MODS() + (size_t)l * 3 * 6144)
        {
            pg8::Gemm g{(const bf16_t*)(WSP() + WS_R1), (const bf16_t*)(WSP() + WS_WIN), MALL, NINP, DM, DM, DM, 0, 0};
            pg8::StaticOrder S; S.init(MALL, NINP, Gl, bidl);
            KAP ap = KARGS();
            EpiProj E{(bf16_t*)(WSP() + WS_Q), (bf16_t*)(WSP() + WS_KAB), (bf16_t*)(WSP() + WS_KC), (bf16_t*)(WSP() + WS_VTAB), (bf16_t*)(WSP() + WS_VTC), (bf16_t*)(WSP() + WS_PG),
                      (const float*)(WSP() + WS_ROPE), ap->in[10] + l * 64, ap->in[11] + l * 64};
            pg8::gemm_phase<EpiProj, pg8::StaticOrder, true, true>(lds, g, S, E, wave);
        }
        GRID_BAR(); TSTAMP(2);
        {
            KAP ap = KARGS();
            const int nunit = 1152 + (last ? 0 : 36);
            unsigned* ctr = CTL() + 64 * l;
            for (;;) {
                if (LEADER()) MISC[24] = atomicAdd(ctr, 1u);
                __syncthreads();
                const int uid = (int)MISC[24];
                __syncthreads();
                if (uid >= nunit) break;
                attn_dispatch(ap, l, uid, wave, (char*)lds_raw);
            }
        }
        GRID_BAR(); TSTAMP(4);
        {
            pg8::Gemm g{(const bf16_t*)(WSP() + WS_Q), (const bf16_t*)(WSP() + WS_WBR), MX, DM, QW, QW, QW, 0, 0};
            pg8::StaticOrder S; S.init(MX, DM, Gl, bidl);
            EpiGateSum E{(bf16_t*)(WSP() + WS_PG)};
            pg8::gemm_phase<EpiGateSum, pg8::StaticOrder, true, true, 6>(lds, g, S, E, wave);
        }
        GRID_BAR(); TSTAMP(5);
        {
            pg8::Gemm g{(const bf16_t*)(WSP() + WS_PG), (const bf16_t*)(WSP() + WS_WOUT), MX, DM, DM, 3072, DM, 0, 0};
            pg8::StaticOrder S; S.init(MX, DM, Gl, bidl);
            EpiBf16<0> E{(bf16_t*)(WSP() + WS_Y), DM};
            pg8::gemm_phase<EpiBf16<0>, pg8::StaticOrder, true, true>(lds, g, S, E, wave);
        }
        GRID_BAR(); TSTAMP(6);
        { KAP ap = KARGS();
          row_phase(gw, NGW, LANE(), MX, (const bf16_t*)(WSP() + WS_Y), ap->in[7] + l * DM, MODL(), 2048,
                  l == 0 ? ap->in[0] : ap->out, l == 0 ? ap->in[2] : (const float*)(WSP() + WS_XC), ap->out, (float*)(WSP() + WS_XC),
                  (bf16_t*)(WSP() + WS_Q), ap->in[17] + l * DM, MODL(), 3072, 4096); }
        GRID_BAR(); TSTAMP(7);
        {
            pg8::Gemm g{(const bf16_t*)(WSP() + WS_Q), (const bf16_t*)(WSP() + WS_W1), MX, FF, DM, DM, DM, 0, 0};
            pg8::StaticOrder S; S.init(MX, FF, Gl, bidl);
            EpiBf16<1> E{(bf16_t*)(WSP() + WS_A), FF};
            pg8::gemm_phase<EpiBf16<1>, pg8::StaticOrder, true, true>(lds, g, S, E, wave);
        }
        GRID_BAR(); TSTAMP(8);
        {
            pg8::Gemm g{(const bf16_t*)(WSP() + WS_A), (const bf16_t*)(WSP() + WS_W2), MX, DM, FF, FF, FF, 0, 0};
            pg8::StaticOrder S; S.init(MX, DM, Gl, bidl);
            EpiBf16<0> E{(bf16_t*)(WSP() + WS_Y2), DM};
            pg8::gemm_phase<EpiBf16<0>, pg8::StaticOrder, true, true>(lds, g, S, E, wave);
        }
        GRID_BAR(); TSTAMP(9);
        if (!last) {
            { KAP ap = KARGS();
              row_phase(gw, NGW, LANE(), MX, (const bf16_t*)(WSP() + WS_Y2), ap->in[18] + l * DM, MODL(), 5120,
                      ap->out, (const float*)(WSP() + WS_XC), ap->out, (float*)(WSP() + WS_XC),
                      (bf16_t*)(WSP() + WS_R1), ap->in[6] + (l + 1) * DM, MODL() + 3 * 6144, 0, 1024); }
            conv_weights(KARGS(), l + 1, (LAS unsigned char*)lds_raw, gw, NGW, wave, LANE());
            GRID_BAR(); TSTAMP(10);
        } else {
            { KAP ap = KARGS();
              row_phase(gw, NGW, LANE(), MX, (const bf16_t*)(WSP() + WS_Y2), ap->in[18] + l * DM, MODL(), 5120,
                      ap->out, (const float*)(WSP() + WS_XC), ap->out, (float*)(WSP() + WS_XC),
                      nullptr, nullptr, nullptr, 0, 0); }
            TSTAMP(10);
        }
    }
#if PROBE_MASK
    if (blockIdx.x == 0 && LEADER()) {
        const unsigned long long t0 = __builtin_amdgcn_s_memrealtime(); const unsigned long long ac = ((unsigned long long)MISC[17] << 32) | MISC[16];
        while (__builtin_amdgcn_s_memrealtime() - t0 < 4ull * ac) __builtin_amdgcn_s_sleep(32);
    }
#endif
}

extern "C" void kernel_launch(void* const* d_in, const int* in_sizes, int n_in, void* d_out, int out_size, void* d_ws, size_t ws_size, hipStream_t stream) {
    static int grid = 0;
    if (grid == 0) {
        if (n_in != 21 || out_size != MLAT * DM || ws_size < WS_END) { fprintf(stderr, "kernel_launch: unexpected shapes (n_in %d, out %d, ws %zu need %zu)\n", n_in, out_size, ws_size, (size_t)WS_END); grid = -1; return; }
        int dev = 0, cus = 0, per_cu = 0;
        if (hipGetDevice(&dev) != hipSuccess || hipDeviceGetAttribute(&cus, hipDeviceAttributeMultiprocessorCount, dev) != hipSuccess) { grid = -1; return; }
        if (hipFuncSetAttribute((const void*)fwd_mega, hipFuncAttributeMaxDynamicSharedMemorySize, LDS_BYTES) != hipSuccess) { fprintf(stderr, "kernel_launch: hipFuncSetAttribute failed\n"); grid = -1; return; }
        if (hipOccupancyMaxActiveBlocksPerMultiprocessor(&per_cu, (const void*)fwd_mega, 512, LDS_BYTES) != hipSuccess || per_cu < 1) { fprintf(stderr, "kernel_launch: occupancy query says %d blocks per CU\n", per_cu); grid = -1; return; }
        grid = cus;
    }
    if (grid < 0) return;
    (void)hipMemsetAsync((char*)d_ws + WS_CTL, 0, CTL_ZERO_BYTES, stream);
    Args a{};
    for (int i = 0; i < 21; ++i) a.in[i] = (const float*)d_in[i];
    a.out = (float*)d_out; a.ws = (unsigned char*)d_ws;
    void* args[] = {&a};
    hipError_t e = hipLaunchCooperativeKernel((const void*)fwd_mega, dim3(grid), dim3(512), args, LDS_BYTES, stream);
    if (e != hipSuccess) fprintf(stderr, "cooperative launch failed: %s (grid %d)\n", hipGetErrorString(e), grid);
}
```

```cpp
#include <hip/hip_runtime.h>
#include <hip/hip_cooperative_groups.h>
#include <cstdio>
#include <cstdint>
namespace cg = cooperative_groups;
#ifndef PROBE_MASK
#define PROBE_MASK 0
#endif

__device__ __forceinline__ int lane_id() { int l; asm volatile("v_mbcnt_lo_u32_b32 %0, -1, 0\n\tv_mbcnt_hi_u32_b32 %0, -1, %0" : "=v"(l)); return l; }
__device__ __forceinline__ int tid_of(int wave) { int t = wave * 64 + lane_id(); asm volatile("" : "+v"(t)); return t; }
namespace pg8 {
#define PG8_LAS __attribute__((address_space(3)))
typedef unsigned short bf16_t;
typedef short bf16x8 __attribute__((ext_vector_type(8)));
typedef float f32x4 __attribute__((ext_vector_type(4)));
typedef unsigned u32x4 __attribute__((ext_vector_type(4)));
constexpr int BM = 256, BK = 64, HALF = 128, HTB = HALF * BK * 2, STAGE_BYTES = 8 * HTB, NXCD = 8, WGM = 8;

__host__ __device__ __forceinline__ int lds_byte(int r, int c) { const int st = (r >> 4) * 2 + (c >> 5), rr = r & 15, cc = c & 31, ob = rr * 64 + cc * 2; return st * 1024 + (ob ^ (((ob >> 9) & 1) << 5)); }
__host__ __device__ __forceinline__ void stage_rc(int b, int& R, int& C) { const int st = b / 1024, sb = b % 1024, swz = sb ^ (((sb >> 9) & 1) << 5); R = (st >> 1) * 16 + swz / 64; C = (st & 1) * 32 + (swz % 64) / 2; }
__host__ __device__ __forceinline__ int perm32(int rho) { const int n = rho >> 4, i = rho & 15; return 8 * (i >> 2) + 4 * n + (i & 3); }

struct Unit { int pm, pn; };
struct Gemm { const bf16_t* A; const bf16_t* Bt; int M, N, K, lda, ldb, a_split; size_t a_stride; };

struct StaticOrder {
    int nM, nN, nwg, G, c;
    __host__ __device__ void init(int M, int N, int G_, int c_) { nM = M / BM; nN = N / BM; nwg = nM * nN; G = G_; c = c_; }
    __host__ __device__ bool next(int i, Unit& u) const {
        const long L = (long)i * G + c; if (L >= nwg) return false;
        int wgid = (int)L; { const int q = nwg / NXCD, r = nwg % NXCD, xcd = wgid % NXCD, off = wgid / NXCD; wgid = (xcd < r ? xcd * (q + 1) : r * (q + 1) + (xcd - r) * q) + off; }
        const int nig = WGM * nN, gid = wgid / nig, fm = gid * WGM, gsz = (nM - fm) < WGM ? (nM - fm) : WGM;
        u.pm = fm + ((wgid % nig) % gsz); u.pn = (wgid % nig) / gsz; return true;
    }
};

__device__ __forceinline__ unsigned cvt_pk_bf16(float lo, float hi) { unsigned r; asm volatile("v_cvt_pk_bf16_f32 %0, %1, %2" : "=v"(r) : "v"(lo), "v"(hi)); return r; }


template <class Epi, class Sched, bool ALIGN_EPI = false, bool SP2 = false, int SEG = 0>
__device__ __forceinline__ void gemm_phase(PG8_LAS unsigned char* lds, const Gemm g, const Sched& S, const Epi& E, int wave_id) {
    const int tid = tid_of(wave_id), wid = wave_id, lane = tid & 63, wr = wid >> 2, wc = wid & 3, fr = lane & 15, fq = lane >> 4;
    const int K = g.K, nt = K / BK;
    unsigned voffA[2], voffB[2];
#pragma unroll
    for (int i = 0; i < 2; ++i) { int R, C; stage_rc(tid * 16 + i * 8192, R, C); const int Rb = Epi::PERM ? ((R & ~31) + perm32(R & 31)) : R;
        voffA[i] = (unsigned)(R * g.lda + C) * 2u; voffB[i] = (unsigned)(Rb * g.ldb + C) * 2u; }
    const size_t kstep = (size_t)(BK * 2);
    const size_t hstepA = (size_t)HALF * g.lda * 2, hstepB = (size_t)HALF * g.ldb * 2;
    const size_t tstepA = 2 * hstepA, tstepB = 2 * hstepB;
    const unsigned ldsw = (unsigned)wid * 1024u;
    const int aoff = lds_byte(wr * 64 + fr, fq * 8), boff = lds_byte(wc * 32 + fr, fq * 8);
#define PG8_SA(b, h) (((b) * 2 + (h)) * HTB)
#define PG8_SB(b, h) ((4 + (b) * 2 + (h)) * HTB)
#define PG8_STAGE(bufoff, gbase, voff) do { _Pragma("unroll") for (int _i = 0; _i < 2; ++_i) \
        __builtin_amdgcn_global_load_lds((const unsigned*)((const char*)(gbase) + (voff)[_i]), (PG8_LAS unsigned*)(lds + (bufoff) + ldsw + _i * 8192), 16, 0, 0); } while (0)
#define PG8_LDA(dst, b, h) do { _Pragma("unroll") for (int m = 0; m < 4; ++m) _Pragma("unroll") for (int k = 0; k < 2; ++k) dst[m][k] = *(const PG8_LAS bf16x8*)(lds + PG8_SA(b, h) + aoff + m * 2048 + k * 1024); } while (0)
#define PG8_LDB(dst, b, h) do { _Pragma("unroll") for (int n = 0; n < 2; ++n) _Pragma("unroll") for (int k = 0; k < 2; ++k) dst[n][k] = *(const PG8_LAS bf16x8*)(lds + PG8_SB(b, h) + boff + n * 2048 + k * 1024); } while (0)
#define PG8_MMA(ai, bj, At, Bt) do { __builtin_amdgcn_s_setprio(1); _Pragma("unroll") for (int m = 0; m < 4; ++m) _Pragma("unroll") for (int n = 0; n < 2; ++n) _Pragma("unroll") for (int k = 0; k < 2; ++k) \
        acc[ai][bj][m][n] = __builtin_amdgcn_mfma_f32_16x16x32_bf16(Bt[n][k], At[m][k], acc[ai][bj][m][n], 0, 0, 0); __builtin_amdgcn_s_setprio(0); } while (0)
#define PG8_WAIT_V(n) asm volatile("s_waitcnt vmcnt(" #n ")" ::: "memory")
#define PG8_WAIT_L(n) asm volatile("s_waitcnt lgkmcnt(" #n ")" ::: "memory")
#define PG8_BAR __builtin_amdgcn_s_barrier()
#define PG8_SCHED __builtin_amdgcn_sched_barrier(0)
#define PG8_ABASE(u) ((const char*)g.A + (size_t)(u).pm * tstepA + (g.a_split ? (size_t)((u).pn / g.a_split) * g.a_stride : (size_t)0))
    Unit cur, nxt; int ui = 0;
    if (!S.next(0, cur)) return;
    f32x4 acc[2][2][4][2];
#pragma unroll
    for (int a = 0; a < 2; ++a)
#pragma unroll
        for (int b = 0; b < 2; ++b)
#pragma unroll
            for (int m = 0; m < 4; ++m)
#pragma unroll
                for (int n = 0; n < 2; ++n) acc[a][b][m][n] = (f32x4){0.f, 0.f, 0.f, 0.f};
    bf16x8 At[4][2], B0[2][2], B1[2][2];
    const char* cA = PG8_ABASE(cur); const char* cB = (const char*)g.Bt + (size_t)cur.pn * tstepB;
    if constexpr (SP2) {
        PG8_STAGE(PG8_SB(0, 0), cB, voffB); PG8_STAGE(PG8_SB(0, 1), cB + hstepB, voffB); PG8_STAGE(PG8_SA(0, 0), cA, voffA); PG8_STAGE(PG8_SA(0, 1), cA + hstepA, voffA);
        if (wr == 1) PG8_BAR;
        PG8_WAIT_V(2); PG8_BAR;
        PG8_STAGE(PG8_SB(1, 0), cB + kstep, voffB); PG8_STAGE(PG8_SA(1, 0), cA + kstep, voffA); PG8_STAGE(PG8_SB(1, 1), cB + hstepB + kstep, voffB);
        PG8_WAIT_V(6); PG8_BAR;
    } else {
        PG8_STAGE(PG8_SB(0, 0), cB, voffB); PG8_STAGE(PG8_SA(0, 0), cA, voffA); PG8_STAGE(PG8_SB(0, 1), cB + hstepB, voffB); PG8_STAGE(PG8_SA(0, 1), cA + hstepA, voffA);
        if (wr == 1) PG8_BAR;
        PG8_WAIT_V(4); PG8_BAR;
        PG8_STAGE(PG8_SB(1, 0), cB + kstep, voffB); PG8_STAGE(PG8_SA(1, 0), cA + kstep, voffA); PG8_STAGE(PG8_SB(1, 1), cB + hstepB + kstep, voffB);
        PG8_WAIT_V(6); PG8_BAR;
    }
    for (;;) {
        const bool has_next = S.next(ui + 1, nxt);
        const char* nA = has_next ? PG8_ABASE(nxt) : cA; const char* nB = has_next ? (const char*)g.Bt + (size_t)nxt.pn * tstepB : cB;
#pragma unroll 1
        for (int t = 0; t < nt; t += 2) {
            const bool last = (t == nt - 2);
            const char* a1 = cA + (size_t)(t + 1) * kstep;
            const char* a2 = last ? nA : cA + (size_t)(t + 2) * kstep; const char* b2 = last ? nB : cB + (size_t)(t + 2) * kstep;
            const char* a3 = a2 + kstep; const char* b3 = b2 + kstep;
            if constexpr (SP2) {
            PG8_LDB(B0, 0, 0); PG8_LDB(B1, 0, 1); PG8_SCHED; PG8_LDA(At, 0, 0); PG8_STAGE(PG8_SA(1, 1), a1 + hstepA, voffA);
            PG8_WAIT_V(8); PG8_WAIT_L(0); PG8_BAR; PG8_MMA(0, 0, At, B0); PG8_MMA(0, 1, At, B1); PG8_BAR; PG8_SCHED;
            PG8_LDA(At, 0, 1); PG8_STAGE(PG8_SB(0, 0), b2, voffB); PG8_STAGE(PG8_SB(0, 1), b2 + hstepB, voffB); PG8_STAGE(PG8_SA(0, 0), a2, voffA);
            PG8_WAIT_V(8); PG8_WAIT_L(0); PG8_BAR; PG8_MMA(1, 0, At, B0); PG8_MMA(1, 1, At, B1); PG8_BAR; PG8_SCHED;
            PG8_LDB(B0, 1, 0); PG8_LDB(B1, 1, 1); PG8_SCHED; PG8_LDA(At, 1, 0); PG8_STAGE(PG8_SA(0, 1), a2 + hstepA, voffA);
            PG8_WAIT_V(8); PG8_WAIT_L(0); PG8_BAR; PG8_MMA(0, 0, At, B0); PG8_MMA(0, 1, At, B1); PG8_BAR; PG8_SCHED;
            PG8_LDA(At, 1, 1); PG8_STAGE(PG8_SB(1, 0), b3, voffB); PG8_STAGE(PG8_SB(1, 1), b3 + hstepB, voffB); PG8_STAGE(PG8_SA(1, 0), a3, voffA);
            PG8_WAIT_V(8); PG8_WAIT_L(0); PG8_BAR; PG8_MMA(1, 0, At, B0); PG8_MMA(1, 1, At, B1); PG8_BAR; PG8_SCHED;
            } else {
            PG8_LDB(B0, 0, 0); PG8_SCHED; PG8_LDA(At, 0, 0); PG8_STAGE(PG8_SA(1, 1), a1 + hstepA, voffA);
            PG8_WAIT_L(8); PG8_BAR; PG8_WAIT_L(0); PG8_MMA(0, 0, At, B0); PG8_BAR; PG8_SCHED;
            PG8_LDB(B1, 0, 1); PG8_STAGE(PG8_SB(0, 0), b2, voffB);
            PG8_BAR; PG8_WAIT_L(0); PG8_MMA(0, 1, At, B1); PG8_BAR;
            PG8_LDA(At, 0, 1); PG8_STAGE(PG8_SA(0, 0), a2, voffA);
            PG8_BAR; PG8_WAIT_L(0); PG8_MMA(1, 0, At, B0); PG8_BAR; PG8_SCHED;
            PG8_STAGE(PG8_SB(0, 1), b2 + hstepB, voffB);
            PG8_WAIT_V(6); PG8_BAR; PG8_MMA(1, 1, At, B1); PG8_BAR;
            PG8_LDB(B0, 1, 0); PG8_SCHED; PG8_LDA(At, 1, 0); PG8_STAGE(PG8_SA(0, 1), a2 + hstepA, voffA);
            PG8_WAIT_L(8); PG8_BAR; PG8_WAIT_L(0); PG8_MMA(0, 0, At, B0); PG8_BAR; PG8_SCHED;
            PG8_LDB(B1, 1, 1); PG8_STAGE(PG8_SB(1, 0), b3, voffB);
            PG8_BAR; PG8_WAIT_L(0); PG8_MMA(0, 1, At, B1); PG8_BAR;
            PG8_LDA(At, 1, 1); PG8_STAGE(PG8_SA(1, 0), a3, voffA);
            PG8_BAR; PG8_WAIT_L(0); PG8_MMA(1, 0, At, B0); PG8_BAR; PG8_SCHED;
            PG8_STAGE(PG8_SB(1, 1), b3 + hstepB, voffB);
            PG8_WAIT_V(6); PG8_BAR; PG8_MMA(1, 1, At, B1); PG8_BAR;
            }
            if constexpr (SEG > 0) {
                if (!last && (t + 2) % SEG == 0) E.segment(acc, (t + 2) / SEG - 1, cur, wr, wc, fr, fq);
            }
        }
        if constexpr (ALIGN_EPI) { if (wr == 0) PG8_BAR; }
        E(acc, cur, wr, wc, fr, fq);
        if (!has_next) break;
#pragma unroll
        for (int a = 0; a < 2; ++a)
#pragma unroll
            for (int b = 0; b < 2; ++b)
#pragma unroll
                for (int m = 0; m < 4; ++m)
#pragma unroll
                    for (int n = 0; n < 2; ++n) acc[a][b][m][n] = (f32x4){0.f, 0.f, 0.f, 0.f};
        cur = nxt; cA = nA; cB = nB; ++ui;
        if constexpr (ALIGN_EPI) { if (wr == 1) PG8_BAR; }
    }
    PG8_WAIT_V(0);
    if constexpr (!ALIGN_EPI) { if (wr == 0) PG8_BAR; }
    PG8_BAR;
#undef PG8_SA
#undef PG8_SB
#undef PG8_STAGE
#undef PG8_LDA
#undef PG8_LDB
#undef PG8_MMA
#undef PG8_WAIT_V
#undef PG8_WAIT_L
#undef PG8_BAR
#undef PG8_SCHED
#undef PG8_ABASE
}
}

using pg8::bf16_t; using pg8::f32x4; using pg8::u32x4; using pg8::Unit; using pg8::cvt_pk_bf16;
typedef short bf16x8 __attribute__((ext_vector_type(8)));
typedef float f32x16 __attribute__((ext_vector_type(16)));
typedef unsigned u32x2 __attribute__((ext_vector_type(2)));
#define LAS __attribute__((address_space(3)))

constexpr int DM = 1024, SEQ = 8192, NB = 2, LCTX = 256, DEPTH = 2;
constexpr int MLAT = NB * SEQ;
constexpr int MALL = MLAT + NB * LCTX;
constexpr int KEYS = LCTX + SEQ;
constexpr int NIN = 5504, NINP = 5632;
constexpr int FF = 4096;
constexpr int QW = 1152;
constexpr float EPS = 1e-6f;
constexpr float LOG2E = 1.4426950408889634f;
constexpr float QSCALE = 0.125f * LOG2E;

constexpr size_t MiB = 1u << 20;
constexpr size_t WS_CTL = 0, CTL_ZERO_BYTES = 256 * 1024;
constexpr size_t WS_MODS = 64 * 1024;
constexpr size_t WS_ROPE = 256 * 1024;
constexpr size_t WS_XC = 1 * MiB;
constexpr size_t WS_WIN = 4 * MiB;
constexpr size_t WS_WBR = WS_WIN + 11 * MiB;
constexpr size_t WS_WOUT = WS_WBR + 9 * MiB / 4;
constexpr size_t WS_W1 = WS_WOUT + 6 * MiB;
constexpr size_t WS_W2 = WS_W1 + 8 * MiB;
constexpr size_t WS_R1 = 40 * MiB;
constexpr size_t WS_KAB = WS_R1 + 33 * MiB;
constexpr size_t WS_KC = WS_KAB + (size_t)NB * KEYS * 256 * 2;
constexpr size_t WS_VTAB = WS_KC + (size_t)NB * KEYS * 384 * 2;
constexpr size_t WS_VTC = WS_VTAB + (size_t)NB * 4 * 64 * KEYS * 2;
constexpr size_t WS_PG = WS_VTC + (size_t)NB * 6 * 64 * KEYS * 2;
constexpr size_t WS_Q = WS_PG + (size_t)MALL * 3072 * 2;
constexpr size_t WS_VB = WS_Q + (size_t)MALL * QW * 2;
constexpr size_t WS_END = WS_VB + (size_t)NB * KEYS * 128 * 2;
constexpr size_t WS_Y = WS_R1;
constexpr size_t WS_A = WS_R1;
constexpr size_t WS_Y2 = WS_A + (size_t)MALL * FF * 2;
static_assert(WS_W2 + 8 * MiB <= WS_R1, "weights");
static_assert(WS_Y + (size_t)MALL * DM * 4 <= WS_PG, "Y overlay");
static_assert(WS_A + (size_t)MALL * FF * 2 <= WS_Q, "A overlay");
static_assert(WS_Y2 + (size_t)MALL * DM * 4 <= WS_END && WS_END <= 256 * MiB, "ws map");

constexpr int LDS_BYTES = 147456;

struct EpiProj {
    static constexpr bool PERM = true;
    bf16_t *Q, *KAB, *KC, *VAB, *VC, *PG; const float *rope, *qn, *kn;
    __device__ __forceinline__ void operator()(const f32x4 (&acc)[2][2][4][2], const Unit& u, int wr, int wc, int fr, int fq) const {
        const int pm = u.pm, hu = 4 * u.pn + wc;
        if (hu >= 86) return;
        const bool lat = pm < 64; int kroff;
        if (lat) { const int b = pm >> 5; kroff = 256 * b + 256; } else { const int b = pm - 64; kroff = -MLAT + SEQ * b; }
        const int row0 = pm * 256 + wr * 64 + fr;
        int pitch, col, radd = 0; bf16_t* base; bool norm = false, rot = false, scl = false; const float* gn = qn;
        if (hu >= 38) { base = PG; pitch = 3072; col = (hu - 38) * 64; }
        else if (hu < 6) { base = Q; pitch = QW; col = hu * 64; rot = true; scl = true; }
        else if (hu < 8) { base = KAB; pitch = 256; col = (hu - 6) * 64; radd = kroff; rot = true; }
        else if (hu < 10) { base = VAB; pitch = 256; col = (hu - 8) * 64; radd = kroff; }
        else if (hu < 16) { base = Q; pitch = QW; col = 384 + (hu - 10) * 64; norm = true; rot = true; scl = true; }
        else if (hu < 18) { base = KAB; pitch = 256; col = 128 + (hu - 16) * 64; radd = kroff; norm = true; rot = true; gn = kn; }
        else if (hu < 20) { base = VAB; pitch = 256; col = 128 + (hu - 18) * 64; radd = kroff; }
        else if (hu < 26) { base = Q; pitch = QW; col = 768 + (hu - 20) * 64; scl = true; }
        else if (hu < 32) { base = KC; pitch = 384; col = (hu - 26) * 64; radd = kroff; }
        else { base = VC; pitch = 384; col = (hu - 32) * 64; radd = kroff; }
        rot = rot && lat;
        bf16_t* pb = base + (size_t)(row0 + radd) * pitch + col + 8 * fq;
        f32x4 g0 = {1.f, 1.f, 1.f, 1.f}, g1 = g0, g2 = g0, g3 = g0;
        if (norm) { g0 = *(const f32x4*)(gn + 8 * fq); g1 = *(const f32x4*)(gn + 8 * fq + 4); g2 = *(const f32x4*)(gn + 32 + 8 * fq); g3 = *(const f32x4*)(gn + 32 + 8 * fq + 4); }
        const float sc = scl ? QSCALE : 1.0f;
#pragma unroll
        for (int ai = 0; ai < 2; ++ai)
#pragma unroll
            for (int m = 0; m < 4; ++m) {
                f32x4 a0 = acc[ai][0][m][0], a1 = acc[ai][0][m][1], b0 = acc[ai][1][m][0], b1 = acc[ai][1][m][1];
                if (norm) {
                    float ss = (a0[0] * a0[0] + a0[1] * a0[1]) + (a0[2] * a0[2] + a0[3] * a0[3]) + (a1[0] * a1[0] + a1[1] * a1[1]) + (a1[2] * a1[2] + a1[3] * a1[3])
                             + (b0[0] * b0[0] + b0[1] * b0[1]) + (b0[2] * b0[2] + b0[3] * b0[3]) + (b1[0] * b1[0] + b1[1] * b1[1]) + (b1[2] * b1[2] + b1[3] * b1[3]);
                    ss += __shfl_xor(ss, 16); ss += __shfl_xor(ss, 32);
                    const float rstd = rsqrtf(ss * (1.f / 64.f) + EPS);
                    a0 = a0 * rstd * g0; a1 = a1 * rstd * g1; b0 = b0 * rstd * g2; b1 = b1 * rstd * g3;
                }
                if (rot) {
                    const int sp = (row0 + ai * 128 + m * 16) & (SEQ - 1);
                    const float* tr = rope + ((sp >> 6) * 16 + 4 * fq) * 2; const float* tc = rope + ((sp & 63) * 16 + 4 * fq) * 2;
                    const f32x4 r0 = *(const f32x4*)tr, r1 = *(const f32x4*)(tr + 4), c0 = *(const f32x4*)tc, c1 = *(const f32x4*)(tc + 4);
                    a0 = (f32x4){a0[0] * r0[0] - a0[1] * r0[1], a0[0] * r0[1] + a0[1] * r0[0], a0[2] * r0[2] - a0[3] * r0[3], a0[2] * r0[3] + a0[3] * r0[2]};
                    a1 = (f32x4){a1[0] * r1[0] - a1[1] * r1[1], a1[0] * r1[1] + a1[1] * r1[0], a1[2] * r1[2] - a1[3] * r1[3], a1[2] * r1[3] + a1[3] * r1[2]};
                    b0 = (f32x4){b0[0] * c0[0] - b0[1] * c0[1], b0[0] * c0[1] + b0[1] * c0[0], b0[2] * c0[2] - b0[3] * c0[3], b0[2] * c0[3] + b0[3] * c0[2]};
                    b1 = (f32x4){b1[0] * c1[0] - b1[1] * c1[1], b1[0] * c1[1] + b1[1] * c1[0], b1[2] * c1[2] - b1[3] * c1[3], b1[2] * c1[3] + b1[3] * c1[2]};
                }
                a0 = a0 * sc; a1 = a1 * sc; b0 = b0 * sc; b1 = b1 * sc;
                u32x4 w0, w1; w0.x = cvt_pk_bf16(a0[0], a0[1]); w0.y = cvt_pk_bf16(a0[2], a0[3]); w0.z = cvt_pk_bf16(a1[0], a1[1]); w0.w = cvt_pk_bf16(a1[2], a1[3]);
                w1.x = cvt_pk_bf16(b0[0], b0[1]); w1.y = cvt_pk_bf16(b0[2], b0[3]); w1.z = cvt_pk_bf16(b1[0], b1[1]); w1.w = cvt_pk_bf16(b1[2], b1[3]);
                bf16_t* p = pb + (size_t)(ai * 128 + m * 16) * pitch;
                *(u32x4*)p = w0; *(u32x4*)(p + 32) = w1;
                if (rot && (m & 1)) asm volatile("" ::: "memory");
            }
    }
};
__device__ __forceinline__ float bf2f(unsigned h) { return __uint_as_float(h << 16); }
struct EpiGateSum {
    static constexpr bool PERM = true;
    bf16_t* PG;
    static __device__ __forceinline__ float ex(float g) { return __builtin_amdgcn_exp2f(fminf(-LOG2E * g, 80.f)); }
    static __device__ __forceinline__ void ratio2(unsigned gq, unsigned gn, float& a0, float& a1) {
        a0 *= (1.0f + ex(bf2f(gn & 0xffffu))) * __builtin_amdgcn_rcpf(1.0f + ex(bf2f(gq & 0xffffu)));
        a1 *= (1.0f + ex(bf2f(gn >> 16))) * __builtin_amdgcn_rcpf(1.0f + ex(bf2f(gq >> 16)));
    }
    __device__ __forceinline__ void segment(f32x4 (&acc)[2][2][4][2], int br, const Unit& u, int wr, int wc, int fr, int fq) const {
        const int row0 = u.pm * 256 + wr * 64 + fr, col0 = u.pn * 256 + wc * 32 + 8 * fq;
        const bf16_t* pb = PG + (size_t)row0 * 3072 + col0 + br * 1024;
#pragma unroll
        for (int ai = 0; ai < 2; ++ai) {
            u32x4 gq[8], gn[8];
#pragma unroll
            for (int q = 0; q < 8; ++q) { const int m = q >> 1, bj = q & 1;
                const bf16_t* p = pb + (size_t)(ai * 128 + m * 16) * 3072 + bj * 128;
                gq[q] = *(const u32x4*)p; gn[q] = *(const u32x4*)(p + 1024); }
#pragma unroll
            for (int q = 0; q < 8; ++q) { const int m = q >> 1, bj = q & 1;
                f32x4& v0 = acc[ai][bj][m][0]; f32x4& v1 = acc[ai][bj][m][1];
                float t0 = v0[0], t1 = v0[1], t2 = v0[2], t3 = v0[3], t4 = v1[0], t5 = v1[1], t6 = v1[2], t7 = v1[3];
                ratio2(gq[q].x, gn[q].x, t0, t1); ratio2(gq[q].y, gn[q].y, t2, t3); ratio2(gq[q].z, gn[q].z, t4, t5); ratio2(gq[q].w, gn[q].w, t6, t7);
                v0 = (f32x4){t0, t1, t2, t3}; v1 = (f32x4){t4, t5, t6, t7}; }
            asm volatile("" ::: "memory");
        }
    }
    static __device__ __forceinline__ unsigned fin2(unsigned g, float a0, float a1) {
        return cvt_pk_bf16(a0 * __builtin_amdgcn_rcpf(1.0f + ex(bf2f(g & 0xffffu))), a1 * __builtin_amdgcn_rcpf(1.0f + ex(bf2f(g >> 16))));
    }
    __device__ __forceinline__ void operator()(const f32x4 (&acc)[2][2][4][2], const Unit& u, int wr, int wc, int fr, int fq) const {
        const int row0 = u.pm * 256 + wr * 64 + fr, col0 = u.pn * 256 + wc * 32 + 8 * fq;
        bf16_t* pb = PG + (size_t)row0 * 3072 + col0;
        u32x4 gq[16];
#pragma unroll
        for (int q = 0; q < 16; ++q) { const int ai = q >> 3, m = (q >> 1) & 3, bj = q & 1; gq[q] = *(const u32x4*)(pb + (size_t)(ai * 128 + m * 16) * 3072 + bj * 128 + 2048); }
#pragma unroll
        for (int q = 0; q < 16; ++q) { const int ai = q >> 3, m = (q >> 1) & 3, bj = q & 1;
            const f32x4 v0 = acc[ai][bj][m][0], v1 = acc[ai][bj][m][1];
            u32x4 w; w.x = fin2(gq[q].x, v0[0], v0[1]); w.y = fin2(gq[q].y, v0[2], v0[3]); w.z = fin2(gq[q].z, v1[0], v1[1]); w.w = fin2(gq[q].w, v1[2], v1[3]);
            *(u32x4*)(pb + (size_t)(ai * 128 + m * 16) * 3072 + bj * 128) = w; }
    }
};
template <int ACT  > struct EpiBf16 {
    static constexpr bool PERM = true;
    bf16_t* O; int ldc;
    __device__ __forceinline__ void operator()(const f32x4 (&acc)[2][2][4][2], const Unit& u, int wr, int wc, int fr, int fq) const {
        const int row0 = u.pm * 256 + wr * 64 + fr, col0 = u.pn * 256 + wc * 32 + 8 * fq;
#pragma unroll
        for (int ai = 0; ai < 2; ++ai)
#pragma unroll
            for (int m = 0; m < 4; ++m)
#pragma unroll
                for (int bj = 0; bj < 2; ++bj) {
                    f32x4 v0 = acc[ai][bj][m][0], v1 = acc[ai][bj][m][1];
                    if (ACT == 1) {
#pragma unroll
                        for (int e = 0; e < 4; ++e) { const float a = fmaxf(v0[e], 0.f), c = fmaxf(v1[e], 0.f); v0[e] = a * a; v1[e] = c * c; }
                    }
                    u32x4 w; w.x = cvt_pk_bf16(v0[0], v0[1]); w.y = cvt_pk_bf16(v0[2], v0[3]); w.z = cvt_pk_bf16(v1[0], v1[1]); w.w = cvt_pk_bf16(v1[2], v1[3]);
                    *(u32x4*)(O + (size_t)(row0 + ai * 128 + m * 16) * ldc + col0 + bj * 128) = w;
                }
    }
};
struct EpiF32 {
    static constexpr bool PERM = true;
    float* O; int ldc;
    __device__ __forceinline__ void operator()(const f32x4 (&acc)[2][2][4][2], const Unit& u, int wr, int wc, int fr, int fq) const {
        const int row0 = u.pm * 256 + wr * 64 + fr, col0 = u.pn * 256 + wc * 32 + 8 * fq;
#pragma unroll
        for (int ai = 0; ai < 2; ++ai)
#pragma unroll
            for (int m = 0; m < 4; ++m)
#pragma unroll
                for (int bj = 0; bj < 2; ++bj) {
                    float* p = O + (size_t)(row0 + ai * 128 + m * 16) * ldc + col0 + bj * 128;
                    *(f32x4*)p = acc[ai][bj][m][0]; *(f32x4*)(p + 4) = acc[ai][bj][m][1];
                }
    }
};

__device__ __forceinline__ float wave_sum(float v) {
#pragma unroll
    for (int o = 1; o < 64; o <<= 1) v += __shfl_xor(v, o);
    return v;
}
__device__ __forceinline__ unsigned f2bf(float f) { unsigned u = __builtin_bit_cast(unsigned, f); return (u + 0x7fffu + ((u >> 16) & 1u)) >> 16; }
__device__ __forceinline__ unsigned pk2(float lo, float hi) { return f2bf(lo) | (f2bf(hi) << 16); }

__device__ __forceinline__ void transpose_item(const float* W, int K, int N, bf16_t* WT, int ldk, int row_off, int copies, int copy_stride, LAS float* scr, int item, int lane, bool headperm = false) {
    const int nblk = N / 32, kb = item / nblk, nb = item % nblk, k0 = 64 * kb, n0 = 32 * nb;
    const int r0 = headperm ? 256 * (nb >> 3) + 128 * (nb & 1) + 32 * ((nb & 7) >> 1) : n0;
#pragma unroll 8
    for (int i = 0; i < 32; ++i) { const int kk = 2 * i + (lane >> 5); scr[kk * 33 + (lane & 31)] = W[(size_t)(k0 + kk) * N + n0 + (lane & 31)]; }
    asm volatile("s_waitcnt lgkmcnt(0)" ::: "memory");
    const int c = lane & 7;
#pragma unroll
    for (int j = 0; j < 4; ++j) { const int n = (lane >> 3) + 8 * j; const LAS float* s = scr + (8 * c) * 33 + n;
        u32x4 o; o.x = pk2(s[0 * 33], s[1 * 33]); o.y = pk2(s[2 * 33], s[3 * 33]); o.z = pk2(s[4 * 33], s[5 * 33]); o.w = pk2(s[6 * 33], s[7 * 33]);
        for (int cc = 0; cc < copies; ++cc) *(u32x4*)(WT + (size_t)(row_off + r0 + n) * ldk + cc * copy_stride + k0 + 8 * c) = o; }
    asm volatile("s_waitcnt lgkmcnt(0)" ::: "memory");
}

struct Args { const float* in[21]; float* out; unsigned char* ws; int pad0, pad1; };
typedef const __attribute__((address_space(4))) Args* KAP;
#define KARGS() ({ KAP p_ = (KAP)__builtin_amdgcn_kernarg_segment_ptr(); asm volatile("" : "+s"(p_)); p_; })

__device__ __forceinline__ void conv_weights(KAP ap, int l, LAS unsigned char* lds, int gw, int NGW, int wave, int lane) {
    unsigned char* ws = ap->ws;
    LAS float* scr = (LAS float*)(lds + wave * 16384);
    constexpr int I_IN = 16 * (NIN / 32), I_BR = 6 * 32, I_OUT = 16 * 32, I_1 = 16 * (FF / 32), I_2 = (FF / 64) * 32;
    constexpr int NITEMS = I_IN + 3 * I_BR + I_OUT + I_1 + I_2;
    for (int it = gw; it < NITEMS; it += NGW) {
        int r = it;
        if (r < I_IN) { transpose_item(ap->in[8] + (size_t)l * DM * NIN, DM, NIN, (bf16_t*)(ws + WS_WIN), DM, 0, 1, 0, scr, r, lane, true); continue; } r -= I_IN;
        if (r < I_BR) { transpose_item(ap->in[13] + (size_t)l * 384 * DM, 384, DM, (bf16_t*)(ws + WS_WBR), 1152, 0, 1, 0, scr, r, lane); continue; } r -= I_BR;
        if (r < I_BR) { transpose_item(ap->in[14] + (size_t)l * 384 * DM, 384, DM, (bf16_t*)(ws + WS_WBR) + 384, 1152, 0, 1, 0, scr, r, lane); continue; } r -= I_BR;
        if (r < I_BR) { transpose_item(ap->in[15] + (size_t)l * 384 * DM, 384, DM, (bf16_t*)(ws + WS_WBR) + 768, 1152, 0, 1, 0, scr, r, lane); continue; } r -= I_BR;
        if (r < I_OUT) { transpose_item(ap->in[16] + (size_t)l * DM * DM, DM, DM, (bf16_t*)(ws + WS_WOUT), DM, 0, 1, 0, scr, r, lane); continue; } r -= I_OUT;
        if (r < I_1) { transpose_item(ap->in[19] + (size_t)l * DM * FF, DM, FF, (bf16_t*)(ws + WS_W1), DM, 0, 1, 0, scr, r, lane); continue; } r -= I_1;
        transpose_item(ap->in[20] + (size_t)l * FF * DM, FF, DM, (bf16_t*)(ws + WS_W2), FF, 0, 1, 0, scr, r, lane);
    }
    unsigned z0 = 0u; asm volatile("" : "+v"(z0));
    for (int i = gw * 64 + lane; i < (NINP - NIN) * DM * 2 / 16; i += NGW * 64) {
        const int prow = i / (DM * 2 / 16), pc = i % (DM * 2 / 16);
        const int row = 21 * 256 + (prow >> 6) * 128 + 64 + (prow & 63);
        *((u32x4*)(ws + WS_WIN + (size_t)row * DM * 2) + pc) = (u32x4){z0, z0, z0, z0};
    }
}

__device__ __forceinline__ void ada_phase(KAP ap, int gw, int NGW, int lane) {
    float* mods = (float*)(ap->ws + WS_MODS);
    const float* c = ap->in[1]; const float* cc = ap->in[3];
    for (int t = gw; t < DEPTH * 32 * 24; t += NGW) {
        const int l = t / (32 * 24), kc = (t / 24) % 32, jc = t % 24, col = jc * 256 + lane * 4;
        const int kk = kc * 32 + (lane & 31);
        const float x0 = c[kk], x1 = c[DM + kk], x2 = cc[kk];
        const float a0 = x0 / (1.f + __expf(-x0)), a1 = x1 / (1.f + __expf(-x1)), a2 = x2 / (1.f + __expf(-x2));
        const float* W = ap->in[4] + ((size_t)l * DM + kc * 32) * 6144 + col;
        f32x4 s0 = {0.f, 0.f, 0.f, 0.f}, s1 = s0, s2 = s0;
#pragma unroll
        for (int k = 0; k < 32; ++k) {
            const f32x4 w = *(const f32x4*)(W + (size_t)k * 6144);
            const float b0 = __int_as_float(__builtin_amdgcn_readlane(__float_as_int(a0), k)), b1 = __int_as_float(__builtin_amdgcn_readlane(__float_as_int(a1), k)), b2 = __int_as_float(__builtin_amdgcn_readlane(__float_as_int(a2), k));
            s0 += w * b0; s1 += w * b1; s2 += w * b2;
            if ((k & 15) == 15) asm volatile("" ::: "memory");
        }
        if (kc == 0) { const f32x4 bb = *(const f32x4*)(ap->in[5] + (size_t)l * 6144 + col); s0 += bb; s1 += bb; s2 += bb; }
        float* m0 = mods + (size_t)(l * 3) * 6144 + col;
#pragma unroll
        for (int e = 0; e < 4; ++e) { atomicAdd(m0 + e, s0[e]); atomicAdd(m0 + 6144 + e, s1[e]); atomicAdd(m0 + 2 * 6144 + e, s2[e]); }
    }
}

__device__ __forceinline__ void row_phase(int gw, int NGW, int lane, int nrows, const bf16_t* Y, const float* gainY, const float* modsG, int gate_off,
                                          const float* rin_lat, const float* rin_ctx, float* rout_lat, float* rout_ctx,
                                          bf16_t* H, const float* gainH, const float* modsH, int shift_off, int scale_off) {
    for (int m = 2 * gw; m < nrows; m += 2 * NGW) {
        const int v = m < MLAT ? (m >> 13) : 2;
        const size_t roff = m < MLAT ? (size_t)m * DM : (size_t)(m - MLAT) * DM;
        const f32x4* xr = (const f32x4*)((m < MLAT ? rin_lat : rin_ctx) + roff) + lane;
        f32x4 x[2][4];
#pragma unroll
        for (int u = 0; u < 2; ++u)
#pragma unroll
            for (int j = 0; j < 4; ++j) x[u][j] = xr[256 * u + 64 * j];
        if (Y) {
            const u32x2* yr = (const u32x2*)(Y + (size_t)m * DM) + lane;
            u32x2 yw[2][4];
#pragma unroll
            for (int u = 0; u < 2; ++u)
#pragma unroll
                for (int j = 0; j < 4; ++j) yw[u][j] = yr[256 * u + 64 * j];
            const f32x4* gy = (const f32x4*)gainY + lane; const f32x4* gt = (const f32x4*)(modsG + (size_t)v * 6144 + gate_off) + lane;
            f32x4* ro = (f32x4*)((m < MLAT ? rout_lat : rout_ctx) + roff) + lane;
#pragma unroll
            for (int u = 0; u < 2; ++u) {
                f32x4 y[4]; float ss = 0.f;
#pragma unroll
                for (int j = 0; j < 4; ++j) { y[j] = (f32x4){bf2f(yw[u][j].x & 0xffffu), bf2f(yw[u][j].x >> 16), bf2f(yw[u][j].y & 0xffffu), bf2f(yw[u][j].y >> 16)}; ss += (y[j].x * y[j].x + y[j].y * y[j].y) + (y[j].z * y[j].z + y[j].w * y[j].w); }
                const float rstd = rsqrtf(wave_sum(ss) * (1.f / DM) + EPS);
#pragma unroll
                for (int j = 0; j < 4; ++j) { x[u][j] = x[u][j] + gt[64 * j] * (y[j] * rstd * gy[64 * j]); ro[256 * u + 64 * j] = x[u][j]; }
            }
        }
        if (H) {
            const f32x4* gh = (const f32x4*)gainH + lane; const f32x4* sh = (const f32x4*)(modsH + (size_t)v * 6144 + shift_off) + lane; const f32x4* sc = (const f32x4*)(modsH + (size_t)v * 6144 + scale_off) + lane;
            u32x2* ho = (u32x2*)(H + (size_t)m * DM) + lane;
#pragma unroll
            for (int u = 0; u < 2; ++u) {
                float ss = 0.f;
#pragma unroll
                for (int j = 0; j < 4; ++j) ss += (x[u][j].x * x[u][j].x + x[u][j].y * x[u][j].y) + (x[u][j].z * x[u][j].z + x[u][j].w * x[u][j].w);
                const float rstd = rsqrtf(wave_sum(ss) * (1.f / DM) + EPS);
#pragma unroll
                for (int j = 0; j < 4; ++j) { const f32x4 h = (x[u][j] * rstd * gh[64 * j]) * (sc[64 * j] + 1.0f) + sh[64 * j]; u32x2 w; w.x = pk2(h.x, h.y); w.y = pk2(h.z, h.w); ho[256 * u + 64 * j] = w; }
            }
        }
    }
}

#include <hip/hip_bf16.h>
#include <cmath>
namespace attn_body {
using bf16=__hip_bfloat16;
using bf16x8=__attribute__((ext_vector_type(8)))short;
using s16x4=__attribute__((ext_vector_type(4)))short;
using f32x16=__attribute__((ext_vector_type(16)))float;
using u32x4=__attribute__((ext_vector_type(4)))unsigned;
constexpr int D=64,QP=1152;
constexpr int BIAS_OFF=90112;
struct UnitCtx { int toff; int qpos0; int gr; int rs; int qc; unsigned vm; float sink2; };
constexpr int NW=8,QBLK=32,QB=QBLK*NW,KVBLK=64;
__device__ __forceinline__ int crow(int r,int hi){return (r&3)+8*(r>>2)+4*hi;}
#define SBAR() __builtin_amdgcn_sched_barrier(0)
constexpr int NSLOT=3, SLOTB=8192;
constexpr int LDS_K=0, LDS_V=NSLOT*SLOTB, LDS_WS=2*NSLOT*SLOTB, LDS_OST=LDS_WS+NW*64*4, LDS_BYTES=LDS_OST+NW*4096;
constexpr float C2=0.125f*1.4426950408889634f;
__device__ __forceinline__ void glds16(const void*gsrc,unsigned lds_dst){unsigned keep;
  asm volatile("s_mov_b32 %0, m0\n\ts_mov_b32 m0, %2\n\ts_nop 0\n\tglobal_load_lds_dwordx4 %1, off\n\ts_mov_b32 m0, %0":"=&s"(keep):"v"(gsrc),"s"(lds_dst):"memory");}
__device__ __forceinline__ float max3f(float a,float b,float c){float r;asm("v_max3_f32 %0, %1, %2, %3":"=v"(r):"v"(a),"v"(b),"v"(c));return r;}
__device__ __forceinline__ float max2f(float a,float b){float r;asm("v_max_f32_e32 %0, %1, %2":"=v"(r):"v"(a),"v"(b));return r;}
__device__ __forceinline__ float fadd_s(float a,float b){float r;asm("v_add_f32_e32 %0, %1, %2":"=v"(r):"v"(a),"v"(b));return r;}
__device__ __forceinline__ float fsub_s(float a,float b){float r;asm("v_sub_f32_e32 %0, %1, %2":"=v"(r):"v"(a),"v"(b));return r;}
typedef float f32x2_t __attribute__((ext_vector_type(2))); typedef __bf16 bf16x2_t __attribute__((ext_vector_type(2)));
__device__ __forceinline__ unsigned cvtpk_s(float lo,float hi){f32x2_t v={lo,hi};bf16x2_t b=__builtin_convertvector(v,bf16x2_t);return __builtin_bit_cast(unsigned,b);}
#define WAIT_BAR(N) asm volatile("s_waitcnt vmcnt(" #N ") lgkmcnt(0)\n\ts_barrier":::"memory")

__device__ __forceinline__ void qkt(f32x16&p0,f32x16&p1,const char*Kslot,const bf16x8*qr,int r32,int hi){ const f32x16 negm={};
  const char*kb=Kslot+hi*1024+r32*16;
  #pragma unroll
  for(int d0=0;d0<4;++d0){
    const bf16x8 b0=*reinterpret_cast<const bf16x8*>(kb+d0*2048);
    const bf16x8 b1=*reinterpret_cast<const bf16x8*>(kb+d0*2048+512);
    if(d0==0){p0=__builtin_amdgcn_mfma_f32_32x32x16_bf16(b0,qr[0],negm,0,0,0);p1=__builtin_amdgcn_mfma_f32_32x32x16_bf16(b1,qr[0],negm,0,0,0);}
    else{p0=__builtin_amdgcn_mfma_f32_32x32x16_bf16(b0,qr[d0],p0,0,0,0);p1=__builtin_amdgcn_mfma_f32_32x32x16_bf16(b1,qr[d0],p1,0,0,0);}}
}
typedef __attribute__((address_space(3))) const char* lds_cptr;
typedef short v4i16_t __attribute__((ext_vector_type(4)));
__device__ __forceinline__ void kload8(bf16x8*kf,lds_cptr kp){
  kf[0]=*(const __attribute__((address_space(3))) bf16x8*)(kp);      kf[1]=*(const __attribute__((address_space(3))) bf16x8*)(kp+512);
  kf[2]=*(const __attribute__((address_space(3))) bf16x8*)(kp+2048); kf[3]=*(const __attribute__((address_space(3))) bf16x8*)(kp+2560);
  kf[4]=*(const __attribute__((address_space(3))) bf16x8*)(kp+4096); kf[5]=*(const __attribute__((address_space(3))) bf16x8*)(kp+4608);
  kf[6]=*(const __attribute__((address_space(3))) bf16x8*)(kp+6144); kf[7]=*(const __attribute__((address_space(3))) bf16x8*)(kp+6656);
}
__device__ __forceinline__ void kload2(bf16x8*kf,lds_cptr kp,int j){ kf[2*j]=*(const __attribute__((address_space(3))) bf16x8*)(kp+j*2048); kf[2*j+1]=*(const __attribute__((address_space(3))) bf16x8*)(kp+j*2048+512); }
__device__ __forceinline__ s16x4 vtr(lds_cptr p){ return __builtin_bit_cast(s16x4,__builtin_amdgcn_ds_read_tr16_b64_v4i16((__attribute__((address_space(3))) v4i16_t*)p)); }
template<int MODE> __device__ __forceinline__ void amask(f32x16&c0,f32x16&c1,int t,const UnitCtx&uc,int hi,lds_cptr shm3){
  if(t<4)return;
  const float NEG=-INFINITY;
  if(MODE==1){ const int dq=64*(uc.toff+t-4)+4*hi-uc.qpos0;
    #pragma unroll
    for(int r=0;r<16;++r){ const int d=dq+(r&3)+8*(r>>2); if(d>128||d<-128)c0[r]=NEG; if(d+32>128||d+32<-128)c1[r]=NEG; } }
  else { const int kr=uc.toff+t-4;
    if(kr<uc.rs||kr>=uc.rs+8){
      #pragma unroll
      for(int r=0;r<16;++r){c0[r]=NEG;c1[r]=NEG;} }
    else { const __attribute__((address_space(3))) float*brow=(const __attribute__((address_space(3))) float*)(shm3+BIAS_OFF)+(kr-uc.gr+7)*31+15-uc.qc;
      unsigned vm=uc.vm; asm volatile("":"+v"(vm));
      #pragma unroll
      for(int r=0;r<16;++r){ const int kc=(r&3)+8*(r>>2)+4*hi; const float b0=brow[kc],b1=brow[kc+32];
        c0[r]=((vm>>r)&1u)?c0[r]+b0:NEG; c1[r]=((vm>>(16+r))&1u)?c1[r]+b1:NEG;
        if((r&3)==3)__builtin_amdgcn_sched_barrier(0); } } }
}
__device__ __forceinline__ float rowmax(const f32x16&p0,const f32x16&p1){
  float a=max3f(p0[0],p0[1],p1[0]),b=max3f(p0[2],p0[3],p1[1]);a=max3f(a,p1[2],p1[3]);
  #pragma unroll
  for(int r=4;r<16;r+=4){a=max3f(a,p0[r],p0[r+1]);b=max3f(b,p0[r+2],p0[r+3]);a=max3f(a,p1[r],p1[r+1]);b=max3f(b,p1[r+2],p1[r+3]);}
  const float m=max2f(a,b);
  auto rr=__builtin_amdgcn_permlane32_swap(__float_as_uint(m),__float_as_uint(m),false,false);
  return max2f(__uint_as_float(rr[0]),__uint_as_float(rr[1]));
}
__device__ __forceinline__ void pv(f32x16*o,int vb,bf16x8 pa0,bf16x8 pa1,bf16x8 pa2,bf16x8 pa3){
  #pragma unroll
  for(int d0=0;d0<2;++d0){s16x4 lo[4],hi[4];
    #pragma unroll
    for(int ks=0;ks<4;++ks){
      asm volatile("ds_read_b64_tr_b16 %0,%1 offset:%c2":"=&v"(lo[ks]):"v"(vb),"i"(d0*4096+ks*1024):"memory");
      asm volatile("ds_read_b64_tr_b16 %0,%1 offset:%c2":"=&v"(hi[ks]):"v"(vb),"i"(d0*4096+ks*1024+512):"memory");}
    asm volatile("s_waitcnt lgkmcnt(0)":::"memory");SBAR();
    #define PK(k) (bf16x8){lo[k][0],lo[k][1],lo[k][2],lo[k][3],hi[k][0],hi[k][1],hi[k][2],hi[k][3]}
    o[d0]=__builtin_amdgcn_mfma_f32_32x32x16_bf16(pa0,PK(0),o[d0],0,0,0);
    o[d0]=__builtin_amdgcn_mfma_f32_32x32x16_bf16(pa1,PK(1),o[d0],0,0,0);
    o[d0]=__builtin_amdgcn_mfma_f32_32x32x16_bf16(pa2,PK(2),o[d0],0,0,0);
    o[d0]=__builtin_amdgcn_mfma_f32_32x32x16_bf16(pa3,PK(3),o[d0],0,0,0);
    #undef PK
  }
}

#ifndef ATTN_STORE16
#define ATTN_STORE16(p,v) (*(u32x4*)(p)=(v))
#endif
template<int KP,int VP,int MODE,int THRL> __device__ __forceinline__ void attn_unit(const bf16*Qb,const bf16*__restrict__ Kh,const bf16*__restrict__ Vh,bf16*Ob,int NT,const UnitCtx uc,char*shm,int wave_id){
  const int tid=tid_of(wave_id),lane=tid&63,r32=lane&31,hi=lane>>5; const int wid=wave_id;
  const bf16*Qw=Qb+(long)(wid*QBLK)*QP;
  const unsigned lds0=(unsigned)(uintptr_t)shm;
  float*wsf=(float*)(shm+LDS_WS)+wid*64;
  const bf16*ksrc=Kh+(long)lane*KP+wid*8;
  const bf16*vsrc=Vh+(long)(16*(wid&3)+(lane>>2))*VP+(wid>>2)*32+(lane&3)*8;
  const unsigned kdst=lds0+LDS_K+wid*1024, vdst=lds0+LDS_V+wid*1024;
  #define KT(t) ((t)<4?(t):(t)+uc.toff)
  #define DMA_K(t,slot) glds16(ksrc+(long)KT(t)*KVBLK*KP,(unsigned)__builtin_amdgcn_readfirstlane(kdst+(slot)))
  #define DMA_V(t,slot) glds16(vsrc+(long)KT(t)*KVBLK*VP,(unsigned)__builtin_amdgcn_readfirstlane(vdst+(slot)))
  const int vb0=(int)(lds0+LDS_V)+((lane>>4)&1)*32+(lane&3)*8+(4*hi+((lane&15)>>2))*64;
  const char*Kbase=shm+LDS_K; bf16x8 kf[8];
  const lds_cptr shm3=(lds_cptr)shm; const lds_cptr kp0=shm3+LDS_K+hi*1024+r32*16; const lds_cptr vp0=shm3+LDS_V+((lane>>4)&1)*32+(lane&3)*8+(4*hi+((lane&15)>>2))*64;
  DMA_K(0,0);DMA_V(0,0);DMA_K(1,SLOTB);
  bf16x8 qr[4];
  #pragma unroll
  for(int d0=0;d0<4;++d0)qr[d0]=*reinterpret_cast<const bf16x8*>(&Qw[(long)r32*QP+d0*16+hi*8]);
  float mhat=0.f,l_reg=0.f;f32x16 o[2];o[0]=f32x16{};o[1]=f32x16{};
  constexpr bool NEGM=(MODE==0);
  f32x16 negm=f32x16{}; const f32x16 zero16=f32x16{}; if(NEGM)asm volatile("":"+v"(negm));
  #define CINIT (NEGM?negm:zero16)
  #define NEGM_SET() do{ if(NEGM){ _Pragma("unroll") for(int r_=0;r_<16;++r_)negm[r_]=-mhat; asm volatile("":"+v"(negm)); } }while(0)
  #define CMASK(P0,P1,t) do{ if(MODE!=0) amask<MODE>(P0,P1,(t),uc,hi,(lds_cptr)shm); }while(0)
  bool resc=false;
  #define START(P0,P1) do{ const float rm=rowmax(P0,P1); resc=false; \
    { const float dl=rm; mhat=fadd_s(mhat,dl); \
      _Pragma("unroll") for(int r=0;r<16;++r){P0[r]=fsub_s(P0[r],dl);P1[r]=fsub_s(P1[r],dl);} NEGM_SET(); } \
    _Pragma("unroll") for(int r=0;r<16;++r)P0[r]=__builtin_amdgcn_exp2f(P0[r]); }while(0)
  #define RESC() do{ if(resc){ asm volatile("s_waitcnt lgkmcnt(0)":::"memory"); \
      _Pragma("unroll") for(int d_=0;d_<2;++d_) _Pragma("unroll") for(int r=0;r<16;++r)o[d_][r]*=wsf[crow(r,hi)]; } }while(0)
  f32x16 pA0,pA1,pB0,pB1;
  int sl_prev=0,sl_cur=0,sl_next=SLOTB;
  #define ROT() do{sl_prev=sl_cur;sl_cur=sl_next;sl_next=(sl_next==(NSLOT-1)*SLOTB)?0:sl_next+SLOTB;}while(0)
  DMA_K(2,2*SLOTB);
  WAIT_BAR(3);
  qkt(pA0,pA1,Kbase,qr,r32,hi);asm volatile("s_nop 15\n\ts_nop 7":"+v"(pA0),"+v"(pA1));CMASK(pA0,pA1,0);
  START(pA0,pA1);
  if(uc.sink2>-1e30f){ l_reg=(hi==0)?__builtin_amdgcn_exp2f(uc.sink2-mhat):0.f; }
  _Pragma("unroll") for(int r=0;r<16;++r)pA1[r]=__builtin_amdgcn_exp2f(pA1[r]);
  WAIT_BAR(0);
  DMA_K(3,0);DMA_V(1,SLOTB);
  ROT();
  kload8(kf,kp0+sl_cur);
  WAIT_BAR(2);
  s16x4 vlo[8],vhi[8]; u32x4 pw0,pw1,pw2,pw3;
  #define PKW(P,B) cvtpk_s(P[B],P[B+1])
  #define PAF(k) __builtin_bit_cast(bf16x8,pw##k)
  #define VFR(i) (bf16x8){vlo[i][0],vlo[i][1],vlo[i][2],vlo[i][3],vhi[i][0],vhi[i][1],vhi[i][2],vhi[i][3]}
  #define PIN(x) asm volatile("":"+v"(x))
  #define MX3(a,b,c) __builtin_fmaxf(__builtin_fmaxf((a),(b)),(c))
  #define GAPA(MF,A0,A1,A2,A3,W0,W1,PW) do{ MF; sacc+=A0; sacc+=A1; sacc+=A2; sacc+=A3; PIN(sacc); W0; W1; PIN(PW); SBAR(); }while(0)
  #define EX(v) __builtin_amdgcn_exp2f(v)
  #define GAPB(MF,X,B) do{ MF; X[B]=EX(X[B]); X[B+1]=EX(X[B+1]); X[B+2]=EX(X[B+2]); X[B+3]=EX(X[B+3]); PIN(X); SBAR(); }while(0)
  #define VRD(i) do{ vlo[i]=vtr(vp_+(((i)>>2)*4096+((i)&3)*1024)); vhi[i]=vtr(vp_+(((i)>>2)*4096+((i)&3)*1024+512)); }while(0)
  #define KRD(G,j) do{ if(G){ kload2(kf,kp0+sl_next,j); SBAR(); } }while(0)
  #define STEP(C0,C1,P0,P1,t,GK,GV,GL) do{ SBAR(); \
    const lds_cptr vp_=vp0+sl_prev; \
    VRD(0); SBAR(); float sacc=(P0[0]+P0[1]); \
    GAPA(C0=__builtin_amdgcn_mfma_f32_32x32x16_bf16(kf[0],qr[0],CINIT,0,0,0), P0[2],P0[3],P0[4],P0[5],     pw0[0]=PKW(P0,0), pw0[1]=PKW(P0,2), pw0); \
    VRD(4); SBAR(); GAPA(C1=__builtin_amdgcn_mfma_f32_32x32x16_bf16(kf[1],qr[0],CINIT,0,0,0), P0[6],P0[7],P0[8],P0[9],     pw0[2]=PKW(P0,4), pw0[3]=PKW(P0,6), pw0); \
    VRD(1); SBAR(); GAPA(C0=__builtin_amdgcn_mfma_f32_32x32x16_bf16(kf[2],qr[1],C0,0,0,0),   P0[10],P0[11],P0[12],P0[13], pw1[0]=PKW(P0,8), pw1[1]=PKW(P0,10), pw1); \
    VRD(5); SBAR(); GAPA(C1=__builtin_amdgcn_mfma_f32_32x32x16_bf16(kf[3],qr[1],C1,0,0,0),   P0[14],P0[15],P1[0],P1[1],   pw1[2]=PKW(P0,12),pw1[3]=PKW(P0,14), pw1); \
    VRD(2); SBAR(); GAPA(C0=__builtin_amdgcn_mfma_f32_32x32x16_bf16(kf[4],qr[2],C0,0,0,0),   P1[2],P1[3],P1[4],P1[5],     pw2[0]=PKW(P1,0), pw2[1]=PKW(P1,2), pw2); \
    VRD(6); SBAR(); GAPA(C1=__builtin_amdgcn_mfma_f32_32x32x16_bf16(kf[5],qr[2],C1,0,0,0),   P1[6],P1[7],P1[8],P1[9],     pw2[2]=PKW(P1,4), pw2[3]=PKW(P1,6), pw2); \
    VRD(3); SBAR(); GAPA(C0=__builtin_amdgcn_mfma_f32_32x32x16_bf16(kf[6],qr[3],C0,0,0,0),   P1[10],P1[11],P1[12],P1[13], pw3[0]=PKW(P1,8), pw3[1]=PKW(P1,10), pw3); \
    VRD(7); SBAR(); GAPA(C1=__builtin_amdgcn_mfma_f32_32x32x16_bf16(kf[7],qr[3],C1,0,0,0),   P1[14],P1[15],0.f,0.f,       pw3[2]=PKW(P1,12),pw3[3]=PKW(P1,14), pw3); \
    l_reg+=sacc; \
    if(!NEGM){ _Pragma("unroll") for(int r=0;r<16;++r){C0[r]-=mhat;C1[r]-=mhat;} } \
    if(GK){DMA_K((t)+3,sl_cur);} if(GV){DMA_V((t)+1,sl_next);} \
    CMASK(C0,C1,t); \
    { float a=MX3(C0[0],C0[1],C1[0]),b=MX3(C0[2],C0[3],C1[1]); a=MX3(a,C1[2],C1[3]); \
      _Pragma("unroll") for(int r=4;r<16;r+=4){a=MX3(a,C0[r],C0[r+1]);b=MX3(b,C0[r+2],C0[r+3]);a=MX3(a,C1[r],C1[r+1]);b=MX3(b,C1[r+2],C1[r+3]);} \
      float rm=__builtin_fmaxf(a,b); { auto rr=__builtin_amdgcn_permlane32_swap(__float_as_uint(rm),__float_as_uint(rm),false,false); rm=__builtin_fmaxf(__uint_as_float(rr[0]),__uint_as_float(rr[1])); } \
      resc=false; \
      if(__builtin_expect(__any(rm>(float)THRL),0)){ const float dl=__builtin_fmaxf(rm,0.f); mhat+=dl; \
        _Pragma("unroll") for(int r=0;r<16;++r){C0[r]-=dl;C1[r]-=dl;} NEGM_SET(); \
        const float f=__builtin_amdgcn_exp2f(-dl); l_reg*=f; if(hi==0)wsf[r32]=f; resc=true; } } \
    SBAR(); \
    GAPB(o[0]=__builtin_amdgcn_mfma_f32_32x32x16_bf16(PAF(0),VFR(0),o[0],0,0,0), C0,0); \
    GAPB(o[1]=__builtin_amdgcn_mfma_f32_32x32x16_bf16(PAF(0),VFR(4),o[1],0,0,0), C0,4); \
    KRD(GL,0); GAPB(o[0]=__builtin_amdgcn_mfma_f32_32x32x16_bf16(PAF(1),VFR(1),o[0],0,0,0), C0,8); \
    KRD(GL,1); GAPB(o[1]=__builtin_amdgcn_mfma_f32_32x32x16_bf16(PAF(1),VFR(5),o[1],0,0,0), C0,12); \
    KRD(GL,2); GAPB(o[0]=__builtin_amdgcn_mfma_f32_32x32x16_bf16(PAF(2),VFR(2),o[0],0,0,0), C1,0); \
    KRD(GL,3); GAPB(o[1]=__builtin_amdgcn_mfma_f32_32x32x16_bf16(PAF(2),VFR(6),o[1],0,0,0), C1,4); \
    GAPB(o[0]=__builtin_amdgcn_mfma_f32_32x32x16_bf16(PAF(3),VFR(3),o[0],0,0,0), C1,8); \
    GAPB(o[1]=__builtin_amdgcn_mfma_f32_32x32x16_bf16(PAF(3),VFR(7),o[1],0,0,0), C1,12); \
    }while(0)
  int t=1;
  for(;t+5<NT;t+=2){
    STEP(pB0,pB1,pA0,pA1,t,true,true,true);     WAIT_BAR(2); RESC(); ROT();
    STEP(pA0,pA1,pB0,pB1,t+1,true,true,true);   WAIT_BAR(2); RESC(); ROT();
  }
  #define ENDW(tt) do{ if((tt)+3<NT){WAIT_BAR(2);} else if((tt)+2<NT){WAIT_BAR(1);} else {WAIT_BAR(0);} }while(0)
  for(;t+1<NT;t+=2){
    STEP(pB0,pB1,pA0,pA1,t,(t+3<NT),(t+1<NT),(t+1<NT));       ENDW(t);   RESC(); ROT();
    STEP(pA0,pA1,pB0,pB1,t+1,(t+4<NT),(t+2<NT),(t+2<NT));     ENDW(t+1); RESC(); ROT();
  }
  STEP(pB0,pB1,pA0,pA1,NT-1,false,false,false); RESC();
  { float sacc=pB0[0]+pB0[1]; _Pragma("unroll") for(int r=2;r<16;++r)sacc+=pB0[r]; _Pragma("unroll") for(int r=0;r<16;++r)sacc+=pB1[r]; l_reg+=sacc;
    pw0=(u32x4){PKW(pB0,0),PKW(pB0,2),PKW(pB0,4),PKW(pB0,6)};pw1=(u32x4){PKW(pB0,8),PKW(pB0,10),PKW(pB0,12),PKW(pB0,14)};pw2=(u32x4){PKW(pB1,0),PKW(pB1,2),PKW(pB1,4),PKW(pB1,6)};pw3=(u32x4){PKW(pB1,8),PKW(pB1,10),PKW(pB1,12),PKW(pB1,14)};
    SBAR(); pv(o,vb0+sl_cur,PAF(0),PAF(1),PAF(2),PAF(3)); }
  #undef PKW
  #undef PAF
  #undef VFR
  #undef PIN
  #undef MX3
  #undef GAPA
  #undef GAPB
  #undef EX
  #undef VRD
  #undef KRD
  #undef STEP
  #undef ENDW
  {auto rr=__builtin_amdgcn_permlane32_swap(__float_as_uint(l_reg),__float_as_uint(l_reg),false,false);l_reg=__uint_as_float(rr[0])+__uint_as_float(rr[1]);}
  if(hi==0)wsf[32+r32]=l_reg;asm volatile("s_waitcnt lgkmcnt(0)":::"memory");
  float rli[16];
  #pragma unroll
  for(int r=0;r<16;++r)rli[r]=__builtin_amdgcn_rcpf(wsf[32+crow(r,hi)]);
  bf16*Ow=Ob+(long)(wid*QBLK)*QP;
  { bf16*stg=(bf16*)(shm+LDS_OST)+wid*2048;
    #pragma unroll
    for(int r=0;r<16;++r){const int orow=crow(r,hi);
      #pragma unroll
      for(int d0=0;d0<2;++d0)stg[orow*64+d0*32+r32]=__float2bfloat16(o[d0][r]*rli[r]);}
    asm volatile("s_waitcnt lgkmcnt(0)":::"memory");
    #pragma unroll
    for(int i=0;i<4;++i){const int row=i*8+(lane>>3),ch=lane&7; const u32x4 v=*(const u32x4*)(stg+row*64+ch*8); ATTN_STORE16(Ow+(long)row*QP+ch*8,v);} }
  asm volatile("s_waitcnt lgkmcnt(0)\n\ts_barrier":::"memory");
  #undef DMA_K
  #undef DMA_V
  #undef CMASK
  #undef KT
  #undef CINIT
  #undef NEGM_SET
  #undef START
  #undef RESC
  #undef ROT
}
constexpr int ATTN_LDS_BYTES=LDS_BYTES;
#undef SBAR
#undef WAIT_BAR
}
__device__ __forceinline__ void attn_dispatch(KAP ap, int l, int uid, int wid, char* shm) {
    using namespace attn_body;
    unsigned char* ws = ap->ws;
    const int r32 = lane_id() & 31;
    const bf16* Qa = (const bf16*)(ws + WS_Q);
    UnitCtx uc; uc.toff = 0; uc.qpos0 = 0; uc.gr = 0; uc.rs = 0; uc.qc = 0; uc.vm = 0u; uc.sink2 = -INFINITY;
    if (uid < 384) {
        const int qb = uid & 31, bh = uid >> 5, b = bh / 6, h = bh % 6;
        const bf16* Qb = Qa + (size_t)(b * SEQ + qb * 256) * QW + (6 + h) * 64;
        const size_t ko = (size_t)b * KEYS * 256 + 128 + (h / 3) * 64;
        attn_unit<256, 256, 0, 8>(Qb, (const bf16*)(ws + WS_KAB) + ko, (const bf16*)(ws + WS_VTAB) + ko, (bf16*)Qb, KEYS / 64, uc, shm, wid);
    } else if (uid < 768) {
        const int u = uid - 384, qb = u & 31, bh = u >> 5, b = bh / 6, h = bh % 6;
        const bf16* Qb = Qa + (size_t)(b * SEQ + qb * 256) * QW + (12 + h) * 64;
        const size_t ko = (size_t)b * KEYS * 384 + h * 64;
        int klo = 4 * qb - 4; klo = klo < 0 ? 0 : (klo > 120 ? 120 : klo);
        int khi = 4 * qb + 3 - 4; khi = (khi < 0 ? 0 : (khi > 120 ? 120 : khi)) + 7;
        const int cnt = khi - klo + 1;
        uc.toff = klo; uc.gr = 4 * qb + (wid >> 1); uc.rs = uc.gr - 4 < 0 ? 0 : (uc.gr - 4 > 120 ? 120 : uc.gr - 4);
        uc.qc = 32 * (wid & 1) + r32;
        { const int wsn = uc.qc - 8 < 0 ? 0 : (uc.qc - 8 > 48 ? 48 : uc.qc - 8), hi = (lane_id() >> 5) & 1; unsigned vm = 0u;
#pragma unroll
          for (int r = 0; r < 16; ++r) { const int kc = (r & 3) + 8 * (r >> 2) + 4 * hi; if (kc >= wsn && kc < wsn + 16) vm |= 1u << r; if (kc + 32 >= wsn && kc + 32 < wsn + 16) vm |= 1u << (16 + r); }
          uc.vm = vm; }
        { const float* rpb = ap->in[12] + (size_t)(l * 6 + h) * 465; float* bl = (float*)(shm + BIAS_OFF); const int tb = tid_of(wid); if (tb < 465) bl[tb] = rpb[tb] * LOG2E; }
        attn_unit<384, 384, 2, 8>(Qb, (const bf16*)(ws + WS_KC) + ko, (const bf16*)(ws + WS_VTC) + ko, (bf16*)Qb, 4 + cnt + (cnt & 1), uc, shm, wid);
    } else if (uid < 1152) {
        const int u = uid - 768, qb = u & 31, bh = u >> 5, b = bh / 6, h = bh % 6;
        const bf16* Qb = Qa + (size_t)(b * SEQ + qb * 256) * QW + h * 64;
        const size_t ko = (size_t)b * KEYS * 256 + (h / 3) * 64;
        const int tlo = 4 * qb - 2 < 0 ? 0 : 4 * qb - 2, thi = 4 * qb + 5 > 127 ? 127 : 4 * qb + 5;
        uc.toff = tlo; uc.qpos0 = 256 * qb + 32 * wid + r32; uc.sink2 = ap->in[9][l * 6 + h] * LOG2E;
        attn_unit<256, 256, 1, 8>(Qb, (const bf16*)(ws + WS_KAB) + ko, (const bf16*)(ws + WS_VTAB) + ko, (bf16*)Qb, 4 + thi - tlo + 1, uc, shm, wid);
    } else {
        const int v = uid - 1152, type = v / 12, b = (v / 6) % 2, h = v % 6;
        const bf16* Qb = Qa + (size_t)(MLAT + b * LCTX) * QW + (type * 6 + h) * 64;
        if (type == 2) {
            const size_t ko = (size_t)b * KEYS * 384 + h * 64;
            attn_unit<384, 384, 0, 8>(Qb, (const bf16*)(ws + WS_KC) + ko, (const bf16*)(ws + WS_VTC) + ko, (bf16*)Qb, 4, uc, shm, wid);
        } else {
            const size_t ko = (size_t)b * KEYS * 256 + type * 128 + (h / 3) * 64;
            if (type == 0) uc.sink2 = ap->in[9][l * 6 + h] * LOG2E;
            attn_unit<256, 256, 0, 8>(Qb, (const bf16*)(ws + WS_KAB) + ko, (const bf16*)(ws + WS_VTAB) + ko, (bf16*)Qb, 4, uc, shm, wid);
        }
    }
}

struct OneUnit { int pm, pn; __device__ __forceinline__ bool next(int i, Unit& u) const { if (i != 0) return false; u.pm = pm; u.pn = pn; return true; } };

#define XB_TMO      128
#define XB_XCNT(j)  (256  + 64 * (j))
#define XB_XSUB(j)  (1280 + 64 * (j))
#define XB_XGEN(j)  (2304 + 64 * (j))
#define XB_TOP      3328
#define XB_TOPGEN   3392
#define XCD_BAR_WORDS 3456
#define XB_SPIN_CAP (1u << 18)

__device__ __forceinline__ unsigned xb_ld(unsigned* p)              { return __hip_atomic_load(p, __ATOMIC_RELAXED, __HIP_MEMORY_SCOPE_AGENT); }
__device__ __forceinline__ unsigned xb_add(unsigned* p, unsigned v) { return __hip_atomic_fetch_add(p, v, __ATOMIC_RELAXED, __HIP_MEMORY_SCOPE_AGENT); }
__device__ __forceinline__ unsigned xb_xcc_id() { return (unsigned)__builtin_amdgcn_s_getreg((3 << 11) | 20) & 0xFu; }
#define XB_SPIN(cond, bar) do { unsigned _sp = 0; while (cond) { __builtin_amdgcn_s_sleep(1); \
    if ((++_sp & 255u) == 0u) { if (xb_ld(&(bar)[XB_TMO])) break; if (_sp > XB_SPIN_CAP) { atomicAdd(&(bar)[XB_TMO], 1u); break; } } } } while (0)

struct XcdBarrier {
    unsigned* bar; unsigned x;
    volatile __attribute__((address_space(3))) unsigned* st;
};

__device__ __forceinline__ XcdBarrier xcd_barrier_post(unsigned* bar, volatile __attribute__((address_space(3))) unsigned* st, bool leader) {
    XcdBarrier b; b.bar = bar; b.x = xb_xcc_id(); b.st = st;
    if (leader) (void)xb_add(&bar[XB_XCNT(b.x)], 1u);
    return b;
}
__device__ __forceinline__ void xcd_barrier_complete(unsigned* bar, unsigned x, unsigned& nloc, unsigned& nx) {
    const unsigned G = gridDim.x * gridDim.y * gridDim.z;
    unsigned sum, cnt, mine, sp = 0u;
    for (;;) {
        sum = 0u; cnt = 0u; mine = 0u;
#pragma unroll
        for (unsigned j = 0; j < 16; ++j) { const unsigned c = xb_ld(&bar[XB_XCNT(j)]); sum += c; cnt += (c > 0u) ? 1u : 0u; mine = (j == x) ? c : mine; }
        if (sum == G) break;
        __builtin_amdgcn_s_sleep(1);
        if ((++sp & 255u) == 0u) { if (xb_ld(&bar[XB_TMO])) break; if (sp > XB_SPIN_CAP) { atomicAdd(&bar[XB_TMO], 1u); break; } }
    }
    nloc = mine > 0u ? mine : 1u; nx = cnt > 0u ? cnt : 1u;
}

__device__ __forceinline__ void xcd_barrier(const XcdBarrier& b, bool leader) {
    asm volatile("s_waitcnt vmcnt(0)" ::: "memory");
    __syncthreads();
    if (leader) {
        unsigned* bar = b.bar;
        __builtin_amdgcn_s_waitcnt(0);
        unsigned nloc = b.st[0], nx = b.st[1];
        if (nloc == 0u) { xcd_barrier_complete(bar, b.x, nloc, nx); b.st[0] = nloc; b.st[1] = nx; }
        const unsigned old = xb_add(&bar[XB_XSUB(b.x)], 1u);
        const unsigned gen = old / nloc;
        if (old + 1u == (gen + 1u) * nloc) {
            __builtin_amdgcn_fence(__ATOMIC_RELEASE, "agent");
            asm volatile("s_waitcnt vmcnt(0)" ::: "memory");
            const unsigned og = xb_add(&bar[XB_TOP], 1u);
            const unsigned tg = og / nx;
            if (og + 1u == (tg + 1u) * nx) xb_add(&bar[XB_TOPGEN], 1u);
            else XB_SPIN(xb_ld(&bar[XB_TOPGEN]) == tg, bar);
            __builtin_amdgcn_fence(__ATOMIC_ACQUIRE, "agent");
            xb_add(&bar[XB_XGEN(b.x)], 1u);
            asm volatile("s_waitcnt vmcnt(0)" ::: "memory");
        } else {
            XB_SPIN(xb_ld(&bar[XB_XGEN(b.x)]) == gen, bar);
            __builtin_amdgcn_fence(__ATOMIC_ACQUIRE, "agent");
            asm volatile("s_waitcnt vmcnt(0)" ::: "memory");
        }
    }
    __syncthreads();
}
__global__ void __launch_bounds__(512, 2) fwd_mega(Args a) {
    extern __shared__ __attribute__((aligned(16))) unsigned char lds_raw[];
    cg::grid_group grid = cg::this_grid();
    PG8_LAS unsigned char* lds = (PG8_LAS unsigned char*)lds_raw;
    const int wave = __builtin_amdgcn_readfirstlane((int)threadIdx.x >> 6);
    const int tid = tid_of(wave);
    const int G = gridDim.x, gw = blockIdx.x * 8 + wave, NGW = G * 8;
#define LANE() ({ int l_ = lane_id(); asm volatile("" : "+v"(l_)); l_; })
#define LEADER() (wave == 0 && lane_id() == 0)
#define WSP() ((unsigned char*)KARGS()->ws)
#define MODS() ((float*)(WSP() + WS_MODS))
#define CTL() ((unsigned*)(WSP() + WS_CTL))
    volatile LAS unsigned* MISC = (volatile LAS unsigned*)((LAS unsigned char*)lds_raw + 131072);
    if (tid < 64) MISC[tid] = 0u;
    __syncthreads();
    { const XcdBarrier xb0 = xcd_barrier_post(CTL() + 4096, MISC + 8, LEADER()); (void)xb0; }
#if PROBE_MASK
    if (blockIdx.x == 0 && tid == 0) { const unsigned long long now = __builtin_amdgcn_s_memrealtime(); MISC[18] = (unsigned)now; MISC[19] = (unsigned)(now >> 32); }
#define TSTAMP(id) do { if (blockIdx.x == 0 && LEADER()) { const unsigned long long now_ = __builtin_amdgcn_s_memrealtime(); const unsigned long long st_ = ((unsigned long long)MISC[19] << 32) | MISC[18]; \
        if ((PROBE_MASK >> (id)) & 1) { const unsigned long long ac_ = (((unsigned long long)MISC[17] << 32) | MISC[16]) + (now_ - st_); MISC[16] = (unsigned)ac_; MISC[17] = (unsigned)(ac_ >> 32); } \
        MISC[18] = (unsigned)now_; MISC[19] = (unsigned)(now_ >> 32); } } while (0)
#else
#define TSTAMP(id) do {} while (0)
#endif
#define GRID_BAR() do { XcdBarrier xb_; xb_.bar = CTL() + 4096; xb_.x = xb_xcc_id(); xb_.st = MISC + 8; xcd_barrier(xb_, LEADER()); } while (0)

    conv_weights(KARGS(), 0, (LAS unsigned char*)lds_raw, gw, NGW, wave, LANE());
    ada_phase(KARGS(), gw, NGW, LANE());
    if (blockIdx.x == 0) {
        float* rope = (float*)(WSP() + WS_ROPE);
        for (int i = tid; i < 128 * 16; i += 512) { const int pos = i >> 4, f = i & 15; const float fr = powf(10000.0f, -(float)f / 16.0f); const float ang = (float)pos * fr; float s, c; sincosf(ang, &s, &c); rope[2 * i] = c; rope[2 * i + 1] = s; }
    }
    grid.sync(); TSTAMP(0);
    { KAP ap = KARGS();
      row_phase(gw, NGW, LANE(), MALL, nullptr, nullptr, nullptr, 0, ap->in[0], ap->in[2], nullptr, nullptr,
              (bf16_t*)(WSP() + WS_R1), ap->in[6], MODS(), 0, 1024); }
    GRID_BAR(); TSTAMP(1);

    {
        constexpr int l = 0;
        const bool last = (l == DEPTH - 1);
        const int MX = last ? MLAT : MALL;
        int bidl = blockIdx.x, Gl = gridDim.x; asm volatile("" : "+s"(bidl), "+s"(Gl));
#define MODL() (MODS() + (size_t)l * 3 * 6144)
        {
            pg8::Gemm g{(const bf16_t*)(WSP() + WS_R1), (const bf16_t*)(WSP() + WS_WIN), MALL, NINP, DM, DM, DM, 0, 0};
            pg8::StaticOrder S; S.init(MALL, NINP, Gl, bidl);
            KAP ap = KARGS();
            EpiProj E{(bf16_t*)(WSP() + WS_Q), (bf16_t*)(WSP() + WS_KAB), (bf16_t*)(WSP() + WS_KC), (bf16_t*)(WSP() + WS_VTAB), (bf16_t*)(WSP() + WS_VTC), (bf16_t*)(WSP() + WS_PG),
                      (const float*)(WSP() + WS_ROPE), ap->in[10] + l * 64, ap->in[11] + l * 64};
            pg8::gemm_phase<EpiProj, pg8::StaticOrder, true, true>(lds, g, S, E, wave);
        }
        GRID_BAR(); TSTAMP(2);
        {
            KAP ap = KARGS();
            const int nctx = last ? 0 : 36, nc2 = last ? 0 : 8, nunit = nctx + 1152 + nc2;
            unsigned* ctr = CTL() + 64 * l;
            unsigned* cdone = CTL() + 128 + 64 * l;
            for (;;) {
                if (LEADER()) MISC[24] = atomicAdd(ctr, 1u);
                __syncthreads();
                const int uid = (int)MISC[24];
                __syncthreads();
                if (uid >= nunit) break;
                if (uid < nctx) {
                    attn_dispatch(ap, l, 1152 + uid, wave, (char*)lds_raw);
                    asm volatile("s_waitcnt vmcnt(0)" ::: "memory"); __syncthreads();
                    if (LEADER()) { __threadfence(); asm volatile("s_waitcnt vmcnt(0)" ::: "memory"); __hip_atomic_fetch_add(cdone, 1u, __ATOMIC_RELAXED, __HIP_MEMORY_SCOPE_AGENT); }
                } else if (uid < nctx + 384 || uid >= nctx + 384 + nc2) {
                    attn_dispatch(ap, l, uid < nctx + 384 ? uid - nctx : uid - nctx - nc2, wave, (char*)lds_raw);
                } else {
                    const int v = uid - nctx - 384;
                    if (LEADER()) { unsigned sp = 0; while (__hip_atomic_load(cdone, __ATOMIC_RELAXED, __HIP_MEMORY_SCOPE_AGENT) < 36u && ++sp < (1u << 20)) __builtin_amdgcn_s_sleep(16); }
                    __syncthreads();
                    __threadfence(); asm volatile("s_waitcnt vmcnt(0)" ::: "memory");
                    __syncthreads();
                    pg8::Gemm g{(const bf16_t*)(WSP() + WS_Q), (const bf16_t*)(WSP() + WS_WBR), MALL, DM, QW, QW, QW, 0, 0};
                    OneUnit S{64 + (v >> 2), v & 3};
                    EpiGateSum E{(bf16_t*)(WSP() + WS_PG)};
                    pg8::gemm_phase<EpiGateSum, OneUnit, true, true, 6>(lds, g, S, E, wave);
                }
            }
        }
        GRID_BAR(); TSTAMP(4);
        {
            pg8::Gemm g{(const bf16_t*)(WSP() + WS_Q), (const bf16_t*)(WSP() + WS_WBR), MLAT, DM, QW, QW, QW, 0, 0};
            pg8::StaticOrder S; S.init(MLAT, DM, Gl, bidl);
            EpiGateSum E{(bf16_t*)(WSP() + WS_PG)};
            pg8::gemm_phase<EpiGateSum, pg8::StaticOrder, true, true, 6>(lds, g, S, E, wave);
        }
        GRID_BAR(); TSTAMP(5);
        {
            pg8::Gemm g{(const bf16_t*)(WSP() + WS_PG), (const bf16_t*)(WSP() + WS_WOUT), MX, DM, DM, 3072, DM, 0, 0};
            pg8::StaticOrder S; S.init(MX, DM, Gl, bidl);
            EpiBf16<0> E{(bf16_t*)(WSP() + WS_Y), DM};
            pg8::gemm_phase<EpiBf16<0>, pg8::StaticOrder, true, true>(lds, g, S, E, wave);
        }
        GRID_BAR(); TSTAMP(6);
        { KAP ap = KARGS();
          row_phase(gw, NGW, LANE(), MX, (const bf16_t*)(WSP() + WS_Y), ap->in[7] + l * DM, MODL(), 2048,
                  l == 0 ? ap->in[0] : ap->out, l == 0 ? ap->in[2] : (const float*)(WSP() + WS_XC), ap->out, (float*)(WSP() + WS_XC),
                  (bf16_t*)(WSP() + WS_Q), ap->in[17] + l * DM, MODL(), 3072, 4096); }
        GRID_BAR(); TSTAMP(7);
        {
            pg8::Gemm g{(const bf16_t*)(WSP() + WS_Q), (const bf16_t*)(WSP() + WS_W1), MX, FF, DM, DM, DM, 0, 0};
            pg8::StaticOrder S; S.init(MX, FF, Gl, bidl);
            EpiBf16<1> E{(bf16_t*)(WSP() + WS_A), FF};
            pg8::gemm_phase<EpiBf16<1>, pg8::StaticOrder, true, true>(lds, g, S, E, wave);
        }
        GRID_BAR(); TSTAMP(8);
        {
            pg8::Gemm g{(const bf16_t*)(WSP() + WS_A), (const bf16_t*)(WSP() + WS_W2), MX, DM, FF, FF, FF, 0, 0};
            pg8::StaticOrder S; S.init(MX, DM, Gl, bidl);
            EpiBf16<0> E{(bf16_t*)(WSP() + WS_Y2), DM};
            pg8::gemm_phase<EpiBf16<0>, pg8::StaticOrder, true, true>(lds, g, S, E, wave);
        }
        GRID_BAR(); TSTAMP(9);
        if (!last) {
            { KAP ap = KARGS();
              row_phase(gw, NGW, LANE(), MX, (const bf16_t*)(WSP() + WS_Y2), ap->in[18] + l * DM, MODL(), 5120,
                      ap->out, (const float*)(WSP() + WS_XC), ap->out, (float*)(WSP() + WS_XC),
                      (bf16_t*)(WSP() + WS_R1), ap->in[6] + (l + 1) * DM, MODL() + 3 * 6144, 0, 1024); }
            conv_weights(KARGS(), l + 1, (LAS unsigned char*)lds_raw, gw, NGW, wave, LANE());
            GRID_BAR(); TSTAMP(10);
        } else {
            { KAP ap = KARGS();
              row_phase(gw, NGW, LANE(), MX, (const bf16_t*)(WSP() + WS_Y2), ap->in[18] + l * DM, MODL(), 5120,
                      ap->out, (const float*)(WSP() + WS_XC), ap->out, (float*)(WSP() + WS_XC),
                      nullptr, nullptr, nullptr, 0, 0); }
            TSTAMP(10);
        }
    }
    {
        constexpr int l = 1;
        const bool last = (l == DEPTH - 1);
        const int MX = last ? MLAT : MALL;
        int bidl = blockIdx.x, Gl = gridDim.x; asm volatile("" : "+s"(bidl), "+s"(Gl));
#define MODL() (MODS() + (size_t)l * 3 * 6144)
        {
            pg8::Gemm g{(const bf16_t*)(WSP() + WS_R1), (const bf16_t*)(WSP() + WS_WIN), MALL, NINP, DM, DM, DM, 0, 0};
            pg8::StaticOrder S; S.init(MALL, NINP, Gl, bidl);
            KAP ap = KARGS();
            EpiProj E{(bf16_t*)(WSP() + WS_Q), (bf16_t*)(WSP() + WS_KAB), (bf16_t*)(WSP() + WS_KC), (bf16_t*)(WSP() + WS_VTAB), (bf16_t*)(WSP() + WS_VTC), (bf16_t*)(WSP() + WS_PG),
                      (const float*)(WSP() + WS_ROPE), ap->in[10] + l * 64, ap->in[11] + l * 64};
            pg8::gemm_phase<EpiProj, pg8::StaticOrder, true, true>(lds, g, S, E, wave);
        }
        GRID_BAR(); TSTAMP(2);
        {
            KAP ap = KARGS();
            const int nctx = last ? 0 : 36, nc2 = last ? 0 : 8, nunit = nctx + 1152 + nc2;
            unsigned* ctr = CTL() + 64 * l;
            unsigned* cdone = CTL() + 128 + 64 * l;
            for (;;) {
                if (LEADER()) MISC[24] = atomicAdd(ctr, 1u);
                __syncthreads();
                const int uid = (int)MISC[24];
                __syncthreads();
                if (uid >= nunit) break;
                if (uid < nctx) {
                    attn_dispatch(ap, l, 1152 + uid, wave, (char*)lds_raw);
                    asm volatile("s_waitcnt vmcnt(0)" ::: "memory"); __syncthreads();
                    if (LEADER()) { __threadfence(); asm volatile("s_waitcnt vmcnt(0)" ::: "memory"); __hip_atomic_fetch_add(cdone, 1u, __ATOMIC_RELAXED, __HIP_MEMORY_SCOPE_AGENT); }
                } else if (uid < nctx + 384 || uid >= nctx + 384 + nc2) {
                    attn_dispatch(ap, l, uid < nctx + 384 ? uid - nctx : uid - nctx - nc2, wave, (char*)lds_raw);
                } else {
                    const int v = uid - nctx - 384;
                    if (LEADER()) { unsigned sp = 0; while (__hip_atomic_load(cdone, __ATOMIC_RELAXED, __HIP_MEMORY_SCOPE_AGENT) < 36u && ++sp < (1u << 20)) __builtin_amdgcn_s_sleep(16); }
                    __syncthreads();
                    __threadfence(); asm volatile("s_waitcnt vmcnt(0)" ::: "memory");
                    __syncthreads();
                    pg8::Gemm g{(const bf16_t*)(WSP() + WS_Q), (const bf16_t*)(WSP() + WS_WBR), MALL, DM, QW, QW, QW, 0, 0};
                    OneUnit S{64 + (v >> 2), v & 3};
                    EpiGateSum E{(bf16_t*)(WSP() + WS_PG)};
                    pg8::gemm_phase<EpiGateSum, OneUnit, true, true, 6>(lds, g, S, E, wave);
                }
            }
        }
        GRID_BAR(); TSTAMP(4);
        {
            pg8::Gemm g{(const bf16_t*)(WSP() + WS_Q), (const bf16_t*)(WSP() + WS_WBR), MLAT, DM, QW, QW, QW, 0, 0};
            pg8::StaticOrder S; S.init(MLAT, DM, Gl, bidl);
            EpiGateSum E{(bf16_t*)(WSP() + WS_PG)};
            pg8::gemm_phase<EpiGateSum, pg8::StaticOrder, true, true, 6>(lds, g, S, E, wave);
        }
        GRID_BAR(); TSTAMP(5);
        {
            pg8::Gemm g{(const bf16_t*)(WSP() + WS_PG), (const bf16_t*)(WSP() + WS_WOUT), MX, DM, DM, 3072, DM, 0, 0};
            pg8::StaticOrder S; S.init(MX, DM, Gl, bidl);
            EpiBf16<0> E{(bf16_t*)(WSP() + WS_Y), DM};
            pg8::gemm_phase<EpiBf16<0>, pg8::StaticOrder, true, true>(lds, g, S, E, wave);
        }
        GRID_BAR(); TSTAMP(6);
        { KAP ap = KARGS();
          row_phase(gw, NGW, LANE(), MX, (const bf16_t*)(WSP() + WS_Y), ap->in[7] + l * DM, MODL(), 2048,
                  l == 0 ? ap->in[0] : ap->out, l == 0 ? ap->in[2] : (const float*)(WSP() + WS_XC), ap->out, (float*)(WSP() + WS_XC),
                  (bf16_t*)(WSP() + WS_Q), ap->in[17] + l * DM, MODL(), 3072, 4096); }
        GRID_BAR(); TSTAMP(7);
        {
            pg8::Gemm g{(const bf16_t*)(WSP() + WS_Q), (const bf16_t*)(WSP() + WS_W1), MX, FF, DM, DM, DM, 0, 0};
            pg8::StaticOrder S; S.init(MX, FF, Gl, bidl);
            EpiBf16<1> E{(bf16_t*)(WSP() + WS_A), FF};
            pg8::gemm_phase<EpiBf16<1>, pg8::StaticOrder, true, true>(lds, g, S, E, wave);
        }
        GRID_BAR(); TSTAMP(8);
        {
            pg8::Gemm g{(const bf16_t*)(WSP() + WS_A), (const bf16_t*)(WSP() + WS_W2), MX, DM, FF, FF, FF, 0, 0};
            pg8::StaticOrder S; S.init(MX, DM, Gl, bidl);
            EpiBf16<0> E{(bf16_t*)(WSP() + WS_Y2), DM};
            pg8::gemm_phase<EpiBf16<0>, pg8::StaticOrder, true, true>(lds, g, S, E, wave);
        }
        GRID_BAR(); TSTAMP(9);
        if (!last) {
            { KAP ap = KARGS();
              row_phase(gw, NGW, LANE(), MX, (const bf16_t*)(WSP() + WS_Y2), ap->in[18] + l * DM, MODL(), 5120,
                      ap->out, (const float*)(WSP() + WS_XC), ap->out, (float*)(WSP() + WS_XC),
                      (bf16_t*)(WSP() + WS_R1), ap->in[6] + (l + 1) * DM, MODL() + 3 * 6144, 0, 1024); }
            conv_weights(KARGS(), l + 1, (LAS unsigned char*)lds_raw, gw, NGW, wave, LANE());
            GRID_BAR(); TSTAMP(10);
        } else {
            { KAP ap = KARGS();
              row_phase(gw, NGW, LANE(), MX, (const bf16_t*)(WSP() + WS_Y2), ap->in[18] + l * DM, MODL(), 5120,
                      ap->out, (const float*)(WSP() + WS_XC), ap->out, (float*)(WSP() + WS_XC),
                      nullptr, nullptr, nullptr, 0, 0); }
            TSTAMP(10);
        }
    }
#if PROBE_MASK
    if (blockIdx.x == 0 && LEADER()) {
        const unsigned long long t0 = __builtin_amdgcn_s_memrealtime(); const unsigned long long ac = ((unsigned long long)MISC[17] << 32) | MISC[16];
        while (__builtin_amdgcn_s_memrealtime() - t0 < 4ull * ac) __builtin_amdgcn_s_sleep(32);
    }
#endif
}

extern "C" void kernel_launch(void* const* d_in, const int* in_sizes, int n_in, void* d_out, int out_size, void* d_ws, size_t ws_size, hipStream_t stream) {
    static int grid = 0;
    if (grid == 0) {
        if (n_in != 21 || out_size != MLAT * DM || ws_size < WS_END) { fprintf(stderr, "kernel_launch: unexpected shapes (n_in %d, out %d, ws %zu need %zu)\n", n_in, out_size, ws_size, (size_t)WS_END); grid = -1; return; }
        int dev = 0, cus = 0, per_cu = 0;
        if (hipGetDevice(&dev) != hipSuccess || hipDeviceGetAttribute(&cus, hipDeviceAttributeMultiprocessorCount, dev) != hipSuccess) { grid = -1; return; }
        if (hipFuncSetAttribute((const void*)fwd_mega, hipFuncAttributeMaxDynamicSharedMemorySize, LDS_BYTES) != hipSuccess) { fprintf(stderr, "kernel_launch: hipFuncSetAttribute failed\n"); grid = -1; return; }
        if (hipOccupancyMaxActiveBlocksPerMultiprocessor(&per_cu, (const void*)fwd_mega, 512, LDS_BYTES) != hipSuccess || per_cu < 1) { fprintf(stderr, "kernel_launch: occupancy query says %d blocks per CU\n", per_cu); grid = -1; return; }
        grid = cus;
    }
    if (grid < 0) return;
    (void)hipMemsetAsync((char*)d_ws + WS_CTL, 0, CTL_ZERO_BYTES, stream);
    Args a{};
    for (int i = 0; i < 21; ++i) a.in[i] = (const float*)d_in[i];
    a.out = (float*)d_out; a.ws = (unsigned char*)d_ws;
    void* args[] = {&a};
    hipError_t e = hipLaunchCooperativeKernel((const void*)fwd_mega, dim3(grid), dim3(512), args, LDS_BYTES, stream);
    if (e != hipSuccess) fprintf(stderr, "cooperative launch failed: %s (grid %d)\n", hipGetErrorString(e), grid);
}
```

```cpp
#include <hip/hip_runtime.h>
#include <hip/hip_cooperative_groups.h>
#include <cstdio>
#include <cstdint>
namespace cg = cooperative_groups;
#ifndef PROBE_MASK
#define PROBE_MASK 0
#endif

__device__ __forceinline__ int lane_id() { int l; asm volatile("v_mbcnt_lo_u32_b32 %0, -1, 0\n\tv_mbcnt_hi_u32_b32 %0, -1, %0" : "=v"(l)); return l; }
__device__ __forceinline__ int tid_of(int wave) { int t = wave * 64 + lane_id(); asm volatile("" : "+v"(t)); return t; }
namespace pg8 {
#define PG8_LAS __attribute__((address_space(3)))
typedef unsigned short bf16_t;
typedef short bf16x8 __attribute__((ext_vector_type(8)));
typedef float f32x4 __attribute__((ext_vector_type(4)));
typedef unsigned u32x4 __attribute__((ext_vector_type(4)));
constexpr int BM = 256, BK = 64, HALF = 128, HTB = HALF * BK * 2, STAGE_BYTES = 8 * HTB, NXCD = 8, WGM = 8;

__host__ __device__ __forceinline__ int lds_byte(int r, int c) { const int st = (r >> 4) * 2 + (c >> 5), rr = r & 15, cc = c & 31, ob = rr * 64 + cc * 2; return st * 1024 + (ob ^ (((ob >> 9) & 1) << 5)); }
__host__ __device__ __forceinline__ void stage_rc(int b, int& R, int& C) { const int st = b / 1024, sb = b % 1024, swz = sb ^ (((sb >> 9) & 1) << 5); R = (st >> 1) * 16 + swz / 64; C = (st & 1) * 32 + (swz % 64) / 2; }
__host__ __device__ __forceinline__ int perm32(int rho) { const int n = rho >> 4, i = rho & 15; return 8 * (i >> 2) + 4 * n + (i & 3); }

struct Unit { int pm, pn; };
struct Gemm { const bf16_t* A; const bf16_t* Bt; int M, N, K, lda, ldb, a_split; size_t a_stride; };

struct StaticOrder {
    int nM, nN, nwg, G, c;
    __host__ __device__ void init(int M, int N, int G_, int c_) { nM = M / BM; nN = N / BM; nwg = nM * nN; G = G_; c = c_; }
    __host__ __device__ bool next(int i, Unit& u) const {
        const long L = (long)i * G + c; if (L >= nwg) return false;
        int wgid = (int)L; { const int q = nwg / NXCD, r = nwg % NXCD, xcd = wgid % NXCD, off = wgid / NXCD; wgid = (xcd < r ? xcd * (q + 1) : r * (q + 1) + (xcd - r) * q) + off; }
        const int nig = WGM * nN, gid = wgid / nig, fm = gid * WGM, gsz = (nM - fm) < WGM ? (nM - fm) : WGM;
        u.pm = fm + ((wgid % nig) % gsz); u.pn = (wgid % nig) / gsz; return true;
    }
};

__device__ __forceinline__ unsigned cvt_pk_bf16(float lo, float hi) { unsigned r; asm volatile("v_cvt_pk_bf16_f32 %0, %1, %2" : "=v"(r) : "v"(lo), "v"(hi)); return r; }


template <class Epi, class Sched, bool ALIGN_EPI = false, bool SP2 = false, int SEG = 0>
__device__ __forceinline__ void gemm_phase(PG8_LAS unsigned char* lds, const Gemm g, const Sched& S, const Epi& E, int wave_id) {
    const int tid = tid_of(wave_id), wid = wave_id, lane = tid & 63, wr = wid >> 2, wc = wid & 3, fr = lane & 15, fq = lane >> 4;
    const int K = g.K, nt = K / BK;
    unsigned voffA[2], voffB[2];
#pragma unroll
    for (int i = 0; i < 2; ++i) { int R, C; stage_rc(tid * 16 + i * 8192, R, C); const int Rb = Epi::PERM ? ((R & ~31) + perm32(R & 31)) : R;
        voffA[i] = (unsigned)(R * g.lda + C) * 2u; voffB[i] = (unsigned)(Rb * g.ldb + C) * 2u; }
    const size_t kstep = (size_t)(BK * 2);
    const size_t hstepA = (size_t)HALF * g.lda * 2, hstepB = (size_t)HALF * g.ldb * 2;
    const size_t tstepA = 2 * hstepA, tstepB = 2 * hstepB;
    const unsigned ldsw = (unsigned)wid * 1024u;
    const int aoff = lds_byte(wr * 64 + fr, fq * 8), boff = lds_byte(wc * 32 + fr, fq * 8);
#define PG8_SA(b, h) (((b) * 2 + (h)) * HTB)
#define PG8_SB(b, h) ((4 + (b) * 2 + (h)) * HTB)
#define PG8_STAGE(bufoff, gbase, voff) do { _Pragma("unroll") for (int _i = 0; _i < 2; ++_i) \
        __builtin_amdgcn_global_load_lds((const unsigned*)((const char*)(gbase) + (voff)[_i]), (PG8_LAS unsigned*)(lds + (bufoff) + ldsw + _i * 8192), 16, 0, 0); } while (0)
#define PG8_LDA(dst, b, h) do { _Pragma("unroll") for (int m = 0; m < 4; ++m) _Pragma("unroll") for (int k = 0; k < 2; ++k) dst[m][k] = *(const PG8_LAS bf16x8*)(lds + PG8_SA(b, h) + aoff + m * 2048 + k * 1024); } while (0)
#define PG8_LDB(dst, b, h) do { _Pragma("unroll") for (int n = 0; n < 2; ++n) _Pragma("unroll") for (int k = 0; k < 2; ++k) dst[n][k] = *(const PG8_LAS bf16x8*)(lds + PG8_SB(b, h) + boff + n * 2048 + k * 1024); } while (0)
#define PG8_MMA(ai, bj, At, Bt) do { __builtin_amdgcn_s_setprio(1); _Pragma("unroll") for (int m = 0; m < 4; ++m) _Pragma("unroll") for (int n = 0; n < 2; ++n) _Pragma("unroll") for (int k = 0; k < 2; ++k) \
        acc[ai][bj][m][n] = __builtin_amdgcn_mfma_f32_16x16x32_bf16(Bt[n][k], At[m][k], acc[ai][bj][m][n], 0, 0, 0); __builtin_amdgcn_s_setprio(0); } while (0)
#define PG8_WAIT_V(n) asm volatile("s_waitcnt vmcnt(" #n ")" ::: "memory")
#define PG8_WAIT_L(n) asm volatile("s_waitcnt lgkmcnt(" #n ")" ::: "memory")
#define PG8_BAR __builtin_amdgcn_s_barrier()
#define PG8_SCHED __builtin_amdgcn_sched_barrier(0)
#define PG8_ABASE(u) ((const char*)g.A + (size_t)(u).pm * tstepA + (g.a_split ? (size_t)((u).pn / g.a_split) * g.a_stride : (size_t)0))
    Unit cur, nxt; int ui = 0;
    if (!S.next(0, cur)) return;
    f32x4 acc[2][2][4][2];
#pragma unroll
    for (int a = 0; a < 2; ++a)
#pragma unroll
        for (int b = 0; b < 2; ++b)
#pragma unroll
            for (int m = 0; m < 4; ++m)
#pragma unroll
                for (int n = 0; n < 2; ++n) acc[a][b][m][n] = (f32x4){0.f, 0.f, 0.f, 0.f};
    bf16x8 At[4][2], B0[2][2], B1[2][2];
    const char* cA = PG8_ABASE(cur); const char* cB = (const char*)g.Bt + (size_t)cur.pn * tstepB;
    if constexpr (SP2) {
        PG8_STAGE(PG8_SB(0, 0), cB, voffB); PG8_STAGE(PG8_SB(0, 1), cB + hstepB, voffB); PG8_STAGE(PG8_SA(0, 0), cA, voffA); PG8_STAGE(PG8_SA(0, 1), cA + hstepA, voffA);
        if (wr == 1) PG8_BAR;
        PG8_WAIT_V(2); PG8_BAR;
        PG8_STAGE(PG8_SB(1, 0), cB + kstep, voffB); PG8_STAGE(PG8_SA(1, 0), cA + kstep, voffA); PG8_STAGE(PG8_SB(1, 1), cB + hstepB + kstep, voffB);
        PG8_WAIT_V(6); PG8_BAR;
    } else {
        PG8_STAGE(PG8_SB(0, 0), cB, voffB); PG8_STAGE(PG8_SA(0, 0), cA, voffA); PG8_STAGE(PG8_SB(0, 1), cB + hstepB, voffB); PG8_STAGE(PG8_SA(0, 1), cA + hstepA, voffA);
        if (wr == 1) PG8_BAR;
        PG8_WAIT_V(4); PG8_BAR;
        PG8_STAGE(PG8_SB(1, 0), cB + kstep, voffB); PG8_STAGE(PG8_SA(1, 0), cA + kstep, voffA); PG8_STAGE(PG8_SB(1, 1), cB + hstepB + kstep, voffB);
        PG8_WAIT_V(6); PG8_BAR;
    }
    for (;;) {
        const bool has_next = S.next(ui + 1, nxt);
        const char* nA = has_next ? PG8_ABASE(nxt) : cA; const char* nB = has_next ? (const char*)g.Bt + (size_t)nxt.pn * tstepB : cB;
#pragma unroll 1
        for (int t = 0; t < nt; t += 2) {
            const bool last = (t == nt - 2);
            const char* a1 = cA + (size_t)(t + 1) * kstep;
            const char* a2 = last ? nA : cA + (size_t)(t + 2) * kstep; const char* b2 = last ? nB : cB + (size_t)(t + 2) * kstep;
            const char* a3 = a2 + kstep; const char* b3 = b2 + kstep;
            if constexpr (SP2) {
            PG8_LDB(B0, 0, 0); PG8_LDB(B1, 0, 1); PG8_SCHED; PG8_LDA(At, 0, 0); PG8_STAGE(PG8_SA(1, 1), a1 + hstepA, voffA);
            PG8_WAIT_V(8); PG8_WAIT_L(0); PG8_BAR; PG8_MMA(0, 0, At, B0); PG8_MMA(0, 1, At, B1); PG8_BAR; PG8_SCHED;
            PG8_LDA(At, 0, 1); PG8_STAGE(PG8_SB(0, 0), b2, voffB); PG8_STAGE(PG8_SB(0, 1), b2 + hstepB, voffB); PG8_STAGE(PG8_SA(0, 0), a2, voffA);
            PG8_WAIT_V(8); PG8_WAIT_L(0); PG8_BAR; PG8_MMA(1, 0, At, B0); PG8_MMA(1, 1, At, B1); PG8_BAR; PG8_SCHED;
            PG8_LDB(B0, 1, 0); PG8_LDB(B1, 1, 1); PG8_SCHED; PG8_LDA(At, 1, 0); PG8_STAGE(PG8_SA(0, 1), a2 + hstepA, voffA);
            PG8_WAIT_V(8); PG8_WAIT_L(0); PG8_BAR; PG8_MMA(0, 0, At, B0); PG8_MMA(0, 1, At, B1); PG8_BAR; PG8_SCHED;
            PG8_LDA(At, 1, 1); PG8_STAGE(PG8_SB(1, 0), b3, voffB); PG8_STAGE(PG8_SB(1, 1), b3 + hstepB, voffB); PG8_STAGE(PG8_SA(1, 0), a3, voffA);
            PG8_WAIT_V(8); PG8_WAIT_L(0); PG8_BAR; PG8_MMA(1, 0, At, B0); PG8_MMA(1, 1, At, B1); PG8_BAR; PG8_SCHED;
            } else {
            PG8_LDB(B0, 0, 0); PG8_SCHED; PG8_LDA(At, 0, 0); PG8_STAGE(PG8_SA(1, 1), a1 + hstepA, voffA);
            PG8_WAIT_L(8); PG8_BAR; PG8_WAIT_L(0); PG8_MMA(0, 0, At, B0); PG8_BAR; PG8_SCHED;
            PG8_LDB(B1, 0, 1); PG8_STAGE(PG8_SB(0, 0), b2, voffB);
            PG8_BAR; PG8_WAIT_L(0); PG8_MMA(0, 1, At, B1); PG8_BAR;
            PG8_LDA(At, 0, 1); PG8_STAGE(PG8_SA(0, 0), a2, voffA);
            PG8_BAR; PG8_WAIT_L(0); PG8_MMA(1, 0, At, B0); PG8_BAR; PG8_SCHED;
            PG8_STAGE(PG8_SB(0, 1), b2 + hstepB, voffB);
            PG8_WAIT_V(6); PG8_BAR; PG8_MMA(1, 1, At, B1); PG8_BAR;
            PG8_LDB(B0, 1, 0); PG8_SCHED; PG8_LDA(At, 1, 0); PG8_STAGE(PG8_SA(0, 1), a2 + hstepA, voffA);
            PG8_WAIT_L(8); PG8_BAR; PG8_WAIT_L(0); PG8_MMA(0, 0, At, B0); PG8_BAR; PG8_SCHED;
            PG8_LDB(B1, 1, 1); PG8_STAGE(PG8_SB(1, 0), b3, voffB);
            PG8_BAR; PG8_WAIT_L(0); PG8_MMA(0, 1, At, B1); PG8_BAR;
            PG8_LDA(At, 1, 1); PG8_STAGE(PG8_SA(1, 0), a3, voffA);
            PG8_BAR; PG8_WAIT_L(0); PG8_MMA(1, 0, At, B0); PG8_BAR; PG8_SCHED;
            PG8_STAGE(PG8_SB(1, 1), b3 + hstepB, voffB);
            PG8_WAIT_V(6); PG8_BAR; PG8_MMA(1, 1, At, B1); PG8_BAR;
            }
            if constexpr (SEG > 0) {
                if (!last && (t + 2) % SEG == 0) E.segment(acc, (t + 2) / SEG - 1, cur, wr, wc, fr, fq);
            }
        }
        if constexpr (ALIGN_EPI) { if (wr == 0) PG8_BAR; }
        E(acc, cur, wr, wc, fr, fq);
        if (!has_next) break;
#pragma unroll
        for (int a = 0; a < 2; ++a)
#pragma unroll
            for (int b = 0; b < 2; ++b)
#pragma unroll
                for (int m = 0; m < 4; ++m)
#pragma unroll
                    for (int n = 0; n < 2; ++n) acc[a][b][m][n] = (f32x4){0.f, 0.f, 0.f, 0.f};
        cur = nxt; cA = nA; cB = nB; ++ui;
        if constexpr (ALIGN_EPI) { if (wr == 1) PG8_BAR; }
    }
    PG8_WAIT_V(0);
    if constexpr (!ALIGN_EPI) { if (wr == 0) PG8_BAR; }
    PG8_BAR;
#undef PG8_SA
#undef PG8_SB
#undef PG8_STAGE
#undef PG8_LDA
#undef PG8_LDB
#undef PG8_MMA
#undef PG8_WAIT_V
#undef PG8_WAIT_L
#undef PG8_BAR
#undef PG8_SCHED
#undef PG8_ABASE
}
}

using pg8::bf16_t; using pg8::f32x4; using pg8::u32x4; using pg8::Unit; using pg8::cvt_pk_bf16;
typedef short bf16x8 __attribute__((ext_vector_type(8)));
typedef float f32x16 __attribute__((ext_vector_type(16)));
typedef unsigned u32x2 __attribute__((ext_vector_type(2)));
#define LAS __attribute__((address_space(3)))

constexpr int DM = 1024, SEQ = 8192, NB = 2, LCTX = 256, DEPTH = 2;
constexpr int MLAT = NB * SEQ;
constexpr int MALL = MLAT + NB * LCTX;
constexpr int KEYS = LCTX + SEQ;
constexpr int NIN = 5504, NINP = 5632;
constexpr int FF = 4096;
constexpr int QW = 1152;
constexpr float EPS = 1e-6f;
constexpr float LOG2E = 1.4426950408889634f;
constexpr float QSCALE = 0.125f * LOG2E;

constexpr size_t MiB = 1u << 20;
constexpr size_t WS_CTL = 0, CTL_ZERO_BYTES = 256 * 1024;
constexpr size_t WS_MODS = 64 * 1024;
constexpr size_t WS_ROPE = 256 * 1024;
constexpr size_t WS_XC = 1 * MiB;
constexpr size_t WS_WIN = 4 * MiB;
constexpr size_t WS_WBR = WS_WIN + 11 * MiB;
constexpr size_t WS_WOUT = WS_WBR + 9 * MiB / 4;
constexpr size_t WS_W1 = WS_WOUT + 6 * MiB;
constexpr size_t WS_W2 = WS_W1 + 8 * MiB;
constexpr size_t WS_R1 = 40 * MiB;
constexpr size_t WS_KAB = WS_R1 + 33 * MiB;
constexpr size_t WS_KC = WS_KAB + (size_t)NB * KEYS * 256 * 2;
constexpr size_t WS_VTAB = WS_KC + (size_t)NB * KEYS * 384 * 2;
constexpr size_t WS_VTC = WS_VTAB + (size_t)NB * 4 * 64 * KEYS * 2;
constexpr size_t WS_PG = WS_VTC + (size_t)NB * 6 * 64 * KEYS * 2;
constexpr size_t WS_Q = WS_PG + (size_t)MALL * 3072 * 2;
constexpr size_t WS_VB = WS_Q + (size_t)MALL * QW * 2;
constexpr size_t WS_END = WS_VB + (size_t)NB * KEYS * 128 * 2;
constexpr size_t WS_Y = WS_R1;
constexpr size_t WS_A = WS_R1;
constexpr size_t WS_Y2 = WS_A + (size_t)MALL * FF * 2;
static_assert(WS_W2 + 8 * MiB <= WS_R1, "weights");
static_assert(WS_Y + (size_t)MALL * DM * 4 <= WS_PG, "Y overlay");
static_assert(WS_A + (size_t)MALL * FF * 2 <= WS_Q, "A overlay");
static_assert(WS_Y2 + (size_t)MALL * DM * 4 <= WS_END && WS_END <= 256 * MiB, "ws map");

constexpr int LDS_BYTES = 147456;

struct EpiProj {
    static constexpr bool PERM = true;
    bf16_t *Q, *KAB, *KC, *VAB, *VC, *PG; const float *rope, *qn, *kn;
    __device__ __forceinline__ void operator()(const f32x4 (&acc)[2][2][4][2], const Unit& u, int wr, int wc, int fr, int fq) const {
        const int pm = u.pm, hu = 4 * u.pn + wc;
        if (hu >= 86) return;
        const bool lat = pm < 64; int kroff;
        if (lat) { const int b = pm >> 5; kroff = 256 * b + 256; } else { const int b = pm - 64; kroff = -MLAT + SEQ * b; }
        const int row0 = pm * 256 + wr * 64 + fr;
        int pitch, col, radd = 0; bf16_t* base; bool norm = false, rot = false, scl = false; const float* gn = qn;
        if (hu >= 38) { base = PG; pitch = 3072; col = (hu - 38) * 64; }
        else if (hu < 6) { base = Q; pitch = QW; col = hu * 64; rot = true; scl = true; }
        else if (hu < 8) { base = KAB; pitch = 256; col = (hu - 6) * 64; radd = kroff; rot = true; }
        else if (hu < 10) { base = VAB; pitch = 256; col = (hu - 8) * 64; radd = kroff; }
        else if (hu < 16) { base = Q; pitch = QW; col = 384 + (hu - 10) * 64; norm = true; rot = true; scl = true; }
        else if (hu < 18) { base = KAB; pitch = 256; col = 128 + (hu - 16) * 64; radd = kroff; norm = true; rot = true; gn = kn; }
        else if (hu < 20) { base = VAB; pitch = 256; col = 128 + (hu - 18) * 64; radd = kroff; }
        else if (hu < 26) { base = Q; pitch = QW; col = 768 + (hu - 20) * 64; scl = true; }
        else if (hu < 32) { base = KC; pitch = 384; col = (hu - 26) * 64; radd = kroff; }
        else { base = VC; pitch = 384; col = (hu - 32) * 64; radd = kroff; }
        rot = rot && lat;
        bf16_t* pb = base + (size_t)(row0 + radd) * pitch + col + 8 * fq;
        f32x4 g0 = {1.f, 1.f, 1.f, 1.f}, g1 = g0, g2 = g0, g3 = g0;
        if (norm) { g0 = *(const f32x4*)(gn + 8 * fq); g1 = *(const f32x4*)(gn + 8 * fq + 4); g2 = *(const f32x4*)(gn + 32 + 8 * fq); g3 = *(const f32x4*)(gn + 32 + 8 * fq + 4); }
        const float sc = scl ? QSCALE : 1.0f;
#pragma unroll
        for (int ai = 0; ai < 2; ++ai)
#pragma unroll
            for (int m = 0; m < 4; ++m) {
                f32x4 a0 = acc[ai][0][m][0], a1 = acc[ai][0][m][1], b0 = acc[ai][1][m][0], b1 = acc[ai][1][m][1];
                if (norm) {
                    float ss = (a0[0] * a0[0] + a0[1] * a0[1]) + (a0[2] * a0[2] + a0[3] * a0[3]) + (a1[0] * a1[0] + a1[1] * a1[1]) + (a1[2] * a1[2] + a1[3] * a1[3])
                             + (b0[0] * b0[0] + b0[1] * b0[1]) + (b0[2] * b0[2] + b0[3] * b0[3]) + (b1[0] * b1[0] + b1[1] * b1[1]) + (b1[2] * b1[2] + b1[3] * b1[3]);
                    ss += __shfl_xor(ss, 16); ss += __shfl_xor(ss, 32);
                    const float rstd = rsqrtf(ss * (1.f / 64.f) + EPS);
                    a0 = a0 * rstd * g0; a1 = a1 * rstd * g1; b0 = b0 * rstd * g2; b1 = b1 * rstd * g3;
                }
                if (rot) {
                    const int sp = (row0 + ai * 128 + m * 16) & (SEQ - 1);
                    const float* tr = rope + ((sp >> 6) * 16 + 4 * fq) * 2; const float* tc = rope + ((sp & 63) * 16 + 4 * fq) * 2;
                    const f32x4 r0 = *(const f32x4*)tr, r1 = *(const f32x4*)(tr + 4), c0 = *(const f32x4*)tc, c1 = *(const f32x4*)(tc + 4);
                    a0 = (f32x4){a0[0] * r0[0] - a0[1] * r0[1], a0[0] * r0[1] + a0[1] * r0[0], a0[2] * r0[2] - a0[3] * r0[3], a0[2] * r0[3] + a0[3] * r0[2]};
                    a1 = (f32x4){a1[0] * r1[0] - a1[1] * r1[1], a1[0] * r1[1] + a1[1] * r1[0], a1[2] * r1[2] - a1[3] * r1[3], a1[2] * r1[3] + a1[3] * r1[2]};
                    b0 = (f32x4){b0[0] * c0[0] - b0[1] * c0[1], b0[0] * c0[1] + b0[1] * c0[0], b0[2] * c0[2] - b0[3] * c0[3], b0[2] * c0[3] + b0[3] * c0[2]};
                    b1 = (f32x4){b1[0] * c1[0] - b1[1] * c1[1], b1[0] * c1[1] + b1[1] * c1[0], b1[2] * c1[2] - b1[3] * c1[3], b1[2] * c1[3] + b1[3] * c1[2]};
                }
                a0 = a0 * sc; a1 = a1 * sc; b0 = b0 * sc; b1 = b1 * sc;
                u32x4 w0, w1; w0.x = cvt_pk_bf16(a0[0], a0[1]); w0.y = cvt_pk_bf16(a0[2], a0[3]); w0.z = cvt_pk_bf16(a1[0], a1[1]); w0.w = cvt_pk_bf16(a1[2], a1[3]);
                w1.x = cvt_pk_bf16(b0[0], b0[1]); w1.y = cvt_pk_bf16(b0[2], b0[3]); w1.z = cvt_pk_bf16(b1[0], b1[1]); w1.w = cvt_pk_bf16(b1[2], b1[3]);
                bf16_t* p = pb + (size_t)(ai * 128 + m * 16) * pitch;
                *(u32x4*)p = w0; *(u32x4*)(p + 32) = w1;
                if (rot && (m & 1)) asm volatile("" ::: "memory");
            }
    }
};
__device__ __forceinline__ float bf2f(unsigned h) { return __uint_as_float(h << 16); }
struct EpiGateSum {
    static constexpr bool PERM = true;
    bf16_t* PG;
    static __device__ __forceinline__ float ex(float g) { return __builtin_amdgcn_exp2f(fminf(-LOG2E * g, 80.f)); }
    static __device__ __forceinline__ void ratio2(unsigned gq, unsigned gn, float& a0, float& a1) {
        a0 *= (1.0f + ex(bf2f(gn & 0xffffu))) * __builtin_amdgcn_rcpf(1.0f + ex(bf2f(gq & 0xffffu)));
        a1 *= (1.0f + ex(bf2f(gn >> 16))) * __builtin_amdgcn_rcpf(1.0f + ex(bf2f(gq >> 16)));
    }
    __device__ __forceinline__ void segment(f32x4 (&acc)[2][2][4][2], int br, const Unit& u, int wr, int wc, int fr, int fq) const {
        const int row0 = u.pm * 256 + wr * 64 + fr, col0 = u.pn * 256 + wc * 32 + 8 * fq;
        const bf16_t* pb = PG + (size_t)row0 * 3072 + col0 + br * 1024;
#pragma unroll
        for (int ai = 0; ai < 2; ++ai) {
            u32x4 gq[8], gn[8];
#pragma unroll
            for (int q = 0; q < 8; ++q) { const int m = q >> 1, bj = q & 1;
                const bf16_t* p = pb + (size_t)(ai * 128 + m * 16) * 3072 + bj * 128;
                gq[q] = *(const u32x4*)p; gn[q] = *(const u32x4*)(p + 1024); }
#pragma unroll
            for (int q = 0; q < 8; ++q) { const int m = q >> 1, bj = q & 1;
                f32x4& v0 = acc[ai][bj][m][0]; f32x4& v1 = acc[ai][bj][m][1];
                float t0 = v0[0], t1 = v0[1], t2 = v0[2], t3 = v0[3], t4 = v1[0], t5 = v1[1], t6 = v1[2], t7 = v1[3];
                ratio2(gq[q].x, gn[q].x, t0, t1); ratio2(gq[q].y, gn[q].y, t2, t3); ratio2(gq[q].z, gn[q].z, t4, t5); ratio2(gq[q].w, gn[q].w, t6, t7);
                v0 = (f32x4){t0, t1, t2, t3}; v1 = (f32x4){t4, t5, t6, t7}; }
            asm volatile("" ::: "memory");
        }
    }
    static __device__ __forceinline__ unsigned fin2(unsigned g, float a0, float a1) {
        return cvt_pk_bf16(a0 * __builtin_amdgcn_rcpf(1.0f + ex(bf2f(g & 0xffffu))), a1 * __builtin_amdgcn_rcpf(1.0f + ex(bf2f(g >> 16))));
    }
    __device__ __forceinline__ void operator()(const f32x4 (&acc)[2][2][4][2], const Unit& u, int wr, int wc, int fr, int fq) const {
        const int row0 = u.pm * 256 + wr * 64 + fr, col0 = u.pn * 256 + wc * 32 + 8 * fq;
        bf16_t* pb = PG + (size_t)row0 * 3072 + col0;
        u32x4 gq[16];
#pragma unroll
        for (int q = 0; q < 16; ++q) { const int ai = q >> 3, m = (q >> 1) & 3, bj = q & 1; gq[q] = *(const u32x4*)(pb + (size_t)(ai * 128 + m * 16) * 3072 + bj * 128 + 2048); }
#pragma unroll
        for (int q = 0; q < 16; ++q) { const int ai = q >> 3, m = (q >> 1) & 3, bj = q & 1;
            const f32x4 v0 = acc[ai][bj][m][0], v1 = acc[ai][bj][m][1];
            u32x4 w; w.x = fin2(gq[q].x, v0[0], v0[1]); w.y = fin2(gq[q].y, v0[2], v0[3]); w.z = fin2(gq[q].z, v1[0], v1[1]); w.w = fin2(gq[q].w, v1[2], v1[3]);
            *(u32x4*)(pb + (size_t)(ai * 128 + m * 16) * 3072 + bj * 128) = w; }
    }
};
template <int ACT  > struct EpiBf16 {
    static constexpr bool PERM = true;
    bf16_t* O; int ldc;
    __device__ __forceinline__ void operator()(const f32x4 (&acc)[2][2][4][2], const Unit& u, int wr, int wc, int fr, int fq) const {
        const int row0 = u.pm * 256 + wr * 64 + fr, col0 = u.pn * 256 + wc * 32 + 8 * fq;
#pragma unroll
        for (int ai = 0; ai < 2; ++ai)
#pragma unroll
            for (int m = 0; m < 4; ++m)
#pragma unroll
                for (int bj = 0; bj < 2; ++bj) {
                    f32x4 v0 = acc[ai][bj][m][0], v1 = acc[ai][bj][m][1];
                    if (ACT == 1) {
#pragma unroll
                        for (int e = 0; e < 4; ++e) { const float a = fmaxf(v0[e], 0.f), c = fmaxf(v1[e], 0.f); v0[e] = a * a; v1[e] = c * c; }
                    }
                    u32x4 w; w.x = cvt_pk_bf16(v0[0], v0[1]); w.y = cvt_pk_bf16(v0[2], v0[3]); w.z = cvt_pk_bf16(v1[0], v1[1]); w.w = cvt_pk_bf16(v1[2], v1[3]);
                    *(u32x4*)(O + (size_t)(row0 + ai * 128 + m * 16) * ldc + col0 + bj * 128) = w;
                }
    }
};
struct EpiF32 {
    static constexpr bool PERM = true;
    float* O; int ldc;
    __device__ __forceinline__ void operator()(const f32x4 (&acc)[2][2][4][2], const Unit& u, int wr, int wc, int fr, int fq) const {
        const int row0 = u.pm * 256 + wr * 64 + fr, col0 = u.pn * 256 + wc * 32 + 8 * fq;
#pragma unroll
        for (int ai = 0; ai < 2; ++ai)
#pragma unroll
            for (int m = 0; m < 4; ++m)
#pragma unroll
                for (int bj = 0; bj < 2; ++bj) {
                    float* p = O + (size_t)(row0 + ai * 128 + m * 16) * ldc + col0 + bj * 128;
                    *(f32x4*)p = acc[ai][bj][m][0]; *(f32x4*)(p + 4) = acc[ai][bj][m][1];
                }
    }
};

__device__ __forceinline__ float wave_sum(float v) {
#pragma unroll
    for (int o = 1; o < 64; o <<= 1) v += __shfl_xor(v, o);
    return v;
}
__device__ __forceinline__ unsigned f2bf(float f) { unsigned u = __builtin_bit_cast(unsigned, f); return (u + 0x7fffu + ((u >> 16) & 1u)) >> 16; }
__device__ __forceinline__ unsigned pk2(float lo, float hi) { return f2bf(lo) | (f2bf(hi) << 16); }

__device__ __forceinline__ void transpose_item(const float* W, int K, int N, bf16_t* WT, int ldk, int row_off, int copies, int copy_stride, LAS float* scr, int item, int lane, bool headperm = false) {
    const int nblk = N / 32, kb = item / nblk, nb = item % nblk, k0 = 64 * kb, n0 = 32 * nb;
    const int r0 = headperm ? 256 * (nb >> 3) + 128 * (nb & 1) + 32 * ((nb & 7) >> 1) : n0;
#pragma unroll 8
    for (int i = 0; i < 32; ++i) { const int kk = 2 * i + (lane >> 5); scr[kk * 33 + (lane & 31)] = W[(size_t)(k0 + kk) * N + n0 + (lane & 31)]; }
    asm volatile("s_waitcnt lgkmcnt(0)" ::: "memory");
    const int c = lane & 7;
#pragma unroll
    for (int j = 0; j < 4; ++j) { const int n = (lane >> 3) + 8 * j; const LAS float* s = scr + (8 * c) * 33 + n;
        u32x4 o; o.x = pk2(s[0 * 33], s[1 * 33]); o.y = pk2(s[2 * 33], s[3 * 33]); o.z = pk2(s[4 * 33], s[5 * 33]); o.w = pk2(s[6 * 33], s[7 * 33]);
        for (int cc = 0; cc < copies; ++cc) *(u32x4*)(WT + (size_t)(row_off + r0 + n) * ldk + cc * copy_stride + k0 + 8 * c) = o; }
    asm volatile("s_waitcnt lgkmcnt(0)" ::: "memory");
}

struct Args { const float* in[21]; float* out; unsigned char* ws; int pad0, pad1; };
typedef const __attribute__((address_space(4))) Args* KAP;
#define KARGS() ({ KAP p_ = (KAP)__builtin_amdgcn_kernarg_segment_ptr(); asm volatile("" : "+s"(p_)); p_; })

__device__ __forceinline__ void conv_weights(KAP ap, int l, LAS unsigned char* lds, int gw, int NGW, int wave, int lane) {
    unsigned char* ws = ap->ws;
    LAS float* scr = (LAS float*)(lds + wave * 16384);
    constexpr int I_IN = 16 * (NIN / 32), I_BR = 6 * 32, I_OUT = 16 * 32, I_1 = 16 * (FF / 32), I_2 = (FF / 64) * 32;
    constexpr int NITEMS = I_IN + 3 * I_BR + I_OUT + I_1 + I_2;
    for (int it = gw; it < NITEMS; it += NGW) {
        int r = it;
        if (r < I_IN) { transpose_item(ap->in[8] + (size_t)l * DM * NIN, DM, NIN, (bf16_t*)(ws + WS_WIN), DM, 0, 1, 0, scr, r, lane, true); continue; } r -= I_IN;
        if (r < I_BR) { transpose_item(ap->in[13] + (size_t)l * 384 * DM, 384, DM, (bf16_t*)(ws + WS_WBR), 1152, 0, 1, 0, scr, r, lane); continue; } r -= I_BR;
        if (r < I_BR) { transpose_item(ap->in[14] + (size_t)l * 384 * DM, 384, DM, (bf16_t*)(ws + WS_WBR) + 384, 1152, 0, 1, 0, scr, r, lane); continue; } r -= I_BR;
        if (r < I_BR) { transpose_item(ap->in[15] + (size_t)l * 384 * DM, 384, DM, (bf16_t*)(ws + WS_WBR) + 768, 1152, 0, 1, 0, scr, r, lane); continue; } r -= I_BR;
        if (r < I_OUT) { transpose_item(ap->in[16] + (size_t)l * DM * DM, DM, DM, (bf16_t*)(ws + WS_WOUT), DM, 0, 1, 0, scr, r, lane); continue; } r -= I_OUT;
        if (r < I_1) { transpose_item(ap->in[19] + (size_t)l * DM * FF, DM, FF, (bf16_t*)(ws + WS_W1), DM, 0, 1, 0, scr, r, lane); continue; } r -= I_1;
        transpose_item(ap->in[20] + (size_t)l * FF * DM, FF, DM, (bf16_t*)(ws + WS_W2), FF, 0, 1, 0, scr, r, lane);
    }
    unsigned z0 = 0u; asm volatile("" : "+v"(z0));
    for (int i = gw * 64 + lane; i < (NINP - NIN) * DM * 2 / 16; i += NGW * 64) {
        const int prow = i / (DM * 2 / 16), pc = i % (DM * 2 / 16);
        const int row = 21 * 256 + (prow >> 6) * 128 + 64 + (prow & 63);
        *((u32x4*)(ws + WS_WIN + (size_t)row * DM * 2) + pc) = (u32x4){z0, z0, z0, z0};
    }
}

__device__ __forceinline__ void ada_phase(KAP ap, int gw, int NGW, int lane) {
    float* mods = (float*)(ap->ws + WS_MODS);
    const float* c = ap->in[1]; const float* cc = ap->in[3];
    for (int t = gw; t < DEPTH * 32 * 24; t += NGW) {
        const int l = t / (32 * 24), kc = (t / 24) % 32, jc = t % 24, col = jc * 256 + lane * 4;
        const int kk = kc * 32 + (lane & 31);
        const float x0 = c[kk], x1 = c[DM + kk], x2 = cc[kk];
        const float a0 = x0 / (1.f + __expf(-x0)), a1 = x1 / (1.f + __expf(-x1)), a2 = x2 / (1.f + __expf(-x2));
        const float* W = ap->in[4] + ((size_t)l * DM + kc * 32) * 6144 + col;
        f32x4 s0 = {0.f, 0.f, 0.f, 0.f}, s1 = s0, s2 = s0;
#pragma unroll
        for (int k = 0; k < 32; ++k) {
            const f32x4 w = *(const f32x4*)(W + (size_t)k * 6144);
            const float b0 = __int_as_float(__builtin_amdgcn_readlane(__float_as_int(a0), k)), b1 = __int_as_float(__builtin_amdgcn_readlane(__float_as_int(a1), k)), b2 = __int_as_float(__builtin_amdgcn_readlane(__float_as_int(a2), k));
            s0 += w * b0; s1 += w * b1; s2 += w * b2;
            if ((k & 15) == 15) asm volatile("" ::: "memory");
        }
        if (kc == 0) { const f32x4 bb = *(const f32x4*)(ap->in[5] + (size_t)l * 6144 + col); s0 += bb; s1 += bb; s2 += bb; }
        float* m0 = mods + (size_t)(l * 3) * 6144 + col;
#pragma unroll
        for (int e = 0; e < 4; ++e) { atomicAdd(m0 + e, s0[e]); atomicAdd(m0 + 6144 + e, s1[e]); atomicAdd(m0 + 2 * 6144 + e, s2[e]); }
    }
}

__device__ __forceinline__ void row_phase(int gw, int NGW, int lane, int nrows, const bf16_t* Y, const float* gainY, const float* modsG, int gate_off,
                                          const float* rin_lat, const float* rin_ctx, float* rout_lat, float* rout_ctx,
                                          bf16_t* H, const float* gainH, const float* modsH, int shift_off, int scale_off) {
    for (int m = 2 * gw; m < nrows; m += 2 * NGW) {
        const int v = m < MLAT ? (m >> 13) : 2;
        const size_t roff = m < MLAT ? (size_t)m * DM : (size_t)(m - MLAT) * DM;
        const f32x4* xr = (const f32x4*)((m < MLAT ? rin_lat : rin_ctx) + roff) + lane;
        f32x4 x[2][4];
#pragma unroll
        for (int u = 0; u < 2; ++u)
#pragma unroll
            for (int j = 0; j < 4; ++j) x[u][j] = xr[256 * u + 64 * j];
        if (Y) {
            const u32x2* yr = (const u32x2*)(Y + (size_t)m * DM) + lane;
            u32x2 yw[2][4];
#pragma unroll
            for (int u = 0; u < 2; ++u)
#pragma unroll
                for (int j = 0; j < 4; ++j) yw[u][j] = yr[256 * u + 64 * j];
            const f32x4* gy = (const f32x4*)gainY + lane; const f32x4* gt = (const f32x4*)(modsG + (size_t)v * 6144 + gate_off) + lane;
            f32x4* ro = (f32x4*)((m < MLAT ? rout_lat : rout_ctx) + roff) + lane;
#pragma unroll
            for (int u = 0; u < 2; ++u) {
                f32x4 y[4]; float ss = 0.f;
#pragma unroll
                for (int j = 0; j < 4; ++j) { y[j] = (f32x4){bf2f(yw[u][j].x & 0xffffu), bf2f(yw[u][j].x >> 16), bf2f(yw[u][j].y & 0xffffu), bf2f(yw[u][j].y >> 16)}; ss += (y[j].x * y[j].x + y[j].y * y[j].y) + (y[j].z * y[j].z + y[j].w * y[j].w); }
                const float rstd = rsqrtf(wave_sum(ss) * (1.f / DM) + EPS);
#pragma unroll
                for (int j = 0; j < 4; ++j) { x[u][j] = x[u][j] + gt[64 * j] * (y[j] * rstd * gy[64 * j]); ro[256 * u + 64 * j] = x[u][j]; }
            }
        }
        if (H) {
            const f32x4* gh = (const f32x4*)gainH + lane; const f32x4* sh = (const f32x4*)(modsH + (size_t)v * 6144 + shift_off) + lane; const f32x4* sc = (const f32x4*)(modsH + (size_t)v * 6144 + scale_off) + lane;
            u32x2* ho = (u32x2*)(H + (size_t)m * DM) + lane;
#pragma unroll
            for (int u = 0; u < 2; ++u) {
                float ss = 0.f;
#pragma unroll
                for (int j = 0; j < 4; ++j) ss += (x[u][j].x * x[u][j].x + x[u][j].y * x[u][j].y) + (x[u][j].z * x[u][j].z + x[u][j].w * x[u][j].w);
                const float rstd = rsqrtf(wave_sum(ss) * (1.f / DM) + EPS);
#pragma unroll
                for (int j = 0; j < 4; ++j) { const f32x4 h = (x[u][j] * rstd * gh[64 * j]) * (sc[64 * j] + 1.0f) + sh[64 * j]; u32x2 w; w.x = pk2(h.x, h.y); w.y = pk2(h.z, h.w); ho[256 * u + 64 * j] = w; }
            }
        }
    }
}

#include <hip/hip_bf16.h>
#include <cmath>
namespace attn_body {
using bf16=__hip_bfloat16;
using bf16x8=__attribute__((ext_vector_type(8)))short;
using s16x4=__attribute__((ext_vector_type(4)))short;
using f32x16=__attribute__((ext_vector_type(16)))float;
using u32x4=__attribute__((ext_vector_type(4)))unsigned;
constexpr int D=64,QP=1152;
constexpr int BIAS_OFF=90112;
struct UnitCtx { int toff; int qpos0; int gr; int rs; int qc; unsigned vm; float sink2; };
constexpr int NW=8,QBLK=32,QB=QBLK*NW,KVBLK=64;
__device__ __forceinline__ int crow(int r,int hi){return (r&3)+8*(r>>2)+4*hi;}
#define SBAR() __builtin_amdgcn_sched_barrier(0)
constexpr int NSLOT=3, SLOTB=8192;
constexpr int LDS_K=0, LDS_V=NSLOT*SLOTB, LDS_WS=2*NSLOT*SLOTB, LDS_OST=LDS_WS+NW*64*4, LDS_BYTES=LDS_OST+NW*4096;
constexpr float C2=0.125f*1.4426950408889634f;
__device__ __forceinline__ void glds16(const void*gsrc,unsigned lds_dst){unsigned keep;
  asm volatile("s_mov_b32 %0, m0\n\ts_mov_b32 m0, %2\n\ts_nop 0\n\tglobal_load_lds_dwordx4 %1, off\n\ts_mov_b32 m0, %0":"=&s"(keep):"v"(gsrc),"s"(lds_dst):"memory");}
__device__ __forceinline__ float max3f(float a,float b,float c){float r;asm("v_max3_f32 %0, %1, %2, %3":"=v"(r):"v"(a),"v"(b),"v"(c));return r;}
__device__ __forceinline__ float max2f(float a,float b){float r;asm("v_max_f32_e32 %0, %1, %2":"=v"(r):"v"(a),"v"(b));return r;}
__device__ __forceinline__ float fadd_s(float a,float b){float r;asm("v_add_f32_e32 %0, %1, %2":"=v"(r):"v"(a),"v"(b));return r;}
__device__ __forceinline__ float fsub_s(float a,float b){float r;asm("v_sub_f32_e32 %0, %1, %2":"=v"(r):"v"(a),"v"(b));return r;}
typedef float f32x2_t __attribute__((ext_vector_type(2))); typedef __bf16 bf16x2_t __attribute__((ext_vector_type(2)));
__device__ __forceinline__ unsigned cvtpk_s(float lo,float hi){f32x2_t v={lo,hi};bf16x2_t b=__builtin_convertvector(v,bf16x2_t);return __builtin_bit_cast(unsigned,b);}
#define WAIT_BAR(N) asm volatile("s_waitcnt vmcnt(" #N ") lgkmcnt(0)\n\ts_barrier":::"memory")

__device__ __forceinline__ void qkt(f32x16&p0,f32x16&p1,const char*Kslot,const bf16x8*qr,int r32,int hi){ const f32x16 negm={};
  const char*kb=Kslot+hi*1024+r32*16;
  #pragma unroll
  for(int d0=0;d0<4;++d0){
    const bf16x8 b0=*reinterpret_cast<const bf16x8*>(kb+d0*2048);
    const bf16x8 b1=*reinterpret_cast<const bf16x8*>(kb+d0*2048+512);
    if(d0==0){p0=__builtin_amdgcn_mfma_f32_32x32x16_bf16(b0,qr[0],negm,0,0,0);p1=__builtin_amdgcn_mfma_f32_32x32x16_bf16(b1,qr[0],negm,0,0,0);}
    else{p0=__builtin_amdgcn_mfma_f32_32x32x16_bf16(b0,qr[d0],p0,0,0,0);p1=__builtin_amdgcn_mfma_f32_32x32x16_bf16(b1,qr[d0],p1,0,0,0);}}
}
typedef __attribute__((address_space(3))) const char* lds_cptr;
typedef short v4i16_t __attribute__((ext_vector_type(4)));
__device__ __forceinline__ void kload8(bf16x8*kf,lds_cptr kp){
  kf[0]=*(const __attribute__((address_space(3))) bf16x8*)(kp);      kf[1]=*(const __attribute__((address_space(3))) bf16x8*)(kp+512);
  kf[2]=*(const __attribute__((address_space(3))) bf16x8*)(kp+2048); kf[3]=*(const __attribute__((address_space(3))) bf16x8*)(kp+2560);
  kf[4]=*(const __attribute__((address_space(3))) bf16x8*)(kp+4096); kf[5]=*(const __attribute__((address_space(3))) bf16x8*)(kp+4608);
  kf[6]=*(const __attribute__((address_space(3))) bf16x8*)(kp+6144); kf[7]=*(const __attribute__((address_space(3))) bf16x8*)(kp+6656);
}
__device__ __forceinline__ void kload2(bf16x8*kf,lds_cptr kp,int j){ kf[2*j]=*(const __attribute__((address_space(3))) bf16x8*)(kp+j*2048); kf[2*j+1]=*(const __attribute__((address_space(3))) bf16x8*)(kp+j*2048+512); }
__device__ __forceinline__ s16x4 vtr(lds_cptr p){ return __builtin_bit_cast(s16x4,__builtin_amdgcn_ds_read_tr16_b64_v4i16((__attribute__((address_space(3))) v4i16_t*)p)); }
template<int MODE> __device__ __forceinline__ void amask(f32x16&c0,f32x16&c1,int t,const UnitCtx&uc,int hi,lds_cptr shm3){
  if(t<4)return;
  const float NEG=-INFINITY;
  if(MODE==1){ const int dq=64*(uc.toff+t-4)+4*hi-uc.qpos0;
    #pragma unroll
    for(int r=0;r<16;++r){ const int d=dq+(r&3)+8*(r>>2); if(d>128||d<-128)c0[r]=NEG; if(d+32>128||d+32<-128)c1[r]=NEG; } }
  else { const int kr=uc.toff+t-4;
    if(kr<uc.rs||kr>=uc.rs+8){
      #pragma unroll
      for(int r=0;r<16;++r){c0[r]=NEG;c1[r]=NEG;} }
    else { const __attribute__((address_space(3))) float*brow=(const __attribute__((address_space(3))) float*)(shm3+BIAS_OFF)+(kr-uc.gr+7)*31+15-uc.qc;
      unsigned vm=uc.vm; asm volatile("":"+v"(vm));
      #pragma unroll
      for(int r=0;r<16;++r){ const int kc=(r&3)+8*(r>>2)+4*hi; const float b0=brow[kc],b1=brow[kc+32];
        c0[r]=__builtin_amdgcn_ubfe(vm,(unsigned)r,1u)?c0[r]+b0:NEG; c1[r]=__builtin_amdgcn_ubfe(vm,(unsigned)(16+r),1u)?c1[r]+b1:NEG;
        if((r&3)==3)__builtin_amdgcn_sched_barrier(0); } } }
}
__device__ __forceinline__ float rowmax(const f32x16&p0,const f32x16&p1){
  float a=max3f(p0[0],p0[1],p1[0]),b=max3f(p0[2],p0[3],p1[1]);a=max3f(a,p1[2],p1[3]);
  #pragma unroll
  for(int r=4;r<16;r+=4){a=max3f(a,p0[r],p0[r+1]);b=max3f(b,p0[r+2],p0[r+3]);a=max3f(a,p1[r],p1[r+1]);b=max3f(b,p1[r+2],p1[r+3]);}
  const float m=max2f(a,b);
  auto rr=__builtin_amdgcn_permlane32_swap(__float_as_uint(m),__float_as_uint(m),false,false);
  return max2f(__uint_as_float(rr[0]),__uint_as_float(rr[1]));
}
__device__ __forceinline__ void pv(f32x16*o,int vb,bf16x8 pa0,bf16x8 pa1,bf16x8 pa2,bf16x8 pa3){
  #pragma unroll
  for(int d0=0;d0<2;++d0){s16x4 lo[4],hi[4];
    #pragma unroll
    for(int ks=0;ks<4;++ks){
      asm volatile("ds_read_b64_tr_b16 %0,%1 offset:%c2":"=&v"(lo[ks]):"v"(vb),"i"(d0*4096+ks*1024):"memory");
      asm volatile("ds_read_b64_tr_b16 %0,%1 offset:%c2":"=&v"(hi[ks]):"v"(vb),"i"(d0*4096+ks*1024+512):"memory");}
    asm volatile("s_waitcnt lgkmcnt(0)":::"memory");SBAR();
    #define PK(k) (bf16x8){lo[k][0],lo[k][1],lo[k][2],lo[k][3],hi[k][0],hi[k][1],hi[k][2],hi[k][3]}
    o[d0]=__builtin_amdgcn_mfma_f32_32x32x16_bf16(pa0,PK(0),o[d0],0,0,0);
    o[d0]=__builtin_amdgcn_mfma_f32_32x32x16_bf16(pa1,PK(1),o[d0],0,0,0);
    o[d0]=__builtin_amdgcn_mfma_f32_32x32x16_bf16(pa2,PK(2),o[d0],0,0,0);
    o[d0]=__builtin_amdgcn_mfma_f32_32x32x16_bf16(pa3,PK(3),o[d0],0,0,0);
    #undef PK
  }
}

#ifndef ATTN_STORE16
#define ATTN_STORE16(p,v) (*(u32x4*)(p)=(v))
#endif
template<int KP,int VP,int MODE,int THRL> __device__ __forceinline__ void attn_unit(const bf16*Qb,const bf16*__restrict__ Kh,const bf16*__restrict__ Vh,bf16*Ob,int NT,const UnitCtx uc,char*shm,int wave_id){
  const int tid=tid_of(wave_id),lane=tid&63,r32=lane&31,hi=lane>>5; const int wid=wave_id;
  const bf16*Qw=Qb+(long)(wid*QBLK)*QP;
  const unsigned lds0=(unsigned)(uintptr_t)shm;
  float*wsf=(float*)(shm+LDS_WS)+wid*64;
  const bf16*ksrc=Kh+(long)lane*KP+wid*8;
  const bf16*vsrc=Vh+(long)(16*(wid&3)+(lane>>2))*VP+(wid>>2)*32+(lane&3)*8;
  const unsigned kdst=lds0+LDS_K+wid*1024, vdst=lds0+LDS_V+wid*1024;
  #define KT(t) ((t)<4?(t):(t)+uc.toff)
  #define DMA_K(t,slot) glds16(ksrc+(long)KT(t)*KVBLK*KP,(unsigned)__builtin_amdgcn_readfirstlane(kdst+(slot)))
  #define DMA_V(t,slot) glds16(vsrc+(long)KT(t)*KVBLK*VP,(unsigned)__builtin_amdgcn_readfirstlane(vdst+(slot)))
  const int vb0=(int)(lds0+LDS_V)+((lane>>4)&1)*32+(lane&3)*8+(4*hi+((lane&15)>>2))*64;
  const char*Kbase=shm+LDS_K; bf16x8 kf[8];
  const lds_cptr shm3=(lds_cptr)shm; const lds_cptr kp0=shm3+LDS_K+hi*1024+r32*16; const lds_cptr vp0=shm3+LDS_V+((lane>>4)&1)*32+(lane&3)*8+(4*hi+((lane&15)>>2))*64;
  DMA_K(0,0);DMA_V(0,0);DMA_K(1,SLOTB);
  bf16x8 qr[4];
  #pragma unroll
  for(int d0=0;d0<4;++d0)qr[d0]=*reinterpret_cast<const bf16x8*>(&Qw[(long)r32*QP+d0*16+hi*8]);
  float mhat=0.f,l_reg=0.f;f32x16 o[2];o[0]=f32x16{};o[1]=f32x16{};
  constexpr bool NEGM=(MODE==0);
  f32x16 negm=f32x16{}; const f32x16 zero16=f32x16{}; if(NEGM)asm volatile("":"+v"(negm));
  #define CINIT (NEGM?negm:zero16)
  #define NEGM_SET() do{ if(NEGM){ _Pragma("unroll") for(int r_=0;r_<16;++r_)negm[r_]=-mhat; asm volatile("":"+v"(negm)); } }while(0)
  #define CMASK(P0,P1,t) do{ if(MODE!=0) amask<MODE>(P0,P1,(t),uc,hi,(lds_cptr)shm); }while(0)
  bool resc=false;
  #define START(P0,P1) do{ const float rm=rowmax(P0,P1); resc=false; \
    { const float dl=rm; mhat=fadd_s(mhat,dl); \
      _Pragma("unroll") for(int r=0;r<16;++r){P0[r]=fsub_s(P0[r],dl);P1[r]=fsub_s(P1[r],dl);} NEGM_SET(); } \
    _Pragma("unroll") for(int r=0;r<16;++r)P0[r]=__builtin_amdgcn_exp2f(P0[r]); }while(0)
  #define RESC() do{ if(resc){ asm volatile("s_waitcnt lgkmcnt(0)":::"memory"); \
      _Pragma("unroll") for(int d_=0;d_<2;++d_) _Pragma("unroll") for(int r=0;r<16;++r)o[d_][r]*=wsf[crow(r,hi)]; } }while(0)
  f32x16 pA0,pA1,pB0,pB1;
  int sl_prev=0,sl_cur=0,sl_next=SLOTB;
  #define ROT() do{sl_prev=sl_cur;sl_cur=sl_next;sl_next=(sl_next==(NSLOT-1)*SLOTB)?0:sl_next+SLOTB;}while(0)
  DMA_K(2,2*SLOTB);
  WAIT_BAR(3);
  qkt(pA0,pA1,Kbase,qr,r32,hi);asm volatile("s_nop 15\n\ts_nop 7":"+v"(pA0),"+v"(pA1));CMASK(pA0,pA1,0);
  START(pA0,pA1);
  if(uc.sink2>-1e30f){ l_reg=(hi==0)?__builtin_amdgcn_exp2f(uc.sink2-mhat):0.f; }
  _Pragma("unroll") for(int r=0;r<16;++r)pA1[r]=__builtin_amdgcn_exp2f(pA1[r]);
  WAIT_BAR(0);
  DMA_K(3,0);DMA_V(1,SLOTB);
  ROT();
  kload8(kf,kp0+sl_cur);
  WAIT_BAR(2);
  s16x4 vlo[8],vhi[8]; u32x4 pw0,pw1,pw2,pw3;
  #define PKW(P,B) cvtpk_s(P[B],P[B+1])
  #define PAF(k) __builtin_bit_cast(bf16x8,pw##k)
  #define VFR(i) (bf16x8){vlo[i][0],vlo[i][1],vlo[i][2],vlo[i][3],vhi[i][0],vhi[i][1],vhi[i][2],vhi[i][3]}
  #define PIN(x) asm volatile("":"+v"(x))
  #define MX3(a,b,c) __builtin_fmaxf(__builtin_fmaxf((a),(b)),(c))
  #define GAPA(MF,A0,A1,A2,A3,W0,W1,PW) do{ MF; sacc+=A0; sacc+=A1; sacc+=A2; sacc+=A3; PIN(sacc); W0; W1; PIN(PW); SBAR(); }while(0)
  #define EX(v) __builtin_amdgcn_exp2f(v)
  #define GAPB(MF,X,B) do{ MF; X[B]=EX(X[B]); X[B+1]=EX(X[B+1]); X[B+2]=EX(X[B+2]); X[B+3]=EX(X[B+3]); PIN(X); SBAR(); }while(0)
  #define VRD(i) do{ vlo[i]=vtr(vp_+(((i)>>2)*4096+((i)&3)*1024)); vhi[i]=vtr(vp_+(((i)>>2)*4096+((i)&3)*1024+512)); }while(0)
  #define KRD(G,j) do{ if(G){ kload2(kf,kp0+sl_next,j); SBAR(); } }while(0)
  #define STEP(C0,C1,P0,P1,t,GK,GV,GL) do{ SBAR(); \
    const lds_cptr vp_=vp0+sl_prev; \
    VRD(0); SBAR(); float sacc=(P0[0]+P0[1]); \
    GAPA(C0=__builtin_amdgcn_mfma_f32_32x32x16_bf16(kf[0],qr[0],CINIT,0,0,0), P0[2],P0[3],P0[4],P0[5],     pw0[0]=PKW(P0,0), pw0[1]=PKW(P0,2), pw0); \
    VRD(4); SBAR(); GAPA(C1=__builtin_amdgcn_mfma_f32_32x32x16_bf16(kf[1],qr[0],CINIT,0,0,0), P0[6],P0[7],P0[8],P0[9],     pw0[2]=PKW(P0,4), pw0[3]=PKW(P0,6), pw0); \
    VRD(1); SBAR(); GAPA(C0=__builtin_amdgcn_mfma_f32_32x32x16_bf16(kf[2],qr[1],C0,0,0,0),   P0[10],P0[11],P0[12],P0[13], pw1[0]=PKW(P0,8), pw1[1]=PKW(P0,10), pw1); \
    VRD(5); SBAR(); GAPA(C1=__builtin_amdgcn_mfma_f32_32x32x16_bf16(kf[3],qr[1],C1,0,0,0),   P0[14],P0[15],P1[0],P1[1],   pw1[2]=PKW(P0,12),pw1[3]=PKW(P0,14), pw1); \
    VRD(2); SBAR(); GAPA(C0=__builtin_amdgcn_mfma_f32_32x32x16_bf16(kf[4],qr[2],C0,0,0,0),   P1[2],P1[3],P1[4],P1[5],     pw2[0]=PKW(P1,0), pw2[1]=PKW(P1,2), pw2); \
    VRD(6); SBAR(); GAPA(C1=__builtin_amdgcn_mfma_f32_32x32x16_bf16(kf[5],qr[2],C1,0,0,0),   P1[6],P1[7],P1[8],P1[9],     pw2[2]=PKW(P1,4), pw2[3]=PKW(P1,6), pw2); \
    VRD(3); SBAR(); GAPA(C0=__builtin_amdgcn_mfma_f32_32x32x16_bf16(kf[6],qr[3],C0,0,0,0),   P1[10],P1[11],P1[12],P1[13], pw3[0]=PKW(P1,8), pw3[1]=PKW(P1,10), pw3); \
    VRD(7); SBAR(); GAPA(C1=__builtin_amdgcn_mfma_f32_32x32x16_bf16(kf[7],qr[3],C1,0,0,0),   P1[14],P1[15],0.f,0.f,       pw3[2]=PKW(P1,12),pw3[3]=PKW(P1,14), pw3); \
    l_reg+=sacc; \
    if(!NEGM){ _Pragma("unroll") for(int r=0;r<16;++r){C0[r]-=mhat;C1[r]-=mhat;} } \
    if(GK){DMA_K((t)+3,sl_cur);} if(GV){DMA_V((t)+1,sl_next);} \
    CMASK(C0,C1,t); \
    { float a=MX3(C0[0],C0[1],C1[0]),b=MX3(C0[2],C0[3],C1[1]); a=MX3(a,C1[2],C1[3]); \
      _Pragma("unroll") for(int r=4;r<16;r+=4){a=MX3(a,C0[r],C0[r+1]);b=MX3(b,C0[r+2],C0[r+3]);a=MX3(a,C1[r],C1[r+1]);b=MX3(b,C1[r+2],C1[r+3]);} \
      float rm=__builtin_fmaxf(a,b); { auto rr=__builtin_amdgcn_permlane32_swap(__float_as_uint(rm),__float_as_uint(rm),false,false); rm=__builtin_fmaxf(__uint_as_float(rr[0]),__uint_as_float(rr[1])); } \
      resc=false; \
      if(__builtin_expect(__any(rm>(float)THRL),0)){ const float dl=__builtin_fmaxf(rm,0.f); mhat+=dl; \
        _Pragma("unroll") for(int r=0;r<16;++r){C0[r]-=dl;C1[r]-=dl;} NEGM_SET(); \
        const float f=__builtin_amdgcn_exp2f(-dl); l_reg*=f; if(hi==0)wsf[r32]=f; resc=true; } } \
    SBAR(); \
    GAPB(o[0]=__builtin_amdgcn_mfma_f32_32x32x16_bf16(PAF(0),VFR(0),o[0],0,0,0), C0,0); \
    GAPB(o[1]=__builtin_amdgcn_mfma_f32_32x32x16_bf16(PAF(0),VFR(4),o[1],0,0,0), C0,4); \
    KRD(GL,0); GAPB(o[0]=__builtin_amdgcn_mfma_f32_32x32x16_bf16(PAF(1),VFR(1),o[0],0,0,0), C0,8); \
    KRD(GL,1); GAPB(o[1]=__builtin_amdgcn_mfma_f32_32x32x16_bf16(PAF(1),VFR(5),o[1],0,0,0), C0,12); \
    KRD(GL,2); GAPB(o[0]=__builtin_amdgcn_mfma_f32_32x32x16_bf16(PAF(2),VFR(2),o[0],0,0,0), C1,0); \
    KRD(GL,3); GAPB(o[1]=__builtin_amdgcn_mfma_f32_32x32x16_bf16(PAF(2),VFR(6),o[1],0,0,0), C1,4); \
    GAPB(o[0]=__builtin_amdgcn_mfma_f32_32x32x16_bf16(PAF(3),VFR(3),o[0],0,0,0), C1,8); \
    GAPB(o[1]=__builtin_amdgcn_mfma_f32_32x32x16_bf16(PAF(3),VFR(7),o[1],0,0,0), C1,12); \
    }while(0)
  int t=1;
  for(;t+5<NT;t+=2){
    STEP(pB0,pB1,pA0,pA1,t,true,true,true);     WAIT_BAR(2); RESC(); ROT();
    STEP(pA0,pA1,pB0,pB1,t+1,true,true,true);   WAIT_BAR(2); RESC(); ROT();
  }
  #define ENDW(tt) do{ if((tt)+3<NT){WAIT_BAR(2);} else if((tt)+2<NT){WAIT_BAR(1);} else {WAIT_BAR(0);} }while(0)
  for(;t+1<NT;t+=2){
    STEP(pB0,pB1,pA0,pA1,t,(t+3<NT),(t+1<NT),(t+1<NT));       ENDW(t);   RESC(); ROT();
    STEP(pA0,pA1,pB0,pB1,t+1,(t+4<NT),(t+2<NT),(t+2<NT));     ENDW(t+1); RESC(); ROT();
  }
  STEP(pB0,pB1,pA0,pA1,NT-1,false,false,false); RESC();
  { float sacc=pB0[0]+pB0[1]; _Pragma("unroll") for(int r=2;r<16;++r)sacc+=pB0[r]; _Pragma("unroll") for(int r=0;r<16;++r)sacc+=pB1[r]; l_reg+=sacc;
    pw0=(u32x4){PKW(pB0,0),PKW(pB0,2),PKW(pB0,4),PKW(pB0,6)};pw1=(u32x4){PKW(pB0,8),PKW(pB0,10),PKW(pB0,12),PKW(pB0,14)};pw2=(u32x4){PKW(pB1,0),PKW(pB1,2),PKW(pB1,4),PKW(pB1,6)};pw3=(u32x4){PKW(pB1,8),PKW(pB1,10),PKW(pB1,12),PKW(pB1,14)};
    SBAR(); pv(o,vb0+sl_cur,PAF(0),PAF(1),PAF(2),PAF(3)); }
  #undef PKW
  #undef PAF
  #undef VFR
  #undef PIN
  #undef MX3
  #undef GAPA
  #undef GAPB
  #undef EX
  #undef VRD
  #undef KRD
  #undef STEP
  #undef ENDW
  {auto rr=__builtin_amdgcn_permlane32_swap(__float_as_uint(l_reg),__float_as_uint(l_reg),false,false);l_reg=__uint_as_float(rr[0])+__uint_as_float(rr[1]);}
  if(hi==0)wsf[32+r32]=l_reg;asm volatile("s_waitcnt lgkmcnt(0)":::"memory");
  float rli[16];
  #pragma unroll
  for(int r=0;r<16;++r)rli[r]=__builtin_amdgcn_rcpf(wsf[32+crow(r,hi)]);
  bf16*Ow=Ob+(long)(wid*QBLK)*QP;
  { bf16*stg=(bf16*)(shm+LDS_OST)+wid*2048;
    #pragma unroll
    for(int r=0;r<16;++r){const int orow=crow(r,hi);
      #pragma unroll
      for(int d0=0;d0<2;++d0)stg[orow*64+d0*32+r32]=__float2bfloat16(o[d0][r]*rli[r]);}
    asm volatile("s_waitcnt lgkmcnt(0)":::"memory");
    #pragma unroll
    for(int i=0;i<4;++i){const int row=i*8+(lane>>3),ch=lane&7; const u32x4 v=*(const u32x4*)(stg+row*64+ch*8); ATTN_STORE16(Ow+(long)row*QP+ch*8,v);} }
  asm volatile("s_waitcnt lgkmcnt(0)\n\ts_barrier":::"memory");
  #undef DMA_K
  #undef DMA_V
  #undef CMASK
  #undef KT
  #undef CINIT
  #undef NEGM_SET
  #undef START
  #undef RESC
  #undef ROT
}
constexpr int ATTN_LDS_BYTES=LDS_BYTES;
#undef SBAR
#undef WAIT_BAR
}
__device__ __forceinline__ void attn_dispatch(KAP ap, int l, int uid, int wid, char* shm) {
    using namespace attn_body;
    unsigned char* ws = ap->ws;
    const int r32 = lane_id() & 31;
    const bf16* Qa = (const bf16*)(ws + WS_Q);
    UnitCtx uc; uc.toff = 0; uc.qpos0 = 0; uc.gr = 0; uc.rs = 0; uc.qc = 0; uc.vm = 0u; uc.sink2 = -INFINITY;
    if (uid < 384) {
        const int qb = uid & 31, bh = uid >> 5, b = bh / 6, h = bh % 6;
        const bf16* Qb = Qa + (size_t)(b * SEQ + qb * 256) * QW + (6 + h) * 64;
        const size_t ko = (size_t)b * KEYS * 256 + 128 + (h / 3) * 64;
        attn_unit<256, 256, 0, 8>(Qb, (const bf16*)(ws + WS_KAB) + ko, (const bf16*)(ws + WS_VTAB) + ko, (bf16*)Qb, KEYS / 64, uc, shm, wid);
    } else if (uid < 768) {
        const int u = uid - 384, qb = u & 31, bh = u >> 5, b = bh / 6, h = bh % 6;
        const bf16* Qb = Qa + (size_t)(b * SEQ + qb * 256) * QW + (12 + h) * 64;
        const size_t ko = (size_t)b * KEYS * 384 + h * 64;
        int klo = 4 * qb - 4; klo = klo < 0 ? 0 : (klo > 120 ? 120 : klo);
        int khi = 4 * qb + 3 - 4; khi = (khi < 0 ? 0 : (khi > 120 ? 120 : khi)) + 7;
        const int cnt = khi - klo + 1;
        uc.toff = klo; uc.gr = 4 * qb + (wid >> 1); uc.rs = uc.gr - 4 < 0 ? 0 : (uc.gr - 4 > 120 ? 120 : uc.gr - 4);
        uc.qc = 32 * (wid & 1) + r32;
        { const int wsn = uc.qc - 8 < 0 ? 0 : (uc.qc - 8 > 48 ? 48 : uc.qc - 8), hi = (lane_id() >> 5) & 1; unsigned vm = 0u;
#pragma unroll
          for (int r = 0; r < 16; ++r) { const int kc = (r & 3) + 8 * (r >> 2) + 4 * hi;
            unsigned b0 = (unsigned)(kc - wsn) < 16u ? 1u : 0u, b1 = (unsigned)(kc + 32 - wsn) < 16u ? 1u : 0u; asm volatile("" : "+v"(b0), "+v"(b1)); vm |= (b0 << r) | (b1 << (16 + r)); }
          uc.vm = vm; }
        { const float* rpb = ap->in[12] + (size_t)(l * 6 + h) * 465; float* bl = (float*)(shm + BIAS_OFF); const int tb = tid_of(wid); if (tb < 465) bl[tb] = rpb[tb] * LOG2E; }
        attn_unit<384, 384, 2, 8>(Qb, (const bf16*)(ws + WS_KC) + ko, (const bf16*)(ws + WS_VTC) + ko, (bf16*)Qb, 4 + cnt + (cnt & 1), uc, shm, wid);
    } else if (uid < 1152) {
        const int u = uid - 768, qb = u & 31, bh = u >> 5, b = bh / 6, h = bh % 6;
        const bf16* Qb = Qa + (size_t)(b * SEQ + qb * 256) * QW + h * 64;
        const size_t ko = (size_t)b * KEYS * 256 + (h / 3) * 64;
        const int tlo = 4 * qb - 2 < 0 ? 0 : 4 * qb - 2, thi = 4 * qb + 5 > 127 ? 127 : 4 * qb + 5;
        uc.toff = tlo; uc.qpos0 = 256 * qb + 32 * wid + r32; uc.sink2 = ap->in[9][l * 6 + h] * LOG2E;
        attn_unit<256, 256, 1, 8>(Qb, (const bf16*)(ws + WS_KAB) + ko, (const bf16*)(ws + WS_VTAB) + ko, (bf16*)Qb, 4 + thi - tlo + 1, uc, shm, wid);
    } else {
        const int v = uid - 1152, type = v / 12, b = (v / 6) % 2, h = v % 6;
        const bf16* Qb = Qa + (size_t)(MLAT + b * LCTX) * QW + (type * 6 + h) * 64;
        if (type == 2) {
            const size_t ko = (size_t)b * KEYS * 384 + h * 64;
            attn_unit<384, 384, 0, 8>(Qb, (const bf16*)(ws + WS_KC) + ko, (const bf16*)(ws + WS_VTC) + ko, (bf16*)Qb, 4, uc, shm, wid);
        } else {
            const size_t ko = (size_t)b * KEYS * 256 + type * 128 + (h / 3) * 64;
            if (type == 0) uc.sink2 = ap->in[9][l * 6 + h] * LOG2E;
            attn_unit<256, 256, 0, 8>(Qb, (const bf16*)(ws + WS_KAB) + ko, (const bf16*)(ws + WS_VTAB) + ko, (bf16*)Qb, 4, uc, shm, wid);
        }
    }
}

struct OneUnit { int pm, pn; __device__ __forceinline__ bool next(int i, Unit& u) const { if (i != 0) return false; u.pm = pm; u.pn = pn; return true; } };

#define XB_TMO      128
#define XB_XCNT(j)  (256  + 64 * (j))
#define XB_XSUB(j)  (1280 + 64 * (j))
#define XB_XGEN(j)  (2304 + 64 * (j))
#define XB_TOP      3328
#define XB_TOPGEN   3392
#define XCD_BAR_WORDS 3456
#define XB_SPIN_CAP (1u << 18)

__device__ __forceinline__ unsigned xb_ld(unsigned* p)              { return __hip_atomic_load(p, __ATOMIC_RELAXED, __HIP_MEMORY_SCOPE_AGENT); }
__device__ __forceinline__ unsigned xb_add(unsigned* p, unsigned v) { return __hip_atomic_fetch_add(p, v, __ATOMIC_RELAXED, __HIP_MEMORY_SCOPE_AGENT); }
__device__ __forceinline__ unsigned xb_xcc_id() { return (unsigned)__builtin_amdgcn_s_getreg((3 << 11) | 20) & 0xFu; }
#define XB_SPIN(cond, bar) do { unsigned _sp = 0; while (cond) { __builtin_amdgcn_s_sleep(1); \
    if ((++_sp & 255u) == 0u) { if (xb_ld(&(bar)[XB_TMO])) break; if (_sp > XB_SPIN_CAP) { atomicAdd(&(bar)[XB_TMO], 1u); break; } } } } while (0)

struct XcdBarrier {
    unsigned* bar; unsigned x;
    volatile __attribute__((address_space(3))) unsigned* st;
};

__device__ __forceinline__ XcdBarrier xcd_barrier_post(unsigned* bar, volatile __attribute__((address_space(3))) unsigned* st, bool leader) {
    XcdBarrier b; b.bar = bar; b.x = xb_xcc_id(); b.st = st;
    if (leader) (void)xb_add(&bar[XB_XCNT(b.x)], 1u);
    return b;
}
__device__ __forceinline__ void xcd_barrier_complete(unsigned* bar, unsigned x, unsigned& nloc, unsigned& nx) {
    const unsigned G = gridDim.x * gridDim.y * gridDim.z;
    unsigned sum, cnt, mine, sp = 0u;
    for (;;) {
        sum = 0u; cnt = 0u; mine = 0u;
#pragma unroll
        for (unsigned j = 0; j < 16; ++j) { const unsigned c = xb_ld(&bar[XB_XCNT(j)]); sum += c; cnt += (c > 0u) ? 1u : 0u; mine = (j == x) ? c : mine; }
        if (sum == G) break;
        __builtin_amdgcn_s_sleep(1);
        if ((++sp & 255u) == 0u) { if (xb_ld(&bar[XB_TMO])) break; if (sp > XB_SPIN_CAP) { atomicAdd(&bar[XB_TMO], 1u); break; } }
    }
    nloc = mine > 0u ? mine : 1u; nx = cnt > 0u ? cnt : 1u;
}

__device__ __forceinline__ void xcd_barrier(const XcdBarrier& b, bool leader) {
    asm volatile("s_waitcnt vmcnt(0)" ::: "memory");
    __syncthreads();
    if (leader) {
        unsigned* bar = b.bar;
        __builtin_amdgcn_s_waitcnt(0);
        unsigned nloc = b.st[0], nx = b.st[1];
        if (nloc == 0u) { xcd_barrier_complete(bar, b.x, nloc, nx); b.st[0] = nloc; b.st[1] = nx; }
        const unsigned old = xb_add(&bar[XB_XSUB(b.x)], 1u);
        const unsigned gen = old / nloc;
        if (old + 1u == (gen + 1u) * nloc) {
            __builtin_amdgcn_fence(__ATOMIC_RELEASE, "agent");
            asm volatile("s_waitcnt vmcnt(0)" ::: "memory");
            const unsigned og = xb_add(&bar[XB_TOP], 1u);
            const unsigned tg = og / nx;
            if (og + 1u == (tg + 1u) * nx) xb_add(&bar[XB_TOPGEN], 1u);
            else XB_SPIN(xb_ld(&bar[XB_TOPGEN]) == tg, bar);
            __builtin_amdgcn_fence(__ATOMIC_ACQUIRE, "agent");
            xb_add(&bar[XB_XGEN(b.x)], 1u);
            asm volatile("s_waitcnt vmcnt(0)" ::: "memory");
        } else {
            XB_SPIN(xb_ld(&bar[XB_XGEN(b.x)]) == gen, bar);
            __builtin_amdgcn_fence(__ATOMIC_ACQUIRE, "agent");
            asm volatile("s_waitcnt vmcnt(0)" ::: "memory");
        }
    }
    __syncthreads();
}
__global__ void __launch_bounds__(512, 2) fwd_mega(Args a) {
    extern __shared__ __attribute__((aligned(16))) unsigned char lds_raw[];
    cg::grid_group grid = cg::this_grid();
    PG8_LAS unsigned char* lds = (PG8_LAS unsigned char*)lds_raw;
    const int wave = __builtin_amdgcn_readfirstlane((int)threadIdx.x >> 6);
    const int tid = tid_of(wave);
    const int G = gridDim.x, gw = blockIdx.x * 8 + wave, NGW = G * 8;
#define LANE() ({ int l_ = lane_id(); asm volatile("" : "+v"(l_)); l_; })
#define LEADER() (wave == 0 && lane_id() == 0)
#define WSP() ((unsigned char*)KARGS()->ws)
#define MODS() ((float*)(WSP() + WS_MODS))
#define CTL() ((unsigned*)(WSP() + WS_CTL))
    volatile LAS unsigned* MISC = (volatile LAS unsigned*)((LAS unsigned char*)lds_raw + 131072);
    if (tid < 64) MISC[tid] = 0u;
    __syncthreads();
    { const XcdBarrier xb0 = xcd_barrier_post(CTL() + 4096, MISC + 8, LEADER()); (void)xb0; }
#if PROBE_MASK
    if (blockIdx.x == 0 && tid == 0) { const unsigned long long now = __builtin_amdgcn_s_memrealtime(); MISC[18] = (unsigned)now; MISC[19] = (unsigned)(now >> 32); }
#define TSTAMP(id) do { if (blockIdx.x == 0 && LEADER()) { const unsigned long long now_ = __builtin_amdgcn_s_memrealtime(); const unsigned long long st_ = ((unsigned long long)MISC[19] << 32) | MISC[18]; \
        if ((PROBE_MASK >> (id)) & 1) { const unsigned long long ac_ = (((unsigned long long)MISC[17] << 32) | MISC[16]) + (now_ - st_); MISC[16] = (unsigned)ac_; MISC[17] = (unsigned)(ac_ >> 32); } \
        MISC[18] = (unsigned)now_; MISC[19] = (unsigned)(now_ >> 32); } } while (0)
#else
#define TSTAMP(id) do {} while (0)
#endif
#define GRID_BAR() do { XcdBarrier xb_; xb_.bar = CTL() + 4096; xb_.x = xb_xcc_id(); xb_.st = MISC + 8; xcd_barrier(xb_, LEADER()); } while (0)

    conv_weights(KARGS(), 0, (LAS unsigned char*)lds_raw, gw, NGW, wave, LANE());
    ada_phase(KARGS(), gw, NGW, LANE());
    if (blockIdx.x == 0) {
        float* rope = (float*)(WSP() + WS_ROPE);
        for (int i = tid; i < 128 * 16; i += 512) { const int pos = i >> 4, f = i & 15; const float fr = powf(10000.0f, -(float)f / 16.0f); const float ang = (float)pos * fr; float s, c; sincosf(ang, &s, &c); rope[2 * i] = c; rope[2 * i + 1] = s; }
    }
    grid.sync(); TSTAMP(0);
    { KAP ap = KARGS();
      row_phase(gw, NGW, LANE(), MALL, nullptr, nullptr, nullptr, 0, ap->in[0], ap->in[2], nullptr, nullptr,
              (bf16_t*)(WSP() + WS_R1), ap->in[6], MODS(), 0, 1024); }
    GRID_BAR(); TSTAMP(1);

    {
        constexpr int l = 0;
        const bool last = (l == DEPTH - 1);
        const int MX = last ? MLAT : MALL;
        int bidl = blockIdx.x, Gl = gridDim.x; asm volatile("" : "+s"(bidl), "+s"(Gl));
#define MODL() (MODS() + (size_t)l * 3 * 6144)
        {
            pg8::Gemm g{(const bf16_t*)(WSP() + WS_R1), (const bf16_t*)(WSP() + WS_WIN), MALL, NINP, DM, DM, DM, 0, 0};
            pg8::StaticOrder S; S.init(MALL, NINP, Gl, bidl);
            KAP ap = KARGS();
            EpiProj E{(bf16_t*)(WSP() + WS_Q), (bf16_t*)(WSP() + WS_KAB), (bf16_t*)(WSP() + WS_KC), (bf16_t*)(WSP() + WS_VTAB), (bf16_t*)(WSP() + WS_VTC), (bf16_t*)(WSP() + WS_PG),
                      (const float*)(WSP() + WS_ROPE), ap->in[10] + l * 64, ap->in[11] + l * 64};
            pg8::gemm_phase<EpiProj, pg8::StaticOrder, true, true>(lds, g, S, E, wave);
        }
        GRID_BAR(); TSTAMP(2);
        {
            KAP ap = KARGS();
            const int nctx = last ? 0 : 36, nc2 = last ? 0 : 16, nunit = nctx + 1152 + nc2;
            unsigned* ctr = CTL() + 64 * l;
            unsigned* cdone = CTL() + 128 + 64 * l;
            for (;;) {
                if (LEADER()) MISC[24] = atomicAdd(ctr, 1u);
                __syncthreads();
                const int uid = (int)MISC[24];
                __syncthreads();
                if (uid >= nunit) break;
                if (uid < nctx) {
                    attn_dispatch(ap, l, 1152 + uid, wave, (char*)lds_raw);
                    asm volatile("s_waitcnt vmcnt(0)" ::: "memory"); __syncthreads();
                    if (LEADER()) { __threadfence(); asm volatile("s_waitcnt vmcnt(0)" ::: "memory"); __hip_atomic_fetch_add(cdone, 1u, __ATOMIC_RELAXED, __HIP_MEMORY_SCOPE_AGENT); }
                } else if (uid < nctx + 384 || uid >= nctx + 384 + nc2) {
                    attn_dispatch(ap, l, uid < nctx + 384 ? uid - nctx : uid - nctx - nc2, wave, (char*)lds_raw);
                } else if (uid >= nctx + 384 + 8) {
                    const int v = uid - nctx - 384 - 8;
                    if (LEADER()) { unsigned sp = 0; while (__hip_atomic_load(cdone + 16, __ATOMIC_RELAXED, __HIP_MEMORY_SCOPE_AGENT) < 8u && ++sp < (1u << 20)) __builtin_amdgcn_s_sleep(16); }
                    __syncthreads();
                    __threadfence(); asm volatile("s_waitcnt vmcnt(0)" ::: "memory");
                    __syncthreads();
                    pg8::Gemm g{(const bf16_t*)(WSP() + WS_PG), (const bf16_t*)(WSP() + WS_WOUT), MALL, DM, DM, 3072, DM, 0, 0};
                    OneUnit S{64 + (v >> 2), v & 3};
                    EpiBf16<0> E{(bf16_t*)(WSP() + WS_Y), DM};
                    pg8::gemm_phase<EpiBf16<0>, OneUnit, true, true>(lds, g, S, E, wave);
                } else {
                    const int v = uid - nctx - 384;
                    if (LEADER()) { unsigned sp = 0; while (__hip_atomic_load(cdone, __ATOMIC_RELAXED, __HIP_MEMORY_SCOPE_AGENT) < 36u && ++sp < (1u << 20)) __builtin_amdgcn_s_sleep(16); }
                    __syncthreads();
                    __threadfence(); asm volatile("s_waitcnt vmcnt(0)" ::: "memory");
                    __syncthreads();
                    pg8::Gemm g{(const bf16_t*)(WSP() + WS_Q), (const bf16_t*)(WSP() + WS_WBR), MALL, DM, QW, QW, QW, 0, 0};
                    OneUnit S{64 + (v >> 2), v & 3};
                    EpiGateSum E{(bf16_t*)(WSP() + WS_PG)};
                    pg8::gemm_phase<EpiGateSum, OneUnit, true, true, 6>(lds, g, S, E, wave);
                    asm volatile("s_waitcnt vmcnt(0)" ::: "memory"); __syncthreads();
                    if (LEADER()) { __threadfence(); asm volatile("s_waitcnt vmcnt(0)" ::: "memory"); __hip_atomic_fetch_add(cdone + 16, 1u, __ATOMIC_RELAXED, __HIP_MEMORY_SCOPE_AGENT); }
                }
            }
        }
        GRID_BAR(); TSTAMP(4);
        {
            pg8::Gemm g{(const bf16_t*)(WSP() + WS_Q), (const bf16_t*)(WSP() + WS_WBR), MLAT, DM, QW, QW, QW, 0, 0};
            pg8::StaticOrder S; S.init(MLAT, DM, Gl, bidl);
            EpiGateSum E{(bf16_t*)(WSP() + WS_PG)};
            pg8::gemm_phase<EpiGateSum, pg8::StaticOrder, true, true, 6>(lds, g, S, E, wave);
        }
        GRID_BAR(); TSTAMP(5);
        {
            pg8::Gemm g{(const bf16_t*)(WSP() + WS_PG), (const bf16_t*)(WSP() + WS_WOUT), MLAT, DM, DM, 3072, DM, 0, 0};
            pg8::StaticOrder S; S.init(MLAT, DM, Gl, bidl);
            EpiBf16<0> E{(bf16_t*)(WSP() + WS_Y), DM};
            pg8::gemm_phase<EpiBf16<0>, pg8::StaticOrder, true, true>(lds, g, S, E, wave);
        }
        GRID_BAR(); TSTAMP(6);
        { KAP ap = KARGS();
          row_phase(gw, NGW, LANE(), MX, (const bf16_t*)(WSP() + WS_Y), ap->in[7] + l * DM, MODL(), 2048,
                  l == 0 ? ap->in[0] : ap->out, l == 0 ? ap->in[2] : (const float*)(WSP() + WS_XC), ap->out, (float*)(WSP() + WS_XC),
                  (bf16_t*)(WSP() + WS_Q), ap->in[17] + l * DM, MODL(), 3072, 4096); }
        GRID_BAR(); TSTAMP(7);
        {
            pg8::Gemm g{(const bf16_t*)(WSP() + WS_Q), (const bf16_t*)(WSP() + WS_W1), MX, FF, DM, DM, DM, 0, 0};
            pg8::StaticOrder S; S.init(MX, FF, Gl, bidl);
            EpiBf16<1> E{(bf16_t*)(WSP() + WS_A), FF};
            pg8::gemm_phase<EpiBf16<1>, pg8::StaticOrder, true, true>(lds, g, S, E, wave);
        }
        GRID_BAR(); TSTAMP(8);
        {
            pg8::Gemm g{(const bf16_t*)(WSP() + WS_A), (const bf16_t*)(WSP() + WS_W2), MX, DM, FF, FF, FF, 0, 0};
            pg8::StaticOrder S; S.init(MX, DM, Gl, bidl);
            EpiBf16<0> E{(bf16_t*)(WSP() + WS_Y2), DM};
            pg8::gemm_phase<EpiBf16<0>, pg8::StaticOrder, true, true>(lds, g, S, E, wave);
        }
        GRID_BAR(); TSTAMP(9);
        if (!last) {
            { KAP ap = KARGS();
              row_phase(gw, NGW, LANE(), MX, (const bf16_t*)(WSP() + WS_Y2), ap->in[18] + l * DM, MODL(), 5120,
                      ap->out, (const float*)(WSP() + WS_XC), ap->out, (float*)(WSP() + WS_XC),
                      (bf16_t*)(WSP() + WS_R1), ap->in[6] + (l + 1) * DM, MODL() + 3 * 6144, 0, 1024); }
            conv_weights(KARGS(), l + 1, (LAS unsigned char*)lds_raw, gw, NGW, wave, LANE());
            GRID_BAR(); TSTAMP(10);
        } else {
            { KAP ap = KARGS();
              row_phase(gw, NGW, LANE(), MX, (const bf16_t*)(WSP() + WS_Y2), ap->in[18] + l * DM, MODL(), 5120,
                      ap->out, (const float*)(WSP() + WS_XC), ap->out, (float*)(WSP() + WS_XC),
                      nullptr, nullptr, nullptr, 0, 0); }
            TSTAMP(10);
        }
    }
    {
        constexpr int l = 1;
        const bool last = (l == DEPTH - 1);
        const int MX = last ? MLAT : MALL;
        int bidl = blockIdx.x, Gl = gridDim.x; asm volatile("" : "+s"(bidl), "+s"(Gl));
#define MODL() (MODS() + (size_t)l * 3 * 6144)
        {
            pg8::Gemm g{(const bf16_t*)(WSP() + WS_R1), (const bf16_t*)(WSP() + WS_WIN), MALL, NINP, DM, DM, DM, 0, 0};
            pg8::StaticOrder S; S.init(MALL, NINP, Gl, bidl);
            KAP ap = KARGS();
            EpiProj E{(bf16_t*)(WSP() + WS_Q), (bf16_t*)(WSP() + WS_KAB), (bf16_t*)(WSP() + WS_KC), (bf16_t*)(WSP() + WS_VTAB), (bf16_t*)(WSP() + WS_VTC), (bf16_t*)(WSP() + WS_PG),
                      (const float*)(WSP() + WS_ROPE), ap->in[10] + l * 64, ap->in[11] + l * 64};
            pg8::gemm_phase<EpiProj, pg8::StaticOrder, true, true>(lds, g, S, E, wave);
        }
        GRID_BAR(); TSTAMP(2);
        {
            KAP ap = KARGS();
            const int nctx = last ? 0 : 36, nc2 = last ? 0 : 16, nunit = nctx + 1152 + nc2;
            unsigned* ctr = CTL() + 64 * l;
            unsigned* cdone = CTL() + 128 + 64 * l;
            for (;;) {
                if (LEADER()) MISC[24] = atomicAdd(ctr, 1u);
                __syncthreads();
                const int uid = (int)MISC[24];
                __syncthreads();
                if (uid >= nunit) break;
                if (uid < nctx) {
                    attn_dispatch(ap, l, 1152 + uid, wave, (char*)lds_raw);
                    asm volatile("s_waitcnt vmcnt(0)" ::: "memory"); __syncthreads();
                    if (LEADER()) { __threadfence(); asm volatile("s_waitcnt vmcnt(0)" ::: "memory"); __hip_atomic_fetch_add(cdone, 1u, __ATOMIC_RELAXED, __HIP_MEMORY_SCOPE_AGENT); }
                } else if (uid < nctx + 384 || uid >= nctx + 384 + nc2) {
                    attn_dispatch(ap, l, uid < nctx + 384 ? uid - nctx : uid - nctx - nc2, wave, (char*)lds_raw);
                } else if (uid >= nctx + 384 + 8) {
                    const int v = uid - nctx - 384 - 8;
                    if (LEADER()) { unsigned sp = 0; while (__hip_atomic_load(cdone + 16, __ATOMIC_RELAXED, __HIP_MEMORY_SCOPE_AGENT) < 8u && ++sp < (1u << 20)) __builtin_amdgcn_s_sleep(16); }
                    __syncthreads();
                    __threadfence(); asm volatile("s_waitcnt vmcnt(0)" ::: "memory");
                    __syncthreads();
                    pg8::Gemm g{(const bf16_t*)(WSP() + WS_PG), (const bf16_t*)(WSP() + WS_WOUT), MALL, DM, DM, 3072, DM, 0, 0};
                    OneUnit S{64 + (v >> 2), v & 3};
                    EpiBf16<0> E{(bf16_t*)(WSP() + WS_Y), DM};
                    pg8::gemm_phase<EpiBf16<0>, OneUnit, true, true>(lds, g, S, E, wave);
                } else {
                    const int v = uid - nctx - 384;
                    if (LEADER()) { unsigned sp = 0; while (__hip_atomic_load(cdone, __ATOMIC_RELAXED, __HIP_MEMORY_SCOPE_AGENT) < 36u && ++sp < (1u << 20)) __builtin_amdgcn_s_sleep(16); }
                    __syncthreads();
                    __threadfence(); asm volatile("s_waitcnt vmcnt(0)" ::: "memory");
                    __syncthreads();
                    pg8::Gemm g{(const bf16_t*)(WSP() + WS_Q), (const bf16_t*)(WSP() + WS_WBR), MALL, DM, QW, QW, QW, 0, 0};
                    OneUnit S{64 + (v >> 2), v & 3};
                    EpiGateSum E{(bf16_t*)(WSP() + WS_PG)};
                    pg8::gemm_phase<EpiGateSum, OneUnit, true, true, 6>(lds, g, S, E, wave);
                    asm volatile("s_waitcnt vmcnt(0)" ::: "memory"); __syncthreads();
                    if (LEADER()) { __threadfence(); asm volatile("s_waitcnt vmcnt(0)" ::: "memory"); __hip_atomic_fetch_add(cdone + 16, 1u, __ATOMIC_RELAXED, __HIP_MEMORY_SCOPE_AGENT); }
                }
            }
        }
        GRID_BAR(); TSTAMP(4);
        {
            pg8::Gemm g{(const bf16_t*)(WSP() + WS_Q), (const bf16_t*)(WSP() + WS_WBR), MLAT, DM, QW, QW, QW, 0, 0};
            pg8::StaticOrder S; S.init(MLAT, DM, Gl, bidl);
            EpiGateSum E{(bf16_t*)(WSP() + WS_PG)};
            pg8::gemm_phase<EpiGateSum, pg8::StaticOrder, true, true, 6>(lds, g, S, E, wave);
        }
        GRID_BAR(); TSTAMP(5);
        {
            pg8::Gemm g{(const bf16_t*)(WSP() + WS_PG), (const bf16_t*)(WSP() + WS_WOUT), MLAT, DM, DM, 3072, DM, 0, 0};
            pg8::StaticOrder S; S.init(MLAT, DM, Gl, bidl);
            EpiBf16<0> E{(bf16_t*)(WSP() + WS_Y), DM};
            pg8::gemm_phase<EpiBf16<0>, pg8::StaticOrder, true, true>(lds, g, S, E, wave);
        }
        GRID_BAR(); TSTAMP(6);
        { KAP ap = KARGS();
          row_phase(gw, NGW, LANE(), MX, (const bf16_t*)(WSP() + WS_Y), ap->in[7] + l * DM, MODL(), 2048,
                  l == 0 ? ap->in[0] : ap->out, l == 0 ? ap->in[2] : (const float*)(WSP() + WS_XC), ap->out, (float*)(WSP() + WS_XC),
                  (bf16_t*)(WSP() + WS_Q), ap->in[17] + l * DM, MODL(), 3072, 4096); }
        GRID_BAR(); TSTAMP(7);
        {
            pg8::Gemm g{(const bf16_t*)(WSP() + WS_Q), (const bf16_t*)(WSP() + WS_W1), MX, FF, DM, DM, DM, 0, 0};
            pg8::StaticOrder S; S.init(MX, FF, Gl, bidl);
            EpiBf16<1> E{(bf16_t*)(WSP() + WS_A), FF};
            pg8::gemm_phase<EpiBf16<1>, pg8::StaticOrder, true, true>(lds, g, S, E, wave);
        }
        GRID_BAR(); TSTAMP(8);
        {
            pg8::Gemm g{(const bf16_t*)(WSP() + WS_A), (const bf16_t*)(WSP() + WS_W2), MX, DM, FF, FF, FF, 0, 0};
            pg8::StaticOrder S; S.init(MX, DM, Gl, bidl);
            EpiBf16<0> E{(bf16_t*)(WSP() + WS_Y2), DM};
            pg8::gemm_phase<EpiBf16<0>, pg8::StaticOrder, true, true>(lds, g, S, E, wave);
        }
        GRID_BAR(); TSTAMP(9);
        if (!last) {
            { KAP ap = KARGS();
              row_phase(gw, NGW, LANE(), MX, (const bf16_t*)(WSP() + WS_Y2), ap->in[18] + l * DM, MODL(), 5120,
                      ap->out, (const float*)(WSP() + WS_XC), ap->out, (float*)(WSP() + WS_XC),
                      (bf16_t*)(WSP() + WS_R1), ap->in[6] + (l + 1) * DM, MODL() + 3 * 6144, 0, 1024); }
            conv_weights(KARGS(), l + 1, (LAS unsigned char*)lds_raw, gw, NGW, wave, LANE());
            GRID_BAR(); TSTAMP(10);
        } else {
            { KAP ap = KARGS();
              row_phase(gw, NGW, LANE(), MX, (const bf16_t*)(WSP() + WS_Y2), ap->in[18] + l * DM, MODL(), 5120,
                      ap->out, (const float*)(WSP() + WS_XC), ap->out, (float*)(WSP() + WS_XC),
                      nullptr, nullptr, nullptr, 0, 0); }
            TSTAMP(10);
        }
    }
#if PROBE_MASK
    if (blockIdx.x == 0 && LEADER()) {
        const unsigned long long t0 = __builtin_amdgcn_s_memrealtime(); const unsigned long long ac = ((unsigned long long)MISC[17] << 32) | MISC[16];
        while (__builtin_amdgcn_s_memrealtime() - t0 < 4ull * ac) __builtin_amdgcn_s_sleep(32);
    }
#endif
}

extern "C" void kernel_launch(void* const* d_in, const int* in_sizes, int n_in, void* d_out, int out_size, void* d_ws, size_t ws_size, hipStream_t stream) {
    static int grid = 0;
    if (grid == 0) {
        if (n_in != 21 || out_size != MLAT * DM || ws_size < WS_END) { fprintf(stderr, "kernel_launch: unexpected shapes (n_in %d, out %d, ws %zu need %zu)\n", n_in, out_size, ws_size, (size_t)WS_END); grid = -1; return; }
        int dev = 0, cus = 0, per_cu = 0;
        if (hipGetDevice(&dev) != hipSuccess || hipDeviceGetAttribute(&cus, hipDeviceAttributeMultiprocessorCount, dev) != hipSuccess) { grid = -1; return; }
        if (hipFuncSetAttribute((const void*)fwd_mega, hipFuncAttributeMaxDynamicSharedMemorySize, LDS_BYTES) != hipSuccess) { fprintf(stderr, "kernel_launch: hipFuncSetAttribute failed\n"); grid = -1; return; }
        if (hipOccupancyMaxActiveBlocksPerMultiprocessor(&per_cu, (const void*)fwd_mega, 512, LDS_BYTES) != hipSuccess || per_cu < 1) { fprintf(stderr, "kernel_launch: occupancy query says %d blocks per CU\n", per_cu); grid = -1; return; }
        grid = cus;
    }
    if (grid < 0) return;
    (void)hipMemsetAsync((char*)d_ws + WS_CTL, 0, CTL_ZERO_BYTES, stream);
    Args a{};
    for (int i = 0; i < 21; ++i) a.in[i] = (const float*)d_in[i];
    a.out = (float*)d_out; a.ws = (unsigned char*)d_ws;
    void* args[] = {&a};
    hipError_t e = hipLaunchCooperativeKernel((const void*)fwd_mega, dim3(grid), dim3(512), args, LDS_BYTES, stream);
    if (e != hipSuccess) fprintf(stderr, "cooperative launch failed: %s (grid %d)\n", hipGetErrorString(e), grid);
}
```
